# Optimizing an MI355X kernel written in HIP

```python
import math
import jax, jax.numpy as jnp
from jax import lax
import numpy as np

D_MODEL = 1024
BATCH = 8
SEQ = 4096
DEPTH = 2

HEAD_DIM = 64
MIX_WIDTH = D_MODEL
N_GROUPS = 4
GROUP_WIDTH = MIX_WIDTH // N_GROUPS
HEADS_PER_GROUP = GROUP_WIDTH // HEAD_DIM
FOX_HEADS = HEADS_PER_GROUP
MOBA_HEADS = HEADS_PER_GROUP
SB_HEADS = HEADS_PER_GROUP
SWA_HEADS = HEADS_PER_GROUP
SWA_KV_HEADS = SWA_HEADS // 2
SWA_KV_WIDTH = SWA_KV_HEADS * HEAD_DIM
QUERY_BLOCK = 128
MOBA_BLOCK = 256
MOBA_TOPK = 3
MOBA_QUERY_CHUNK = 32
SWA_WINDOW = 128
NUM_BUCKETS = 32
REL_MAX_DISTANCE = 1024
RMS_EPS = 1e-6
FORGET_BIAS_INIT = 2.0
NEG_INF = -1e30
ATTN_SCALE = HEAD_DIM ** -0.5
SPLIT_SIZES = (
    GROUP_WIDTH, GROUP_WIDTH, GROUP_WIDTH, FOX_HEADS, GROUP_WIDTH,
    GROUP_WIDTH, GROUP_WIDTH, GROUP_WIDTH, GROUP_WIDTH,
    GROUP_WIDTH, GROUP_WIDTH, GROUP_WIDTH, GROUP_WIDTH,
    GROUP_WIDTH, SWA_KV_WIDTH, SWA_KV_WIDTH, GROUP_WIDTH,
)
IN_WIDTH = sum(SPLIT_SIZES)

kernel_name = 'hybrid_fox_moba_stickbreak_swa_block'


def rms_norm(x, gain):
    xf = x.astype(jnp.float32)
    y = xf * lax.rsqrt(jnp.mean(xf * xf, axis=-1, keepdims=True) + RMS_EPS)
    return (y * gain.astype(jnp.float32)).astype(x.dtype)


def split_columns(proj):
    parts, off = [], 0
    for w in SPLIT_SIZES:
        parts.append(proj[..., off:off + w])
        off += w
    return parts


def to_heads(t, n):
    b, s, _ = t.shape
    return t.reshape(b, s, n, HEAD_DIM).transpose(0, 2, 1, 3)


def from_heads(o):
    b, h, s, d = o.shape
    return o.transpose(0, 2, 1, 3).reshape(b, s, h * d)


def unblock(out):
    nb, b, h, qb, d = out.shape
    return out.transpose(1, 2, 0, 3, 4).reshape(b, h, nb * qb, d)


def rel_bucket(dist):
    max_exact = NUM_BUCKETS // 2
    d = jnp.maximum(dist, 0)
    log_ratio = jnp.log(jnp.maximum(d, 1).astype(jnp.float32) / max_exact) / math.log(REL_MAX_DISTANCE / max_exact)
    large = max_exact + (log_ratio * (NUM_BUCKETS - max_exact)).astype(jnp.int32)
    large = jnp.minimum(large, NUM_BUCKETS - 1)
    return jnp.where(d < max_exact, d, large)


def forgetting_attention(q, k, v, log_f):
    b, h, t_len, d = q.shape
    c = jnp.cumsum(log_f, axis=-1)
    pos = jnp.arange(t_len)

    def block(i):
        start = i * QUERY_BLOCK
        q_i = lax.dynamic_slice_in_dim(q, start, QUERY_BLOCK, axis=2)
        c_i = lax.dynamic_slice_in_dim(c, start, QUERY_BLOCK, axis=2)
        t = start + jnp.arange(QUERY_BLOCK)
        s = jnp.einsum('bhqd,bhkd->bhqk', q_i, k).astype(jnp.float32) * ATTN_SCALE
        s = s + c_i[..., :, None] - c[..., None, :]
        s = jnp.where(t[:, None] >= pos[None, :], s, NEG_INF)
        p = jax.nn.softmax(s, axis=-1).astype(v.dtype)
        return jnp.einsum('bhqk,bhkd->bhqd', p, v)

    return unblock(lax.map(block, jnp.arange(t_len // QUERY_BLOCK)))


def moba_attention(q, k, v, rel_bias_h):
    b, h, t_len, d = q.shape
    t_pad = -(-t_len // MOBA_BLOCK) * MOBA_BLOCK
    if t_pad != t_len:
        padw = ((0, 0), (0, 0), (0, t_pad - t_len), (0, 0))
        q, k, v = jnp.pad(q, padw), jnp.pad(k, padw), jnp.pad(v, padw)
    nblk = t_pad // MOBA_BLOCK
    k_eff = min(MOBA_TOPK, nblk)
    k_blocks = k.reshape(b, h, nblk, MOBA_BLOCK, d)
    v_blocks = v.reshape(b, h, nblk, MOBA_BLOCK, d)
    k_mean = jnp.mean(k_blocks.astype(jnp.float32), axis=3)
    gate = jnp.einsum('bhtd,bhnd->bhtn', q.astype(jnp.float32), k_mean)
    q_blk = jnp.arange(t_pad) // MOBA_BLOCK
    past = jnp.arange(nblk)[None, :] < q_blk[:, None]
    gate = jnp.where(past, gate, NEG_INF)
    _, sel = lax.top_k(gate, k_eff)
    n_valid = jnp.minimum(q_blk, k_eff)
    sel_valid = jnp.arange(k_eff)[None, :] < n_valid[:, None]
    b_idx = jnp.arange(b)[:, None, None, None]
    h_idx = jnp.arange(h)[None, :, None, None]
    h_idx5 = h_idx[..., None]
    blk_off = jnp.arange(MOBA_BLOCK)

    def chunk(ci):
        start = ci * MOBA_QUERY_CHUNK
        q_c = lax.dynamic_slice_in_dim(q, start, MOBA_QUERY_CHUNK, axis=2)
        sel_c = lax.dynamic_slice_in_dim(sel, start, MOBA_QUERY_CHUNK, axis=2)
        valid_c = lax.dynamic_slice_in_dim(sel_valid, start, MOBA_QUERY_CHUNK, axis=0)
        t = start + jnp.arange(MOBA_QUERY_CHUNK)
        k_sel = k_blocks[b_idx, h_idx, sel_c]
        v_sel = v_blocks[b_idx, h_idx, sel_c]
        s_sel = jnp.einsum('bhqd,bhqnkd->bhqnk', q_c, k_sel).astype(jnp.float32) * ATTN_SCALE
        key_pos = sel_c[..., None] * MOBA_BLOCK + blk_off
        dist = t[None, None, :, None, None] - key_pos
        s_sel = s_sel + rel_bias_h[h_idx5, rel_bucket(dist)].astype(jnp.float32)
        s_sel = jnp.where(valid_c[None, None, :, :, None], s_sel, NEG_INF)
        own_start = (start // MOBA_BLOCK) * MOBA_BLOCK
        k_own = lax.dynamic_slice_in_dim(k, own_start, MOBA_BLOCK, axis=2)
        v_own = lax.dynamic_slice_in_dim(v, own_start, MOBA_BLOCK, axis=2)
        s_own = jnp.einsum('bhqd,bhkd->bhqk', q_c, k_own).astype(jnp.float32) * ATTN_SCALE
        dist_own = t[:, None] - (own_start + blk_off)[None, :]
        s_own = s_own + rel_bias_h[:, rel_bucket(dist_own)][None].astype(jnp.float32)
        s_own = jnp.where(dist_own >= 0, s_own, NEG_INF)
        n_sel = k_eff * MOBA_BLOCK
        s_all = jnp.concatenate([s_sel.reshape(b, h, MOBA_QUERY_CHUNK, n_sel), s_own], axis=-1)
        p = jax.nn.softmax(s_all, axis=-1).astype(v.dtype)
        p_sel = p[..., :n_sel].reshape(b, h, MOBA_QUERY_CHUNK, k_eff, MOBA_BLOCK)
        p_own = p[..., n_sel:]
        return (jnp.einsum('bhqnk,bhqnkd->bhqd', p_sel, v_sel)
                + jnp.einsum('bhqk,bhkd->bhqd', p_own, v_own))

    out = unblock(lax.map(chunk, jnp.arange(t_pad // MOBA_QUERY_CHUNK)))
    return out[:, :, :t_len]


def stick_breaking_attention(q, k, v):
    b, h, t_len, d = q.shape
    pos = jnp.arange(t_len)

    def block(i):
        start = i * QUERY_BLOCK
        q_i = lax.dynamic_slice_in_dim(q, start, QUERY_BLOCK, axis=2)
        t = start + jnp.arange(QUERY_BLOCK)
        z = jnp.einsum('bhqd,bhkd->bhqk', q_i, k).astype(jnp.float32) * ATTN_SCALE
        strict = pos[None, :] < t[:, None]
        log_keep = jnp.where(strict, jax.nn.log_sigmoid(-z), 0.0)
        suffix = lax.cumsum(log_keep, axis=3, reverse=True) - log_keep
        a = jnp.where(strict, jnp.exp(jax.nn.log_sigmoid(z) + suffix), 0.0)
        return jnp.einsum('bhqk,bhkd->bhqd', a.astype(v.dtype), v)

    return unblock(lax.map(block, jnp.arange(t_len // QUERY_BLOCK)))


def swa_sink_attention(q, k, v, sinks, rel_bias_h):
    b, h, t_len, d = q.shape
    hkv = k.shape[1]
    g = h // hkv
    w = SWA_WINDOW
    nb = t_len // w
    qb = q.reshape(b, hkv, g, nb, w, d)

    def band(a):
        ab = a.reshape(b, hkv, nb, w, d)
        prev = jnp.pad(ab, ((0, 0), (0, 0), (1, 0), (0, 0), (0, 0)))[:, :, :-1]
        return jnp.concatenate([prev, ab], axis=3)

    kb, vb = band(k), band(v)
    s = jnp.einsum('bkgnqd,bknsd->bkgnqs', qb, kb).astype(jnp.float32) * ATTN_SCALE
    qi = jnp.arange(w)
    kj = jnp.arange(2 * w)
    dist = qi[:, None] + w - kj[None, :]
    bias = rel_bias_h[:, rel_bucket(dist)].astype(jnp.float32).reshape(hkv, g, 1, w, 2 * w)
    key_pos = jnp.arange(nb)[:, None] * w - w + kj[None, :]
    allowed = ((dist >= 0) & (dist < w))[None] & (key_pos >= 0)[:, None, :]
    s = jnp.where(allowed, s + bias, NEG_INF)
    sink = jnp.broadcast_to(sinks.astype(jnp.float32).reshape(1, hkv, g, 1, 1, 1), s.shape[:-1] + (1,))
    p = jax.nn.softmax(jnp.concatenate([s, sink], axis=-1), axis=-1)[..., :-1]
    o = jnp.einsum('bkgnqs,bknsd->bkgnqd', p.astype(v.dtype), vb)
    return o.reshape(b, h, t_len, d)


def hybrid_layer(x, norm_gain, w_in, b_forget, fox_qk_gain, moba_qk_gain, swa_qk_gain, sinks, w_out, rel_bias):
    hn = rms_norm(x, norm_gain)
    proj = jnp.einsum('btd,de->bte', hn, w_in)
    (fq, fk, fv, ff, fg, mq, mk, mv, mg, sq, sk, sv, sg, wq, wk, wv, wg) = split_columns(proj)
    log_f = jax.nn.log_sigmoid((ff + b_forget).astype(jnp.float32)).transpose(0, 2, 1)
    o_fox = forgetting_attention(rms_norm(to_heads(fq, FOX_HEADS), fox_qk_gain[0]),
                                 rms_norm(to_heads(fk, FOX_HEADS), fox_qk_gain[1]),
                                 to_heads(fv, FOX_HEADS), log_f)
    o_moba = moba_attention(rms_norm(to_heads(mq, MOBA_HEADS), moba_qk_gain[0]),
                            rms_norm(to_heads(mk, MOBA_HEADS), moba_qk_gain[1]),
                            to_heads(mv, MOBA_HEADS), rel_bias[:, :MOBA_HEADS].T)
    o_sb = stick_breaking_attention(to_heads(sq, SB_HEADS), to_heads(sk, SB_HEADS), to_heads(sv, SB_HEADS))
    o_swa = swa_sink_attention(rms_norm(to_heads(wq, SWA_HEADS), swa_qk_gain[0]),
                               rms_norm(to_heads(wk, SWA_KV_HEADS), swa_qk_gain[1]),
                               to_heads(wv, SWA_KV_HEADS), sinks, rel_bias[:, MOBA_HEADS:].T)
    y = jnp.concatenate([from_heads(o_fox) * jax.nn.silu(fg),
                         from_heads(o_moba) * jax.nn.silu(mg),
                         from_heads(o_sb) * jax.nn.silu(sg),
                         from_heads(o_swa) * jax.nn.silu(wg)], axis=-1)
    return x + jnp.einsum('bte,ed->btd', y, w_out)


def setup_inputs(seed: int = 0) -> dict:
    key = jax.random.key(seed)
    ks = jax.random.split(key, 10)
    x = jax.random.normal(ks[0], (BATCH, SEQ, D_MODEL), jnp.float32)
    norm_gain = 1.0 + 0.02 * jax.random.normal(ks[1], (DEPTH, D_MODEL), jnp.float32)
    w_in = jax.random.normal(ks[2], (DEPTH, D_MODEL, IN_WIDTH), jnp.float32) * D_MODEL ** -0.5
    b_forget = FORGET_BIAS_INIT + 0.1 * jax.random.normal(ks[3], (DEPTH, FOX_HEADS), jnp.float32)
    fox_qk_gain = 1.0 + 0.02 * jax.random.normal(ks[4], (DEPTH, 2, HEAD_DIM), jnp.float32)
    moba_qk_gain = 1.0 + 0.02 * jax.random.normal(ks[5], (DEPTH, 2, HEAD_DIM), jnp.float32)
    swa_qk_gain = 1.0 + 0.02 * jax.random.normal(ks[6], (DEPTH, 2, HEAD_DIM), jnp.float32)
    sinks = 0.5 * jax.random.normal(ks[7], (DEPTH, SWA_HEADS), jnp.float32)
    w_out = jax.random.normal(ks[8], (DEPTH, MIX_WIDTH, D_MODEL), jnp.float32) * MIX_WIDTH ** -0.5
    rel_bias = 0.1 * jax.random.normal(ks[9], (NUM_BUCKETS, MOBA_HEADS + SWA_HEADS), jnp.float32)
    return {'x': x, 'norm_gain': norm_gain, 'w_in': w_in, 'b_forget': b_forget,
            'fox_qk_gain': fox_qk_gain, 'moba_qk_gain': moba_qk_gain, 'swa_qk_gain': swa_qk_gain,
            'sinks': sinks, 'w_out': w_out, 'rel_bias': rel_bias}


def reference(x, norm_gain, w_in, b_forget, fox_qk_gain, moba_qk_gain, swa_qk_gain, sinks, w_out, rel_bias):
    for layer in range(DEPTH):
        x = hybrid_layer(x, norm_gain[layer], w_in[layer], b_forget[layer], fox_qk_gain[layer],
                         moba_qk_gain[layer], swa_qk_gain[layer], sinks[layer], w_out[layer], rel_bias)
    return x
```

```cpp
#include <hip/hip_runtime.h>
#include <cstdio>
#include <cstdint>
#include <cmath>
namespace pg8 {
#define PG8_LAS __attribute__((address_space(3)))
typedef unsigned short bf16_t;
typedef short bf16x8 __attribute__((ext_vector_type(8)));
typedef float f32x4 __attribute__((ext_vector_type(4)));
typedef unsigned u32x4 __attribute__((ext_vector_type(4)));
constexpr int BM = 256, BK = 64, HALF = 128, HTB = HALF * BK * 2  , STAGE_BYTES = 8 * HTB, NXCD = 8, WGM = 8;

__host__ __device__ __forceinline__ int lds_byte(int r, int c) { const int st = (r >> 4) * 2 + (c >> 5), rr = r & 15, cc = c & 31, ob = rr * 64 + cc * 2; return st * 1024 + (ob ^ (((ob >> 9) & 1) << 5)); }
__host__ __device__ __forceinline__ void stage_rc(int b, int& R, int& C) { const int st = b / 1024, sb = b % 1024, swz = sb ^ (((sb >> 9) & 1) << 5); R = (st >> 1) * 16 + swz / 64; C = (st & 1) * 32 + (swz % 64) / 2; }
__host__ __device__ __forceinline__ int perm32(int rho) { const int n = rho >> 4, i = rho & 15; return 8 * (i >> 2) + 4 * n + (i & 3); }

struct Unit { int pm, pn; };
struct Gemm { const bf16_t* A; const bf16_t* Bt; int M, N, K; };

struct StaticOrder {
    int nM, nN, nwg, G, c;
    __host__ __device__ void init(int M, int N, int G_, int c_) { nM = M / BM; nN = N / BM; nwg = nM * nN; G = G_; c = c_; }
    __host__ __device__ bool next(int i, Unit& u) const {
        const long L = (long)i * G + c; if (L >= nwg) return false;
        int wgid = (int)L; { const int q = nwg / NXCD, r = nwg % NXCD, xcd = wgid % NXCD, off = wgid / NXCD; wgid = (xcd < r ? xcd * (q + 1) : r * (q + 1) + (xcd - r) * q) + off; }
        const int nig = WGM * nN, gid = wgid / nig, fm = gid * WGM, gsz = (nM - fm) < WGM ? (nM - fm) : WGM;
        u.pm = fm + ((wgid % nig) % gsz); u.pn = (wgid % nig) / gsz; return true;
    }
    __device__ __forceinline__ void a_ready(const Unit&) const {}
    __device__ __forceinline__ void done(const Unit&) const {}
};

__device__ __forceinline__ unsigned cvt_pk_bf16(float lo, float hi) { unsigned r; asm volatile("v_cvt_pk_bf16_f32 %0, %1, %2" : "=v"(r) : "v"(lo), "v"(hi)); return r; }
typedef float f32x2 __attribute__((ext_vector_type(2)));
constexpr float C2 = 0.125f * 1.4426950408889634f;
constexpr float RMS_EPS = 1e-6f;
constexpr size_t GS = (size_t)8 * 4 * 4096 * 64;
struct EpiIn {
    static constexpr bool PERM = true, AFTER_DRAIN = false;
    bf16_t *Q, *K, *V, *G; const float *gfox, *gmoba, *gswa;
    __device__ __forceinline__ void operator()(const f32x4 (&acc)[2][2][4][2], const Unit& u, int wr, int wc, int fr, int fq) const {
        const int T = u.pn;
        const int b = (u.pm * BM) >> 12, t0 = ((u.pm * BM) & 4095) + wr * 64 + fr;
        int mode = 1, nh = 4, head = wc; float scale = 1.f; const float* gain = nullptr; bf16_t* base = nullptr;
        switch (T) {
            case 0: mode = 0; gain = gfox; scale = C2; base = Q; break;
            case 1: mode = 0; gain = gfox + 64; base = K; break;
            case 2: base = V; break;
            case 4: mode = 0; gain = gmoba; scale = C2; base = Q + GS; break;
            case 5: mode = 0; gain = gmoba + 64; base = K + GS; break;
            case 6: base = V + GS; break;
            case 8: scale = C2; base = Q + 2 * GS; break;
            case 9: base = K + 2 * GS; break;
            case 10: base = V + 2 * GS; break;
            case 12: mode = 0; gain = gswa; scale = C2; base = Q + 3 * GS; break;
            case 13: nh = 2; if (wc < 2) { mode = 0; gain = gswa + 64; base = K + 3 * GS; } else { base = V + 3 * GS; head = wc - 2; } break;
            default: mode = 2; break;
        }
        if (mode == 2) {
            bf16_t* gp = G + (size_t)(u.pm * BM + wr * 64 + fr) * 1024 + (T >> 2) * 256 + 64 * wc + 8 * fq;
#pragma unroll
            for (int ai = 0; ai < 2; ++ai)
#pragma unroll
                for (int m = 0; m < 4; ++m)
#pragma unroll
                    for (int bj = 0; bj < 2; ++bj) {
                        f32x4 v0 = acc[ai][bj][m][0], v1 = acc[ai][bj][m][1];
#pragma unroll
                        for (int j = 0; j < 4; ++j) { v0[j] = v0[j] / (1.f + __expf(-v0[j])); v1[j] = v1[j] / (1.f + __expf(-v1[j])); }
                        u32x4 w; w.x = cvt_pk_bf16(v0[0], v0[1]); w.y = cvt_pk_bf16(v0[2], v0[3]); w.z = cvt_pk_bf16(v1[0], v1[1]); w.w = cvt_pk_bf16(v1[2], v1[3]);
                        *(u32x4*)(gp + (size_t)(ai * HALF + m * 16) * 1024 + 32 * bj) = w;
                    }
            return;
        }
        f32x4 gv[2][2];
#pragma unroll
        for (int bj = 0; bj < 2; ++bj)
#pragma unroll
            for (int n = 0; n < 2; ++n) gv[bj][n] = (mode == 0) ? *(const f32x4*)(gain + 32 * bj + 8 * fq + 4 * n) : (f32x4){1.f, 1.f, 1.f, 1.f};
        bf16_t* dp = base + ((size_t)(b * nh + head) * 4096 + t0) * 64 + 8 * fq;
#pragma unroll
        for (int ai = 0; ai < 2; ++ai)
#pragma unroll
            for (int m = 0; m < 4; ++m) {
                float r = scale;
                if (mode == 0) {
                    float ss = 0.f;
#pragma unroll
                    for (int bj = 0; bj < 2; ++bj)
#pragma unroll
                        for (int n = 0; n < 2; ++n) { const f32x4 x = acc[ai][bj][m][n]; ss += (x[0] * x[0] + x[1] * x[1]) + (x[2] * x[2] + x[3] * x[3]); }
                    ss += __shfl_xor(ss, 16); ss += __shfl_xor(ss, 32);
                    r = scale / sqrtf(ss * (1.0f / 64.0f) + RMS_EPS);
                }
#pragma unroll
                for (int bj = 0; bj < 2; ++bj) {
                    const f32x4 v0 = acc[ai][bj][m][0] * gv[bj][0] * r, v1 = acc[ai][bj][m][1] * gv[bj][1] * r;
                    u32x4 w; w.x = cvt_pk_bf16(v0[0], v0[1]); w.y = cvt_pk_bf16(v0[2], v0[3]); w.z = cvt_pk_bf16(v1[0], v1[1]); w.w = cvt_pk_bf16(v1[2], v1[3]);
                    *(u32x4*)(dp + (size_t)(ai * HALF + m * 16) * 64 + 32 * bj) = w;
                }
            }
    }
};
struct EpiRes {
    static constexpr bool PERM = false, AFTER_DRAIN = false;
    const float* base; float* out;
    __device__ __forceinline__ void operator()(const f32x4 (&acc)[2][2][4][2], const Unit& u, int wr, int wc, int fr, int fq) const {
        const int col0 = u.pn * BM + wc * 32 + 4 * fq;
#pragma unroll
        for (int ai = 0; ai < 2; ++ai)
#pragma unroll
            for (int m = 0; m < 4; ++m) {
                const size_t off = (size_t)(u.pm * BM + ai * HALF + wr * 64 + m * 16 + fr) * 1024 + col0;
#pragma unroll
                for (int bj = 0; bj < 2; ++bj)
#pragma unroll
                    for (int n = 0; n < 2; ++n) { const f32x4 bs = *(const f32x4*)(base + off + bj * HALF + n * 16); *(f32x4*)(out + off + bj * HALF + n * 16) = bs + acc[ai][bj][m][n]; }
            }
    }
};

template <class Epi, class Sched, bool ALIGN_EPI = false, bool SP2 = false>
__device__ __forceinline__ void gemm_phase(PG8_LAS unsigned char* lds, const Gemm g, const Sched& S, const Epi& E) {
    const int tid = threadIdx.x, wid = __builtin_amdgcn_readfirstlane(tid >> 6), lane = tid & 63, wr = wid >> 2, wc = wid & 3, fr = lane & 15, fq = lane >> 4;
    const int K = g.K, nt = K / BK;
    unsigned voffA[2], voffB[2];
#pragma unroll
    for (int i = 0; i < 2; ++i) { int R, C; stage_rc(tid * 16 + i * 8192, R, C); const int Rb = Epi::PERM ? ((R & ~31) + perm32(R & 31)) : R;
        voffA[i] = (unsigned)(R * K + C) * 2u; voffB[i] = (unsigned)(Rb * K + C) * 2u; }
    const size_t kstep = (size_t)(BK * 2);
    const size_t hstep = (size_t)HALF * K * 2;
    const size_t tstep = 2 * hstep;
    const unsigned ldsw = (unsigned)wid * 1024u;
    const int aoff = lds_byte(wr * 64 + fr, fq * 8), boff = lds_byte(wc * 32 + fr, fq * 8);
#define PG8_SA(b, h) (((b) * 2 + (h)) * HTB)
#define PG8_SB(b, h) ((4 + (b) * 2 + (h)) * HTB)
#define PG8_STAGE(bufoff, gbase, voff) do { _Pragma("unroll") for (int _i = 0; _i < 2; ++_i) \
        __builtin_amdgcn_global_load_lds((const unsigned*)((const char*)(gbase) + (voff)[_i]), (PG8_LAS unsigned*)(lds + (bufoff) + ldsw + _i * 8192), 16, 0, 0); } while (0)
#define PG8_LDA(dst, b, h) do { _Pragma("unroll") for (int m = 0; m < 4; ++m) _Pragma("unroll") for (int k = 0; k < 2; ++k) dst[m][k] = *(const PG8_LAS bf16x8*)(lds + PG8_SA(b, h) + aoff + m * 2048 + k * 1024); } while (0)
#define PG8_LDB(dst, b, h) do { _Pragma("unroll") for (int n = 0; n < 2; ++n) _Pragma("unroll") for (int k = 0; k < 2; ++k) dst[n][k] = *(const PG8_LAS bf16x8*)(lds + PG8_SB(b, h) + boff + n * 2048 + k * 1024); } while (0)
#define PG8_MMA(ai, bj, At, Bt) do { __builtin_amdgcn_s_setprio(1); _Pragma("unroll") for (int m = 0; m < 4; ++m) _Pragma("unroll") for (int n = 0; n < 2; ++n) _Pragma("unroll") for (int k = 0; k < 2; ++k) \
        acc[ai][bj][m][n] = __builtin_amdgcn_mfma_f32_16x16x32_bf16(Bt[n][k], At[m][k], acc[ai][bj][m][n], 0, 0, 0); __builtin_amdgcn_s_setprio(0); } while (0)
#define PG8_WAIT_V(n) asm volatile("s_waitcnt vmcnt(" #n ")" ::: "memory")
#define PG8_WAIT_L(n) asm volatile("s_waitcnt lgkmcnt(" #n ")" ::: "memory")
#define PG8_BAR __builtin_amdgcn_s_barrier()
#define PG8_SCHED __builtin_amdgcn_sched_barrier(0)
    Unit cur, nxt; int ui = 0;
    if (!S.next(0, cur)) return;
    f32x4 acc[2][2][4][2];
#pragma unroll
    for (int a = 0; a < 2; ++a)
#pragma unroll
        for (int b = 0; b < 2; ++b)
#pragma unroll
            for (int m = 0; m < 4; ++m)
#pragma unroll
                for (int n = 0; n < 2; ++n) acc[a][b][m][n] = (f32x4){0.f, 0.f, 0.f, 0.f};
    bf16x8 At[4][2], B0[2][2], B1[2][2];
    const char* cA = (const char*)g.A + (size_t)cur.pm * tstep; const char* cB = (const char*)g.Bt + (size_t)cur.pn * tstep;
    S.a_ready(cur);
    if constexpr (SP2) {
        PG8_STAGE(PG8_SB(0, 0), cB, voffB); PG8_STAGE(PG8_SB(0, 1), cB + hstep, voffB); PG8_STAGE(PG8_SA(0, 0), cA, voffA); PG8_STAGE(PG8_SA(0, 1), cA + hstep, voffA);
        if (wr == 1) PG8_BAR;
        PG8_WAIT_V(2); PG8_BAR;
        PG8_STAGE(PG8_SB(1, 0), cB + kstep, voffB); PG8_STAGE(PG8_SA(1, 0), cA + kstep, voffA); PG8_STAGE(PG8_SB(1, 1), cB + hstep + kstep, voffB);
        PG8_WAIT_V(6); PG8_BAR;
    } else {
        PG8_STAGE(PG8_SB(0, 0), cB, voffB); PG8_STAGE(PG8_SA(0, 0), cA, voffA); PG8_STAGE(PG8_SB(0, 1), cB + hstep, voffB); PG8_STAGE(PG8_SA(0, 1), cA + hstep, voffA);
        if (wr == 1) PG8_BAR;
        PG8_WAIT_V(4); PG8_BAR;
        PG8_STAGE(PG8_SB(1, 0), cB + kstep, voffB); PG8_STAGE(PG8_SA(1, 0), cA + kstep, voffA); PG8_STAGE(PG8_SB(1, 1), cB + hstep + kstep, voffB);
        PG8_WAIT_V(6); PG8_BAR;
    }
    for (;;) {
        const bool has_next = S.next(ui + 1, nxt);
        const char* nA = has_next ? (const char*)g.A + (size_t)nxt.pm * tstep : cA; const char* nB = has_next ? (const char*)g.Bt + (size_t)nxt.pn * tstep : cB;
        for (int t = 0; t < nt; t += 2) {
            const bool last = (t == nt - 2);
            const char* a1 = cA + (size_t)(t + 1) * kstep;
            const char* a2 = last ? nA : cA + (size_t)(t + 2) * kstep; const char* b2 = last ? nB : cB + (size_t)(t + 2) * kstep;
            const char* a3 = a2 + kstep; const char* b3 = b2 + kstep;
            if (last && has_next) S.a_ready(nxt);
            if constexpr (SP2) {
            PG8_LDB(B0, 0, 0); PG8_LDB(B1, 0, 1); PG8_SCHED; PG8_LDA(At, 0, 0); PG8_STAGE(PG8_SA(1, 1), a1 + hstep, voffA);
            PG8_WAIT_V(8); PG8_WAIT_L(0); PG8_BAR; PG8_MMA(0, 0, At, B0); PG8_MMA(0, 1, At, B1); PG8_BAR; PG8_SCHED;
            PG8_LDA(At, 0, 1); PG8_STAGE(PG8_SB(0, 0), b2, voffB); PG8_STAGE(PG8_SB(0, 1), b2 + hstep, voffB); PG8_STAGE(PG8_SA(0, 0), a2, voffA);
            PG8_WAIT_V(8); PG8_WAIT_L(0); PG8_BAR; PG8_MMA(1, 0, At, B0); PG8_MMA(1, 1, At, B1); PG8_BAR; PG8_SCHED;
            PG8_LDB(B0, 1, 0); PG8_LDB(B1, 1, 1); PG8_SCHED; PG8_LDA(At, 1, 0); PG8_STAGE(PG8_SA(0, 1), a2 + hstep, voffA);
            PG8_WAIT_V(8); PG8_WAIT_L(0); PG8_BAR; PG8_MMA(0, 0, At, B0); PG8_MMA(0, 1, At, B1); PG8_BAR; PG8_SCHED;
            PG8_LDA(At, 1, 1); PG8_STAGE(PG8_SB(1, 0), b3, voffB); PG8_STAGE(PG8_SB(1, 1), b3 + hstep, voffB); PG8_STAGE(PG8_SA(1, 0), a3, voffA);
            PG8_WAIT_V(8); PG8_WAIT_L(0); PG8_BAR; PG8_MMA(1, 0, At, B0); PG8_MMA(1, 1, At, B1); PG8_BAR; PG8_SCHED;
            } else {
            PG8_LDB(B0, 0, 0); PG8_SCHED; PG8_LDA(At, 0, 0); PG8_STAGE(PG8_SA(1, 1), a1 + hstep, voffA);
            PG8_WAIT_L(8); PG8_BAR; PG8_WAIT_L(0); PG8_MMA(0, 0, At, B0); PG8_BAR; PG8_SCHED;
            PG8_LDB(B1, 0, 1); PG8_STAGE(PG8_SB(0, 0), b2, voffB);
            PG8_BAR; PG8_WAIT_L(0); PG8_MMA(0, 1, At, B1); PG8_BAR;
            PG8_LDA(At, 0, 1); PG8_STAGE(PG8_SA(0, 0), a2, voffA);
            PG8_BAR; PG8_WAIT_L(0); PG8_MMA(1, 0, At, B0); PG8_BAR; PG8_SCHED;
            PG8_STAGE(PG8_SB(0, 1), b2 + hstep, voffB);
            PG8_WAIT_V(6); PG8_BAR; PG8_MMA(1, 1, At, B1); PG8_BAR;
            PG8_LDB(B0, 1, 0); PG8_SCHED; PG8_LDA(At, 1, 0); PG8_STAGE(PG8_SA(0, 1), a2 + hstep, voffA);
            PG8_WAIT_L(8); PG8_BAR; PG8_WAIT_L(0); PG8_MMA(0, 0, At, B0); PG8_BAR; PG8_SCHED;
            PG8_LDB(B1, 1, 1); PG8_STAGE(PG8_SB(1, 0), b3, voffB);
            PG8_BAR; PG8_WAIT_L(0); PG8_MMA(0, 1, At, B1); PG8_BAR;
            PG8_LDA(At, 1, 1); PG8_STAGE(PG8_SA(1, 0), a3, voffA);
            PG8_BAR; PG8_WAIT_L(0); PG8_MMA(1, 0, At, B0); PG8_BAR; PG8_SCHED;
            PG8_STAGE(PG8_SB(1, 1), b3 + hstep, voffB);
            PG8_WAIT_V(6); PG8_BAR; PG8_MMA(1, 1, At, B1); PG8_BAR;
            }
        }
        if constexpr (ALIGN_EPI) { if (wr == 0) PG8_BAR; }
        if constexpr (!Epi::AFTER_DRAIN) { E(acc, cur, wr, wc, fr, fq); S.done(cur); }
        if (!has_next) break;
#pragma unroll
        for (int a = 0; a < 2; ++a)
#pragma unroll
            for (int b = 0; b < 2; ++b)
#pragma unroll
                for (int m = 0; m < 4; ++m)
#pragma unroll
                    for (int n = 0; n < 2; ++n) acc[a][b][m][n] = (f32x4){0.f, 0.f, 0.f, 0.f};
        cur = nxt; cA = nA; cB = nB; ++ui;
        if constexpr (ALIGN_EPI) { if (wr == 1) PG8_BAR; }
    }
    PG8_WAIT_V(0);
    if constexpr (!ALIGN_EPI) { if (wr == 0) PG8_BAR; }
    PG8_BAR;
    if constexpr (Epi::AFTER_DRAIN) { E.fused(acc, cur, wr, wc, fr, fq, lds, wid, lane); S.done(cur); }
#undef PG8_SA
#undef PG8_SB
#undef PG8_STAGE
#undef PG8_LDA
#undef PG8_LDB
#undef PG8_MMA
#undef PG8_WAIT_V
#undef PG8_WAIT_L
#undef PG8_BAR
#undef PG8_SCHED
}
}
constexpr int NB = 8, SEQ = 4096, DM = 1024, NTOK = NB * SEQ, INW = 3844, NPERM = 3840, NLAYER = 2;
constexpr size_t MiB = 1u << 20;
constexpr size_t WS_CTL = 0, CTL_ZERO_BYTES = 1 * MiB;
constexpr size_t WS_WIN = 2 * MiB;
constexpr size_t WS_WOUT = 18 * MiB;
constexpr size_t WS_LC = 22 * MiB;
constexpr size_t WS_CTOT = 22 * MiB + 512 * 1024;
constexpr size_t WS_TAB = 23 * MiB;
constexpr size_t WS_KM = 24 * MiB;
constexpr size_t WS_HN = 32 * MiB;
constexpr size_t WS_Q = 96 * MiB, WS_K = 160 * MiB, WS_V = 216 * MiB, WS_G = 272 * MiB, WS_END = 336 * MiB;
constexpr float LOG2E = 1.4426950408889634f;
constexpr int NWAVES = 8;
constexpr int RING_BYTES = 131072, LDS_BYTES = 147456;

#define GAS __attribute__((address_space(1)))
#define LAS __attribute__((address_space(3)))
typedef unsigned short bf16;
typedef unsigned v4u __attribute__((ext_vector_type(4)));
typedef float f32x4 __attribute__((ext_vector_type(4)));
__device__ __forceinline__ unsigned f2bf(float f) { unsigned u = __builtin_bit_cast(unsigned, f); return (u + 0x7fffu + ((u >> 16) & 1u)) >> 16; }
__device__ __forceinline__ unsigned pk2(float lo, float hi) { return f2bf(lo) | (f2bf(hi) << 16); }
__device__ __forceinline__ float bf2f(unsigned v) { return __uint_as_float(v << 16); }
__device__ __forceinline__ float wave_sum(float v) {
#pragma unroll
    for (int o = 1; o < 64; o <<= 1) v += __shfl_xor(v, o);
    return v;
}
__device__ __forceinline__ int rel_bucket(int d) {
    if (d < 16) return d;
    int b = 16;
    b += (d >= 21); b += (d >= 27); b += (d >= 35); b += (d >= 46); b += (d >= 59); b += (d >= 77); b += (d >= 99); b += (d >= 128);
    b += (d >= 166); b += (d >= 216); b += (d >= 280); b += (d >= 363); b += (d >= 470); b += (d >= 609); b += (d >= 790);
    return b;
}

struct Args { const float* x; const float* norm_gain; const float* w_in; const float* b_forget; const float* fox_g; const float* moba_g; const float* swa_g; const float* sinks; const float* w_out; const float* rel_bias; float* out; unsigned char* ws; int ph_lo, ph_hi; };

struct Frame { LAS unsigned char* lds; int tid, lane, wave, vcu, G; };

__device__ __forceinline__ void transpose_item(const float* W, int ldw, bf16* WT, int dst_row0, int src_col0, LAS float* scr, int kb, int lane) {
    const int k0 = 64 * kb;
#pragma unroll 8
    for (int i = 0; i < 32; ++i) { const int kk = 2 * i + (lane >> 5); scr[kk * 33 + (lane & 31)] = W[(size_t)(k0 + kk) * ldw + src_col0 + (lane & 31)]; }
    asm volatile("s_waitcnt lgkmcnt(0)" ::: "memory");
    const int c = lane & 7;
#pragma unroll
    for (int j = 0; j < 4; ++j) { const int n = (lane >> 3) + 8 * j; const LAS float* s = scr + (8 * c) * 33 + n;
        v4u o; o.x = pk2(s[0 * 33], s[1 * 33]); o.y = pk2(s[2 * 33], s[3 * 33]); o.z = pk2(s[4 * 33], s[5 * 33]); o.w = pk2(s[6 * 33], s[7 * 33]);
        *(v4u*)(WT + (size_t)(dst_row0 + n) * 1024 + k0 + 8 * c) = o; }
    asm volatile("s_waitcnt lgkmcnt(0)" ::: "memory");
}
__device__ __forceinline__ int tile_src(int T, int wc) {
    switch (T) { case 0: return 0 + 64 * wc; case 1: return 256 + 64 * wc; case 2: return 512 + 64 * wc; case 3: return 772 + 64 * wc;
        case 4: return 1028 + 64 * wc; case 5: return 1284 + 64 * wc; case 6: return 1540 + 64 * wc; case 7: return 1796 + 64 * wc;
        case 8: return 2052 + 64 * wc; case 9: return 2308 + 64 * wc; case 10: return 2564 + 64 * wc; case 11: return 2820 + 64 * wc;
        case 12: return 3076 + 64 * wc; case 13: return wc < 2 ? 3332 + 64 * wc : 3460 + 64 * (wc - 2); default: return 3588 + 64 * wc; }
}
__device__ __forceinline__ void p_weights(Frame& F, const Args& a) {
    LAS float* scr = (LAS float*)(F.lds + F.wave * 16384);
    const int gw = F.vcu * NWAVES + F.wave, NGW = F.G * NWAVES;
    bf16* win = (bf16*)(a.ws + WS_WIN); bf16* wout = (bf16*)(a.ws + WS_WOUT);
    constexpr int I_IN = 120 * 16, I_OUT = 32 * 16;
    for (int it = gw; it < 2 * (I_IN + I_OUT); it += NGW) {
        const int layer = it / (I_IN + I_OUT); int r = it % (I_IN + I_OUT);
        if (r < I_IN) { const int kb = r / 120, g = r % 120, T = g >> 3, gg = g & 7, bj = gg >> 2, wc = gg & 3;
            transpose_item(a.w_in + (size_t)layer * DM * INW, INW, win + (size_t)layer * NPERM * DM, 32 * g, tile_src(T, wc) + 32 * bj, scr, kb, F.lane); }
        else { r -= I_IN; const int kb = r / 32, g = r % 32;
            transpose_item(a.w_out + (size_t)layer * DM * DM, DM, wout + (size_t)layer * DM * DM, 32 * g, 32 * g, scr, kb, F.lane); }
    }
    if (F.vcu == 0) { float* tab = (float*)(a.ws + WS_TAB);
        for (int i = F.tid; i < 8 * 1024; i += NWAVES * 64) { const int hc = i >> 10, d = i & 1023; tab[i] = a.rel_bias[rel_bucket(d) * 8 + hc] * LOG2E; } }
}
__device__ __forceinline__ void p_norm(Frame& F, const Args& a, int layer, const float* xin) {
    LAS float* lfs = (LAS float*)F.lds;
    const int chunk = F.vcu, b = chunk >> 5, cidx = chunk & 31, lane = F.lane;
    const float* gain = a.norm_gain + layer * DM; const float* wl = a.w_in + (size_t)layer * DM * INW;
    f32x4 g[4], gw[4][4];
#pragma unroll
    for (int j = 0; j < 4; ++j) { g[j] = *(const f32x4*)(gain + 256 * j + 4 * lane);
#pragma unroll
        for (int i = 0; i < 4; ++i) { gw[j][i] = *(const f32x4*)(wl + (size_t)(256 * j + 4 * lane + i) * INW + 768) * g[j][i]; } }
    f32x4 bfv = *(const f32x4*)(a.b_forget + layer * 4);
    bf16* HN = (bf16*)(a.ws + WS_HN);
    for (int r = 0; r < 16; ++r) {
        const int rl = 16 * F.wave + r; const size_t row = (size_t)128 * chunk + rl;
        const f32x4* xr = (const f32x4*)(xin + row * DM) + lane;
        f32x4 v[4]; float ss = 0.f; f32x4 p = {0.f, 0.f, 0.f, 0.f};
#pragma unroll
        for (int j = 0; j < 4; ++j) { v[j] = xr[64 * j]; ss += (v[j][0] * v[j][0] + v[j][1] * v[j][1]) + (v[j][2] * v[j][2] + v[j][3] * v[j][3]);
#pragma unroll
            for (int i = 0; i < 4; ++i) p += gw[j][i] * v[j][i]; }
        const float rstd = 1.0f / sqrtf(wave_sum(ss) * (1.0f / DM) + pg8::RMS_EPS);
        unsigned long long* o8 = (unsigned long long*)(HN + row * DM) + lane;
#pragma unroll
        for (int j = 0; j < 4; ++j) { const f32x4 y = v[j] * rstd * g[j]; o8[64 * j] = (unsigned long long)pk2(y[0], y[1]) | ((unsigned long long)pk2(y[2], y[3]) << 32); }
#pragma unroll
        for (int h = 0; h < 4; ++h) { const float u = wave_sum(p[h]) * rstd + bfv[h];
            const float sp = fmaxf(-u, 0.f) + log1pf(expf(-fabsf(u)));
            if (lane == 0) lfs[h * 128 + rl] = -sp * LOG2E; }
    }
    __syncthreads();
    if (F.wave < 4) { const int h = F.wave; const float x0 = lfs[h * 128 + 2 * lane], x1 = lfs[h * 128 + 2 * lane + 1]; float s = x0 + x1;
#pragma unroll
        for (int o = 1; o < 64; o <<= 1) { const float t = __shfl_up(s, o); if (lane >= o) s += t; }
        float* LC = (float*)(a.ws + WS_LC) + (size_t)(b * 4 + h) * SEQ + cidx * 128 + 2 * lane; LC[0] = s - x1; LC[1] = s;
        if (lane == 63) ((float*)(a.ws + WS_CTOT))[(b * 4 + h) * 32 + cidx] = s; }
    __syncthreads();
}

__global__ void __launch_bounds__(64) km_kernel(const bf16* Kb, float* KM) {
    const int n = blockIdx.x, bh = blockIdx.y, d = threadIdx.x; const bf16* kp = Kb + ((size_t)bh * SEQ + 256 * n) * 64 + d; float s = 0.f;
    for (int i = 0; i < 256; ++i) s += bf2f(kp[i * 64]);
    KM[((size_t)bh * 16 + n) * 64 + d] = s * (1.0f / 256.0f);
}
struct NArgs { const bf16 *Q, *K, *V, *G; bf16* Y; const float *LC, *CTOT, *TAB, *KM, *sinks; int mode, pad; };
__global__ void __launch_bounds__(64) naive_attn(NArgs a) {
    __shared__ float cb[33];
    const int lane = threadIdx.x, bh = blockIdx.y, b = bh >> 2, h = bh & 3, tw = blockIdx.x * 64, t = tw + lane, mode = a.mode;
    const bf16* Qp = a.Q + ((size_t)bh * SEQ + t) * 64;
    const int kvh = (mode == 3) ? (b * 2 + (h >> 1)) : bh;
    const bf16* Kp = a.K + (size_t)kvh * SEQ * 64; const bf16* Vp = a.V + (size_t)kvh * SEQ * 64;
    float q[64], o[64];
#pragma unroll
    for (int d = 0; d < 64; ++d) { q[d] = bf2f(Qp[d]); o[d] = 0.f; }
    float m = -INFINITY, l = 0.f, ct = 0.f, R = 0.f;
    unsigned selmask = 0u; const int qb = tw >> 8;
    if (mode == 0) { if (lane == 0) { float s = 0.f; for (int c = 0; c < 32; ++c) { cb[c] = s; s += a.CTOT[bh * 32 + c]; } } __syncthreads(); ct = cb[t >> 7] + a.LC[(size_t)bh * SEQ + t]; }
    if (mode == 1) {
        if (qb <= 3) selmask = (1u << qb) - 1u;
        else { float v1 = -INFINITY, v2 = -INFINITY, v3 = -INFINITY; int i1 = 0, i2 = 0, i3 = 0;
            for (int n = 0; n < qb; ++n) { const float* km = a.KM + ((size_t)bh * 16 + n) * 64; float s = 0.f;
#pragma unroll
                for (int d = 0; d < 64; ++d) s += q[d] * km[d];
                if (s > v1) { v3 = v2; i3 = i2; v2 = v1; i2 = i1; v1 = s; i1 = n; } else if (s > v2) { v3 = v2; i3 = i2; v2 = s; i2 = n; } else if (s > v3) { v3 = s; i3 = n; } }
            selmask = (1u << i1) | (1u << i2) | (1u << i3); }
    }
    const float* tab = a.TAB + ((mode == 3 ? 4 : 0) + h) * 1024;
    int s_lo = 0, s_hi = tw + 63, step = 1;
    if (mode == 3) s_lo = tw - 127 < 0 ? 0 : tw - 127;
    if (mode == 2) { s_lo = tw + 62; s_hi = 0; step = -1; }
    for (int s = s_lo; step > 0 ? s <= s_hi : s >= s_hi; s += step) {
        const int dist = t - s; bool valid;
        if (mode == 0) valid = dist >= 0;
        else if (mode == 1) { const int n = s >> 8; valid = (n == qb) ? (dist >= 0) : (((selmask >> n) & 1u) != 0u); }
        else if (mode == 2) valid = dist > 0;
        else valid = dist >= 0 && dist < 128;
        const bf16* kr = Kp + (size_t)s * 64; const bf16* vr = Vp + (size_t)s * 64;
        float z = 0.f;
#pragma unroll
        for (int d = 0; d < 64; ++d) z += q[d] * bf2f(kr[d]);
        if (!valid) continue;
        float p;
        if (mode == 2) {
            const float L2 = -(fmaxf(z, 0.f) + log2f(1.f + exp2f(-fabsf(z))));
            p = exp2f(z + L2 + R); R += L2;
#pragma unroll
            for (int d = 0; d < 64; ++d) o[d] += p * bf2f(vr[d]);
        } else {
            float xx = z;
            if (mode == 0) xx += ct - (cb[s >> 7] + a.LC[(size_t)bh * SEQ + s]);
            else xx += tab[dist < 1023 ? dist : 1023];
            const float mn = fmaxf(m, xx), al = exp2f(m - mn); p = exp2f(xx - mn); l = l * al + p; m = mn;
#pragma unroll
            for (int d = 0; d < 64; ++d) o[d] = o[d] * al + p * bf2f(vr[d]);
        }
    }
    float inv = 1.f;
    if (mode == 3) l += exp2f(a.sinks[h] * LOG2E - m);
    if (mode != 2) inv = 1.f / l;
    const bf16* gp = a.G + (size_t)(b * SEQ + t) * DM + mode * 256 + h * 64; bf16* yp = a.Y + (size_t)(b * SEQ + t) * DM + mode * 256 + h * 64;
#pragma unroll
    for (int d = 0; d < 64; ++d) yp[d] = (bf16)f2bf(o[d] * inv * bf2f(gp[d]));
}

__global__ void __launch_bounds__(NWAVES * 64, 2) mk_fwd(Args a) {
    extern __shared__ __attribute__((aligned(16))) unsigned char lds[];
    Frame F; F.lds = (LAS unsigned char*)lds; F.tid = threadIdx.x; F.lane = F.tid & 63; F.wave = __builtin_amdgcn_readfirstlane(F.tid >> 6);
    F.G = gridDim.x; { const int bx = blockIdx.x; F.vcu = (F.G % 8 == 0) ? (bx % 8) * (F.G / 8) + bx / 8 : bx; }
    bf16* HN = (bf16*)(a.ws + WS_HN);
#define PHASE_ON(k) (a.ph_lo <= (k) && (k) < a.ph_hi)
#define LAYER_PHASES(layer) do { \
    if (PHASE_ON(4 * (layer) + 0)) { \
        if ((layer) == 0) { p_weights(F, a); __syncthreads(); } \
        p_norm(F, a, (layer), (layer) == 0 ? a.x : a.out); \
    } \
    if (PHASE_ON(4 * (layer) + 1)) { \
        pg8::Gemm g{HN, (const bf16*)(a.ws + WS_WIN) + (size_t)(layer) * NPERM * DM, NTOK, NPERM, DM}; \
        pg8::StaticOrder S; S.init(NTOK, NPERM, F.G, (int)blockIdx.x); \
        pg8::EpiIn E{(bf16*)(a.ws + WS_Q), (bf16*)(a.ws + WS_K), (bf16*)(a.ws + WS_V), (bf16*)(a.ws + WS_G), a.fox_g + (layer) * 128, a.moba_g + (layer) * 128, a.swa_g + (layer) * 128}; \
        pg8::gemm_phase<pg8::EpiIn, pg8::StaticOrder, true, true>(F.lds, g, S, E); \
    } \
    if (PHASE_ON(4 * (layer) + 3)) { \
        pg8::Gemm g{HN  , (const bf16*)(a.ws + WS_WOUT) + (size_t)(layer) * DM * DM, NTOK, DM, DM}; \
        pg8::StaticOrder S; S.init(NTOK, DM, F.G, (int)blockIdx.x); \
        pg8::EpiRes E{(layer) == 0 ? a.x : a.out, a.out}; \
        pg8::gemm_phase<pg8::EpiRes, pg8::StaticOrder, true, true>(F.lds, g, S, E); \
    } } while (0)
    LAYER_PHASES(0);
    LAYER_PHASES(1);
}

extern "C" void kernel_launch(void* const* d_in, const int* in_sizes, int n_in, void* d_out, int out_size, void* d_ws, size_t ws_size, hipStream_t stream) {
    static int ok = 0;
    if (ok == 0) {
        if (n_in != 10 || in_sizes[0] != NTOK * DM || out_size != NTOK * DM || ws_size < WS_END) { fprintf(stderr, "kernel_launch: unexpected shapes (n_in %d, in0 %d, out %d, ws %zu)\n", n_in, n_in > 0 ? in_sizes[0] : -1, out_size, ws_size); ok = -1; return; }
        if (hipFuncSetAttribute((const void*)mk_fwd, hipFuncAttributeMaxDynamicSharedMemorySize, LDS_BYTES) != hipSuccess) { fprintf(stderr, "kernel_launch: hipFuncSetAttribute failed\n"); ok = -1; return; }
        ok = 1;
    }
    if (ok < 0) return;
    Args a{};
    a.x = (const float*)d_in[0]; a.norm_gain = (const float*)d_in[1]; a.w_in = (const float*)d_in[2]; a.b_forget = (const float*)d_in[3]; a.fox_g = (const float*)d_in[4];
    a.moba_g = (const float*)d_in[5]; a.swa_g = (const float*)d_in[6]; a.sinks = (const float*)d_in[7]; a.w_out = (const float*)d_in[8]; a.rel_bias = (const float*)d_in[9];
    a.out = (float*)d_out; a.ws = (unsigned char*)d_ws;
    unsigned char* ws = (unsigned char*)d_ws;
    for (int layer = 0; layer < NLAYER; ++layer) {
        for (int sub = 0; sub < 2; ++sub) { a.ph_lo = 4 * layer + sub; a.ph_hi = a.ph_lo + 1; hipLaunchKernelGGL(mk_fwd, dim3(256), dim3(NWAVES * 64), LDS_BYTES, stream, a); }
        km_kernel<<<dim3(16, 32), 64, 0, stream>>>((const bf16*)(ws + WS_K) + pg8::GS, (float*)(ws + WS_KM));
        for (int mode = 0; mode < 4; ++mode) {
            NArgs n{}; n.Q = (const bf16*)(ws + WS_Q) + mode * pg8::GS; n.K = (const bf16*)(ws + WS_K) + mode * pg8::GS; n.V = (const bf16*)(ws + WS_V) + mode * pg8::GS; n.G = (const bf16*)(ws + WS_G);
            n.Y = (bf16*)(ws + WS_HN); n.LC = (const float*)(ws + WS_LC); n.CTOT = (const float*)(ws + WS_CTOT); n.TAB = (const float*)(ws + WS_TAB); n.KM = (const float*)(ws + WS_KM);
            n.sinks = (const float*)d_in[7] + layer * 4; n.mode = mode;
            naive_attn<<<dim3(64, 32), 64, 0, stream>>>(n);
        }
        a.ph_lo = 4 * layer + 3; a.ph_hi = a.ph_lo + 1; hipLaunchKernelGGL(mk_fwd, dim3(256), dim3(NWAVES * 64), LDS_BYTES, stream, a);
    }
}
```

```cpp
#include <hip/hip_runtime.h>
#include <cstdio>
#include <cstdint>
#include <cmath>
namespace pg8 {
#define PG8_LAS __attribute__((address_space(3)))
typedef unsigned short bf16_t;
typedef short bf16x8 __attribute__((ext_vector_type(8)));
typedef float f32x4 __attribute__((ext_vector_type(4)));
typedef unsigned u32x4 __attribute__((ext_vector_type(4)));
constexpr int BM = 256, BK = 64, HALF = 128, HTB = HALF * BK * 2  , STAGE_BYTES = 8 * HTB, NXCD = 8, WGM = 8;

__host__ __device__ __forceinline__ int lds_byte(int r, int c) { const int st = (r >> 4) * 2 + (c >> 5), rr = r & 15, cc = c & 31, ob = rr * 64 + cc * 2; return st * 1024 + (ob ^ (((ob >> 9) & 1) << 5)); }
__host__ __device__ __forceinline__ void stage_rc(int b, int& R, int& C) { const int st = b / 1024, sb = b % 1024, swz = sb ^ (((sb >> 9) & 1) << 5); R = (st >> 1) * 16 + swz / 64; C = (st & 1) * 32 + (swz % 64) / 2; }
__host__ __device__ __forceinline__ int perm32(int rho) { const int n = rho >> 4, i = rho & 15; return 8 * (i >> 2) + 4 * n + (i & 3); }

struct Unit { int pm, pn; };
struct Gemm { const bf16_t* A; const bf16_t* Bt; int M, N, K; };

struct StaticOrder {
    int nM, nN, nwg, G, c;
    __host__ __device__ void init(int M, int N, int G_, int c_) { nM = M / BM; nN = N / BM; nwg = nM * nN; G = G_; c = c_; }
    __host__ __device__ bool next(int i, Unit& u) const {
        const long L = (long)i * G + c; if (L >= nwg) return false;
        int wgid = (int)L; { const int q = nwg / NXCD, r = nwg % NXCD, xcd = wgid % NXCD, off = wgid / NXCD; wgid = (xcd < r ? xcd * (q + 1) : r * (q + 1) + (xcd - r) * q) + off; }
        const int nig = WGM * nN, gid = wgid / nig, fm = gid * WGM, gsz = (nM - fm) < WGM ? (nM - fm) : WGM;
        u.pm = fm + ((wgid % nig) % gsz); u.pn = (wgid % nig) / gsz; return true;
    }
    __device__ __forceinline__ void a_ready(const Unit&) const {}
    __device__ __forceinline__ void done(const Unit&) const {}
};

__device__ __forceinline__ unsigned cvt_pk_bf16(float lo, float hi) { unsigned r; asm volatile("v_cvt_pk_bf16_f32 %0, %1, %2" : "=v"(r) : "v"(lo), "v"(hi)); return r; }
typedef float f32x2 __attribute__((ext_vector_type(2)));
constexpr float C2 = 0.125f * 1.4426950408889634f;
constexpr float RMS_EPS = 1e-6f;
constexpr size_t GS = (size_t)8 * 4 * 4096 * 64;
struct EpiIn {
    static constexpr bool PERM = true, AFTER_DRAIN = false;
    bf16_t *Q, *K, *V, *G; const float *gfox, *gmoba, *gswa;
    __device__ __forceinline__ void operator()(const f32x4 (&acc)[2][2][4][2], const Unit& u, int wr, int wc, int fr, int fq) const {
        const int T = u.pn;
        const int b = (u.pm * BM) >> 12, t0 = ((u.pm * BM) & 4095) + wr * 64 + fr;
        int mode = 1, nh = 4, head = wc; float scale = 1.f; const float* gain = nullptr; bf16_t* base = nullptr;
        switch (T) {
            case 0: mode = 0; gain = gfox; scale = C2; base = Q; break;
            case 1: mode = 0; gain = gfox + 64; base = K; break;
            case 2: base = V; break;
            case 4: mode = 0; gain = gmoba; scale = C2; base = Q + GS; break;
            case 5: mode = 0; gain = gmoba + 64; base = K + GS; break;
            case 6: base = V + GS; break;
            case 8: scale = C2; base = Q + 2 * GS; break;
            case 9: base = K + 2 * GS; break;
            case 10: base = V + 2 * GS; break;
            case 12: mode = 0; gain = gswa; scale = C2; base = Q + 3 * GS; break;
            case 13: nh = 2; if (wc < 2) { mode = 0; gain = gswa + 64; base = K + 3 * GS; } else { base = V + 3 * GS; head = wc - 2; } break;
            default: mode = 2; break;
        }
        if (mode == 2) {
            bf16_t* gp = G + (size_t)(u.pm * BM + wr * 64 + fr) * 1024 + (T >> 2) * 256 + 64 * wc + 8 * fq;
#pragma unroll
            for (int ai = 0; ai < 2; ++ai)
#pragma unroll
                for (int m = 0; m < 4; ++m)
#pragma unroll
                    for (int bj = 0; bj < 2; ++bj) {
                        f32x4 v0 = acc[ai][bj][m][0], v1 = acc[ai][bj][m][1];
#pragma unroll
                        for (int j = 0; j < 4; ++j) { v0[j] = v0[j] / (1.f + __expf(-v0[j])); v1[j] = v1[j] / (1.f + __expf(-v1[j])); }
                        u32x4 w; w.x = cvt_pk_bf16(v0[0], v0[1]); w.y = cvt_pk_bf16(v0[2], v0[3]); w.z = cvt_pk_bf16(v1[0], v1[1]); w.w = cvt_pk_bf16(v1[2], v1[3]);
                        *(u32x4*)(gp + (size_t)(ai * HALF + m * 16) * 1024 + 32 * bj) = w;
                    }
            return;
        }
        f32x4 gv[2][2];
#pragma unroll
        for (int bj = 0; bj < 2; ++bj)
#pragma unroll
            for (int n = 0; n < 2; ++n) gv[bj][n] = (mode == 0) ? *(const f32x4*)(gain + 32 * bj + 8 * fq + 4 * n) : (f32x4){1.f, 1.f, 1.f, 1.f};
        bf16_t* dp = base + ((size_t)(b * nh + head) * 4096 + t0) * 64 + 8 * fq;
#pragma unroll
        for (int ai = 0; ai < 2; ++ai)
#pragma unroll
            for (int m = 0; m < 4; ++m) {
                float r = scale;
                if (mode == 0) {
                    float ss = 0.f;
#pragma unroll
                    for (int bj = 0; bj < 2; ++bj)
#pragma unroll
                        for (int n = 0; n < 2; ++n) { const f32x4 x = acc[ai][bj][m][n]; ss += (x[0] * x[0] + x[1] * x[1]) + (x[2] * x[2] + x[3] * x[3]); }
                    ss += __shfl_xor(ss, 16); ss += __shfl_xor(ss, 32);
                    r = scale / sqrtf(ss * (1.0f / 64.0f) + RMS_EPS);
                }
#pragma unroll
                for (int bj = 0; bj < 2; ++bj) {
                    const f32x4 v0 = acc[ai][bj][m][0] * gv[bj][0] * r, v1 = acc[ai][bj][m][1] * gv[bj][1] * r;
                    u32x4 w; w.x = cvt_pk_bf16(v0[0], v0[1]); w.y = cvt_pk_bf16(v0[2], v0[3]); w.z = cvt_pk_bf16(v1[0], v1[1]); w.w = cvt_pk_bf16(v1[2], v1[3]);
                    *(u32x4*)(dp + (size_t)(ai * HALF + m * 16) * 64 + 32 * bj) = w;
                }
            }
    }
};
struct EpiRes {
    static constexpr bool PERM = false, AFTER_DRAIN = false;
    const float* base; float* out;
    __device__ __forceinline__ void operator()(const f32x4 (&acc)[2][2][4][2], const Unit& u, int wr, int wc, int fr, int fq) const {
        const int col0 = u.pn * BM + wc * 32 + 4 * fq;
#pragma unroll
        for (int ai = 0; ai < 2; ++ai)
#pragma unroll
            for (int m = 0; m < 4; ++m) {
                const size_t off = (size_t)(u.pm * BM + ai * HALF + wr * 64 + m * 16 + fr) * 1024 + col0;
#pragma unroll
                for (int bj = 0; bj < 2; ++bj)
#pragma unroll
                    for (int n = 0; n < 2; ++n) { const f32x4 bs = *(const f32x4*)(base + off + bj * HALF + n * 16); *(f32x4*)(out + off + bj * HALF + n * 16) = bs + acc[ai][bj][m][n]; }
            }
    }
};

template <class Epi, class Sched, bool ALIGN_EPI = false, bool SP2 = false>
__device__ __forceinline__ void gemm_phase(PG8_LAS unsigned char* lds, const Gemm g, const Sched& S, const Epi& E) {
    const int tid = threadIdx.x, wid = __builtin_amdgcn_readfirstlane(tid >> 6), lane = tid & 63, wr = wid >> 2, wc = wid & 3, fr = lane & 15, fq = lane >> 4;
    const int K = g.K, nt = K / BK;
    unsigned voffA[2], voffB[2];
#pragma unroll
    for (int i = 0; i < 2; ++i) { int R, C; stage_rc(tid * 16 + i * 8192, R, C); const int Rb = Epi::PERM ? ((R & ~31) + perm32(R & 31)) : R;
        voffA[i] = (unsigned)(R * K + C) * 2u; voffB[i] = (unsigned)(Rb * K + C) * 2u; }
    const size_t kstep = (size_t)(BK * 2);
    const size_t hstep = (size_t)HALF * K * 2;
    const size_t tstep = 2 * hstep;
    const unsigned ldsw = (unsigned)wid * 1024u;
    const int aoff = lds_byte(wr * 64 + fr, fq * 8), boff = lds_byte(wc * 32 + fr, fq * 8);
#define PG8_SA(b, h) (((b) * 2 + (h)) * HTB)
#define PG8_SB(b, h) ((4 + (b) * 2 + (h)) * HTB)
#define PG8_STAGE(bufoff, gbase, voff) do { _Pragma("unroll") for (int _i = 0; _i < 2; ++_i) \
        __builtin_amdgcn_global_load_lds((const unsigned*)((const char*)(gbase) + (voff)[_i]), (PG8_LAS unsigned*)(lds + (bufoff) + ldsw + _i * 8192), 16, 0, 0); } while (0)
#define PG8_LDA(dst, b, h) do { _Pragma("unroll") for (int m = 0; m < 4; ++m) _Pragma("unroll") for (int k = 0; k < 2; ++k) dst[m][k] = *(const PG8_LAS bf16x8*)(lds + PG8_SA(b, h) + aoff + m * 2048 + k * 1024); } while (0)
#define PG8_LDB(dst, b, h) do { _Pragma("unroll") for (int n = 0; n < 2; ++n) _Pragma("unroll") for (int k = 0; k < 2; ++k) dst[n][k] = *(const PG8_LAS bf16x8*)(lds + PG8_SB(b, h) + boff + n * 2048 + k * 1024); } while (0)
#define PG8_MMA(ai, bj, At, Bt) do { __builtin_amdgcn_s_setprio(1); _Pragma("unroll") for (int m = 0; m < 4; ++m) _Pragma("unroll") for (int n = 0; n < 2; ++n) _Pragma("unroll") for (int k = 0; k < 2; ++k) \
        acc[ai][bj][m][n] = __builtin_amdgcn_mfma_f32_16x16x32_bf16(Bt[n][k], At[m][k], acc[ai][bj][m][n], 0, 0, 0); __builtin_amdgcn_s_setprio(0); } while (0)
#define PG8_WAIT_V(n) asm volatile("s_waitcnt vmcnt(" #n ")" ::: "memory")
#define PG8_WAIT_L(n) asm volatile("s_waitcnt lgkmcnt(" #n ")" ::: "memory")
#define PG8_BAR __builtin_amdgcn_s_barrier()
#define PG8_SCHED __builtin_amdgcn_sched_barrier(0)
    Unit cur, nxt; int ui = 0;
    if (!S.next(0, cur)) return;
    f32x4 acc[2][2][4][2];
#pragma unroll
    for (int a = 0; a < 2; ++a)
#pragma unroll
        for (int b = 0; b < 2; ++b)
#pragma unroll
            for (int m = 0; m < 4; ++m)
#pragma unroll
                for (int n = 0; n < 2; ++n) acc[a][b][m][n] = (f32x4){0.f, 0.f, 0.f, 0.f};
    bf16x8 At[4][2], B0[2][2], B1[2][2];
    const char* cA = (const char*)g.A + (size_t)cur.pm * tstep; const char* cB = (const char*)g.Bt + (size_t)cur.pn * tstep;
    S.a_ready(cur);
    if constexpr (SP2) {
        PG8_STAGE(PG8_SB(0, 0), cB, voffB); PG8_STAGE(PG8_SB(0, 1), cB + hstep, voffB); PG8_STAGE(PG8_SA(0, 0), cA, voffA); PG8_STAGE(PG8_SA(0, 1), cA + hstep, voffA);
        if (wr == 1) PG8_BAR;
        PG8_WAIT_V(2); PG8_BAR;
        PG8_STAGE(PG8_SB(1, 0), cB + kstep, voffB); PG8_STAGE(PG8_SA(1, 0), cA + kstep, voffA); PG8_STAGE(PG8_SB(1, 1), cB + hstep + kstep, voffB);
        PG8_WAIT_V(6); PG8_BAR;
    } else {
        PG8_STAGE(PG8_SB(0, 0), cB, voffB); PG8_STAGE(PG8_SA(0, 0), cA, voffA); PG8_STAGE(PG8_SB(0, 1), cB + hstep, voffB); PG8_STAGE(PG8_SA(0, 1), cA + hstep, voffA);
        if (wr == 1) PG8_BAR;
        PG8_WAIT_V(4); PG8_BAR;
        PG8_STAGE(PG8_SB(1, 0), cB + kstep, voffB); PG8_STAGE(PG8_SA(1, 0), cA + kstep, voffA); PG8_STAGE(PG8_SB(1, 1), cB + hstep + kstep, voffB);
        PG8_WAIT_V(6); PG8_BAR;
    }
    for (;;) {
        const bool has_next = S.next(ui + 1, nxt);
        const char* nA = has_next ? (const char*)g.A + (size_t)nxt.pm * tstep : cA; const char* nB = has_next ? (const char*)g.Bt + (size_t)nxt.pn * tstep : cB;
        for (int t = 0; t < nt; t += 2) {
            const bool last = (t == nt - 2);
            const char* a1 = cA + (size_t)(t + 1) * kstep;
            const char* a2 = last ? nA : cA + (size_t)(t + 2) * kstep; const char* b2 = last ? nB : cB + (size_t)(t + 2) * kstep;
            const char* a3 = a2 + kstep; const char* b3 = b2 + kstep;
            if (last && has_next) S.a_ready(nxt);
            if constexpr (SP2) {
            PG8_LDB(B0, 0, 0); PG8_LDB(B1, 0, 1); PG8_SCHED; PG8_LDA(At, 0, 0); PG8_STAGE(PG8_SA(1, 1), a1 + hstep, voffA);
            PG8_WAIT_V(8); PG8_WAIT_L(0); PG8_BAR; PG8_MMA(0, 0, At, B0); PG8_MMA(0, 1, At, B1); PG8_BAR; PG8_SCHED;
            PG8_LDA(At, 0, 1); PG8_STAGE(PG8_SB(0, 0), b2, voffB); PG8_STAGE(PG8_SB(0, 1), b2 + hstep, voffB); PG8_STAGE(PG8_SA(0, 0), a2, voffA);
            PG8_WAIT_V(8); PG8_WAIT_L(0); PG8_BAR; PG8_MMA(1, 0, At, B0); PG8_MMA(1, 1, At, B1); PG8_BAR; PG8_SCHED;
            PG8_LDB(B0, 1, 0); PG8_LDB(B1, 1, 1); PG8_SCHED; PG8_LDA(At, 1, 0); PG8_STAGE(PG8_SA(0, 1), a2 + hstep, voffA);
            PG8_WAIT_V(8); PG8_WAIT_L(0); PG8_BAR; PG8_MMA(0, 0, At, B0); PG8_MMA(0, 1, At, B1); PG8_BAR; PG8_SCHED;
            PG8_LDA(At, 1, 1); PG8_STAGE(PG8_SB(1, 0), b3, voffB); PG8_STAGE(PG8_SB(1, 1), b3 + hstep, voffB); PG8_STAGE(PG8_SA(1, 0), a3, voffA);
            PG8_WAIT_V(8); PG8_WAIT_L(0); PG8_BAR; PG8_MMA(1, 0, At, B0); PG8_MMA(1, 1, At, B1); PG8_BAR; PG8_SCHED;
            } else {
            PG8_LDB(B0, 0, 0); PG8_SCHED; PG8_LDA(At, 0, 0); PG8_STAGE(PG8_SA(1, 1), a1 + hstep, voffA);
            PG8_WAIT_L(8); PG8_BAR; PG8_WAIT_L(0); PG8_MMA(0, 0, At, B0); PG8_BAR; PG8_SCHED;
            PG8_LDB(B1, 0, 1); PG8_STAGE(PG8_SB(0, 0), b2, voffB);
            PG8_BAR; PG8_WAIT_L(0); PG8_MMA(0, 1, At, B1); PG8_BAR;
            PG8_LDA(At, 0, 1); PG8_STAGE(PG8_SA(0, 0), a2, voffA);
            PG8_BAR; PG8_WAIT_L(0); PG8_MMA(1, 0, At, B0); PG8_BAR; PG8_SCHED;
            PG8_STAGE(PG8_SB(0, 1), b2 + hstep, voffB);
            PG8_WAIT_V(6); PG8_BAR; PG8_MMA(1, 1, At, B1); PG8_BAR;
            PG8_LDB(B0, 1, 0); PG8_SCHED; PG8_LDA(At, 1, 0); PG8_STAGE(PG8_SA(0, 1), a2 + hstep, voffA);
            PG8_WAIT_L(8); PG8_BAR; PG8_WAIT_L(0); PG8_MMA(0, 0, At, B0); PG8_BAR; PG8_SCHED;
            PG8_LDB(B1, 1, 1); PG8_STAGE(PG8_SB(1, 0), b3, voffB);
            PG8_BAR; PG8_WAIT_L(0); PG8_MMA(0, 1, At, B1); PG8_BAR;
            PG8_LDA(At, 1, 1); PG8_STAGE(PG8_SA(1, 0), a3, voffA);
            PG8_BAR; PG8_WAIT_L(0); PG8_MMA(1, 0, At, B0); PG8_BAR; PG8_SCHED;
            PG8_STAGE(PG8_SB(1, 1), b3 + hstep, voffB);
            PG8_WAIT_V(6); PG8_BAR; PG8_MMA(1, 1, At, B1); PG8_BAR;
            }
        }
        if constexpr (ALIGN_EPI) { if (wr == 0) PG8_BAR; }
        if constexpr (!Epi::AFTER_DRAIN) { E(acc, cur, wr, wc, fr, fq); S.done(cur); }
        if (!has_next) break;
#pragma unroll
        for (int a = 0; a < 2; ++a)
#pragma unroll
            for (int b = 0; b < 2; ++b)
#pragma unroll
                for (int m = 0; m < 4; ++m)
#pragma unroll
                    for (int n = 0; n < 2; ++n) acc[a][b][m][n] = (f32x4){0.f, 0.f, 0.f, 0.f};
        cur = nxt; cA = nA; cB = nB; ++ui;
        if constexpr (ALIGN_EPI) { if (wr == 1) PG8_BAR; }
    }
    PG8_WAIT_V(0);
    if constexpr (!ALIGN_EPI) { if (wr == 0) PG8_BAR; }
    PG8_BAR;
    if constexpr (Epi::AFTER_DRAIN) { E.fused(acc, cur, wr, wc, fr, fq, lds, wid, lane); S.done(cur); }
#undef PG8_SA
#undef PG8_SB
#undef PG8_STAGE
#undef PG8_LDA
#undef PG8_LDB
#undef PG8_MMA
#undef PG8_WAIT_V
#undef PG8_WAIT_L
#undef PG8_BAR
#undef PG8_SCHED
}
}
constexpr int NB = 8, SEQ = 4096, DM = 1024, NTOK = NB * SEQ, INW = 3844, NPERM = 3840, NLAYER = 2;
constexpr size_t MiB = 1u << 20;
constexpr size_t WS_CTL = 0, CTL_ZERO_BYTES = 1 * MiB;
constexpr size_t WS_WIN = 2 * MiB;
constexpr size_t WS_WOUT = 18 * MiB;
constexpr size_t WS_LC = 22 * MiB;
constexpr size_t WS_CTOT = 22 * MiB + 512 * 1024;
constexpr size_t WS_TAB = 23 * MiB;
constexpr size_t WS_KM = 24 * MiB;
constexpr size_t WS_MF = 25 * MiB;
constexpr int CW_QUEUE = 64;
constexpr size_t WS_HN = 32 * MiB;
constexpr size_t WS_Q = 96 * MiB, WS_K = 160 * MiB, WS_V = 216 * MiB, WS_G = 272 * MiB, WS_END = 336 * MiB;
constexpr float LOG2E = 1.4426950408889634f;
constexpr int NWAVES = 8;
#ifndef ENGINE_MASK
#define ENGINE_MASK 15
#endif
constexpr int RING_BYTES = 131072, LDS_BYTES = 147456;

#define GAS __attribute__((address_space(1)))
#define LAS __attribute__((address_space(3)))
typedef unsigned short bf16;
typedef unsigned v4u __attribute__((ext_vector_type(4)));
typedef float f32x4 __attribute__((ext_vector_type(4)));
__device__ __forceinline__ unsigned f2bf(float f) { unsigned u = __builtin_bit_cast(unsigned, f); return (u + 0x7fffu + ((u >> 16) & 1u)) >> 16; }
__device__ __forceinline__ unsigned pk2(float lo, float hi) { return f2bf(lo) | (f2bf(hi) << 16); }
__device__ __forceinline__ float bf2f(unsigned v) { return __uint_as_float(v << 16); }
__device__ __forceinline__ float wave_sum(float v) {
#pragma unroll
    for (int o = 1; o < 64; o <<= 1) v += __shfl_xor(v, o);
    return v;
}
__device__ __forceinline__ int rel_bucket(int d) {
    if (d < 16) return d;
    int b = 16;
    b += (d >= 21); b += (d >= 27); b += (d >= 35); b += (d >= 46); b += (d >= 59); b += (d >= 77); b += (d >= 99); b += (d >= 128);
    b += (d >= 166); b += (d >= 216); b += (d >= 280); b += (d >= 363); b += (d >= 470); b += (d >= 609); b += (d >= 790);
    return b;
}

struct Args { const float* x; const float* norm_gain; const float* w_in; const float* b_forget; const float* fox_g; const float* moba_g; const float* swa_g; const float* sinks; const float* w_out; const float* rel_bias; float* out; unsigned char* ws; int ph_lo, ph_hi, tmask, pad; };

struct Frame { LAS unsigned char* lds; int tid, lane, wave, vcu, G; };

__device__ __forceinline__ void transpose_item(const float* W, int ldw, bf16* WT, int dst_row0, int src_col0, LAS float* scr, int kb, int lane) {
    const int k0 = 64 * kb;
#pragma unroll 8
    for (int i = 0; i < 32; ++i) { const int kk = 2 * i + (lane >> 5); scr[kk * 33 + (lane & 31)] = W[(size_t)(k0 + kk) * ldw + src_col0 + (lane & 31)]; }
    asm volatile("s_waitcnt lgkmcnt(0)" ::: "memory");
    const int c = lane & 7;
#pragma unroll
    for (int j = 0; j < 4; ++j) { const int n = (lane >> 3) + 8 * j; const LAS float* s = scr + (8 * c) * 33 + n;
        v4u o; o.x = pk2(s[0 * 33], s[1 * 33]); o.y = pk2(s[2 * 33], s[3 * 33]); o.z = pk2(s[4 * 33], s[5 * 33]); o.w = pk2(s[6 * 33], s[7 * 33]);
        *(v4u*)(WT + (size_t)(dst_row0 + n) * 1024 + k0 + 8 * c) = o; }
    asm volatile("s_waitcnt lgkmcnt(0)" ::: "memory");
}
__device__ __forceinline__ int tile_src(int T, int wc) {
    switch (T) { case 0: return 0 + 64 * wc; case 1: return 256 + 64 * wc; case 2: return 512 + 64 * wc; case 3: return 772 + 64 * wc;
        case 4: return 1028 + 64 * wc; case 5: return 1284 + 64 * wc; case 6: return 1540 + 64 * wc; case 7: return 1796 + 64 * wc;
        case 8: return 2052 + 64 * wc; case 9: return 2308 + 64 * wc; case 10: return 2564 + 64 * wc; case 11: return 2820 + 64 * wc;
        case 12: return 3076 + 64 * wc; case 13: return wc < 2 ? 3332 + 64 * wc : 3460 + 64 * (wc - 2); default: return 3588 + 64 * wc; }
}
__device__ __forceinline__ void p_weights(Frame& F, const Args& a) {
    LAS float* scr = (LAS float*)(F.lds + F.wave * 16384);
    const int gw = F.vcu * NWAVES + F.wave, NGW = F.G * NWAVES;
    bf16* win = (bf16*)(a.ws + WS_WIN); bf16* wout = (bf16*)(a.ws + WS_WOUT);
    constexpr int I_IN = 120 * 16, I_OUT = 32 * 16;
    for (int it = gw; it < 2 * (I_IN + I_OUT); it += NGW) {
        const int layer = it / (I_IN + I_OUT); int r = it % (I_IN + I_OUT);
        if (r < I_IN) { const int kb = r / 120, g = r % 120, T = g >> 3, gg = g & 7, bj = gg >> 2, wc = gg & 3;
            transpose_item(a.w_in + (size_t)layer * DM * INW, INW, win + (size_t)layer * NPERM * DM, 32 * g, tile_src(T, wc) + 32 * bj, scr, kb, F.lane); }
        else { r -= I_IN; const int kb = r / 32, g = r % 32;
            transpose_item(a.w_out + (size_t)layer * DM * DM, DM, wout + (size_t)layer * DM * DM, 32 * g, 32 * g, scr, kb, F.lane); }
    }
    if (F.vcu == 0) { float* tab = (float*)(a.ws + WS_TAB);
        for (int i = F.tid; i < 8 * 1024; i += NWAVES * 64) { const int hc = i >> 10, d = i & 1023; tab[i] = a.rel_bias[rel_bucket(d) * 8 + hc] * LOG2E; } }
}
__device__ __forceinline__ void p_consts(Frame& F, const Args& a, int layer) {
    if (F.vcu == 0 && F.wave == 0) {
        const int lane = F.lane; float* MF = (float*)(a.ws + WS_MF) + layer * 4;
        float bm = 0.f;
#pragma unroll
        for (int j = 0; j < 4; ++j) bm = fmaxf(bm, fabsf(a.rel_bias[64 * j + lane]));
#pragma unroll
        for (int o = 1; o < 64; o <<= 1) bm = fmaxf(bm, __shfl_xor(bm, o));
        const float* gp[3] = {a.fox_g + layer * 128, a.moba_g + layer * 128, a.swa_g + layer * 128};
#pragma unroll
        for (int k = 0; k < 3; ++k) { float mq = fabsf(gp[k][lane]), mk = fabsf(gp[k][64 + lane]);
#pragma unroll
            for (int o = 1; o < 64; o <<= 1) { mq = fmaxf(mq, __shfl_xor(mq, o)); mk = fmaxf(mk, __shfl_xor(mk, o)); }
            const float m = 8.f * LOG2E * mq * mk * 1.02f + 0.1f + (k == 0 ? 0.f : bm * LOG2E);
            if (lane == 0) MF[k == 0 ? 0 : (k == 1 ? 1 : 3)] = m; }
        if (lane == 0) MF[2] = 0.f;
    }
}
__device__ __forceinline__ void p_norm(Frame& F, const Args& a, int layer, const float* xin) {
    LAS float* lfs = (LAS float*)F.lds;
    const int chunk = F.vcu, b = chunk >> 5, cidx = chunk & 31, lane = F.lane;
    const float* gain = a.norm_gain + layer * DM; const float* wl = a.w_in + (size_t)layer * DM * INW;
    f32x4 g[4], gw[4][4];
#pragma unroll
    for (int j = 0; j < 4; ++j) { g[j] = *(const f32x4*)(gain + 256 * j + 4 * lane);
#pragma unroll
        for (int i = 0; i < 4; ++i) { gw[j][i] = *(const f32x4*)(wl + (size_t)(256 * j + 4 * lane + i) * INW + 768) * g[j][i]; } }
    f32x4 bfv = *(const f32x4*)(a.b_forget + layer * 4);
    bf16* HN = (bf16*)(a.ws + WS_HN);
    for (int r = 0; r < 16; ++r) {
        const int rl = 16 * F.wave + r; const size_t row = (size_t)128 * chunk + rl;
        const f32x4* xr = (const f32x4*)(xin + row * DM) + lane;
        f32x4 v[4]; float ss = 0.f; f32x4 p = {0.f, 0.f, 0.f, 0.f};
#pragma unroll
        for (int j = 0; j < 4; ++j) { v[j] = xr[64 * j]; ss += (v[j][0] * v[j][0] + v[j][1] * v[j][1]) + (v[j][2] * v[j][2] + v[j][3] * v[j][3]);
#pragma unroll
            for (int i = 0; i < 4; ++i) p += gw[j][i] * v[j][i]; }
        const float rstd = 1.0f / sqrtf(wave_sum(ss) * (1.0f / DM) + pg8::RMS_EPS);
        unsigned long long* o8 = (unsigned long long*)(HN + row * DM) + lane;
#pragma unroll
        for (int j = 0; j < 4; ++j) { const f32x4 y = v[j] * rstd * g[j]; o8[64 * j] = (unsigned long long)pk2(y[0], y[1]) | ((unsigned long long)pk2(y[2], y[3]) << 32); }
#pragma unroll
        for (int h = 0; h < 4; ++h) { const float u = wave_sum(p[h]) * rstd + bfv[h];
            const float sp = fmaxf(-u, 0.f) + log1pf(expf(-fabsf(u)));
            if (lane == 0) lfs[h * 128 + rl] = -sp * LOG2E; }
    }
    __syncthreads();
    if (F.wave < 4) { const int h = F.wave; const float x0 = lfs[h * 128 + 2 * lane], x1 = lfs[h * 128 + 2 * lane + 1]; float s = x0 + x1;
#pragma unroll
        for (int o = 1; o < 64; o <<= 1) { const float t = __shfl_up(s, o); if (lane >= o) s += t; }
        float* LC = (float*)(a.ws + WS_LC) + (size_t)(b * 4 + h) * SEQ + cidx * 128 + 2 * lane; LC[0] = s - x1; LC[1] = s;
        if (lane == 63) ((float*)(a.ws + WS_CTOT))[(b * 4 + h) * 32 + cidx] = s; }
    __syncthreads();
}

namespace att {
using bf16x8 = __attribute__((ext_vector_type(8))) short;
using s16x4 = __attribute__((ext_vector_type(4))) short;
using f32x16 = __attribute__((ext_vector_type(16))) float;
using u32x4 = __attribute__((ext_vector_type(4))) unsigned;
typedef __attribute__((address_space(3))) const char* lds_cptr;
typedef __attribute__((address_space(3))) char* lds_ptr;
typedef short v4i16_t __attribute__((ext_vector_type(4)));
typedef float f32x2_t __attribute__((ext_vector_type(2))); typedef __bf16 bf16x2_t __attribute__((ext_vector_type(2)));
constexpr int NSLOT = 3, SLOTB = 8192;
constexpr int L_K = 0, L_V = NSLOT * SLOTB, L_WS = 2 * NSLOT * SLOTB, L_OST = L_WS + 8 * 256, L_TAB = L_OST + 8 * 4096, L_CS = L_TAB + 4096, L_MISC = L_CS + 16384, L_END = L_MISC + 1024;
static_assert(L_END <= 131072, "attention LDS map");
constexpr float THR2 = 90.f;
#define SBAR() __builtin_amdgcn_sched_barrier(0)
__device__ __forceinline__ int crow(int r, int hi) { return (r & 3) + 8 * (r >> 2) + 4 * hi; }
__device__ __forceinline__ void glds16(const void* gsrc, unsigned lds_dst) { unsigned keep;
    asm volatile("s_mov_b32 %0, m0\n\ts_mov_b32 m0, %2\n\ts_nop 0\n\tglobal_load_lds_dwordx4 %1, off\n\ts_mov_b32 m0, %0" : "=&s"(keep) : "v"(gsrc), "s"(lds_dst) : "memory"); }
__device__ __forceinline__ unsigned cvtpk_s(float lo, float hi) { f32x2_t v = {lo, hi}; bf16x2_t b = __builtin_convertvector(v, bf16x2_t); return __builtin_bit_cast(unsigned, b); }
__device__ __forceinline__ s16x4 vtr(lds_cptr p) { return __builtin_bit_cast(s16x4, __builtin_amdgcn_ds_read_tr16_b64_v4i16((__attribute__((address_space(3))) v4i16_t*)p)); }
#define MFMA32(a, b, c) __builtin_amdgcn_mfma_f32_32x32x16_bf16(a, b, c, 0, 0, 0)
__device__ __forceinline__ void qkt(f32x16& p0, f32x16& p1, lds_cptr kp, const bf16x8* qr, float cinit) {
    f32x16 c;
#pragma unroll
    for (int r = 0; r < 16; ++r) c[r] = cinit;
    p0 = c; p1 = c;
#pragma unroll
    for (int d0 = 0; d0 < 4; ++d0) {
        const bf16x8 b0 = *(const __attribute__((address_space(3))) bf16x8*)(kp + d0 * 2048);
        const bf16x8 b1 = *(const __attribute__((address_space(3))) bf16x8*)(kp + d0 * 2048 + 512);
        p0 = MFMA32(b0, qr[d0], p0); p1 = MFMA32(b1, qr[d0], p1);
    }
}
__device__ __forceinline__ void pv(f32x16* o, lds_cptr vp, bf16x8 pa0, bf16x8 pa1, bf16x8 pa2, bf16x8 pa3) {
#pragma unroll
    for (int d0 = 0; d0 < 2; ++d0) { s16x4 lo[4], hi[4];
#pragma unroll
        for (int ks = 0; ks < 4; ++ks) { lo[ks] = vtr(vp + d0 * 4096 + ks * 1024); hi[ks] = vtr(vp + d0 * 4096 + ks * 1024 + 512); }
#define PK(k) (bf16x8){lo[k][0], lo[k][1], lo[k][2], lo[k][3], hi[k][0], hi[k][1], hi[k][2], hi[k][3]}
        o[d0] = MFMA32(pa0, PK(0), o[d0]); o[d0] = MFMA32(pa1, PK(1), o[d0]); o[d0] = MFMA32(pa2, PK(2), o[d0]); o[d0] = MFMA32(pa3, PK(3), o[d0]);
#undef PK
    }
}
struct ACtx { const bf16 *Q, *K, *V, *G; bf16* Y; const float *LC, *CTOT, *TAB, *KM, *MF; const float* sinks; };
#define WAITBAR(N) asm volatile("s_waitcnt vmcnt(" #N ") lgkmcnt(0)\n\ts_barrier" ::: "memory")

template <int TYPE> __device__ __forceinline__ void attn_unit(const ACtx& C, int bh, int qb, lds_ptr shm) {
    const int tid = threadIdx.x, lane = tid & 63, r32 = lane & 31, hi = lane >> 5; const int wid = __builtin_amdgcn_readfirstlane(tid >> 6);
    const int b = bh >> 2, h = bh & 3, q0 = qb * 256, qrel = wid * 32 + r32, t = q0 + qrel;
    const int kvh = (TYPE == 3) ? (b * 2 + (h >> 1)) : bh;
    const bf16* Qw = C.Q + TYPE * pg8::GS + ((size_t)bh * SEQ + q0 + wid * 32) * 64;
    const bf16* Kh = C.K + TYPE * pg8::GS + (size_t)kvh * SEQ * 64; const bf16* Vh = C.V + TYPE * pg8::GS + (size_t)kvh * SEQ * 64;
    const unsigned lds0 = (unsigned)(size_t)shm;
    __attribute__((address_space(3))) float* wsf = (__attribute__((address_space(3))) float*)(shm + L_WS) + wid * 64;
    __attribute__((address_space(3))) float* tabL = (__attribute__((address_space(3))) float*)(shm + L_TAB);
    __attribute__((address_space(3))) float* cs = (__attribute__((address_space(3))) float*)(shm + L_CS);
    __attribute__((address_space(3))) float* misc = (__attribute__((address_space(3))) float*)(shm + L_MISC);
    __attribute__((address_space(3))) int* misci = (__attribute__((address_space(3))) int*)(shm + L_MISC);
    const bf16* ksrc = Kh + (size_t)lane * 64 + wid * 8;
    const bf16* vsrc = Vh + (size_t)(16 * (wid & 3) + (lane >> 2)) * 64 + (wid >> 2) * 32 + (lane & 3) * 8;
    const unsigned kdst = lds0 + L_K + wid * 1024, vdst = lds0 + L_V + wid * 1024;
#define DMA_KV(tile, slot) do { glds16(ksrc + (size_t)(tile) * 4096, (unsigned)__builtin_amdgcn_readfirstlane(kdst + (slot) * SLOTB)); glds16(vsrc + (size_t)(tile) * 4096, (unsigned)__builtin_amdgcn_readfirstlane(vdst + (slot) * SLOTB)); } while (0)
    const lds_cptr kp0 = (lds_cptr)shm + L_K + hi * 1024 + r32 * 16;
    const lds_cptr vp0 = (lds_cptr)shm + L_V + ((lane >> 4) & 1) * 32 + (lane & 3) * 8 + (4 * hi + ((lane & 15) >> 2)) * 64;
    const float Mf = (TYPE == 2) ? 0.f : C.MF[TYPE];
    const int t_hi = 4 * qb + 3; int t_lo = 0;
    if (TYPE == 3) { t_lo = 4 * qb - 2; if (t_lo < 0) t_lo = 0; }
    unsigned sel = 0u; float ct = 0.f;
    if (TYPE == 0) {
        if (wid == 0) { const float v = lane < 32 ? C.CTOT[bh * 32 + lane] : 0.f; float s = v;
#pragma unroll
            for (int o = 1; o < 64; o <<= 1) { const float u = __shfl_up(s, o); if (lane >= o) s += u; }
            if (lane < 32) misc[lane] = s - v; }
        __syncthreads();
        for (int s = tid; s < q0 + 256; s += 512) cs[s] = misc[s >> 7] + C.LC[(size_t)bh * SEQ + s];
        __syncthreads();
        const float cref = cs[q0];
        if (wid == 0) { const bool skip = (lane < 4 * qb) && (cs[64 * lane + 63] - cref > 2.f * Mf + THR2);
            const int cnt = __popcll(__ballot(skip)); if (lane == 0) misci[40] = cnt; }
        __syncthreads();
        t_lo = misci[40]; ct = cs[t];
    }
    if (TYPE == 1 || TYPE == 3) {
        const float* tg = C.TAB + ((TYPE == 3 ? 4 : 0) + h) * 1024;
        for (int i = tid; i < 1024; i += 512) tabL[i] = tg[i];
        if (TYPE == 1) { const float* kg = C.KM + (size_t)bh * 16 * 64; for (int i = tid; i < qb * 64; i += 512) cs[i] = kg[i]; }
        __syncthreads();
        if (TYPE == 1) {
            if (qb <= 3) sel = (1u << qb) - 1u;
            else { float qf[64];
#pragma unroll
                for (int c8 = 0; c8 < 8; ++c8) { const u32x4 w = *(const u32x4*)(Qw + (size_t)r32 * 64 + c8 * 8);
#pragma unroll
                    for (int j = 0; j < 4; ++j) { qf[c8 * 8 + 2 * j] = __uint_as_float(w[j] << 16); qf[c8 * 8 + 2 * j + 1] = __uint_as_float(w[j] & 0xffff0000u); } }
                float v1 = -INFINITY, v2 = -INFINITY, v3 = -INFINITY; int i1 = 0, i2 = 0, i3 = 0;
                for (int n = 0; n < qb; ++n) { float s = 0.f;
#pragma unroll
                    for (int d = 0; d < 64; ++d) s += qf[d] * cs[n * 64 + d];
                    if (s > v1) { v3 = v2; i3 = i2; v2 = v1; i2 = i1; v1 = s; i1 = n; } else if (s > v2) { v3 = v2; i3 = i2; v2 = s; i2 = n; } else if (s > v3) { v3 = s; i3 = n; } }
                sel = (1u << i1) | (1u << i2) | (1u << i3); }
        }
    }
    const int n_tiles = t_hi - t_lo + 1;
    DMA_KV(t_hi, 0);
    bf16x8 qr[4];
#pragma unroll
    for (int d0 = 0; d0 < 4; ++d0) qr[d0] = *reinterpret_cast<const bf16x8*>(&Qw[(size_t)r32 * 64 + d0 * 16 + hi * 8]);
    f32x16 o[2]; o[0] = f32x16{}; o[1] = f32x16{};
    float lsum = 0.f, carry = 0.f; bool done_w = false;
    const int jdiag = wid >> 1;
    const int jlo_w = (TYPE == 3) ? ((32 * wid - 127) >> 6) : -100000;
    if (TYPE == 2) { if (tid < 16) misci[64 + tid] = 0; }
    int slot = 0;
    for (int i = 0; i < n_tiles; ++i) {
        const int tile = t_hi - i, jr = tile - 4 * qb;
        const int nslot = (slot == NSLOT - 1) ? 0 : slot + 1;
        if (i + 1 < n_tiles) { DMA_KV(tile - 1, nslot); WAITBAR(2); } else { WAITBAR(0); }
        if (TYPE == 2 && i > 0) { int alld = 1;
#pragma unroll
            for (int w = 0; w < 8; ++w) alld &= misci[64 + ((i - 1) & 1) * 8 + w];
            if (alld) break; }
        const bool active = (jr <= jdiag) && (jr >= jlo_w) && !(TYPE == 2 && done_w);
        if (active) {
            f32x16 p0, p1;
            float cinit = -Mf;
            if (TYPE == 0) cinit = ct - Mf;
            bool far = false;
            if (TYPE == 1) { far = (q0 + 32 * wid - 64 * tile - 63) >= 790; if (far) cinit += tabL[1023]; }
            qkt(p0, p1, kp0 + slot * SLOTB, qr, cinit);
            const int kb = 64 * jr + 4 * hi;
            if (TYPE == 0) {
#pragma unroll
                for (int g4 = 0; g4 < 4; ++g4) { const f32x4 c0 = *(const __attribute__((address_space(3))) f32x4*)(cs + 64 * tile + 8 * g4 + 4 * hi), c1 = *(const __attribute__((address_space(3))) f32x4*)(cs + 64 * tile + 32 + 8 * g4 + 4 * hi);
#pragma unroll
                    for (int j = 0; j < 4; ++j) { p0[4 * g4 + j] -= c0[j]; p1[4 * g4 + j] -= c1[j]; } }
                if (jr == jdiag) {
#pragma unroll
                    for (int r = 0; r < 16; ++r) { const int kv = kb + (r & 3) + 8 * (r >> 2); if (kv > qrel) p0[r] = -INFINITY; if (kv + 32 > qrel) p1[r] = -INFINITY; } }
#pragma unroll
                for (int r = 0; r < 16; ++r) { p0[r] = __builtin_amdgcn_exp2f(p0[r]); p1[r] = __builtin_amdgcn_exp2f(p1[r]); }
            }
            if (TYPE == 1 || TYPE == 3) {
                if (!far) {
#pragma unroll
                    for (int r = 0; r < 16; ++r) { const int kv = kb + (r & 3) + 8 * (r >> 2); int d0_ = qrel - kv, d1_ = d0_ - 32;
                        d0_ = d0_ < 0 ? 0 : (d0_ > 1023 ? 1023 : d0_); d1_ = d1_ < 0 ? 0 : (d1_ > 1023 ? 1023 : d1_);
                        p0[r] += tabL[d0_]; p1[r] += tabL[d1_]; } }
                if (TYPE == 1) {
                    if (jr >= 0) { if (jr == jdiag) {
#pragma unroll
                            for (int r = 0; r < 16; ++r) { const int kv = kb + (r & 3) + 8 * (r >> 2); if (kv > qrel) p0[r] = -INFINITY; if (kv + 32 > qrel) p1[r] = -INFINITY; } } }
                    else { const bool keep = ((sel >> (tile >> 2)) & 1u) != 0u; if (!keep) {
#pragma unroll
                            for (int r = 0; r < 16; ++r) { p0[r] = -INFINITY; p1[r] = -INFINITY; } } }
                } else {
#pragma unroll
                    for (int r = 0; r < 16; ++r) { const int kv = kb + (r & 3) + 8 * (r >> 2); const int d0_ = qrel - kv, d1_ = d0_ - 32;
                        if (d0_ < 0 || d0_ >= 128) p0[r] = -INFINITY; if (d1_ < 0 || d1_ >= 128) p1[r] = -INFINITY; }
                }
#pragma unroll
                for (int r = 0; r < 16; ++r) { p0[r] = __builtin_amdgcn_exp2f(p0[r]); p1[r] = __builtin_amdgcn_exp2f(p1[r]); }
            }
            if (TYPE == 2) {
                f32x16 L0, L1;
#pragma unroll
                for (int r = 0; r < 16; ++r) { const int kv = kb + (r & 3) + 8 * (r >> 2);
                    const float z0 = p0[r], z1 = p1[r];
                    float a0 = -(fmaxf(z0, 0.f) + __builtin_amdgcn_logf(1.f + __builtin_amdgcn_exp2f(-fabsf(z0))));
                    float a1 = -(fmaxf(z1, 0.f) + __builtin_amdgcn_logf(1.f + __builtin_amdgcn_exp2f(-fabsf(z1))));
                    if (jr == jdiag) { if (kv >= qrel) a0 = 0.f; if (kv + 32 >= qrel) a1 = 0.f; }
                    L0[r] = a0; L1[r] = a1; }
                float own[8], part[8];
#pragma unroll
                for (int rb = 0; rb < 4; ++rb) { own[rb] = (L0[4 * rb] + L0[4 * rb + 1]) + (L0[4 * rb + 2] + L0[4 * rb + 3]); own[4 + rb] = (L1[4 * rb] + L1[4 * rb + 1]) + (L1[4 * rb + 2] + L1[4 * rb + 3]); }
#pragma unroll
                for (int rb = 0; rb < 8; ++rb) { auto rr = __builtin_amdgcn_permlane32_swap(__float_as_uint(own[rb]), __float_as_uint(own[rb]), false, false); part[rb] = __uint_as_float(hi ? rr[0] : rr[1]); }
                float run = carry;
#pragma unroll
                for (int rb = 7; rb >= 0; --rb) {
                    float E = run + (hi == 0 ? part[rb] : 0.f); run += own[rb] + part[rb];
#pragma unroll
                    for (int j = 3; j >= 0; --j) { const int r = 4 * (rb & 3) + j; const int kv = kb + (r & 3) + 8 * (r >> 2) + (rb >= 4 ? 32 : 0);
                        const float z = rb >= 4 ? p1[r] : p0[r], Lv = rb >= 4 ? L1[r] : L0[r];
                        float pp = __builtin_amdgcn_exp2f(z + Lv + E); E += Lv;
                        if (jr == jdiag && kv >= qrel) pp = 0.f;
                        if (rb >= 4) p1[r] = pp; else p0[r] = pp; } }
                carry = run;
                done_w = __all(carry < -100.f) != 0;
            }
            float ps = 0.f;
#pragma unroll
            for (int r = 0; r < 16; ++r) ps += p0[r] + p1[r];
            lsum += ps;
            u32x4 pw0, pw1, pw2, pw3;
#pragma unroll
            for (int j = 0; j < 4; ++j) { pw0[j] = cvtpk_s(p0[2 * j], p0[2 * j + 1]); pw1[j] = cvtpk_s(p0[8 + 2 * j], p0[9 + 2 * j]); pw2[j] = cvtpk_s(p1[2 * j], p1[2 * j + 1]); pw3[j] = cvtpk_s(p1[8 + 2 * j], p1[9 + 2 * j]); }
            pv(o, vp0 + slot * SLOTB, __builtin_bit_cast(bf16x8, pw0), __builtin_bit_cast(bf16x8, pw1), __builtin_bit_cast(bf16x8, pw2), __builtin_bit_cast(bf16x8, pw3));
        }
        if (TYPE == 2) { if (lane == 0) misci[64 + (i & 1) * 8 + wid] = done_w ? 1 : 0; }
        slot = nslot;
    }
    { auto rr = __builtin_amdgcn_permlane32_swap(__float_as_uint(lsum), __float_as_uint(lsum), false, false); lsum = __uint_as_float(rr[0]) + __uint_as_float(rr[1]); }
    if (TYPE == 3) lsum += __builtin_amdgcn_exp2f(C.sinks[h] * LOG2E - Mf);
    if (hi == 0) wsf[r32] = (TYPE == 2) ? 1.f : 1.f / lsum;
    asm volatile("s_waitcnt lgkmcnt(0)" ::: "memory");
    __attribute__((address_space(3))) bf16* stg = (__attribute__((address_space(3))) bf16*)(shm + L_OST) + wid * 2048;
#pragma unroll
    for (int r = 0; r < 16; ++r) { const int orow = crow(r, hi); const float rl = wsf[orow];
#pragma unroll
        for (int d0 = 0; d0 < 2; ++d0) stg[orow * 64 + d0 * 32 + r32] = (bf16)f2bf(o[d0][r] * rl); }
    asm volatile("s_waitcnt lgkmcnt(0)" ::: "memory");
    const size_t yrow0 = (size_t)(b * SEQ + q0 + wid * 32);
#pragma unroll
    for (int i = 0; i < 4; ++i) { const int row = i * 8 + (lane >> 3), ch = lane & 7;
        const u32x4 v = *(const __attribute__((address_space(3))) u32x4*)(stg + row * 64 + ch * 8);
        const size_t off = (yrow0 + row) * DM + TYPE * 256 + h * 64 + ch * 8;
        const u32x4 g = *(const u32x4*)(C.G + off); u32x4 w;
#pragma unroll
        for (int j = 0; j < 4; ++j) { const float a0 = __uint_as_float(v[j] << 16) * __uint_as_float(g[j] << 16), a1 = __uint_as_float(v[j] & 0xffff0000u) * __uint_as_float(g[j] & 0xffff0000u); w[j] = pk2(a0, a1); }
        *(u32x4*)(C.Y + off) = w; }
    WAITBAR(0);
#undef DMA_KV
}
#undef SBAR
}
__global__ void __launch_bounds__(64) km_kernel(const bf16* Kb, float* KM) {
    const int n = blockIdx.x, bh = blockIdx.y, d = threadIdx.x; const bf16* kp = Kb + ((size_t)bh * SEQ + 256 * n) * 64 + d; float s = 0.f;
    for (int i = 0; i < 256; ++i) s += bf2f(kp[i * 64]);
    KM[((size_t)bh * 16 + n) * 64 + d] = s * (1.0f / 256.0f);
}
struct NArgs { const bf16 *Q, *K, *V, *G; bf16* Y; const float *LC, *CTOT, *TAB, *KM, *sinks; int mode, pad; };
__global__ void __launch_bounds__(64) naive_attn(NArgs a) {
    __shared__ float cb[33];
    const int lane = threadIdx.x, bh = blockIdx.y, b = bh >> 2, h = bh & 3, tw = blockIdx.x * 64, t = tw + lane, mode = a.mode;
    const bf16* Qp = a.Q + ((size_t)bh * SEQ + t) * 64;
    const int kvh = (mode == 3) ? (b * 2 + (h >> 1)) : bh;
    const bf16* Kp = a.K + (size_t)kvh * SEQ * 64; const bf16* Vp = a.V + (size_t)kvh * SEQ * 64;
    float q[64], o[64];
#pragma unroll
    for (int d = 0; d < 64; ++d) { q[d] = bf2f(Qp[d]); o[d] = 0.f; }
    float m = -INFINITY, l = 0.f, ct = 0.f, R = 0.f;
    unsigned selmask = 0u; const int qb = tw >> 8;
    if (mode == 0) { if (lane == 0) { float s = 0.f; for (int c = 0; c < 32; ++c) { cb[c] = s; s += a.CTOT[bh * 32 + c]; } } __syncthreads(); ct = cb[t >> 7] + a.LC[(size_t)bh * SEQ + t]; }
    if (mode == 1) {
        if (qb <= 3) selmask = (1u << qb) - 1u;
        else { float v1 = -INFINITY, v2 = -INFINITY, v3 = -INFINITY; int i1 = 0, i2 = 0, i3 = 0;
            for (int n = 0; n < qb; ++n) { const float* km = a.KM + ((size_t)bh * 16 + n) * 64; float s = 0.f;
#pragma unroll
                for (int d = 0; d < 64; ++d) s += q[d] * km[d];
                if (s > v1) { v3 = v2; i3 = i2; v2 = v1; i2 = i1; v1 = s; i1 = n; } else if (s > v2) { v3 = v2; i3 = i2; v2 = s; i2 = n; } else if (s > v3) { v3 = s; i3 = n; } }
            selmask = (1u << i1) | (1u << i2) | (1u << i3); }
    }
    const float* tab = a.TAB + ((mode == 3 ? 4 : 0) + h) * 1024;
    int s_lo = 0, s_hi = tw + 63, step = 1;
    if (mode == 3) s_lo = tw - 127 < 0 ? 0 : tw - 127;
    if (mode == 2) { s_lo = tw + 62; s_hi = 0; step = -1; }
    for (int s = s_lo; step > 0 ? s <= s_hi : s >= s_hi; s += step) {
        const int dist = t - s; bool valid;
        if (mode == 0) valid = dist >= 0;
        else if (mode == 1) { const int n = s >> 8; valid = (n == qb) ? (dist >= 0) : (((selmask >> n) & 1u) != 0u); }
        else if (mode == 2) valid = dist > 0;
        else valid = dist >= 0 && dist < 128;
        const bf16* kr = Kp + (size_t)s * 64; const bf16* vr = Vp + (size_t)s * 64;
        float z = 0.f;
#pragma unroll
        for (int d = 0; d < 64; ++d) z += q[d] * bf2f(kr[d]);
        if (!valid) continue;
        float p;
        if (mode == 2) {
            const float L2 = -(fmaxf(z, 0.f) + log2f(1.f + exp2f(-fabsf(z))));
            p = exp2f(z + L2 + R); R += L2;
#pragma unroll
            for (int d = 0; d < 64; ++d) o[d] += p * bf2f(vr[d]);
        } else {
            float xx = z;
            if (mode == 0) xx += ct - (cb[s >> 7] + a.LC[(size_t)bh * SEQ + s]);
            else xx += tab[dist < 1023 ? dist : 1023];
            const float mn = fmaxf(m, xx), al = exp2f(m - mn); p = exp2f(xx - mn); l = l * al + p; m = mn;
#pragma unroll
            for (int d = 0; d < 64; ++d) o[d] = o[d] * al + p * bf2f(vr[d]);
        }
    }
    float inv = 1.f;
    if (mode == 3) l += exp2f(a.sinks[h] * LOG2E - m);
    if (mode != 2) inv = 1.f / l;
    const bf16* gp = a.G + (size_t)(b * SEQ + t) * DM + mode * 256 + h * 64; bf16* yp = a.Y + (size_t)(b * SEQ + t) * DM + mode * 256 + h * 64;
#pragma unroll
    for (int d = 0; d < 64; ++d) yp[d] = (bf16)f2bf(o[d] * inv * bf2f(gp[d]));
}

__device__ __forceinline__ void p_attn(Frame& F, const Args& a, int layer) {
    att::ACtx C{(const bf16*)(a.ws + WS_Q), (const bf16*)(a.ws + WS_K), (const bf16*)(a.ws + WS_V), (const bf16*)(a.ws + WS_G), (bf16*)(a.ws + WS_HN),
                (const float*)(a.ws + WS_LC), (const float*)(a.ws + WS_CTOT), (const float*)(a.ws + WS_TAB), (const float*)(a.ws + WS_KM), (const float*)(a.ws + WS_MF) + layer * 4, a.sinks + layer * 4};
    unsigned* head = (unsigned*)(a.ws + WS_CTL) + CW_QUEUE + 64 * layer;
    LAS int* slot = (LAS int*)(F.lds + att::L_MISC) + 200;
    att::lds_ptr shm = (att::lds_ptr)F.lds;
    for (;;) {
        if (F.tid == 0) slot[0] = (int)__hip_atomic_fetch_add(head, 1u, __ATOMIC_RELAXED, __HIP_MEMORY_SCOPE_AGENT);
        __syncthreads();
        const int u = slot[0];
        __syncthreads();
        if (u >= 2048) break;
        const int ty = u >> 9, r = u & 511, qb = 15 - (r >> 5), bh = r & 31;
        if (ty == 0) { if (a.tmask & 2) att::attn_unit<1>(C, bh, qb, shm); }
        else if (ty == 1) { if (a.tmask & 1) att::attn_unit<0>(C, bh, qb, shm); }
        else if (ty == 2) { if (a.tmask & 4) att::attn_unit<2>(C, bh, qb, shm); }
        else { if (a.tmask & 8) att::attn_unit<3>(C, bh, qb, shm); }
    }
}

__global__ void __launch_bounds__(NWAVES * 64, 2) mk_fwd(Args a) {
    extern __shared__ __attribute__((aligned(16))) unsigned char lds[];
    Frame F; F.lds = (LAS unsigned char*)lds; F.tid = threadIdx.x; F.lane = F.tid & 63; F.wave = __builtin_amdgcn_readfirstlane(F.tid >> 6);
    F.G = gridDim.x; { const int bx = blockIdx.x; F.vcu = (F.G % 8 == 0) ? (bx % 8) * (F.G / 8) + bx / 8 : bx; }
    bf16* HN = (bf16*)(a.ws + WS_HN);
#define PHASE_ON(k) (a.ph_lo <= (k) && (k) < a.ph_hi)
#define LAYER_PHASES(layer) do { \
    if (PHASE_ON(4 * (layer) + 0)) { \
        if ((layer) == 0) { p_weights(F, a); __syncthreads(); } \
        p_consts(F, a, (layer)); \
        p_norm(F, a, (layer), (layer) == 0 ? a.x : a.out); \
    } \
    if (PHASE_ON(4 * (layer) + 1)) { \
        pg8::Gemm g{HN, (const bf16*)(a.ws + WS_WIN) + (size_t)(layer) * NPERM * DM, NTOK, NPERM, DM}; \
        pg8::StaticOrder S; S.init(NTOK, NPERM, F.G, (int)blockIdx.x); \
        pg8::EpiIn E{(bf16*)(a.ws + WS_Q), (bf16*)(a.ws + WS_K), (bf16*)(a.ws + WS_V), (bf16*)(a.ws + WS_G), a.fox_g + (layer) * 128, a.moba_g + (layer) * 128, a.swa_g + (layer) * 128}; \
        pg8::gemm_phase<pg8::EpiIn, pg8::StaticOrder, true, true>(F.lds, g, S, E); \
    } \
    if (PHASE_ON(4 * (layer) + 2)) { p_attn(F, a, (layer)); } \
    if (PHASE_ON(4 * (layer) + 3)) { \
        pg8::Gemm g{HN  , (const bf16*)(a.ws + WS_WOUT) + (size_t)(layer) * DM * DM, NTOK, DM, DM}; \
        pg8::StaticOrder S; S.init(NTOK, DM, F.G, (int)blockIdx.x); \
        pg8::EpiRes E{(layer) == 0 ? a.x : a.out, a.out}; \
        pg8::gemm_phase<pg8::EpiRes, pg8::StaticOrder, true, true>(F.lds, g, S, E); \
    } } while (0)
    LAYER_PHASES(0);
    LAYER_PHASES(1);
}

extern "C" void kernel_launch(void* const* d_in, const int* in_sizes, int n_in, void* d_out, int out_size, void* d_ws, size_t ws_size, hipStream_t stream) {
    static int ok = 0;
    if (ok == 0) {
        if (n_in != 10 || in_sizes[0] != NTOK * DM || out_size != NTOK * DM || ws_size < WS_END) { fprintf(stderr, "kernel_launch: unexpected shapes (n_in %d, in0 %d, out %d, ws %zu)\n", n_in, n_in > 0 ? in_sizes[0] : -1, out_size, ws_size); ok = -1; return; }
        if (hipFuncSetAttribute((const void*)mk_fwd, hipFuncAttributeMaxDynamicSharedMemorySize, LDS_BYTES) != hipSuccess) { fprintf(stderr, "kernel_launch: hipFuncSetAttribute failed\n"); ok = -1; return; }
        ok = 1;
    }
    if (ok < 0) return;
    Args a{};
    a.x = (const float*)d_in[0]; a.norm_gain = (const float*)d_in[1]; a.w_in = (const float*)d_in[2]; a.b_forget = (const float*)d_in[3]; a.fox_g = (const float*)d_in[4];
    a.moba_g = (const float*)d_in[5]; a.swa_g = (const float*)d_in[6]; a.sinks = (const float*)d_in[7]; a.w_out = (const float*)d_in[8]; a.rel_bias = (const float*)d_in[9];
    a.out = (float*)d_out; a.ws = (unsigned char*)d_ws;
    unsigned char* ws = (unsigned char*)d_ws;
    a.tmask = ENGINE_MASK;
    if (hipMemsetAsync(ws + WS_CTL, 0, CTL_ZERO_BYTES, stream) != hipSuccess) { fprintf(stderr, "kernel_launch: memset failed\n"); return; }
    for (int layer = 0; layer < NLAYER; ++layer) {
        for (int sub = 0; sub < 2; ++sub) { a.ph_lo = 4 * layer + sub; a.ph_hi = a.ph_lo + 1; hipLaunchKernelGGL(mk_fwd, dim3(256), dim3(NWAVES * 64), LDS_BYTES, stream, a); }
        km_kernel<<<dim3(16, 32), 64, 0, stream>>>((const bf16*)(ws + WS_K) + pg8::GS, (float*)(ws + WS_KM));
        for (int mode = 0; mode < 4; ++mode) {
            if (ENGINE_MASK & (1 << mode)) continue;
            NArgs n{}; n.Q = (const bf16*)(ws + WS_Q) + mode * pg8::GS; n.K = (const bf16*)(ws + WS_K) + mode * pg8::GS; n.V = (const bf16*)(ws + WS_V) + mode * pg8::GS; n.G = (const bf16*)(ws + WS_G);
            n.Y = (bf16*)(ws + WS_HN); n.LC = (const float*)(ws + WS_LC); n.CTOT = (const float*)(ws + WS_CTOT); n.TAB = (const float*)(ws + WS_TAB); n.KM = (const float*)(ws + WS_KM);
            n.sinks = (const float*)d_in[7] + layer * 4; n.mode = mode;
            naive_attn<<<dim3(64, 32), 64, 0, stream>>>(n);
        }
        a.ph_lo = 4 * layer + 2; a.ph_hi = a.ph_lo + 1; hipLaunchKernelGGL(mk_fwd, dim3(256), dim3(NWAVES * 64), LDS_BYTES, stream, a);
        a.ph_lo = 4 * layer + 3; a.ph_hi = a.ph_lo + 1; hipLaunchKernelGGL(mk_fwd, dim3(256), dim3(NWAVES * 64), LDS_BYTES, stream, a);
    }
}
```

```cpp
#include <hip/hip_runtime.h>
#include <cstdio>
#include <cstdint>
#include <cmath>
namespace pg8 {
#define PG8_LAS __attribute__((address_space(3)))
typedef unsigned short bf16_t;
typedef short bf16x8 __attribute__((ext_vector_type(8)));
typedef float f32x4 __attribute__((ext_vector_type(4)));
typedef unsigned u32x4 __attribute__((ext_vector_type(4)));
constexpr int BM = 256, BK = 64, HALF = 128, HTB = HALF * BK * 2  , STAGE_BYTES = 8 * HTB, NXCD = 8, WGM = 8;

__host__ __device__ __forceinline__ int lds_byte(int r, int c) { const int st = (r >> 4) * 2 + (c >> 5), rr = r & 15, cc = c & 31, ob = rr * 64 + cc * 2; return st * 1024 + (ob ^ (((ob >> 9) & 1) << 5)); }
__host__ __device__ __forceinline__ void stage_rc(int b, int& R, int& C) { const int st = b / 1024, sb = b % 1024, swz = sb ^ (((sb >> 9) & 1) << 5); R = (st >> 1) * 16 + swz / 64; C = (st & 1) * 32 + (swz % 64) / 2; }
__host__ __device__ __forceinline__ int perm32(int rho) { const int n = rho >> 4, i = rho & 15; return 8 * (i >> 2) + 4 * n + (i & 3); }

struct Unit { int pm, pn; };
struct Gemm { const bf16_t* A; const bf16_t* Bt; int M, N, K; };

struct StaticOrder {
    int nM, nN, nwg, G, c;
    __host__ __device__ void init(int M, int N, int G_, int c_) { nM = M / BM; nN = N / BM; nwg = nM * nN; G = G_; c = c_; }
    __host__ __device__ bool next(int i, Unit& u) const {
        const long L = (long)i * G + c; if (L >= nwg) return false;
        int wgid = (int)L; { const int q = nwg / NXCD, r = nwg % NXCD, xcd = wgid % NXCD, off = wgid / NXCD; wgid = (xcd < r ? xcd * (q + 1) : r * (q + 1) + (xcd - r) * q) + off; }
        const int nig = WGM * nN, gid = wgid / nig, fm = gid * WGM, gsz = (nM - fm) < WGM ? (nM - fm) : WGM;
        u.pm = fm + ((wgid % nig) % gsz); u.pn = (wgid % nig) / gsz; return true;
    }
    __device__ __forceinline__ void a_ready(const Unit&) const {}
    __device__ __forceinline__ void done(const Unit&) const {}
};

__device__ __forceinline__ unsigned cvt_pk_bf16(float lo, float hi) { unsigned r; asm volatile("v_cvt_pk_bf16_f32 %0, %1, %2" : "=v"(r) : "v"(lo), "v"(hi)); return r; }
typedef float f32x2 __attribute__((ext_vector_type(2)));
constexpr float C2 = 0.125f * 1.4426950408889634f;
constexpr float RMS_EPS = 1e-6f;
constexpr size_t GS = (size_t)8 * 4 * 4096 * 64;
struct EpiIn {
    static constexpr bool PERM = true, AFTER_DRAIN = false;
    bf16_t *Q, *K, *V, *G; const float *gfox, *gmoba, *gswa; float* KM;
    __device__ __forceinline__ void operator()(const f32x4 (&acc)[2][2][4][2], const Unit& u, int wr, int wc, int fr, int fq) const {
        const int T = u.pn;
        const int b = (u.pm * BM) >> 12, t0 = ((u.pm * BM) & 4095) + wr * 64 + fr;
        int mode = 1, nh = 4, head = wc; float scale = 1.f; const float* gain = nullptr; bf16_t* base = nullptr;
        switch (T) {
            case 0: mode = 0; gain = gfox; scale = C2; base = Q; break;
            case 1: mode = 0; gain = gfox + 64; base = K; break;
            case 2: base = V; break;
            case 4: mode = 0; gain = gmoba; scale = C2; base = Q + GS; break;
            case 5: mode = 0; gain = gmoba + 64; base = K + GS; break;
            case 6: base = V + GS; break;
            case 8: scale = C2; base = Q + 2 * GS; break;
            case 9: base = K + 2 * GS; break;
            case 10: base = V + 2 * GS; break;
            case 12: mode = 0; gain = gswa; scale = C2; base = Q + 3 * GS; break;
            case 13: nh = 2; if (wc < 2) { mode = 0; gain = gswa + 64; base = K + 3 * GS; } else { base = V + 3 * GS; head = wc - 2; } break;
            default: mode = 2; break;
        }
        if (mode == 2) {
            bf16_t* gp = G + (size_t)(u.pm * BM + wr * 64 + fr) * 1024 + (T >> 2) * 256 + 64 * wc + 8 * fq;
#pragma unroll
            for (int ai = 0; ai < 2; ++ai)
#pragma unroll
                for (int m = 0; m < 4; ++m)
#pragma unroll
                    for (int bj = 0; bj < 2; ++bj) {
                        f32x4 v0 = acc[ai][bj][m][0], v1 = acc[ai][bj][m][1];
#pragma unroll
                        for (int j = 0; j < 4; ++j) { v0[j] = v0[j] / (1.f + __expf(-v0[j])); v1[j] = v1[j] / (1.f + __expf(-v1[j])); }
                        u32x4 w; w.x = cvt_pk_bf16(v0[0], v0[1]); w.y = cvt_pk_bf16(v0[2], v0[3]); w.z = cvt_pk_bf16(v1[0], v1[1]); w.w = cvt_pk_bf16(v1[2], v1[3]);
                        *(u32x4*)(gp + (size_t)(ai * HALF + m * 16) * 1024 + 32 * bj) = w;
                    }
            return;
        }
        f32x4 gv[2][2];
#pragma unroll
        for (int bj = 0; bj < 2; ++bj)
#pragma unroll
            for (int n = 0; n < 2; ++n) gv[bj][n] = (mode == 0) ? *(const f32x4*)(gain + 32 * bj + 8 * fq + 4 * n) : (f32x4){1.f, 1.f, 1.f, 1.f};
        bf16_t* dp = base + ((size_t)(b * nh + head) * 4096 + t0) * 64 + 8 * fq;
        f32x4 cs4[2][2];
#pragma unroll
        for (int bj = 0; bj < 2; ++bj)
#pragma unroll
            for (int n = 0; n < 2; ++n) cs4[bj][n] = (f32x4){0.f, 0.f, 0.f, 0.f};
#pragma unroll
        for (int ai = 0; ai < 2; ++ai)
#pragma unroll
            for (int m = 0; m < 4; ++m) {
                float r = scale;
                if (mode == 0) {
                    float ss = 0.f;
#pragma unroll
                    for (int bj = 0; bj < 2; ++bj)
#pragma unroll
                        for (int n = 0; n < 2; ++n) { const f32x4 x = acc[ai][bj][m][n]; ss += (x[0] * x[0] + x[1] * x[1]) + (x[2] * x[2] + x[3] * x[3]); }
                    ss += __shfl_xor(ss, 16); ss += __shfl_xor(ss, 32);
                    r = scale / sqrtf(ss * (1.0f / 64.0f) + RMS_EPS);
                }
#pragma unroll
                for (int bj = 0; bj < 2; ++bj) {
                    const f32x4 v0 = acc[ai][bj][m][0] * gv[bj][0] * r, v1 = acc[ai][bj][m][1] * gv[bj][1] * r;
                    if (T == 5) { cs4[bj][0] += v0; cs4[bj][1] += v1; }
                    u32x4 w; w.x = cvt_pk_bf16(v0[0], v0[1]); w.y = cvt_pk_bf16(v0[2], v0[3]); w.z = cvt_pk_bf16(v1[0], v1[1]); w.w = cvt_pk_bf16(v1[2], v1[3]);
                    *(u32x4*)(dp + (size_t)(ai * HALF + m * 16) * 64 + 32 * bj) = w;
                }
            }
        if (T == 5) {
            float* kmp = KM + ((size_t)((b * 4 + wc) * 16 + (((u.pm * BM) & 4095) >> 8))) * 64 + 8 * fq;
#pragma unroll
            for (int bj = 0; bj < 2; ++bj)
#pragma unroll
                for (int n = 0; n < 2; ++n)
#pragma unroll
                    for (int j = 0; j < 4; ++j) { float s = cs4[bj][n][j];
                        s += __shfl_xor(s, 1); s += __shfl_xor(s, 2); s += __shfl_xor(s, 4); s += __shfl_xor(s, 8);
                        if (fr == 0) atomicAdd(kmp + 32 * bj + 4 * n + j, s * (1.0f / 256.0f)); }
        }
    }
};
struct EpiRes {
    static constexpr bool PERM = false, AFTER_DRAIN = false;
    const float* base; float* out;
    __device__ __forceinline__ void operator()(const f32x4 (&acc)[2][2][4][2], const Unit& u, int wr, int wc, int fr, int fq) const {
        const int col0 = u.pn * BM + wc * 32 + 4 * fq;
#pragma unroll
        for (int ai = 0; ai < 2; ++ai)
#pragma unroll
            for (int m = 0; m < 4; ++m) {
                const size_t off = (size_t)(u.pm * BM + ai * HALF + wr * 64 + m * 16 + fr) * 1024 + col0;
#pragma unroll
                for (int bj = 0; bj < 2; ++bj)
#pragma unroll
                    for (int n = 0; n < 2; ++n) { const f32x4 bs = *(const f32x4*)(base + off + bj * HALF + n * 16); *(f32x4*)(out + off + bj * HALF + n * 16) = bs + acc[ai][bj][m][n]; }
            }
    }
};

template <class Epi, class Sched, bool ALIGN_EPI = false, bool SP2 = false>
__device__ __forceinline__ void gemm_phase(PG8_LAS unsigned char* lds, const Gemm g, const Sched& S, const Epi& E) {
    const int tid = threadIdx.x, wid = __builtin_amdgcn_readfirstlane(tid >> 6), lane = tid & 63, wr = wid >> 2, wc = wid & 3, fr = lane & 15, fq = lane >> 4;
    const int K = g.K, nt = K / BK;
    unsigned voffA[2], voffB[2];
#pragma unroll
    for (int i = 0; i < 2; ++i) { int R, C; stage_rc(tid * 16 + i * 8192, R, C); const int Rb = Epi::PERM ? ((R & ~31) + perm32(R & 31)) : R;
        voffA[i] = (unsigned)(R * K + C) * 2u; voffB[i] = (unsigned)(Rb * K + C) * 2u; }
    const size_t kstep = (size_t)(BK * 2);
    const size_t hstep = (size_t)HALF * K * 2;
    const size_t tstep = 2 * hstep;
    const unsigned ldsw = (unsigned)wid * 1024u;
    const int aoff = lds_byte(wr * 64 + fr, fq * 8), boff = lds_byte(wc * 32 + fr, fq * 8);
#define PG8_SA(b, h) (((b) * 2 + (h)) * HTB)
#define PG8_SB(b, h) ((4 + (b) * 2 + (h)) * HTB)
#define PG8_STAGE(bufoff, gbase, voff) do { _Pragma("unroll") for (int _i = 0; _i < 2; ++_i) \
        __builtin_amdgcn_global_load_lds((const unsigned*)((const char*)(gbase) + (voff)[_i]), (PG8_LAS unsigned*)(lds + (bufoff) + ldsw + _i * 8192), 16, 0, 0); } while (0)
#define PG8_LDA(dst, b, h) do { _Pragma("unroll") for (int m = 0; m < 4; ++m) _Pragma("unroll") for (int k = 0; k < 2; ++k) dst[m][k] = *(const PG8_LAS bf16x8*)(lds + PG8_SA(b, h) + aoff + m * 2048 + k * 1024); } while (0)
#define PG8_LDB(dst, b, h) do { _Pragma("unroll") for (int n = 0; n < 2; ++n) _Pragma("unroll") for (int k = 0; k < 2; ++k) dst[n][k] = *(const PG8_LAS bf16x8*)(lds + PG8_SB(b, h) + boff + n * 2048 + k * 1024); } while (0)
#define PG8_MMA(ai, bj, At, Bt) do { __builtin_amdgcn_s_setprio(1); _Pragma("unroll") for (int m = 0; m < 4; ++m) _Pragma("unroll") for (int n = 0; n < 2; ++n) _Pragma("unroll") for (int k = 0; k < 2; ++k) \
        acc[ai][bj][m][n] = __builtin_amdgcn_mfma_f32_16x16x32_bf16(Bt[n][k], At[m][k], acc[ai][bj][m][n], 0, 0, 0); __builtin_amdgcn_s_setprio(0); } while (0)
#define PG8_WAIT_V(n) asm volatile("s_waitcnt vmcnt(" #n ")" ::: "memory")
#define PG8_WAIT_L(n) asm volatile("s_waitcnt lgkmcnt(" #n ")" ::: "memory")
#define PG8_BAR __builtin_amdgcn_s_barrier()
#define PG8_SCHED __builtin_amdgcn_sched_barrier(0)
    Unit cur, nxt; int ui = 0;
    if (!S.next(0, cur)) return;
    f32x4 acc[2][2][4][2];
#pragma unroll
    for (int a = 0; a < 2; ++a)
#pragma unroll
        for (int b = 0; b < 2; ++b)
#pragma unroll
            for (int m = 0; m < 4; ++m)
#pragma unroll
                for (int n = 0; n < 2; ++n) acc[a][b][m][n] = (f32x4){0.f, 0.f, 0.f, 0.f};
    bf16x8 At[4][2], B0[2][2], B1[2][2];
    const char* cA = (const char*)g.A + (size_t)cur.pm * tstep; const char* cB = (const char*)g.Bt + (size_t)cur.pn * tstep;
    S.a_ready(cur);
    if constexpr (SP2) {
        PG8_STAGE(PG8_SB(0, 0), cB, voffB); PG8_STAGE(PG8_SB(0, 1), cB + hstep, voffB); PG8_STAGE(PG8_SA(0, 0), cA, voffA); PG8_STAGE(PG8_SA(0, 1), cA + hstep, voffA);
        if (wr == 1) PG8_BAR;
        PG8_WAIT_V(2); PG8_BAR;
        PG8_STAGE(PG8_SB(1, 0), cB + kstep, voffB); PG8_STAGE(PG8_SA(1, 0), cA + kstep, voffA); PG8_STAGE(PG8_SB(1, 1), cB + hstep + kstep, voffB);
        PG8_WAIT_V(6); PG8_BAR;
    } else {
        PG8_STAGE(PG8_SB(0, 0), cB, voffB); PG8_STAGE(PG8_SA(0, 0), cA, voffA); PG8_STAGE(PG8_SB(0, 1), cB + hstep, voffB); PG8_STAGE(PG8_SA(0, 1), cA + hstep, voffA);
        if (wr == 1) PG8_BAR;
        PG8_WAIT_V(4); PG8_BAR;
        PG8_STAGE(PG8_SB(1, 0), cB + kstep, voffB); PG8_STAGE(PG8_SA(1, 0), cA + kstep, voffA); PG8_STAGE(PG8_SB(1, 1), cB + hstep + kstep, voffB);
        PG8_WAIT_V(6); PG8_BAR;
    }
    for (;;) {
        const bool has_next = S.next(ui + 1, nxt);
        const char* nA = has_next ? (const char*)g.A + (size_t)nxt.pm * tstep : cA; const char* nB = has_next ? (const char*)g.Bt + (size_t)nxt.pn * tstep : cB;
        for (int t = 0; t < nt; t += 2) {
            const bool last = (t == nt - 2);
            const char* a1 = cA + (size_t)(t + 1) * kstep;
            const char* a2 = last ? nA : cA + (size_t)(t + 2) * kstep; const char* b2 = last ? nB : cB + (size_t)(t + 2) * kstep;
            const char* a3 = a2 + kstep; const char* b3 = b2 + kstep;
            if (last && has_next) S.a_ready(nxt);
            if constexpr (SP2) {
            PG8_LDB(B0, 0, 0); PG8_LDB(B1, 0, 1); PG8_SCHED; PG8_LDA(At, 0, 0); PG8_STAGE(PG8_SA(1, 1), a1 + hstep, voffA);
            PG8_WAIT_V(8); PG8_WAIT_L(0); PG8_BAR; PG8_MMA(0, 0, At, B0); PG8_MMA(0, 1, At, B1); PG8_BAR; PG8_SCHED;
            PG8_LDA(At, 0, 1); PG8_STAGE(PG8_SB(0, 0), b2, voffB); PG8_STAGE(PG8_SB(0, 1), b2 + hstep, voffB); PG8_STAGE(PG8_SA(0, 0), a2, voffA);
            PG8_WAIT_V(8); PG8_WAIT_L(0); PG8_BAR; PG8_MMA(1, 0, At, B0); PG8_MMA(1, 1, At, B1); PG8_BAR; PG8_SCHED;
            PG8_LDB(B0, 1, 0); PG8_LDB(B1, 1, 1); PG8_SCHED; PG8_LDA(At, 1, 0); PG8_STAGE(PG8_SA(0, 1), a2 + hstep, voffA);
            PG8_WAIT_V(8); PG8_WAIT_L(0); PG8_BAR; PG8_MMA(0, 0, At, B0); PG8_MMA(0, 1, At, B1); PG8_BAR; PG8_SCHED;
            PG8_LDA(At, 1, 1); PG8_STAGE(PG8_SB(1, 0), b3, voffB); PG8_STAGE(PG8_SB(1, 1), b3 + hstep, voffB); PG8_STAGE(PG8_SA(1, 0), a3, voffA);
            PG8_WAIT_V(8); PG8_WAIT_L(0); PG8_BAR; PG8_MMA(1, 0, At, B0); PG8_MMA(1, 1, At, B1); PG8_BAR; PG8_SCHED;
            } else {
            PG8_LDB(B0, 0, 0); PG8_SCHED; PG8_LDA(At, 0, 0); PG8_STAGE(PG8_SA(1, 1), a1 + hstep, voffA);
            PG8_WAIT_L(8); PG8_BAR; PG8_WAIT_L(0); PG8_MMA(0, 0, At, B0); PG8_BAR; PG8_SCHED;
            PG8_LDB(B1, 0, 1); PG8_STAGE(PG8_SB(0, 0), b2, voffB);
            PG8_BAR; PG8_WAIT_L(0); PG8_MMA(0, 1, At, B1); PG8_BAR;
            PG8_LDA(At, 0, 1); PG8_STAGE(PG8_SA(0, 0), a2, voffA);
            PG8_BAR; PG8_WAIT_L(0); PG8_MMA(1, 0, At, B0); PG8_BAR; PG8_SCHED;
            PG8_STAGE(PG8_SB(0, 1), b2 + hstep, voffB);
            PG8_WAIT_V(6); PG8_BAR; PG8_MMA(1, 1, At, B1); PG8_BAR;
            PG8_LDB(B0, 1, 0); PG8_SCHED; PG8_LDA(At, 1, 0); PG8_STAGE(PG8_SA(0, 1), a2 + hstep, voffA);
            PG8_WAIT_L(8); PG8_BAR; PG8_WAIT_L(0); PG8_MMA(0, 0, At, B0); PG8_BAR; PG8_SCHED;
            PG8_LDB(B1, 1, 1); PG8_STAGE(PG8_SB(1, 0), b3, voffB);
            PG8_BAR; PG8_WAIT_L(0); PG8_MMA(0, 1, At, B1); PG8_BAR;
            PG8_LDA(At, 1, 1); PG8_STAGE(PG8_SA(1, 0), a3, voffA);
            PG8_BAR; PG8_WAIT_L(0); PG8_MMA(1, 0, At, B0); PG8_BAR; PG8_SCHED;
            PG8_STAGE(PG8_SB(1, 1), b3 + hstep, voffB);
            PG8_WAIT_V(6); PG8_BAR; PG8_MMA(1, 1, At, B1); PG8_BAR;
            }
        }
        if constexpr (ALIGN_EPI) { if (wr == 0) PG8_BAR; }
        if constexpr (!Epi::AFTER_DRAIN) { E(acc, cur, wr, wc, fr, fq); S.done(cur); }
        if (!has_next) break;
#pragma unroll
        for (int a = 0; a < 2; ++a)
#pragma unroll
            for (int b = 0; b < 2; ++b)
#pragma unroll
                for (int m = 0; m < 4; ++m)
#pragma unroll
                    for (int n = 0; n < 2; ++n) acc[a][b][m][n] = (f32x4){0.f, 0.f, 0.f, 0.f};
        cur = nxt; cA = nA; cB = nB; ++ui;
        if constexpr (ALIGN_EPI) { if (wr == 1) PG8_BAR; }
    }
    PG8_WAIT_V(0);
    if constexpr (!ALIGN_EPI) { if (wr == 0) PG8_BAR; }
    PG8_BAR;
    if constexpr (Epi::AFTER_DRAIN) { E.fused(acc, cur, wr, wc, fr, fq, lds, wid, lane); S.done(cur); }
#undef PG8_SA
#undef PG8_SB
#undef PG8_STAGE
#undef PG8_LDA
#undef PG8_LDB
#undef PG8_MMA
#undef PG8_WAIT_V
#undef PG8_WAIT_L
#undef PG8_BAR
#undef PG8_SCHED
}
}
constexpr int NB = 8, SEQ = 4096, DM = 1024, NTOK = NB * SEQ, INW = 3844, NPERM = 3840, NLAYER = 2;
constexpr size_t MiB = 1u << 20;
constexpr size_t WS_CTL = 0, CTL_ZERO_BYTES = 1 * MiB;
constexpr size_t WS_WIN = 2 * MiB;
constexpr size_t WS_WOUT = 18 * MiB;
constexpr size_t WS_LC = 22 * MiB;
constexpr size_t WS_CTOT = 22 * MiB + 512 * 1024;
constexpr size_t WS_TAB = 23 * MiB;
constexpr size_t WS_KM = 24 * MiB;
constexpr size_t WS_MF = 25 * MiB;
constexpr int CW_BAR = 4096;
constexpr int CW_QUEUE = 64;
constexpr size_t WS_HN = 32 * MiB;
constexpr size_t WS_Q = 96 * MiB, WS_K = 160 * MiB, WS_V = 216 * MiB, WS_G = 272 * MiB, WS_END = 336 * MiB;
constexpr float LOG2E = 1.4426950408889634f;
constexpr int NWAVES = 8;
#ifndef N_LAUNCHES
#define N_LAUNCHES 1
#endif
constexpr int RING_BYTES = 131072, LDSCTL_OFF = RING_BYTES, MISC_OFF = LDSCTL_OFF + 320, LDS_BYTES = 147456;

#define GAS __attribute__((address_space(1)))
#define LAS __attribute__((address_space(3)))
typedef unsigned short bf16;
typedef unsigned v4u __attribute__((ext_vector_type(4)));
typedef float f32x4 __attribute__((ext_vector_type(4)));
__device__ __forceinline__ unsigned f2bf(float f) { unsigned u = __builtin_bit_cast(unsigned, f); return (u + 0x7fffu + ((u >> 16) & 1u)) >> 16; }
__device__ __forceinline__ unsigned pk2(float lo, float hi) { return f2bf(lo) | (f2bf(hi) << 16); }
__device__ __forceinline__ float bf2f(unsigned v) { return __uint_as_float(v << 16); }
__device__ __forceinline__ float wave_sum(float v) {
#pragma unroll
    for (int o = 1; o < 64; o <<= 1) v += __shfl_xor(v, o);
    return v;
}
#define RLX_AGENT __ATOMIC_RELAXED, __HIP_MEMORY_SCOPE_AGENT
#define XB_TMO      128
#define XB_XCNT(j)  (256  + 64 * (j))
#define XB_XSUB(j)  (1280 + 64 * (j))
#define XB_XGEN(j)  (2304 + 64 * (j))
#define XB_TOP      3328
#define XB_TOPGEN   3392
#define XCD_BAR_WORDS 3456
#define XB_SPIN_CAP (1u << 18)

__device__ __forceinline__ unsigned xb_ld(unsigned* p)              { return __hip_atomic_load(p, __ATOMIC_RELAXED, __HIP_MEMORY_SCOPE_AGENT); }
__device__ __forceinline__ unsigned xb_add(unsigned* p, unsigned v) { return __hip_atomic_fetch_add(p, v, __ATOMIC_RELAXED, __HIP_MEMORY_SCOPE_AGENT); }
__device__ __forceinline__ unsigned xb_xcc_id() { return (unsigned)__builtin_amdgcn_s_getreg((3 << 11) | 20) & 0xFu; }
#define XB_SPIN(cond, bar) do { unsigned _sp = 0; while (cond) { __builtin_amdgcn_s_sleep(1); \
    if ((++_sp & 255u) == 0u) { if (xb_ld(&(bar)[XB_TMO])) break; if (_sp > XB_SPIN_CAP) { atomicAdd(&(bar)[XB_TMO], 1u); break; } } } } while (0)

struct XcdBarrier {
    unsigned* bar; unsigned x;
    volatile LAS unsigned* st;
};

__device__ __forceinline__ XcdBarrier xcd_barrier_post(unsigned* bar, volatile LAS unsigned* st) {
    XcdBarrier b; b.bar = bar; b.x = xb_xcc_id(); b.st = st;
    if (threadIdx.x == 0) (void)xb_add(&bar[XB_XCNT(b.x)], 1u);
    return b;
}
__device__ __forceinline__ void xcd_barrier_complete(unsigned* bar, unsigned x, unsigned& nloc, unsigned& nx) {
    const unsigned G = gridDim.x * gridDim.y * gridDim.z;
    unsigned sum, cnt, mine, sp = 0u;
    for (;;) {
        sum = 0u; cnt = 0u; mine = 0u;
#pragma unroll
        for (unsigned j = 0; j < 16; ++j) { const unsigned c = xb_ld(&bar[XB_XCNT(j)]); sum += c; cnt += (c > 0u) ? 1u : 0u; mine = (j == x) ? c : mine; }
        if (sum == G) break;
        __builtin_amdgcn_s_sleep(1);
        if ((++sp & 255u) == 0u) { if (xb_ld(&bar[XB_TMO])) break; if (sp > XB_SPIN_CAP) { atomicAdd(&bar[XB_TMO], 1u); break; } }
    }
    nloc = mine > 0u ? mine : 1u; nx = cnt > 0u ? cnt : 1u;
}

__device__ __forceinline__ void xcd_barrier(const XcdBarrier& b) {
    asm volatile("s_waitcnt vmcnt(0)" ::: "memory");
    __syncthreads();
    if (threadIdx.x == 0) {
        unsigned* bar = b.bar;
        __builtin_amdgcn_s_waitcnt(0);
        unsigned nloc = b.st[0], nx = b.st[1];
        if (nloc == 0u) { xcd_barrier_complete(bar, b.x, nloc, nx); b.st[0] = nloc; b.st[1] = nx; }
        const unsigned old = xb_add(&bar[XB_XSUB(b.x)], 1u);
        const unsigned gen = old / nloc;
        if (old + 1u == (gen + 1u) * nloc) {
            __builtin_amdgcn_fence(__ATOMIC_RELEASE, "agent");
            asm volatile("s_waitcnt vmcnt(0)" ::: "memory");
            const unsigned og = xb_add(&bar[XB_TOP], 1u);
            const unsigned tg = og / nx;
            if (og + 1u == (tg + 1u) * nx) xb_add(&bar[XB_TOPGEN], 1u);
            else XB_SPIN(xb_ld(&bar[XB_TOPGEN]) == tg, bar);
            __builtin_amdgcn_fence(__ATOMIC_ACQUIRE, "agent");
            xb_add(&bar[XB_XGEN(b.x)], 1u);
            asm volatile("s_waitcnt vmcnt(0)" ::: "memory");
        } else {
            XB_SPIN(xb_ld(&bar[XB_XGEN(b.x)]) == gen, bar);
            __builtin_amdgcn_fence(__ATOMIC_ACQUIRE, "agent");
            asm volatile("s_waitcnt vmcnt(0)" ::: "memory");
        }
    }
    __syncthreads();
}

__device__ __forceinline__ int rel_bucket(int d) {
    if (d < 16) return d;
    int b = 16;
    b += (d >= 21); b += (d >= 27); b += (d >= 35); b += (d >= 46); b += (d >= 59); b += (d >= 77); b += (d >= 99); b += (d >= 128);
    b += (d >= 166); b += (d >= 216); b += (d >= 280); b += (d >= 363); b += (d >= 470); b += (d >= 609); b += (d >= 790);
    return b;
}

struct Args { const float* x; const float* norm_gain; const float* w_in; const float* b_forget; const float* fox_g; const float* moba_g; const float* swa_g; const float* sinks; const float* w_out; const float* rel_bias; float* out; unsigned char* ws; int ph_lo, ph_hi, tmask, pad; };

struct Frame { LAS unsigned char* lds; int tid, lane, wave, vcu, G; };

__device__ __forceinline__ void transpose_item(const float* W, int ldw, bf16* WT, int dst_row0, int src_col0, LAS float* scr, int kb, int lane) {
    const int k0 = 64 * kb;
#pragma unroll 8
    for (int i = 0; i < 32; ++i) { const int kk = 2 * i + (lane >> 5); scr[kk * 33 + (lane & 31)] = W[(size_t)(k0 + kk) * ldw + src_col0 + (lane & 31)]; }
    asm volatile("s_waitcnt lgkmcnt(0)" ::: "memory");
    const int c = lane & 7;
#pragma unroll
    for (int j = 0; j < 4; ++j) { const int n = (lane >> 3) + 8 * j; const LAS float* s = scr + (8 * c) * 33 + n;
        v4u o; o.x = pk2(s[0 * 33], s[1 * 33]); o.y = pk2(s[2 * 33], s[3 * 33]); o.z = pk2(s[4 * 33], s[5 * 33]); o.w = pk2(s[6 * 33], s[7 * 33]);
        *(v4u*)(WT + (size_t)(dst_row0 + n) * 1024 + k0 + 8 * c) = o; }
    asm volatile("s_waitcnt lgkmcnt(0)" ::: "memory");
}
__device__ __forceinline__ int tile_src(int T, int wc) {
    switch (T) { case 0: return 0 + 64 * wc; case 1: return 256 + 64 * wc; case 2: return 512 + 64 * wc; case 3: return 772 + 64 * wc;
        case 4: return 1028 + 64 * wc; case 5: return 1284 + 64 * wc; case 6: return 1540 + 64 * wc; case 7: return 1796 + 64 * wc;
        case 8: return 2052 + 64 * wc; case 9: return 2308 + 64 * wc; case 10: return 2564 + 64 * wc; case 11: return 2820 + 64 * wc;
        case 12: return 3076 + 64 * wc; case 13: return wc < 2 ? 3332 + 64 * wc : 3460 + 64 * (wc - 2); default: return 3588 + 64 * wc; }
}
__device__ __forceinline__ void p_weights(Frame& F, const Args& a) {
    LAS float* scr = (LAS float*)(F.lds + F.wave * 16384);
    const int gw = F.vcu * NWAVES + F.wave, NGW = F.G * NWAVES;
    bf16* win = (bf16*)(a.ws + WS_WIN); bf16* wout = (bf16*)(a.ws + WS_WOUT);
    constexpr int I_IN = 120 * 16, I_OUT = 32 * 16;
    for (int it = gw; it < 2 * (I_IN + I_OUT); it += NGW) {
        const int layer = it / (I_IN + I_OUT); int r = it % (I_IN + I_OUT);
        if (r < I_IN) { const int kb = r / 120, g = r % 120, T = g >> 3, gg = g & 7, bj = gg >> 2, wc = gg & 3;
            transpose_item(a.w_in + (size_t)layer * DM * INW, INW, win + (size_t)layer * NPERM * DM, 32 * g, tile_src(T, wc) + 32 * bj, scr, kb, F.lane); }
        else { r -= I_IN; const int kb = r / 32, g = r % 32;
            transpose_item(a.w_out + (size_t)layer * DM * DM, DM, wout + (size_t)layer * DM * DM, 32 * g, 32 * g, scr, kb, F.lane); }
    }
    if (F.vcu == 0) { float* tab = (float*)(a.ws + WS_TAB);
        for (int i = F.tid; i < 8 * 1024; i += NWAVES * 64) { const int hc = i >> 10, d = i & 1023; tab[i] = a.rel_bias[rel_bucket(d) * 8 + hc] * LOG2E; } }
}
__device__ __forceinline__ void p_consts(Frame& F, const Args& a, int layer) {
    if (F.vcu == 0 && F.wave == 0) {
        const int lane = F.lane; float* MF = (float*)(a.ws + WS_MF) + layer * 4;
        float bm = 0.f;
#pragma unroll
        for (int j = 0; j < 4; ++j) bm = fmaxf(bm, fabsf(a.rel_bias[64 * j + lane]));
#pragma unroll
        for (int o = 1; o < 64; o <<= 1) bm = fmaxf(bm, __shfl_xor(bm, o));
        const float* gp[3] = {a.fox_g + layer * 128, a.moba_g + layer * 128, a.swa_g + layer * 128};
#pragma unroll
        for (int k = 0; k < 3; ++k) { float mq = fabsf(gp[k][lane]), mk = fabsf(gp[k][64 + lane]);
#pragma unroll
            for (int o = 1; o < 64; o <<= 1) { mq = fmaxf(mq, __shfl_xor(mq, o)); mk = fmaxf(mk, __shfl_xor(mk, o)); }
            const float m = 8.f * LOG2E * mq * mk * 1.02f + 0.1f + (k == 0 ? 0.f : bm * LOG2E);
            if (lane == 0) MF[k == 0 ? 0 : (k == 1 ? 1 : 3)] = m; }
        if (lane == 0) MF[2] = 0.f;
    }
}
__device__ __forceinline__ void p_norm(Frame& F, const Args& a, int layer, const float* xin) {
    LAS float* lfs = (LAS float*)F.lds;
    const int lane = F.lane;
    { float* KM = (float*)(a.ws + WS_KM); for (int i = F.vcu * (NWAVES * 64) + F.tid; i < 32 * 16 * 64; i += F.G * NWAVES * 64) KM[i] = 0.f; }
    const float* gain = a.norm_gain + layer * DM; const float* wl = a.w_in + (size_t)layer * DM * INW;
    f32x4 g[4], gw[4][4];
#pragma unroll
    for (int j = 0; j < 4; ++j) { g[j] = *(const f32x4*)(gain + 256 * j + 4 * lane);
#pragma unroll
        for (int i = 0; i < 4; ++i) { gw[j][i] = *(const f32x4*)(wl + (size_t)(256 * j + 4 * lane + i) * INW + 768) * g[j][i]; } }
    f32x4 bfv = *(const f32x4*)(a.b_forget + layer * 4);
    bf16* HN = (bf16*)(a.ws + WS_HN);
    for (int chunk = F.vcu; chunk < NTOK / 128; chunk += F.G) {
    const int b = chunk >> 5, cidx = chunk & 31;
    for (int r = 0; r < 16; ++r) {
        const int rl = 16 * F.wave + r; const size_t row = (size_t)128 * chunk + rl;
        const f32x4* xr = (const f32x4*)(xin + row * DM) + lane;
        f32x4 v[4]; float ss = 0.f; f32x4 p = {0.f, 0.f, 0.f, 0.f};
#pragma unroll
        for (int j = 0; j < 4; ++j) { v[j] = xr[64 * j]; ss += (v[j][0] * v[j][0] + v[j][1] * v[j][1]) + (v[j][2] * v[j][2] + v[j][3] * v[j][3]);
#pragma unroll
            for (int i = 0; i < 4; ++i) p += gw[j][i] * v[j][i]; }
        const float rstd = 1.0f / sqrtf(wave_sum(ss) * (1.0f / DM) + pg8::RMS_EPS);
        unsigned long long* o8 = (unsigned long long*)(HN + row * DM) + lane;
#pragma unroll
        for (int j = 0; j < 4; ++j) { const f32x4 y = v[j] * rstd * g[j]; o8[64 * j] = (unsigned long long)pk2(y[0], y[1]) | ((unsigned long long)pk2(y[2], y[3]) << 32); }
#pragma unroll
        for (int h = 0; h < 4; ++h) { const float u = wave_sum(p[h]) * rstd + bfv[h];
            const float sp = fmaxf(-u, 0.f) + log1pf(expf(-fabsf(u)));
            if (lane == 0) lfs[h * 128 + rl] = -sp * LOG2E; }
    }
    __syncthreads();
    if (F.wave < 4) { const int h = F.wave; const float x0 = lfs[h * 128 + 2 * lane], x1 = lfs[h * 128 + 2 * lane + 1]; float s = x0 + x1;
#pragma unroll
        for (int o = 1; o < 64; o <<= 1) { const float t = __shfl_up(s, o); if (lane >= o) s += t; }
        float* LC = (float*)(a.ws + WS_LC) + (size_t)(b * 4 + h) * SEQ + cidx * 128 + 2 * lane; LC[0] = s - x1; LC[1] = s;
        if (lane == 63) ((float*)(a.ws + WS_CTOT))[(b * 4 + h) * 32 + cidx] = s; }
    __syncthreads();
    }
}

namespace att {
using bf16x8 = __attribute__((ext_vector_type(8))) short;
using s16x4 = __attribute__((ext_vector_type(4))) short;
using f32x16 = __attribute__((ext_vector_type(16))) float;
using u32x4 = __attribute__((ext_vector_type(4))) unsigned;
typedef __attribute__((address_space(3))) const char* lds_cptr;
typedef __attribute__((address_space(3))) char* lds_ptr;
typedef short v4i16_t __attribute__((ext_vector_type(4)));
typedef float f32x2_t __attribute__((ext_vector_type(2))); typedef __bf16 bf16x2_t __attribute__((ext_vector_type(2)));
constexpr int NSLOT = 3, SLOTB = 8192;
constexpr int L_K = 0, L_V = NSLOT * SLOTB, L_WS = 2 * NSLOT * SLOTB, L_OST = L_WS + 8 * 256, L_TAB = L_OST + 8 * 4096, L_CS = L_TAB + 4096, L_MISC = L_CS + 16384, L_END = L_MISC + 1024;
static_assert(L_END <= 131072, "attention LDS map");
constexpr float THR2 = 90.f;
#define SBAR() __builtin_amdgcn_sched_barrier(0)
__device__ __forceinline__ int crow(int r, int hi) { return (r & 3) + 8 * (r >> 2) + 4 * hi; }
__device__ __forceinline__ void glds16(const void* gsrc, unsigned lds_dst) { unsigned keep;
    asm volatile("s_mov_b32 %0, m0\n\ts_mov_b32 m0, %2\n\ts_nop 0\n\tglobal_load_lds_dwordx4 %1, off\n\ts_mov_b32 m0, %0" : "=&s"(keep) : "v"(gsrc), "s"(lds_dst) : "memory"); }
__device__ __forceinline__ unsigned cvtpk_s(float lo, float hi) { f32x2_t v = {lo, hi}; bf16x2_t b = __builtin_convertvector(v, bf16x2_t); return __builtin_bit_cast(unsigned, b); }
__device__ __forceinline__ s16x4 vtr(lds_cptr p) { return __builtin_bit_cast(s16x4, __builtin_amdgcn_ds_read_tr16_b64_v4i16((__attribute__((address_space(3))) v4i16_t*)p)); }
#define MFMA32(a, b, c) __builtin_amdgcn_mfma_f32_32x32x16_bf16(a, b, c, 0, 0, 0)
__device__ __forceinline__ void qkt(f32x16& p0, f32x16& p1, lds_cptr kp, const bf16x8* qr, float cinit) {
    f32x16 c;
#pragma unroll
    for (int r = 0; r < 16; ++r) c[r] = cinit;
    p0 = c; p1 = c;
#pragma unroll
    for (int d0 = 0; d0 < 4; ++d0) {
        const bf16x8 b0 = *(const __attribute__((address_space(3))) bf16x8*)(kp + d0 * 2048);
        const bf16x8 b1 = *(const __attribute__((address_space(3))) bf16x8*)(kp + d0 * 2048 + 512);
        p0 = MFMA32(b0, qr[d0], p0); p1 = MFMA32(b1, qr[d0], p1);
    }
}
__device__ __forceinline__ void pv(f32x16* o, lds_cptr vp, bf16x8 pa0, bf16x8 pa1, bf16x8 pa2, bf16x8 pa3) {
#pragma unroll
    for (int d0 = 0; d0 < 2; ++d0) { s16x4 lo[4], hi[4];
#pragma unroll
        for (int ks = 0; ks < 4; ++ks) { lo[ks] = vtr(vp + d0 * 4096 + ks * 1024); hi[ks] = vtr(vp + d0 * 4096 + ks * 1024 + 512); }
#define PK(k) (bf16x8){lo[k][0], lo[k][1], lo[k][2], lo[k][3], hi[k][0], hi[k][1], hi[k][2], hi[k][3]}
        o[d0] = MFMA32(pa0, PK(0), o[d0]); o[d0] = MFMA32(pa1, PK(1), o[d0]); o[d0] = MFMA32(pa2, PK(2), o[d0]); o[d0] = MFMA32(pa3, PK(3), o[d0]);
#undef PK
    }
}
struct ACtx { const bf16 *Q, *K, *V, *G; bf16* Y; const float *LC, *CTOT, *TAB, *KM, *MF; const float* sinks; };
#define WAITBAR(N) asm volatile("s_waitcnt vmcnt(" #N ") lgkmcnt(0)\n\ts_barrier" ::: "memory")

template <int TYPE> __device__ __forceinline__ void attn_unit(const ACtx& C, int bh, int qb, lds_ptr shm) {
    const int tid = threadIdx.x, lane = tid & 63, r32 = lane & 31, hi = lane >> 5; const int wid = __builtin_amdgcn_readfirstlane(tid >> 6);
    const int b = bh >> 2, h = bh & 3, q0 = qb * 256, qrel = wid * 32 + r32, t = q0 + qrel;
    const int kvh = (TYPE == 3) ? (b * 2 + (h >> 1)) : bh;
    const bf16* Qw = C.Q + TYPE * pg8::GS + ((size_t)bh * SEQ + q0 + wid * 32) * 64;
    const bf16* Kh = C.K + TYPE * pg8::GS + (size_t)kvh * SEQ * 64; const bf16* Vh = C.V + TYPE * pg8::GS + (size_t)kvh * SEQ * 64;
    const unsigned lds0 = (unsigned)(size_t)shm;
    __attribute__((address_space(3))) float* wsf = (__attribute__((address_space(3))) float*)(shm + L_WS) + wid * 64;
    __attribute__((address_space(3))) float* tabL = (__attribute__((address_space(3))) float*)(shm + L_TAB);
    __attribute__((address_space(3))) float* cs = (__attribute__((address_space(3))) float*)(shm + L_CS);
    __attribute__((address_space(3))) float* misc = (__attribute__((address_space(3))) float*)(shm + L_MISC);
    __attribute__((address_space(3))) int* misci = (__attribute__((address_space(3))) int*)(shm + L_MISC);
    const bf16* ksrc = Kh + (size_t)lane * 64 + wid * 8;
    const bf16* vsrc = Vh + (size_t)(16 * (wid & 3) + (lane >> 2)) * 64 + (wid >> 2) * 32 + (lane & 3) * 8;
    const unsigned kdst = lds0 + L_K + wid * 1024, vdst = lds0 + L_V + wid * 1024;
#define DMA_KV(tile, slot) do { glds16(ksrc + (size_t)(tile) * 4096, (unsigned)__builtin_amdgcn_readfirstlane(kdst + (slot) * SLOTB)); glds16(vsrc + (size_t)(tile) * 4096, (unsigned)__builtin_amdgcn_readfirstlane(vdst + (slot) * SLOTB)); } while (0)
    const lds_cptr kp0 = (lds_cptr)shm + L_K + hi * 1024 + r32 * 16;
    const lds_cptr vp0 = (lds_cptr)shm + L_V + ((lane >> 4) & 1) * 32 + (lane & 3) * 8 + (4 * hi + ((lane & 15) >> 2)) * 64;
    const float Mf = (TYPE == 2) ? 0.f : C.MF[TYPE];
    const int t_hi = 4 * qb + 3; int t_lo = 0;
    if (TYPE == 3) { t_lo = 4 * qb - 2; if (t_lo < 0) t_lo = 0; }
    unsigned sel = 0u; float ct = 0.f;
    if (TYPE == 0) {
        if (wid == 0) { const float v = lane < 32 ? C.CTOT[bh * 32 + lane] : 0.f; float s = v;
#pragma unroll
            for (int o = 1; o < 64; o <<= 1) { const float u = __shfl_up(s, o); if (lane >= o) s += u; }
            if (lane < 32) misc[lane] = s - v; }
        __syncthreads();
        for (int s = tid; s < q0 + 256; s += 512) cs[s] = misc[s >> 7] + C.LC[(size_t)bh * SEQ + s];
        __syncthreads();
        const float cref = cs[q0];
        if (wid == 0) { const bool skip = (lane < 4 * qb) && (cs[64 * lane + 63] - cref > 2.f * Mf + THR2);
            const int cnt = __popcll(__ballot(skip)); if (lane == 0) misci[40] = cnt; }
        __syncthreads();
        t_lo = misci[40]; ct = cs[t];
    }
    if (TYPE == 1 || TYPE == 3) {
        const float* tg = C.TAB + ((TYPE == 3 ? 4 : 0) + h) * 1024;
        for (int i = tid; i < 1024; i += 512) tabL[i] = tg[i];
        if (TYPE == 1) { const float* kg = C.KM + (size_t)bh * 16 * 64; for (int i = tid; i < qb * 64; i += 512) cs[i] = kg[i]; }
        __syncthreads();
        if (TYPE == 1) {
            if (qb <= 3) sel = (1u << qb) - 1u;
            else { float qf[64];
#pragma unroll
                for (int c8 = 0; c8 < 8; ++c8) { const u32x4 w = *(const u32x4*)(Qw + (size_t)r32 * 64 + c8 * 8);
#pragma unroll
                    for (int j = 0; j < 4; ++j) { qf[c8 * 8 + 2 * j] = __uint_as_float(w[j] << 16); qf[c8 * 8 + 2 * j + 1] = __uint_as_float(w[j] & 0xffff0000u); } }
                float v1 = -INFINITY, v2 = -INFINITY, v3 = -INFINITY; int i1 = 0, i2 = 0, i3 = 0;
                for (int n = 0; n < qb; ++n) { float s = 0.f;
#pragma unroll
                    for (int d = 0; d < 64; ++d) s += qf[d] * cs[n * 64 + d];
                    if (s > v1) { v3 = v2; i3 = i2; v2 = v1; i2 = i1; v1 = s; i1 = n; } else if (s > v2) { v3 = v2; i3 = i2; v2 = s; i2 = n; } else if (s > v3) { v3 = s; i3 = n; } }
                sel = (1u << i1) | (1u << i2) | (1u << i3); }
        }
    }
    const int n_tiles = t_hi - t_lo + 1;
    DMA_KV(t_hi, 0);
    bf16x8 qr[4];
#pragma unroll
    for (int d0 = 0; d0 < 4; ++d0) qr[d0] = *reinterpret_cast<const bf16x8*>(&Qw[(size_t)r32 * 64 + d0 * 16 + hi * 8]);
    f32x16 o[2]; o[0] = f32x16{}; o[1] = f32x16{};
    float lsum = 0.f, carry = 0.f; bool done_w = false;
    const int jdiag = wid >> 1;
    const int jlo_w = (TYPE == 3) ? ((32 * wid - 127) >> 6) : -100000;
    if (TYPE == 2) { if (tid < 16) misci[64 + tid] = 0; }
    int slot = 0;
    for (int i = 0; i < n_tiles; ++i) {
        const int tile = t_hi - i, jr = tile - 4 * qb;
        const int nslot = (slot == NSLOT - 1) ? 0 : slot + 1;
        if (i + 1 < n_tiles) { DMA_KV(tile - 1, nslot); WAITBAR(2); } else { WAITBAR(0); }
        if (TYPE == 2 && i > 0) { int alld = 1;
#pragma unroll
            for (int w = 0; w < 8; ++w) alld &= misci[64 + ((i - 1) & 1) * 8 + w];
            if (alld) break; }
        const bool active = (jr <= jdiag) && (jr >= jlo_w) && !(TYPE == 2 && done_w);
        if (active) {
            f32x16 p0, p1;
            float cinit = -Mf;
            if (TYPE == 0) cinit = ct - Mf;
            bool far = false;
            if (TYPE == 1) { far = (q0 + 32 * wid - 64 * tile - 63) >= 790; if (far) cinit += tabL[1023]; }
            qkt(p0, p1, kp0 + slot * SLOTB, qr, cinit);
            const int kb = 64 * jr + 4 * hi;
            if (TYPE == 0) {
#pragma unroll
                for (int g4 = 0; g4 < 4; ++g4) { const f32x4 c0 = *(const __attribute__((address_space(3))) f32x4*)(cs + 64 * tile + 8 * g4 + 4 * hi), c1 = *(const __attribute__((address_space(3))) f32x4*)(cs + 64 * tile + 32 + 8 * g4 + 4 * hi);
#pragma unroll
                    for (int j = 0; j < 4; ++j) { p0[4 * g4 + j] -= c0[j]; p1[4 * g4 + j] -= c1[j]; } }
                if (jr == jdiag) {
#pragma unroll
                    for (int r = 0; r < 16; ++r) { const int kv = kb + (r & 3) + 8 * (r >> 2); if (kv > qrel) p0[r] = -INFINITY; if (kv + 32 > qrel) p1[r] = -INFINITY; } }
#pragma unroll
                for (int r = 0; r < 16; ++r) { p0[r] = __builtin_amdgcn_exp2f(p0[r]); p1[r] = __builtin_amdgcn_exp2f(p1[r]); }
            }
            if (TYPE == 1 || TYPE == 3) {
                if (!far) {
#pragma unroll
                    for (int r = 0; r < 16; ++r) { const int kv = kb + (r & 3) + 8 * (r >> 2); int d0_ = qrel - kv, d1_ = d0_ - 32;
                        d0_ = d0_ < 0 ? 0 : (d0_ > 1023 ? 1023 : d0_); d1_ = d1_ < 0 ? 0 : (d1_ > 1023 ? 1023 : d1_);
                        p0[r] += tabL[d0_]; p1[r] += tabL[d1_]; } }
                if (TYPE == 1) {
                    if (jr >= 0) { if (jr == jdiag) {
#pragma unroll
                            for (int r = 0; r < 16; ++r) { const int kv = kb + (r & 3) + 8 * (r >> 2); if (kv > qrel) p0[r] = -INFINITY; if (kv + 32 > qrel) p1[r] = -INFINITY; } } }
                    else { const bool keep = ((sel >> (tile >> 2)) & 1u) != 0u; if (!keep) {
#pragma unroll
                            for (int r = 0; r < 16; ++r) { p0[r] = -INFINITY; p1[r] = -INFINITY; } } }
                } else {
#pragma unroll
                    for (int r = 0; r < 16; ++r) { const int kv = kb + (r & 3) + 8 * (r >> 2); const int d0_ = qrel - kv, d1_ = d0_ - 32;
                        if (d0_ < 0 || d0_ >= 128) p0[r] = -INFINITY; if (d1_ < 0 || d1_ >= 128) p1[r] = -INFINITY; }
                }
#pragma unroll
                for (int r = 0; r < 16; ++r) { p0[r] = __builtin_amdgcn_exp2f(p0[r]); p1[r] = __builtin_amdgcn_exp2f(p1[r]); }
            }
            if (TYPE == 2) {
                f32x16 L0, L1;
#pragma unroll
                for (int r = 0; r < 16; ++r) { const int kv = kb + (r & 3) + 8 * (r >> 2);
                    const float z0 = p0[r], z1 = p1[r];
                    float a0 = -(fmaxf(z0, 0.f) + __builtin_amdgcn_logf(1.f + __builtin_amdgcn_exp2f(-fabsf(z0))));
                    float a1 = -(fmaxf(z1, 0.f) + __builtin_amdgcn_logf(1.f + __builtin_amdgcn_exp2f(-fabsf(z1))));
                    if (jr == jdiag) { if (kv >= qrel) a0 = 0.f; if (kv + 32 >= qrel) a1 = 0.f; }
                    L0[r] = a0; L1[r] = a1; }
                float own[8], part[8];
#pragma unroll
                for (int rb = 0; rb < 4; ++rb) { own[rb] = (L0[4 * rb] + L0[4 * rb + 1]) + (L0[4 * rb + 2] + L0[4 * rb + 3]); own[4 + rb] = (L1[4 * rb] + L1[4 * rb + 1]) + (L1[4 * rb + 2] + L1[4 * rb + 3]); }
#pragma unroll
                for (int rb = 0; rb < 8; ++rb) { auto rr = __builtin_amdgcn_permlane32_swap(__float_as_uint(own[rb]), __float_as_uint(own[rb]), false, false); part[rb] = __uint_as_float(hi ? rr[0] : rr[1]); }
                float run = carry;
#pragma unroll
                for (int rb = 7; rb >= 0; --rb) {
                    float E = run + (hi == 0 ? part[rb] : 0.f); run += own[rb] + part[rb];
#pragma unroll
                    for (int j = 3; j >= 0; --j) { const int r = 4 * (rb & 3) + j; const int kv = kb + (r & 3) + 8 * (r >> 2) + (rb >= 4 ? 32 : 0);
                        const float z = rb >= 4 ? p1[r] : p0[r], Lv = rb >= 4 ? L1[r] : L0[r];
                        float pp = __builtin_amdgcn_exp2f(z + Lv + E); E += Lv;
                        if (jr == jdiag && kv >= qrel) pp = 0.f;
                        if (rb >= 4) p1[r] = pp; else p0[r] = pp; } }
                carry = run;
                done_w = __all(carry < -100.f) != 0;
            }
            float ps = 0.f;
#pragma unroll
            for (int r = 0; r < 16; ++r) ps += p0[r] + p1[r];
            lsum += ps;
            u32x4 pw0, pw1, pw2, pw3;
#pragma unroll
            for (int j = 0; j < 4; ++j) { pw0[j] = cvtpk_s(p0[2 * j], p0[2 * j + 1]); pw1[j] = cvtpk_s(p0[8 + 2 * j], p0[9 + 2 * j]); pw2[j] = cvtpk_s(p1[2 * j], p1[2 * j + 1]); pw3[j] = cvtpk_s(p1[8 + 2 * j], p1[9 + 2 * j]); }
            pv(o, vp0 + slot * SLOTB, __builtin_bit_cast(bf16x8, pw0), __builtin_bit_cast(bf16x8, pw1), __builtin_bit_cast(bf16x8, pw2), __builtin_bit_cast(bf16x8, pw3));
        }
        if (TYPE == 2) { if (lane == 0) misci[64 + (i & 1) * 8 + wid] = done_w ? 1 : 0; }
        slot = nslot;
    }
    { auto rr = __builtin_amdgcn_permlane32_swap(__float_as_uint(lsum), __float_as_uint(lsum), false, false); lsum = __uint_as_float(rr[0]) + __uint_as_float(rr[1]); }
    if (TYPE == 3) lsum += __builtin_amdgcn_exp2f(C.sinks[h] * LOG2E - Mf);
    if (hi == 0) wsf[r32] = (TYPE == 2) ? 1.f : 1.f / lsum;
    asm volatile("s_waitcnt lgkmcnt(0)" ::: "memory");
    __attribute__((address_space(3))) bf16* stg = (__attribute__((address_space(3))) bf16*)(shm + L_OST) + wid * 2048;
#pragma unroll
    for (int r = 0; r < 16; ++r) { const int orow = crow(r, hi); const float rl = wsf[orow];
#pragma unroll
        for (int d0 = 0; d0 < 2; ++d0) stg[orow * 64 + d0 * 32 + r32] = (bf16)f2bf(o[d0][r] * rl); }
    asm volatile("s_waitcnt lgkmcnt(0)" ::: "memory");
    const size_t yrow0 = (size_t)(b * SEQ + q0 + wid * 32);
#pragma unroll
    for (int i = 0; i < 4; ++i) { const int row = i * 8 + (lane >> 3), ch = lane & 7;
        const u32x4 v = *(const __attribute__((address_space(3))) u32x4*)(stg + row * 64 + ch * 8);
        const size_t off = (yrow0 + row) * DM + TYPE * 256 + h * 64 + ch * 8;
        const u32x4 g = *(const u32x4*)(C.G + off); u32x4 w;
#pragma unroll
        for (int j = 0; j < 4; ++j) { const float a0 = __uint_as_float(v[j] << 16) * __uint_as_float(g[j] << 16), a1 = __uint_as_float(v[j] & 0xffff0000u) * __uint_as_float(g[j] & 0xffff0000u); w[j] = pk2(a0, a1); }
        *(u32x4*)(C.Y + off) = w; }
    WAITBAR(0);
#undef DMA_KV
}
#undef SBAR
}
__device__ __forceinline__ void p_attn(Frame& F, const Args& a, int layer) {
    att::ACtx C{(const bf16*)(a.ws + WS_Q), (const bf16*)(a.ws + WS_K), (const bf16*)(a.ws + WS_V), (const bf16*)(a.ws + WS_G), (bf16*)(a.ws + WS_HN),
                (const float*)(a.ws + WS_LC), (const float*)(a.ws + WS_CTOT), (const float*)(a.ws + WS_TAB), (const float*)(a.ws + WS_KM), (const float*)(a.ws + WS_MF) + layer * 4, a.sinks + layer * 4};
    unsigned* head = (unsigned*)(a.ws + WS_CTL) + CW_QUEUE + 64 * layer;
    LAS int* slot = (LAS int*)(F.lds + att::L_MISC) + 200;
    att::lds_ptr shm = (att::lds_ptr)F.lds;
    for (;;) {
        if (F.tid == 0) slot[0] = (int)__hip_atomic_fetch_add(head, 1u, __ATOMIC_RELAXED, __HIP_MEMORY_SCOPE_AGENT);
        __syncthreads();
        const int u = slot[0];
        __syncthreads();
        if (u >= 2048) break;
        const int ty = u >> 9, r = u & 511, qb = 15 - (r >> 5), bh = r & 31;
        if (ty == 0) { if (a.tmask & 2) att::attn_unit<1>(C, bh, qb, shm); }
        else if (ty == 1) { if (a.tmask & 1) att::attn_unit<0>(C, bh, qb, shm); }
        else if (ty == 2) { if (a.tmask & 4) att::attn_unit<2>(C, bh, qb, shm); }
        else { if (a.tmask & 8) att::attn_unit<3>(C, bh, qb, shm); }
    }
}

__global__ void __launch_bounds__(NWAVES * 64, 2) mk_fwd(Args a) {
    extern __shared__ __attribute__((aligned(16))) unsigned char lds[];
    Frame F; F.lds = (LAS unsigned char*)lds; F.tid = threadIdx.x; F.lane = F.tid & 63; F.wave = __builtin_amdgcn_readfirstlane(F.tid >> 6);
    F.G = gridDim.x; { const int bx = blockIdx.x; F.vcu = (F.G % 8 == 0) ? (bx % 8) * (F.G / 8) + bx / 8 : bx; }
    bf16* HN = (bf16*)(a.ws + WS_HN);
    for (int u = F.tid; u < (LDS_BYTES - LDSCTL_OFF) / 4; u += NWAVES * 64) ((LAS unsigned*)(F.lds + LDSCTL_OFF))[u] = 0u;
    __syncthreads();
    XcdBarrier bar; bar.bar = (unsigned*)(a.ws + WS_CTL) + CW_BAR; bar.x = 0; bar.st = nullptr;
    if (a.ph_hi - a.ph_lo > 1) bar = xcd_barrier_post((unsigned*)(a.ws + WS_CTL) + CW_BAR, (volatile LAS unsigned*)(F.lds + MISC_OFF) + 8);
#define PHASE_ON(k) (a.ph_lo <= (k) && (k) < a.ph_hi)
#define SEAM(k) do { if (PHASE_ON(k) && PHASE_ON((k) + 1)) xcd_barrier(bar); } while (0)
#define LAYER_PHASES(layer) do { \
    if (PHASE_ON(4 * (layer) + 0)) { \
        if ((layer) == 0) { p_weights(F, a); __syncthreads(); } \
        p_consts(F, a, (layer)); \
        p_norm(F, a, (layer), (layer) == 0 ? a.x : a.out); \
    } \
    SEAM(4 * (layer) + 0); \
    if (PHASE_ON(4 * (layer) + 1)) { \
        pg8::Gemm g{HN, (const bf16*)(a.ws + WS_WIN) + (size_t)(layer) * NPERM * DM, NTOK, NPERM, DM}; \
        pg8::StaticOrder S; S.init(NTOK, NPERM, F.G, (int)blockIdx.x); \
        pg8::EpiIn E{(bf16*)(a.ws + WS_Q), (bf16*)(a.ws + WS_K), (bf16*)(a.ws + WS_V), (bf16*)(a.ws + WS_G), a.fox_g + (layer) * 128, a.moba_g + (layer) * 128, a.swa_g + (layer) * 128, (float*)(a.ws + WS_KM)}; \
        pg8::gemm_phase<pg8::EpiIn, pg8::StaticOrder, true, true>(F.lds, g, S, E); \
    } \
    SEAM(4 * (layer) + 1); \
    if (PHASE_ON(4 * (layer) + 2)) { p_attn(F, a, (layer)); } \
    SEAM(4 * (layer) + 2); \
    if (PHASE_ON(4 * (layer) + 3)) { \
        pg8::Gemm g{HN  , (const bf16*)(a.ws + WS_WOUT) + (size_t)(layer) * DM * DM, NTOK, DM, DM}; \
        pg8::StaticOrder S; S.init(NTOK, DM, F.G, (int)blockIdx.x); \
        pg8::EpiRes E{(layer) == 0 ? a.x : a.out, a.out}; \
        pg8::gemm_phase<pg8::EpiRes, pg8::StaticOrder, true, true>(F.lds, g, S, E); \
    } \
    SEAM(4 * (layer) + 3); } while (0)
    LAYER_PHASES(0);
    LAYER_PHASES(1);
}

extern "C" void kernel_launch(void* const* d_in, const int* in_sizes, int n_in, void* d_out, int out_size, void* d_ws, size_t ws_size, hipStream_t stream) {
    static int ok = 0, grid = 0;
    if (ok == 0) {
        if (n_in != 10 || in_sizes[0] != NTOK * DM || out_size != NTOK * DM || ws_size < WS_END) { fprintf(stderr, "kernel_launch: unexpected shapes (n_in %d, in0 %d, out %d, ws %zu)\n", n_in, n_in > 0 ? in_sizes[0] : -1, out_size, ws_size); ok = -1; return; }
        if (hipFuncSetAttribute((const void*)mk_fwd, hipFuncAttributeMaxDynamicSharedMemorySize, LDS_BYTES) != hipSuccess) { fprintf(stderr, "kernel_launch: hipFuncSetAttribute failed\n"); ok = -1; return; }
        int dev = 0, cus = 0; if (hipGetDevice(&dev) != hipSuccess || hipDeviceGetAttribute(&cus, hipDeviceAttributeMultiprocessorCount, dev) != hipSuccess) { fprintf(stderr, "kernel_launch: device query failed\n"); ok = -1; return; }
        grid = cus < 256 ? (cus / 8) * 8 : 256; if (grid < 8) grid = cus;
        ok = 1;
    }
    if (ok < 0) return;
    Args a{};
    a.x = (const float*)d_in[0]; a.norm_gain = (const float*)d_in[1]; a.w_in = (const float*)d_in[2]; a.b_forget = (const float*)d_in[3]; a.fox_g = (const float*)d_in[4];
    a.moba_g = (const float*)d_in[5]; a.swa_g = (const float*)d_in[6]; a.sinks = (const float*)d_in[7]; a.w_out = (const float*)d_in[8]; a.rel_bias = (const float*)d_in[9];
    a.out = (float*)d_out; a.ws = (unsigned char*)d_ws;
    unsigned char* ws = (unsigned char*)d_ws;
    a.tmask = 15;
    if (hipMemsetAsync(ws + WS_CTL, 0, CTL_ZERO_BYTES, stream) != hipSuccess) { fprintf(stderr, "kernel_launch: memset failed\n"); return; }
#if N_LAUNCHES == 1
    a.ph_lo = 0; a.ph_hi = 8; hipLaunchKernelGGL(mk_fwd, dim3(grid), dim3(NWAVES * 64), LDS_BYTES, stream, a);
#else
    for (int ph = 0; ph < 8; ++ph) { a.ph_lo = ph; a.ph_hi = ph + 1; hipLaunchKernelGGL(mk_fwd, dim3(grid), dim3(NWAVES * 64), LDS_BYTES, stream, a); }
#endif
}
```

```cpp
#include <hip/hip_runtime.h>
#include <cstdio>
#include <cstdint>
#include <cmath>
namespace pg8 {
#define PG8_LAS __attribute__((address_space(3)))
typedef unsigned short bf16_t;
typedef short bf16x8 __attribute__((ext_vector_type(8)));
typedef float f32x4 __attribute__((ext_vector_type(4)));
typedef unsigned u32x4 __attribute__((ext_vector_type(4)));
constexpr int BM = 256, BK = 64, HALF = 128, HTB = HALF * BK * 2  , STAGE_BYTES = 8 * HTB, NXCD = 8, WGM = 8;

__host__ __device__ __forceinline__ int lds_byte(int r, int c) { const int st = (r >> 4) * 2 + (c >> 5), rr = r & 15, cc = c & 31, ob = rr * 64 + cc * 2; return st * 1024 + (ob ^ (((ob >> 9) & 1) << 5)); }
__host__ __device__ __forceinline__ void stage_rc(int b, int& R, int& C) { const int st = b / 1024, sb = b % 1024, swz = sb ^ (((sb >> 9) & 1) << 5); R = (st >> 1) * 16 + swz / 64; C = (st & 1) * 32 + (swz % 64) / 2; }
__host__ __device__ __forceinline__ int perm32(int rho) { const int n = rho >> 4, i = rho & 15; return 8 * (i >> 2) + 4 * n + (i & 3); }

struct Unit { int pm, pn; };
struct Gemm { const bf16_t* A; const bf16_t* Bt; int M, N, K; };

struct StaticOrder {
    int nM, nN, nwg, G, c;
    __host__ __device__ void init(int M, int N, int G_, int c_) { nM = M / BM; nN = N / BM; nwg = nM * nN; G = G_; c = c_; }
    __host__ __device__ bool next(int i, Unit& u) const {
        const long L = (long)i * G + c; if (L >= nwg) return false;
        int wgid = (int)L; { const int q = nwg / NXCD, r = nwg % NXCD, xcd = wgid % NXCD, off = wgid / NXCD; wgid = (xcd < r ? xcd * (q + 1) : r * (q + 1) + (xcd - r) * q) + off; }
        const int nig = WGM * nN, gid = wgid / nig, fm = gid * WGM, gsz = (nM - fm) < WGM ? (nM - fm) : WGM;
        u.pm = fm + ((wgid % nig) % gsz); u.pn = (wgid % nig) / gsz; return true;
    }
    __device__ __forceinline__ void a_ready(const Unit&) const {}
    __device__ __forceinline__ void done(const Unit&) const {}
};

__device__ __forceinline__ unsigned cvt_pk_bf16(float lo, float hi) { unsigned r; asm volatile("v_cvt_pk_bf16_f32 %0, %1, %2" : "=v"(r) : "v"(lo), "v"(hi)); return r; }
typedef float f32x2 __attribute__((ext_vector_type(2)));
constexpr float C2 = 0.125f * 1.4426950408889634f;
constexpr float RMS_EPS = 1e-6f;
constexpr size_t GS = (size_t)8 * 4 * 4096 * 64;
struct EpiIn {
    static constexpr bool PERM = true, AFTER_DRAIN = false;
    bf16_t *Q, *K, *V, *G; const float *gfox, *gmoba, *gswa; float* KM;
    __device__ __forceinline__ void operator()(const f32x4 (&acc)[2][2][4][2], const Unit& u, int wr, int wc, int fr, int fq) const {
        const int T = u.pn;
        const int b = (u.pm * BM) >> 12, t0 = ((u.pm * BM) & 4095) + wr * 64 + fr;
        int mode = 1, nh = 4, head = wc; float scale = 1.f; const float* gain = nullptr; bf16_t* base = nullptr;
        switch (T) {
            case 0: mode = 0; gain = gfox; scale = C2; base = Q; break;
            case 1: mode = 0; gain = gfox + 64; base = K; break;
            case 2: base = V; break;
            case 4: mode = 0; gain = gmoba; scale = C2; base = Q + GS; break;
            case 5: mode = 0; gain = gmoba + 64; base = K + GS; break;
            case 6: base = V + GS; break;
            case 8: scale = C2; base = Q + 2 * GS; break;
            case 9: base = K + 2 * GS; break;
            case 10: base = V + 2 * GS; break;
            case 12: mode = 0; gain = gswa; scale = C2; base = Q + 3 * GS; break;
            case 13: nh = 2; if (wc < 2) { mode = 0; gain = gswa + 64; base = K + 3 * GS; } else { base = V + 3 * GS; head = wc - 2; } break;
            default: mode = 2; break;
        }
        if (mode == 2) {
            bf16_t* gp = G + (size_t)(u.pm * BM + wr * 64 + fr) * 1024 + (T >> 2) * 256 + 64 * wc + 8 * fq;
#pragma unroll
            for (int ai = 0; ai < 2; ++ai)
#pragma unroll
                for (int m = 0; m < 4; ++m)
#pragma unroll
                    for (int bj = 0; bj < 2; ++bj) {
                        f32x4 v0 = acc[ai][bj][m][0], v1 = acc[ai][bj][m][1];
#pragma unroll
                        for (int j = 0; j < 4; ++j) { v0[j] = v0[j] / (1.f + __expf(-v0[j])); v1[j] = v1[j] / (1.f + __expf(-v1[j])); }
                        u32x4 w; w.x = cvt_pk_bf16(v0[0], v0[1]); w.y = cvt_pk_bf16(v0[2], v0[3]); w.z = cvt_pk_bf16(v1[0], v1[1]); w.w = cvt_pk_bf16(v1[2], v1[3]);
                        *(u32x4*)(gp + (size_t)(ai * HALF + m * 16) * 1024 + 32 * bj) = w;
                    }
            return;
        }
        f32x4 gv[2][2];
#pragma unroll
        for (int bj = 0; bj < 2; ++bj)
#pragma unroll
            for (int n = 0; n < 2; ++n) gv[bj][n] = (mode == 0) ? *(const f32x4*)(gain + 32 * bj + 8 * fq + 4 * n) : (f32x4){1.f, 1.f, 1.f, 1.f};
        bf16_t* dp = base + ((size_t)(b * nh + head) * 4096 + t0) * 64 + 8 * fq;
        f32x4 cs4[2][2];
#pragma unroll
        for (int bj = 0; bj < 2; ++bj)
#pragma unroll
            for (int n = 0; n < 2; ++n) cs4[bj][n] = (f32x4){0.f, 0.f, 0.f, 0.f};
#pragma unroll
        for (int ai = 0; ai < 2; ++ai)
#pragma unroll
            for (int m = 0; m < 4; ++m) {
                float r = scale;
                if (mode == 0) {
                    float ss = 0.f;
#pragma unroll
                    for (int bj = 0; bj < 2; ++bj)
#pragma unroll
                        for (int n = 0; n < 2; ++n) { const f32x4 x = acc[ai][bj][m][n]; ss += (x[0] * x[0] + x[1] * x[1]) + (x[2] * x[2] + x[3] * x[3]); }
                    ss += __shfl_xor(ss, 16); ss += __shfl_xor(ss, 32);
                    r = scale / sqrtf(ss * (1.0f / 64.0f) + RMS_EPS);
                }
#pragma unroll
                for (int bj = 0; bj < 2; ++bj) {
                    const f32x4 v0 = acc[ai][bj][m][0] * gv[bj][0] * r, v1 = acc[ai][bj][m][1] * gv[bj][1] * r;
                    if (T == 5) { cs4[bj][0] += v0; cs4[bj][1] += v1; }
                    u32x4 w; w.x = cvt_pk_bf16(v0[0], v0[1]); w.y = cvt_pk_bf16(v0[2], v0[3]); w.z = cvt_pk_bf16(v1[0], v1[1]); w.w = cvt_pk_bf16(v1[2], v1[3]);
                    *(u32x4*)(dp + (size_t)(ai * HALF + m * 16) * 64 + 32 * bj) = w;
                }
            }
        if (T == 5) {
            float* kmp = KM + ((size_t)((b * 4 + wc) * 16 + (((u.pm * BM) & 4095) >> 8))) * 64 + 8 * fq;
#pragma unroll
            for (int bj = 0; bj < 2; ++bj)
#pragma unroll
                for (int n = 0; n < 2; ++n)
#pragma unroll
                    for (int j = 0; j < 4; ++j) { float s = cs4[bj][n][j];
                        s += __shfl_xor(s, 1); s += __shfl_xor(s, 2); s += __shfl_xor(s, 4); s += __shfl_xor(s, 8);
                        if (fr == 0) atomicAdd(kmp + 32 * bj + 4 * n + j, s * (1.0f / 256.0f)); }
        }
    }
};
struct EpiRes {
    static constexpr bool PERM = false, AFTER_DRAIN = false;
    const float* base; float* out;
    __device__ __forceinline__ void operator()(const f32x4 (&acc)[2][2][4][2], const Unit& u, int wr, int wc, int fr, int fq) const {
        const int col0 = u.pn * BM + wc * 32 + 4 * fq;
#pragma unroll
        for (int ai = 0; ai < 2; ++ai)
#pragma unroll
            for (int m = 0; m < 4; ++m) {
                const size_t off = (size_t)(u.pm * BM + ai * HALF + wr * 64 + m * 16 + fr) * 1024 + col0;
#pragma unroll
                for (int bj = 0; bj < 2; ++bj)
#pragma unroll
                    for (int n = 0; n < 2; ++n) { const f32x4 bs = *(const f32x4*)(base + off + bj * HALF + n * 16); *(f32x4*)(out + off + bj * HALF + n * 16) = bs + acc[ai][bj][m][n]; }
            }
    }
};

template <class Epi, class Sched, bool ALIGN_EPI = false, bool SP2 = false>
__device__ __forceinline__ void gemm_phase(PG8_LAS unsigned char* lds, const Gemm g, const Sched& S, const Epi& E) {
    const int tid = threadIdx.x, wid = __builtin_amdgcn_readfirstlane(tid >> 6), lane = tid & 63, wr = wid >> 2, wc = wid & 3, fr = lane & 15, fq = lane >> 4;
    const int K = g.K, nt = K / BK;
    unsigned voffA[2], voffB[2];
#pragma unroll
    for (int i = 0; i < 2; ++i) { int R, C; stage_rc(tid * 16 + i * 8192, R, C); const int Rb = Epi::PERM ? ((R & ~31) + perm32(R & 31)) : R;
        voffA[i] = (unsigned)(R * K + C) * 2u; voffB[i] = (unsigned)(Rb * K + C) * 2u; }
    const size_t kstep = (size_t)(BK * 2);
    const size_t hstep = (size_t)HALF * K * 2;
    const size_t tstep = 2 * hstep;
    const unsigned ldsw = (unsigned)wid * 1024u;
    const int aoff = lds_byte(wr * 64 + fr, fq * 8), boff = lds_byte(wc * 32 + fr, fq * 8);
#define PG8_SA(b, h) (((b) * 2 + (h)) * HTB)
#define PG8_SB(b, h) ((4 + (b) * 2 + (h)) * HTB)
#define PG8_STAGE(bufoff, gbase, voff) do { _Pragma("unroll") for (int _i = 0; _i < 2; ++_i) \
        __builtin_amdgcn_global_load_lds((const unsigned*)((const char*)(gbase) + (voff)[_i]), (PG8_LAS unsigned*)(lds + (bufoff) + ldsw + _i * 8192), 16, 0, 0); } while (0)
#define PG8_LDA(dst, b, h) do { _Pragma("unroll") for (int m = 0; m < 4; ++m) _Pragma("unroll") for (int k = 0; k < 2; ++k) dst[m][k] = *(const PG8_LAS bf16x8*)(lds + PG8_SA(b, h) + aoff + m * 2048 + k * 1024); } while (0)
#define PG8_LDB(dst, b, h) do { _Pragma("unroll") for (int n = 0; n < 2; ++n) _Pragma("unroll") for (int k = 0; k < 2; ++k) dst[n][k] = *(const PG8_LAS bf16x8*)(lds + PG8_SB(b, h) + boff + n * 2048 + k * 1024); } while (0)
#define PG8_MMA(ai, bj, At, Bt) do { __builtin_amdgcn_s_setprio(1); _Pragma("unroll") for (int m = 0; m < 4; ++m) _Pragma("unroll") for (int n = 0; n < 2; ++n) _Pragma("unroll") for (int k = 0; k < 2; ++k) \
        acc[ai][bj][m][n] = __builtin_amdgcn_mfma_f32_16x16x32_bf16(Bt[n][k], At[m][k], acc[ai][bj][m][n], 0, 0, 0); __builtin_amdgcn_s_setprio(0); } while (0)
#define PG8_WAIT_V(n) asm volatile("s_waitcnt vmcnt(" #n ")" ::: "memory")
#define PG8_WAIT_L(n) asm volatile("s_waitcnt lgkmcnt(" #n ")" ::: "memory")
#define PG8_BAR __builtin_amdgcn_s_barrier()
#define PG8_SCHED __builtin_amdgcn_sched_barrier(0)
    Unit cur, nxt; int ui = 0;
    if (!S.next(0, cur)) return;
    f32x4 acc[2][2][4][2];
#pragma unroll
    for (int a = 0; a < 2; ++a)
#pragma unroll
        for (int b = 0; b < 2; ++b)
#pragma unroll
            for (int m = 0; m < 4; ++m)
#pragma unroll
                for (int n = 0; n < 2; ++n) acc[a][b][m][n] = (f32x4){0.f, 0.f, 0.f, 0.f};
    bf16x8 At[4][2], B0[2][2], B1[2][2];
    const char* cA = (const char*)g.A + (size_t)cur.pm * tstep; const char* cB = (const char*)g.Bt + (size_t)cur.pn * tstep;
    S.a_ready(cur);
    if constexpr (SP2) {
        PG8_STAGE(PG8_SB(0, 0), cB, voffB); PG8_STAGE(PG8_SB(0, 1), cB + hstep, voffB); PG8_STAGE(PG8_SA(0, 0), cA, voffA); PG8_STAGE(PG8_SA(0, 1), cA + hstep, voffA);
        if (wr == 1) PG8_BAR;
        PG8_WAIT_V(2); PG8_BAR;
        PG8_STAGE(PG8_SB(1, 0), cB + kstep, voffB); PG8_STAGE(PG8_SA(1, 0), cA + kstep, voffA); PG8_STAGE(PG8_SB(1, 1), cB + hstep + kstep, voffB);
        PG8_WAIT_V(6); PG8_BAR;
    } else {
        PG8_STAGE(PG8_SB(0, 0), cB, voffB); PG8_STAGE(PG8_SA(0, 0), cA, voffA); PG8_STAGE(PG8_SB(0, 1), cB + hstep, voffB); PG8_STAGE(PG8_SA(0, 1), cA + hstep, voffA);
        if (wr == 1) PG8_BAR;
        PG8_WAIT_V(4); PG8_BAR;
        PG8_STAGE(PG8_SB(1, 0), cB + kstep, voffB); PG8_STAGE(PG8_SA(1, 0), cA + kstep, voffA); PG8_STAGE(PG8_SB(1, 1), cB + hstep + kstep, voffB);
        PG8_WAIT_V(6); PG8_BAR;
    }
    for (;;) {
        const bool has_next = S.next(ui + 1, nxt);
        const char* nA = has_next ? (const char*)g.A + (size_t)nxt.pm * tstep : cA; const char* nB = has_next ? (const char*)g.Bt + (size_t)nxt.pn * tstep : cB;
        for (int t = 0; t < nt; t += 2) {
            const bool last = (t == nt - 2);
            const char* a1 = cA + (size_t)(t + 1) * kstep;
            const char* a2 = last ? nA : cA + (size_t)(t + 2) * kstep; const char* b2 = last ? nB : cB + (size_t)(t + 2) * kstep;
            const char* a3 = a2 + kstep; const char* b3 = b2 + kstep;
            if (last && has_next) S.a_ready(nxt);
            if constexpr (SP2) {
            PG8_LDB(B0, 0, 0); PG8_LDB(B1, 0, 1); PG8_SCHED; PG8_LDA(At, 0, 0); PG8_STAGE(PG8_SA(1, 1), a1 + hstep, voffA);
            PG8_WAIT_V(8); PG8_WAIT_L(0); PG8_BAR; PG8_MMA(0, 0, At, B0); PG8_MMA(0, 1, At, B1); PG8_BAR; PG8_SCHED;
            PG8_LDA(At, 0, 1); PG8_STAGE(PG8_SB(0, 0), b2, voffB); PG8_STAGE(PG8_SB(0, 1), b2 + hstep, voffB); PG8_STAGE(PG8_SA(0, 0), a2, voffA);
            PG8_WAIT_V(8); PG8_WAIT_L(0); PG8_BAR; PG8_MMA(1, 0, At, B0); PG8_MMA(1, 1, At, B1); PG8_BAR; PG8_SCHED;
            PG8_LDB(B0, 1, 0); PG8_LDB(B1, 1, 1); PG8_SCHED; PG8_LDA(At, 1, 0); PG8_STAGE(PG8_SA(0, 1), a2 + hstep, voffA);
            PG8_WAIT_V(8); PG8_WAIT_L(0); PG8_BAR; PG8_MMA(0, 0, At, B0); PG8_MMA(0, 1, At, B1); PG8_BAR; PG8_SCHED;
            PG8_LDA(At, 1, 1); PG8_STAGE(PG8_SB(1, 0), b3, voffB); PG8_STAGE(PG8_SB(1, 1), b3 + hstep, voffB); PG8_STAGE(PG8_SA(1, 0), a3, voffA);
            PG8_WAIT_V(8); PG8_WAIT_L(0); PG8_BAR; PG8_MMA(1, 0, At, B0); PG8_MMA(1, 1, At, B1); PG8_BAR; PG8_SCHED;
            } else {
            PG8_LDB(B0, 0, 0); PG8_SCHED; PG8_LDA(At, 0, 0); PG8_STAGE(PG8_SA(1, 1), a1 + hstep, voffA);
            PG8_WAIT_L(8); PG8_BAR; PG8_WAIT_L(0); PG8_MMA(0, 0, At, B0); PG8_BAR; PG8_SCHED;
            PG8_LDB(B1, 0, 1); PG8_STAGE(PG8_SB(0, 0), b2, voffB);
            PG8_BAR; PG8_WAIT_L(0); PG8_MMA(0, 1, At, B1); PG8_BAR;
            PG8_LDA(At, 0, 1); PG8_STAGE(PG8_SA(0, 0), a2, voffA);
            PG8_BAR; PG8_WAIT_L(0); PG8_MMA(1, 0, At, B0); PG8_BAR; PG8_SCHED;
            PG8_STAGE(PG8_SB(0, 1), b2 + hstep, voffB);
            PG8_WAIT_V(6); PG8_BAR; PG8_MMA(1, 1, At, B1); PG8_BAR;
            PG8_LDB(B0, 1, 0); PG8_SCHED; PG8_LDA(At, 1, 0); PG8_STAGE(PG8_SA(0, 1), a2 + hstep, voffA);
            PG8_WAIT_L(8); PG8_BAR; PG8_WAIT_L(0); PG8_MMA(0, 0, At, B0); PG8_BAR; PG8_SCHED;
            PG8_LDB(B1, 1, 1); PG8_STAGE(PG8_SB(1, 0), b3, voffB);
            PG8_BAR; PG8_WAIT_L(0); PG8_MMA(0, 1, At, B1); PG8_BAR;
            PG8_LDA(At, 1, 1); PG8_STAGE(PG8_SA(1, 0), a3, voffA);
            PG8_BAR; PG8_WAIT_L(0); PG8_MMA(1, 0, At, B0); PG8_BAR; PG8_SCHED;
            PG8_STAGE(PG8_SB(1, 1), b3 + hstep, voffB);
            PG8_WAIT_V(6); PG8_BAR; PG8_MMA(1, 1, At, B1); PG8_BAR;
            }
        }
        if constexpr (ALIGN_EPI) { if (wr == 0) PG8_BAR; }
        if constexpr (!Epi::AFTER_DRAIN) { E(acc, cur, wr, wc, fr, fq); S.done(cur); }
        if (!has_next) break;
#pragma unroll
        for (int a = 0; a < 2; ++a)
#pragma unroll
            for (int b = 0; b < 2; ++b)
#pragma unroll
                for (int m = 0; m < 4; ++m)
#pragma unroll
                    for (int n = 0; n < 2; ++n) acc[a][b][m][n] = (f32x4){0.f, 0.f, 0.f, 0.f};
        cur = nxt; cA = nA; cB = nB; ++ui;
        if constexpr (ALIGN_EPI) { if (wr == 1) PG8_BAR; }
    }
    PG8_WAIT_V(0);
    if constexpr (!ALIGN_EPI) { if (wr == 0) PG8_BAR; }
    PG8_BAR;
    if constexpr (Epi::AFTER_DRAIN) { E.fused(acc, cur, wr, wc, fr, fq, lds, wid, lane); S.done(cur); }
#undef PG8_SA
#undef PG8_SB
#undef PG8_STAGE
#undef PG8_LDA
#undef PG8_LDB
#undef PG8_MMA
#undef PG8_WAIT_V
#undef PG8_WAIT_L
#undef PG8_BAR
#undef PG8_SCHED
}
}
constexpr int NB = 8, SEQ = 4096, DM = 1024, NTOK = NB * SEQ, INW = 3844, NPERM = 3840, NLAYER = 2;
constexpr size_t MiB = 1u << 20;
constexpr size_t WS_CTL = 0, CTL_ZERO_BYTES = 1 * MiB;
constexpr size_t WS_WIN = 2 * MiB;
constexpr size_t WS_WOUT = 18 * MiB;
constexpr size_t WS_LC = 22 * MiB;
constexpr size_t WS_CTOT = 22 * MiB + 512 * 1024;
constexpr size_t WS_TAB = 23 * MiB;
constexpr size_t WS_KM = 24 * MiB;
constexpr size_t WS_MF = 25 * MiB;
constexpr int CW_BAR = 4096;
constexpr int CW_QUEUE = 64;
constexpr size_t WS_HN = 32 * MiB;
constexpr size_t WS_Q = 96 * MiB, WS_K = 160 * MiB, WS_V = 216 * MiB, WS_G = 272 * MiB, WS_END = 336 * MiB;
constexpr float LOG2E = 1.4426950408889634f;
constexpr int NWAVES = 8;
#define TIMER_SEL -1
#define TIMER_FS 100
#define TIMER_WG 37
#define PROBE_ATT 0
#define PROBE_REPS 2
#define PROBE_P1 0
#define PROBE_P3 0
#define PROBE_P0 0
#ifndef N_LAUNCHES
#define N_LAUNCHES 1
#endif
constexpr int RING_BYTES = 131072, LDSCTL_OFF = 139264, MISC_OFF = LDSCTL_OFF + 320, LDS_BYTES = 147456;

#define GAS __attribute__((address_space(1)))
#define LAS __attribute__((address_space(3)))
typedef unsigned short bf16;
typedef unsigned v4u __attribute__((ext_vector_type(4)));
typedef float f32x4 __attribute__((ext_vector_type(4)));
__device__ __forceinline__ unsigned f2bf(float f) { unsigned u = __builtin_bit_cast(unsigned, f); return (u + 0x7fffu + ((u >> 16) & 1u)) >> 16; }
__device__ __forceinline__ unsigned pk2(float lo, float hi) { return f2bf(lo) | (f2bf(hi) << 16); }
__device__ __forceinline__ float bf2f(unsigned v) { return __uint_as_float(v << 16); }
__device__ __forceinline__ float wave_sum(float v) {
#pragma unroll
    for (int o = 1; o < 64; o <<= 1) v += __shfl_xor(v, o);
    return v;
}
#define RLX_AGENT __ATOMIC_RELAXED, __HIP_MEMORY_SCOPE_AGENT
#define XB_TMO      128
#define XB_XCNT(j)  (256  + 64 * (j))
#define XB_XSUB(j)  (1280 + 64 * (j))
#define XB_XGEN(j)  (2304 + 64 * (j))
#define XB_TOP      3328
#define XB_TOPGEN   3392
#define XCD_BAR_WORDS 3456
#define XB_SPIN_CAP (1u << 18)

__device__ __forceinline__ unsigned xb_ld(unsigned* p)              { return __hip_atomic_load(p, __ATOMIC_RELAXED, __HIP_MEMORY_SCOPE_AGENT); }
__device__ __forceinline__ unsigned xb_add(unsigned* p, unsigned v) { return __hip_atomic_fetch_add(p, v, __ATOMIC_RELAXED, __HIP_MEMORY_SCOPE_AGENT); }
__device__ __forceinline__ unsigned xb_xcc_id() { return (unsigned)__builtin_amdgcn_s_getreg((3 << 11) | 20) & 0xFu; }
#define XB_SPIN(cond, bar) do { unsigned _sp = 0; while (cond) { __builtin_amdgcn_s_sleep(1); \
    if ((++_sp & 255u) == 0u) { if (xb_ld(&(bar)[XB_TMO])) break; if (_sp > XB_SPIN_CAP) { atomicAdd(&(bar)[XB_TMO], 1u); break; } } } } while (0)

struct XcdBarrier {
    unsigned* bar; unsigned x;
    volatile LAS unsigned* st;
};

__device__ __forceinline__ XcdBarrier xcd_barrier_post(unsigned* bar, volatile LAS unsigned* st) {
    XcdBarrier b; b.bar = bar; b.x = xb_xcc_id(); b.st = st;
    if (threadIdx.x == 0) (void)xb_add(&bar[XB_XCNT(b.x)], 1u);
    return b;
}
__device__ __forceinline__ void xcd_barrier_complete(unsigned* bar, unsigned x, unsigned& nloc, unsigned& nx) {
    const unsigned G = gridDim.x * gridDim.y * gridDim.z;
    unsigned sum, cnt, mine, sp = 0u;
    for (;;) {
        sum = 0u; cnt = 0u; mine = 0u;
#pragma unroll
        for (unsigned j = 0; j < 16; ++j) { const unsigned c = xb_ld(&bar[XB_XCNT(j)]); sum += c; cnt += (c > 0u) ? 1u : 0u; mine = (j == x) ? c : mine; }
        if (sum == G) break;
        __builtin_amdgcn_s_sleep(1);
        if ((++sp & 255u) == 0u) { if (xb_ld(&bar[XB_TMO])) break; if (sp > XB_SPIN_CAP) { atomicAdd(&bar[XB_TMO], 1u); break; } }
    }
    nloc = mine > 0u ? mine : 1u; nx = cnt > 0u ? cnt : 1u;
}

__device__ __forceinline__ void xcd_barrier(const XcdBarrier& b) {
    asm volatile("s_waitcnt vmcnt(0)" ::: "memory");
    __syncthreads();
    if (threadIdx.x == 0) {
        unsigned* bar = b.bar;
        __builtin_amdgcn_s_waitcnt(0);
        unsigned nloc = b.st[0], nx = b.st[1];
        if (nloc == 0u) { xcd_barrier_complete(bar, b.x, nloc, nx); b.st[0] = nloc; b.st[1] = nx; }
        const unsigned old = xb_add(&bar[XB_XSUB(b.x)], 1u);
        const unsigned gen = old / nloc;
        if (old + 1u == (gen + 1u) * nloc) {
            __builtin_amdgcn_fence(__ATOMIC_RELEASE, "agent");
            asm volatile("s_waitcnt vmcnt(0)" ::: "memory");
            const unsigned og = xb_add(&bar[XB_TOP], 1u);
            const unsigned tg = og / nx;
            if (og + 1u == (tg + 1u) * nx) xb_add(&bar[XB_TOPGEN], 1u);
            else XB_SPIN(xb_ld(&bar[XB_TOPGEN]) == tg, bar);
            __builtin_amdgcn_fence(__ATOMIC_ACQUIRE, "agent");
            xb_add(&bar[XB_XGEN(b.x)], 1u);
            asm volatile("s_waitcnt vmcnt(0)" ::: "memory");
        } else {
            XB_SPIN(xb_ld(&bar[XB_XGEN(b.x)]) == gen, bar);
            __builtin_amdgcn_fence(__ATOMIC_ACQUIRE, "agent");
            asm volatile("s_waitcnt vmcnt(0)" ::: "memory");
        }
    }
    __syncthreads();
}

__device__ __forceinline__ int rel_bucket(int d) {
    if (d < 16) return d;
    int b = 16;
    b += (d >= 21); b += (d >= 27); b += (d >= 35); b += (d >= 46); b += (d >= 59); b += (d >= 77); b += (d >= 99); b += (d >= 128);
    b += (d >= 166); b += (d >= 216); b += (d >= 280); b += (d >= 363); b += (d >= 470); b += (d >= 609); b += (d >= 790);
    return b;
}

struct Args { const float* x; const float* norm_gain; const float* w_in; const float* b_forget; const float* fox_g; const float* moba_g; const float* swa_g; const float* sinks; const float* w_out; const float* rel_bias; float* out; unsigned char* ws; int ph_lo, ph_hi, tmask, pad; };

struct Frame { LAS unsigned char* lds; int tid, lane, wave, vcu, G; };

__device__ __forceinline__ void transpose_item(const float* W, int ldw, bf16* WT, int dst_row0, int src_col0, LAS float* scr, int kb, int lane) {
    const int k0 = 64 * kb;
#pragma unroll 8
    for (int i = 0; i < 32; ++i) { const int kk = 2 * i + (lane >> 5); scr[kk * 33 + (lane & 31)] = W[(size_t)(k0 + kk) * ldw + src_col0 + (lane & 31)]; }
    asm volatile("s_waitcnt lgkmcnt(0)" ::: "memory");
    const int c = lane & 7;
#pragma unroll
    for (int j = 0; j < 4; ++j) { const int n = (lane >> 3) + 8 * j; const LAS float* s = scr + (8 * c) * 33 + n;
        v4u o; o.x = pk2(s[0 * 33], s[1 * 33]); o.y = pk2(s[2 * 33], s[3 * 33]); o.z = pk2(s[4 * 33], s[5 * 33]); o.w = pk2(s[6 * 33], s[7 * 33]);
        *(v4u*)(WT + (size_t)(dst_row0 + n) * 1024 + k0 + 8 * c) = o; }
    asm volatile("s_waitcnt lgkmcnt(0)" ::: "memory");
}
__device__ __forceinline__ int tile_src(int T, int wc) {
    switch (T) { case 0: return 0 + 64 * wc; case 1: return 256 + 64 * wc; case 2: return 512 + 64 * wc; case 3: return 772 + 64 * wc;
        case 4: return 1028 + 64 * wc; case 5: return 1284 + 64 * wc; case 6: return 1540 + 64 * wc; case 7: return 1796 + 64 * wc;
        case 8: return 2052 + 64 * wc; case 9: return 2308 + 64 * wc; case 10: return 2564 + 64 * wc; case 11: return 2820 + 64 * wc;
        case 12: return 3076 + 64 * wc; case 13: return wc < 2 ? 3332 + 64 * wc : 3460 + 64 * (wc - 2); default: return 3588 + 64 * wc; }
}
__device__ __forceinline__ void p_weights(Frame& F, const Args& a) {
    LAS float* scr = (LAS float*)(F.lds + F.wave * 16384);
    const int gw = F.vcu * NWAVES + F.wave, NGW = F.G * NWAVES;
    bf16* win = (bf16*)(a.ws + WS_WIN); bf16* wout = (bf16*)(a.ws + WS_WOUT);
    constexpr int I_IN = 120 * 16, I_OUT = 32 * 16;
    for (int it = gw; it < 2 * (I_IN + I_OUT); it += NGW) {
        const int layer = it / (I_IN + I_OUT); int r = it % (I_IN + I_OUT);
        if (r < I_IN) { const int kb = r / 120, g = r % 120, T = g >> 3, gg = g & 7, bj = gg >> 2, wc = gg & 3;
            transpose_item(a.w_in + (size_t)layer * DM * INW, INW, win + (size_t)layer * NPERM * DM, 32 * g, tile_src(T, wc) + 32 * bj, scr, kb, F.lane); }
        else { r -= I_IN; const int kb = r / 32, g = r % 32;
            transpose_item(a.w_out + (size_t)layer * DM * DM, DM, wout + (size_t)layer * DM * DM, 32 * g, 32 * g, scr, kb, F.lane); }
    }
    if (F.vcu == 0) { float* tab = (float*)(a.ws + WS_TAB);
        for (int i = F.tid; i < 8 * 1024; i += NWAVES * 64) { const int hc = i >> 10, d = i & 1023; tab[i] = a.rel_bias[rel_bucket(d) * 8 + hc] * LOG2E; } }
}
__device__ __forceinline__ void p_consts(Frame& F, const Args& a, int layer) {
    if (F.vcu == 0 && F.wave == 0) {
        const int lane = F.lane; float* MF = (float*)(a.ws + WS_MF) + layer * 4;
        float bm = 0.f;
#pragma unroll
        for (int j = 0; j < 4; ++j) bm = fmaxf(bm, fabsf(a.rel_bias[64 * j + lane]));
#pragma unroll
        for (int o = 1; o < 64; o <<= 1) bm = fmaxf(bm, __shfl_xor(bm, o));
        const float* gp[3] = {a.fox_g + layer * 128, a.moba_g + layer * 128, a.swa_g + layer * 128};
#pragma unroll
        for (int k = 0; k < 3; ++k) { float mq = fabsf(gp[k][lane]), mk = fabsf(gp[k][64 + lane]);
#pragma unroll
            for (int o = 1; o < 64; o <<= 1) { mq = fmaxf(mq, __shfl_xor(mq, o)); mk = fmaxf(mk, __shfl_xor(mk, o)); }
            const float m = 8.f * LOG2E * mq * mk * 1.02f + 0.1f + (k == 0 ? 0.f : bm * LOG2E);
            if (lane == 0) MF[k == 0 ? 0 : (k == 1 ? 1 : 3)] = m; }
        if (lane == 0) MF[2] = 0.f;
    }
}
__device__ __forceinline__ void p_norm(Frame& F, const Args& a, int layer, const float* xin) {
    LAS float* lfs = (LAS float*)F.lds;
    const int lane = F.lane;
    { float* KM = (float*)(a.ws + WS_KM); for (int i = F.vcu * (NWAVES * 64) + F.tid; i < 32 * 16 * 64; i += F.G * NWAVES * 64) KM[i] = 0.f; }
    const float* gain = a.norm_gain + layer * DM; const float* wl = a.w_in + (size_t)layer * DM * INW;
    f32x4 g[4], gw[4][4];
#pragma unroll
    for (int j = 0; j < 4; ++j) { g[j] = *(const f32x4*)(gain + 256 * j + 4 * lane);
#pragma unroll
        for (int i = 0; i < 4; ++i) { gw[j][i] = *(const f32x4*)(wl + (size_t)(256 * j + 4 * lane + i) * INW + 768) * g[j][i]; } }
    f32x4 bfv = *(const f32x4*)(a.b_forget + layer * 4);
    bf16* HN = (bf16*)(a.ws + WS_HN);
    for (int chunk = F.vcu; chunk < NTOK / 128; chunk += F.G) {
    const int b = chunk >> 5, cidx = chunk & 31;
    for (int r0 = 0; r0 < 16; r0 += 4) {
        f32x4 v[4][4];
#pragma unroll
        for (int rr = 0; rr < 4; ++rr) { const size_t row = (size_t)128 * chunk + 16 * F.wave + r0 + rr; const f32x4* xr = (const f32x4*)(xin + row * DM) + lane;
#pragma unroll
            for (int j = 0; j < 4; ++j) v[rr][j] = xr[64 * j]; }
#pragma unroll
        for (int rr = 0; rr < 4; ++rr) {
            const int rl = 16 * F.wave + r0 + rr; const size_t row = (size_t)128 * chunk + rl;
            float ss = 0.f; f32x4 p = {0.f, 0.f, 0.f, 0.f};
#pragma unroll
            for (int j = 0; j < 4; ++j) { ss += (v[rr][j][0] * v[rr][j][0] + v[rr][j][1] * v[rr][j][1]) + (v[rr][j][2] * v[rr][j][2] + v[rr][j][3] * v[rr][j][3]);
#pragma unroll
                for (int i = 0; i < 4; ++i) p += gw[j][i] * v[rr][j][i]; }
            const float rstd = 1.0f / sqrtf(wave_sum(ss) * (1.0f / DM) + pg8::RMS_EPS);
            unsigned long long* o8 = (unsigned long long*)(HN + row * DM) + lane;
#pragma unroll
            for (int j = 0; j < 4; ++j) { const f32x4 y = v[rr][j] * rstd * g[j]; o8[64 * j] = (unsigned long long)pk2(y[0], y[1]) | ((unsigned long long)pk2(y[2], y[3]) << 32); }
#pragma unroll
            for (int h = 0; h < 4; ++h) p[h] = wave_sum(p[h]) * rstd + bfv[h];
            { const float u = lane == 0 ? p[0] : (lane == 1 ? p[1] : (lane == 2 ? p[2] : p[3]));
                const float sp = fmaxf(-u, 0.f) + log1pf(expf(-fabsf(u)));
                if (lane < 4) lfs[lane * 128 + rl] = -sp * LOG2E; }
        }
    }
    __syncthreads();
    if (F.wave < 4) { const int h = F.wave; const float x0 = lfs[h * 128 + 2 * lane], x1 = lfs[h * 128 + 2 * lane + 1]; float s = x0 + x1;
#pragma unroll
        for (int o = 1; o < 64; o <<= 1) { const float t = __shfl_up(s, o); if (lane >= o) s += t; }
        float* LC = (float*)(a.ws + WS_LC) + (size_t)(b * 4 + h) * SEQ + cidx * 128 + 2 * lane; LC[0] = s - x1; LC[1] = s;
        if (lane == 63) ((float*)(a.ws + WS_CTOT))[(b * 4 + h) * 32 + cidx] = s; }
    __syncthreads();
    }
}

namespace att {
using bf16x8 = __attribute__((ext_vector_type(8))) short;
using s16x4 = __attribute__((ext_vector_type(4))) short;
using f32x16 = __attribute__((ext_vector_type(16))) float;
using u32x4 = __attribute__((ext_vector_type(4))) unsigned;
typedef __attribute__((address_space(3))) const char* lds_cptr;
typedef __attribute__((address_space(3))) char* lds_ptr;
typedef short v4i16_t __attribute__((ext_vector_type(4)));
typedef float f32x2_t __attribute__((ext_vector_type(2))); typedef __bf16 bf16x2_t __attribute__((ext_vector_type(2)));
constexpr int NSLOT = 5, PFD = 3, SLOTB = 8192;
constexpr int L_K = 0, L_V = NSLOT * SLOTB, L_OST = 0  , L_WS = 2 * NSLOT * SLOTB, L_CS = L_WS + 8 * 256, L_TAB = L_CS + 16384, L_G = L_TAB + 4608, L_MISC = L_G + 8 * 4096, L_END = L_MISC + 1024;
static_assert(L_END <= 139264 && 8 * 4096 <= NSLOT * SLOTB, "attention LDS map (the kernel's control words start at 136 KiB)");
constexpr float THR2 = 90.f;
#define SBAR() __builtin_amdgcn_sched_barrier(0)
__device__ __forceinline__ int crow(int r, int hi) { return (r & 3) + 8 * (r >> 2) + 4 * hi; }
__device__ __forceinline__ void glds16(const void* gsrc, unsigned lds_dst) { unsigned keep;
    asm volatile("s_mov_b32 %0, m0\n\ts_mov_b32 m0, %2\n\ts_nop 0\n\tglobal_load_lds_dwordx4 %1, off\n\ts_mov_b32 m0, %0" : "=&s"(keep) : "v"(gsrc), "s"(lds_dst) : "memory"); }
__device__ __forceinline__ unsigned cvtpk_s(float lo, float hi) { f32x2_t v = {lo, hi}; bf16x2_t b = __builtin_convertvector(v, bf16x2_t); return __builtin_bit_cast(unsigned, b); }
__device__ __forceinline__ s16x4 vtr(lds_cptr p) { return __builtin_bit_cast(s16x4, __builtin_amdgcn_ds_read_tr16_b64_v4i16((__attribute__((address_space(3))) v4i16_t*)p)); }
#define MFMA32(a, b, c) __builtin_amdgcn_mfma_f32_32x32x16_bf16(a, b, c, 0, 0, 0)
__device__ __forceinline__ void qkt(f32x16& p0, f32x16& p1, lds_cptr kp, const bf16x8* qr, float cinit) {
    f32x16 c;
#pragma unroll
    for (int r = 0; r < 16; ++r) c[r] = cinit;
    p0 = c; p1 = c;
#pragma unroll
    for (int d0 = 0; d0 < 4; ++d0) {
        const bf16x8 b0 = *(const __attribute__((address_space(3))) bf16x8*)(kp + d0 * 2048);
        const bf16x8 b1 = *(const __attribute__((address_space(3))) bf16x8*)(kp + d0 * 2048 + 512);
        p0 = MFMA32(b0, qr[d0], p0); p1 = MFMA32(b1, qr[d0], p1);
    }
}
__device__ __forceinline__ void pv(f32x16* o, lds_cptr vp, bf16x8 pa0, bf16x8 pa1, bf16x8 pa2, bf16x8 pa3) {
#pragma unroll
    for (int d0 = 0; d0 < 2; ++d0) { s16x4 lo[4], hi[4];
#pragma unroll
        for (int ks = 0; ks < 4; ++ks) { lo[ks] = vtr(vp + d0 * 4096 + ks * 1024); hi[ks] = vtr(vp + d0 * 4096 + ks * 1024 + 512); }
#define PK(k) (bf16x8){lo[k][0], lo[k][1], lo[k][2], lo[k][3], hi[k][0], hi[k][1], hi[k][2], hi[k][3]}
        o[d0] = MFMA32(pa0, PK(0), o[d0]); o[d0] = MFMA32(pa1, PK(1), o[d0]); o[d0] = MFMA32(pa2, PK(2), o[d0]); o[d0] = MFMA32(pa3, PK(3), o[d0]);
#undef PK
    }
}
__device__ __forceinline__ void kload(bf16x8* kf, lds_cptr kp) {
#pragma unroll
    for (int d0 = 0; d0 < 4; ++d0) { kf[2 * d0] = *(const __attribute__((address_space(3))) bf16x8*)(kp + d0 * 2048); kf[2 * d0 + 1] = *(const __attribute__((address_space(3))) bf16x8*)(kp + d0 * 2048 + 512); }
}
__device__ __forceinline__ void vload(s16x4* vlo, s16x4* vhi, lds_cptr vp) {
#pragma unroll
    for (int i = 0; i < 8; ++i) { vlo[i] = vtr(vp + (i >> 2) * 4096 + (i & 3) * 1024); vhi[i] = vtr(vp + (i >> 2) * 4096 + (i & 3) * 1024 + 512); }
}
__device__ __forceinline__ void qkt_r(f32x16& p0, f32x16& p1, const bf16x8* kf, const bf16x8* qr, float cinit) {
    f32x16 c;
#pragma unroll
    for (int r = 0; r < 16; ++r) c[r] = cinit;
    p0 = c; p1 = c;
#pragma unroll
    for (int d0 = 0; d0 < 4; ++d0) { p0 = MFMA32(kf[2 * d0], qr[d0], p0); p1 = MFMA32(kf[2 * d0 + 1], qr[d0], p1); }
}
__device__ __forceinline__ void pv_r(f32x16* o, const s16x4* vlo, const s16x4* vhi, bf16x8 pa0, bf16x8 pa1, bf16x8 pa2, bf16x8 pa3) {
#define VFR(i) (bf16x8){vlo[i][0], vlo[i][1], vlo[i][2], vlo[i][3], vhi[i][0], vhi[i][1], vhi[i][2], vhi[i][3]}
    o[0] = MFMA32(pa0, VFR(0), o[0]); o[1] = MFMA32(pa0, VFR(4), o[1]); o[0] = MFMA32(pa1, VFR(1), o[0]); o[1] = MFMA32(pa1, VFR(5), o[1]);
    o[0] = MFMA32(pa2, VFR(2), o[0]); o[1] = MFMA32(pa2, VFR(6), o[1]); o[0] = MFMA32(pa3, VFR(3), o[0]); o[1] = MFMA32(pa3, VFR(7), o[1]);
#undef VFR
}
struct ACtx { const bf16 *Q, *K, *V, *G; bf16* Y; const float *LC, *CTOT, *TAB, *KM, *MF; const float* sinks; };
#define WAITBAR(N) asm volatile("s_waitcnt vmcnt(" #N ") lgkmcnt(0)\n\ts_barrier" ::: "memory")

template <int TYPE> __device__ __forceinline__ void attn_unit(const ACtx& C, int bh, int qb, lds_ptr shm) {
    int tid = threadIdx.x; asm volatile("" : "+v"(tid));
    const int lane = tid & 63, r32 = lane & 31, hi = lane >> 5; const int wid = __builtin_amdgcn_readfirstlane(tid >> 6);
    const int b = bh >> 2, h = bh & 3, q0 = qb * 256, qrel = wid * 32 + r32, t = q0 + qrel;
    const int kvh = (TYPE == 3) ? (b * 2 + (h >> 1)) : bh;
    const bf16* Qw = C.Q + TYPE * pg8::GS + ((size_t)bh * SEQ + q0 + wid * 32) * 64;
    const bf16* Kh = C.K + TYPE * pg8::GS + (size_t)kvh * SEQ * 64; const bf16* Vh = C.V + TYPE * pg8::GS + (size_t)kvh * SEQ * 64;
    const unsigned lds0 = (unsigned)(size_t)shm;
    __attribute__((address_space(3))) float* wsf = (__attribute__((address_space(3))) float*)(shm + L_WS) + wid * 64;
    __attribute__((address_space(3))) float* tabL = (__attribute__((address_space(3))) float*)(shm + L_TAB);
    __attribute__((address_space(3))) float* cs = (__attribute__((address_space(3))) float*)(shm + L_CS);
    __attribute__((address_space(3))) float* misc = (__attribute__((address_space(3))) float*)(shm + L_MISC);
    __attribute__((address_space(3))) int* misci = (__attribute__((address_space(3))) int*)(shm + L_MISC);
    const bf16* ksrc = Kh + (size_t)lane * 64 + wid * 8;
    const bf16* vsrc = Vh + (size_t)(16 * (wid & 3) + (lane >> 2)) * 64 + (wid >> 2) * 32 + (lane & 3) * 8;
    const unsigned kdst = lds0 + L_K + wid * 1024, vdst = lds0 + L_V + wid * 1024;
#define DMA_KV(tile, slot) do { glds16(ksrc + (size_t)(tile) * 4096, (unsigned)__builtin_amdgcn_readfirstlane(kdst + (slot) * SLOTB)); glds16(vsrc + (size_t)(tile) * 4096, (unsigned)__builtin_amdgcn_readfirstlane(vdst + (slot) * SLOTB)); } while (0)
    const lds_cptr kp0 = (lds_cptr)shm + L_K + hi * 1024 + r32 * 16;
    const lds_cptr vp0 = (lds_cptr)shm + L_V + ((lane >> 4) & 1) * 32 + (lane & 3) * 8 + (4 * hi + ((lane & 15) >> 2)) * 64;
    const float Mf = (TYPE == 2) ? 0.f : C.MF[TYPE];
    const int t_hi = 4 * qb + 3; int t_lo = 0;
    if (TYPE == 3) { t_lo = 4 * qb - 2; if (t_lo < 0) t_lo = 0; }
    const size_t yrow0 = (size_t)(b * SEQ + q0 + wid * 32);
    { const bf16* gsrc = C.G + (yrow0 + (lane >> 3)) * DM + TYPE * 256 + h * 64 + (lane & 7) * 8;
#pragma unroll
        for (int i = 0; i < 4; ++i) glds16(gsrc + (size_t)(8 * i) * DM, (unsigned)__builtin_amdgcn_readfirstlane(lds0 + L_G + wid * 4096 + i * 1024)); }
    DMA_KV(t_hi, 0); DMA_KV(t_hi - 1, 1); DMA_KV(t_hi - 2, 2);
    bf16x8 qr[4];
#pragma unroll
    for (int d0 = 0; d0 < 4; ++d0) qr[d0] = *reinterpret_cast<const bf16x8*>(&Qw[(size_t)r32 * 64 + d0 * 16 + hi * 8]);
    unsigned sel = 0u; float ct = 0.f;
    if (TYPE == 0) {
        float lv[8]; const float* lcp = C.LC + (size_t)bh * SEQ;
#pragma unroll
        for (int k = 0; k < 8; ++k) { const int s = tid + 512 * k; lv[k] = (s < q0 + 256) ? lcp[s] : 0.f; }
        if (wid == 0) { const float v = lane < 32 ? C.CTOT[bh * 32 + lane] : 0.f; float s = v;
#pragma unroll
            for (int o = 1; o < 64; o <<= 1) { const float u = __shfl_up(s, o); if (lane >= o) s += u; }
            if (lane < 32) misc[lane] = s - v; }
        __syncthreads();
#pragma unroll
        for (int k = 0; k < 8; ++k) { const int s = tid + 512 * k; if (s < q0 + 256) cs[s] = misc[s >> 7] + lv[k]; }
        __syncthreads();
        const float cref = cs[q0];
        if (wid == 0) { const bool skip = (lane < 4 * qb) && (cs[64 * lane + 63] - cref > 2.f * Mf + THR2);
            const int cnt = __popcll(__ballot(skip)); if (lane == 0) misci[40] = cnt; }
        __syncthreads();
        t_lo = misci[40]; ct = cs[t];
    }
    if (TYPE == 1 || TYPE == 3) {
        const float* tg = C.TAB + ((TYPE == 3 ? 4 : 0) + h) * 1024;
        { float tv[3]; const float b31 = (TYPE == 1) ? tg[1023] : 0.f; float k0 = 0.f, k1 = 0.f;
#pragma unroll
            for (int k = 0; k < 3; ++k) { const int j = tid + 512 * k, d = 1023 - j; tv[k] = (j < 1088 && d >= 0 && (TYPE == 1 || d < 128)) ? tg[d] - b31 : -INFINITY; }
            if (TYPE == 1) { const float* kg = C.KM + (size_t)bh * 16 * 64; if (tid < qb * 64) k0 = kg[tid]; if (tid + 512 < qb * 64) k1 = kg[tid + 512]; }
#pragma unroll
            for (int k = 0; k < 3; ++k) { const int j = tid + 512 * k; if (j < 1088) tabL[j] = tv[k]; }
            if (TYPE == 1) { cs[tid] = k0; cs[tid + 512] = k1; } }
        __syncthreads();
        if (TYPE == 1) {
            if (qb <= 3) sel = (1u << qb) - 1u;
            else {
                float qf[32];
#pragma unroll
                for (int d0 = 0; d0 < 4; ++d0) { const u32x4 w = __builtin_bit_cast(u32x4, qr[d0]);
#pragma unroll
                    for (int j = 0; j < 4; ++j) { qf[d0 * 8 + 2 * j] = __uint_as_float(w[j] << 16); qf[d0 * 8 + 2 * j + 1] = __uint_as_float(w[j] & 0xffff0000u); } }
                float v1 = -INFINITY, v2 = -INFINITY, v3 = -INFINITY; int i1 = 0, i2 = 0, i3 = 0;
                for (int n = 0; n < qb; ++n) { float s = 0.f;
#pragma unroll
                    for (int d0 = 0; d0 < 4; ++d0) { const f32x4 ka = *(const __attribute__((address_space(3))) f32x4*)(cs + n * 64 + d0 * 16 + hi * 8), kb4 = *(const __attribute__((address_space(3))) f32x4*)(cs + n * 64 + d0 * 16 + hi * 8 + 4);
#pragma unroll
                        for (int j = 0; j < 4; ++j) { s += qf[d0 * 8 + j] * ka[j]; s += qf[d0 * 8 + 4 + j] * kb4[j]; } }
                    { auto rr = __builtin_amdgcn_permlane32_swap(__float_as_uint(s), __float_as_uint(s), false, false); s = __uint_as_float(rr[0]) + __uint_as_float(rr[1]); }
                    if (s > v1) { v3 = v2; i3 = i2; v2 = v1; i2 = i1; v1 = s; i1 = n; } else if (s > v2) { v3 = v2; i3 = i2; v2 = s; i2 = n; } else if (s > v3) { v3 = s; i3 = n; } }
                sel = (1u << i1) | (1u << i2) | (1u << i3); }
        }
    }
    const int n_tiles = t_hi - t_lo + 1;
    asm volatile("" : "+v"(qr[0]), "+v"(qr[1]), "+v"(qr[2]), "+v"(qr[3]));
    f32x16 o[2]; o[0] = f32x16{}; o[1] = f32x16{}; f32x16 lacc = f32x16{};
    float carry = 0.f; bool done_w = false;
    f32x16 cvec;
    { const float c0_ = (TYPE == 2) ? 0.f : ((TYPE == 0) ? ct - Mf : -Mf);
#pragma unroll
        for (int r = 0; r < 16; ++r) cvec[r] = c0_; }
    asm volatile("" : "+v"(cvec));
    const bf16x8 ones = {0x3f80, 0x3f80, 0x3f80, 0x3f80, 0x3f80, 0x3f80, 0x3f80, 0x3f80};
    const int jdiag = wid >> 1;
    const int jlo_w = (TYPE == 3) ? ((32 * wid - 127) >> 6) : -100000;
    if (TYPE == 2) { if (tid < 16) misci[64 + tid] = 0; }
    bf16x8 kf[8]; s16x4 vlo[8], vhi[8];
    int slot = 0, pslot = PFD;
    for (int i = 0; i < n_tiles; ++i) {
        const int tile = t_hi - i, jr = tile - 4 * qb;
        { const int tp = tile - PFD; DMA_KV(tp < 0 ? 0 : tp, pslot); }
        pslot = (pslot == NSLOT - 1) ? 0 : pslot + 1;
        WAITBAR(6);
        if (TYPE == 2 && i > 0) { int alld = 1;
#pragma unroll
            for (int w = 0; w < 8; ++w) alld &= misci[64 + ((i - 1) & 1) * 8 + w];
            if (alld) break; }
        const bool active = (jr <= jdiag) && (jr >= jlo_w) && !(TYPE == 2 && done_w);
        if (active) {
            f32x16 p0, p1;
            kload(kf, kp0 + slot * SLOTB); SBAR();
            if (TYPE == 2) { p0 = MFMA32(kf[0], qr[0], (f32x16{})); p1 = MFMA32(kf[1], qr[0], (f32x16{})); } else { p0 = MFMA32(kf[0], qr[0], cvec); p1 = MFMA32(kf[1], qr[0], cvec); }
#pragma unroll
            for (int d0 = 1; d0 < 4; ++d0) { p0 = MFMA32(kf[2 * d0], qr[d0], p0); p1 = MFMA32(kf[2 * d0 + 1], qr[d0], p1); }
            SBAR();
            vload(vlo, vhi, vp0 + slot * SLOTB); SBAR();
            const int kb = 64 * jr + 4 * hi;
            unsigned keepm = 0xffffffffu;
            if (TYPE == 0) {
#pragma unroll
                for (int g4 = 0; g4 < 4; ++g4) { const f32x4 c0 = *(const __attribute__((address_space(3))) f32x4*)(cs + 64 * tile + 8 * g4 + 4 * hi), c1 = *(const __attribute__((address_space(3))) f32x4*)(cs + 64 * tile + 32 + 8 * g4 + 4 * hi);
#pragma unroll
                    for (int j = 0; j < 4; ++j) { p0[4 * g4 + j] -= c0[j]; p1[4 * g4 + j] -= c1[j]; } }
                if (jr == jdiag) {
#pragma unroll
                    for (int r = 0; r < 16; ++r) { const int kv = kb + (r & 3) + 8 * (r >> 2); if (kv > qrel) p0[r] = -INFINITY; if (kv + 32 > qrel) p1[r] = -INFINITY; } }
#pragma unroll
                for (int r = 0; r < 16; ++r) { p0[r] = __builtin_amdgcn_exp2f(p0[r]); p1[r] = __builtin_amdgcn_exp2f(p1[r]); }
            }
            if (TYPE == 1 || TYPE == 3) {
                const bool far = (TYPE == 1) && ((q0 + 32 * wid - 64 * tile - 63) >= 790);
                if (!far) { const __attribute__((address_space(3))) float* tp_ = tabL + (1023 - (qrel - kb));
#pragma unroll
                    for (int r = 0; r < 16; ++r) { p0[r] += tp_[(r & 3) + 8 * (r >> 2)]; p1[r] += tp_[(r & 3) + 8 * (r >> 2) + 32]; } }
                if (TYPE == 1 && jr < 0) keepm = ((sel >> (tile >> 2)) & 1u) ? 0xffffffffu : 0u;
#pragma unroll
                for (int r = 0; r < 16; ++r) { p0[r] = __builtin_amdgcn_exp2f(p0[r]); p1[r] = __builtin_amdgcn_exp2f(p1[r]); }
            }
            if (TYPE == 2) {
                f32x16 L0, L1;
#pragma unroll
                for (int r = 0; r < 16; ++r) { const int kv = kb + (r & 3) + 8 * (r >> 2);
                    const float z0 = p0[r], z1 = p1[r];
                    float a0 = -(fmaxf(z0, 0.f) + __builtin_amdgcn_logf(1.f + __builtin_amdgcn_exp2f(-fabsf(z0))));
                    float a1 = -(fmaxf(z1, 0.f) + __builtin_amdgcn_logf(1.f + __builtin_amdgcn_exp2f(-fabsf(z1))));
                    if (jr == jdiag) { if (kv >= qrel) a0 = 0.f; if (kv + 32 >= qrel) a1 = 0.f; }
                    L0[r] = a0; L1[r] = a1; }
                float own[8], part[8];
#pragma unroll
                for (int rb = 0; rb < 4; ++rb) { own[rb] = (L0[4 * rb] + L0[4 * rb + 1]) + (L0[4 * rb + 2] + L0[4 * rb + 3]); own[4 + rb] = (L1[4 * rb] + L1[4 * rb + 1]) + (L1[4 * rb + 2] + L1[4 * rb + 3]); }
#pragma unroll
                for (int rb = 0; rb < 8; ++rb) { auto rr = __builtin_amdgcn_permlane32_swap(__float_as_uint(own[rb]), __float_as_uint(own[rb]), false, false); part[rb] = __uint_as_float(hi ? rr[0] : rr[1]); }
                float run = carry;
#pragma unroll
                for (int rb = 7; rb >= 0; --rb) {
                    float E = run + (hi == 0 ? part[rb] : 0.f); run += own[rb] + part[rb];
#pragma unroll
                    for (int j = 3; j >= 0; --j) { const int r = 4 * (rb & 3) + j; const int kv = kb + (r & 3) + 8 * (r >> 2) + (rb >= 4 ? 32 : 0);
                        const float z = rb >= 4 ? p1[r] : p0[r], Lv = rb >= 4 ? L1[r] : L0[r];
                        float pp = __builtin_amdgcn_exp2f(z + Lv + E); E += Lv;
                        if (jr == jdiag && kv >= qrel) pp = 0.f;
                        if (rb >= 4) p1[r] = pp; else p0[r] = pp; } }
                carry = run;
                done_w = __all(carry < -100.f) != 0;
            }
            u32x4 pw0, pw1, pw2, pw3;
#pragma unroll
            for (int j = 0; j < 4; ++j) { pw0[j] = cvtpk_s(p0[2 * j], p0[2 * j + 1]); pw1[j] = cvtpk_s(p0[8 + 2 * j], p0[9 + 2 * j]); pw2[j] = cvtpk_s(p1[2 * j], p1[2 * j + 1]); pw3[j] = cvtpk_s(p1[8 + 2 * j], p1[9 + 2 * j]); }
            if (TYPE == 1) { pw0 &= keepm; pw1 &= keepm; pw2 &= keepm; pw3 &= keepm; }
            const bf16x8 pa0 = __builtin_bit_cast(bf16x8, pw0), pa1 = __builtin_bit_cast(bf16x8, pw1), pa2 = __builtin_bit_cast(bf16x8, pw2), pa3 = __builtin_bit_cast(bf16x8, pw3);
            pv_r(o, vlo, vhi, pa0, pa1, pa2, pa3);
            if (TYPE != 2) { lacc = MFMA32(pa0, ones, lacc); lacc = MFMA32(pa1, ones, lacc); lacc = MFMA32(pa2, ones, lacc); lacc = MFMA32(pa3, ones, lacc); }
        }
        if (TYPE == 2) { if (lane == 0) misci[64 + (i & 1) * 8 + wid] = done_w ? 1 : 0; }
        slot = (slot == NSLOT - 1) ? 0 : slot + 1;
    }
    asm volatile("s_waitcnt vmcnt(0) lgkmcnt(0)\n\ts_barrier" ::: "memory");
    float rli[16];
    { const float sk = (TYPE == 3) ? __builtin_amdgcn_exp2f(C.sinks[h] * LOG2E - Mf) : 0.f;
#pragma unroll
        for (int r = 0; r < 16; ++r) rli[r] = (TYPE == 2) ? 1.f : 1.f / (lacc[r] + sk); }
    __attribute__((address_space(3))) bf16* stg = (__attribute__((address_space(3))) bf16*)(shm + L_OST) + wid * 2048;
    const __attribute__((address_space(3))) bf16* gst = (const __attribute__((address_space(3))) bf16*)(shm + L_G) + wid * 2048;
#pragma unroll
    for (int r = 0; r < 16; ++r) { const int orow = crow(r, hi); const float rl = rli[r];
#pragma unroll
        for (int d0 = 0; d0 < 2; ++d0) stg[orow * 64 + d0 * 32 + r32] = (bf16)f2bf(o[d0][r] * rl); }
    asm volatile("s_waitcnt lgkmcnt(0)" ::: "memory");
#pragma unroll
    for (int i = 0; i < 4; ++i) { const int row = i * 8 + (lane >> 3), ch = lane & 7;
        const u32x4 v = *(const __attribute__((address_space(3))) u32x4*)(stg + row * 64 + ch * 8);
        const u32x4 g = *(const __attribute__((address_space(3))) u32x4*)(gst + row * 64 + ch * 8); u32x4 w;
        const size_t off = (yrow0 + row) * DM + TYPE * 256 + h * 64 + ch * 8;
#pragma unroll
        for (int j = 0; j < 4; ++j) { const float a0 = __uint_as_float(v[j] << 16) * __uint_as_float(g[j] << 16), a1 = __uint_as_float(v[j] & 0xffff0000u) * __uint_as_float(g[j] & 0xffff0000u); w[j] = pk2(a0, a1); }
        *(u32x4*)(C.Y + off) = w; }
    asm volatile("s_waitcnt lgkmcnt(0)\n\ts_barrier" ::: "memory");
#undef DMA_KV
}
#undef SBAR
}
#define TACC(F) ((volatile LAS unsigned*)((F).lds + MISC_OFF) + 16)
#define TSTAMP(F, k) do { if (TIMER_SEL >= 0 && (F).vcu == TIMER_WG && (F).tid == 0) { const unsigned now_ = (unsigned)__builtin_amdgcn_s_memrealtime(); TACC(F)[k] += now_ - TACC(F)[31]; TACC(F)[31] = now_; } } while (0)
__device__ __forceinline__ void p_attn(Frame& F, const Args& a, int layer, int rep, int tmask) {
    att::ACtx C{(const bf16*)(a.ws + WS_Q), (const bf16*)(a.ws + WS_K), (const bf16*)(a.ws + WS_V), (const bf16*)(a.ws + WS_G), (bf16*)(a.ws + WS_HN),
                (const float*)(a.ws + WS_LC), (const float*)(a.ws + WS_CTOT), (const float*)(a.ws + WS_TAB), (const float*)(a.ws + WS_KM), (const float*)(a.ws + WS_MF) + layer * 4, a.sinks + layer * 4};
    unsigned* head = (unsigned*)(a.ws + WS_CTL) + CW_QUEUE + 64 * (layer + 2 * rep);
    LAS int* slot = (LAS int*)(F.lds + att::L_MISC) + 200;
    att::lds_ptr shm = (att::lds_ptr)F.lds;
    if (F.tid == 0) slot[0] = (int)__hip_atomic_fetch_add(head, 1u, __ATOMIC_RELAXED, __HIP_MEMORY_SCOPE_AGENT);
    __syncthreads();
    int u = slot[0];
    while (u < 2048) {
        int unext = 0;
        if (F.tid == 0) unext = (int)__hip_atomic_fetch_add(head, 1u, __ATOMIC_RELAXED, __HIP_MEMORY_SCOPE_AGENT);
        const int ty = u >> 9, r = u & 511, qb = 15 - (r >> 5), bh = r & 31;
        TSTAMP(F, 20);
        if (ty == 0) { if (tmask & 2) att::attn_unit<1>(C, bh, qb, shm); }
        else if (ty == 1) { if (tmask & 1) att::attn_unit<0>(C, bh, qb, shm); }
        else if (ty == 2) { if (tmask & 4) att::attn_unit<2>(C, bh, qb, shm); }
        else { if (tmask & 8) att::attn_unit<3>(C, bh, qb, shm); }
        TSTAMP(F, 8 + ty);
        if (F.tid == 0) slot[0] = unext;
        __syncthreads();
        u = slot[0];
    }
    __syncthreads();
}

__global__ void __launch_bounds__(NWAVES * 64, 2) mk_fwd(Args a) {
    extern __shared__ __attribute__((aligned(16))) unsigned char lds[];
    Frame F; F.lds = (LAS unsigned char*)lds; F.tid = threadIdx.x; F.lane = F.tid & 63; F.wave = __builtin_amdgcn_readfirstlane(F.tid >> 6);
    F.G = gridDim.x; { const int bx = blockIdx.x; F.vcu = (F.G % 8 == 0) ? (bx % 8) * (F.G / 8) + bx / 8 : bx; }
    bf16* HN = (bf16*)(a.ws + WS_HN);
    for (int u = F.tid; u < (LDS_BYTES - LDSCTL_OFF) / 4; u += NWAVES * 64) ((LAS unsigned*)(F.lds + LDSCTL_OFF))[u] = 0u;
    __syncthreads();
    XcdBarrier bar; bar.bar = (unsigned*)(a.ws + WS_CTL) + CW_BAR; bar.x = 0; bar.st = nullptr;
    if (a.ph_hi - a.ph_lo > 1) bar = xcd_barrier_post((unsigned*)(a.ws + WS_CTL) + CW_BAR, (volatile LAS unsigned*)(F.lds + MISC_OFF) + 8);
#define PHASE_ON(k) (a.ph_lo <= (k) && (k) < a.ph_hi)
#define SEAM(k) do { if (PHASE_ON(k) && PHASE_ON((k) + 1)) xcd_barrier(bar); } while (0)
#define LAYER_PHASES(layer) do { \
    if (PHASE_ON(4 * (layer) + 0)) { \
        if ((layer) == 0) { p_weights(F, a); __syncthreads(); } \
        p_consts(F, a, (layer)); \
        p_norm(F, a, (layer), (layer) == 0 ? a.x : a.out); \
        if (PROBE_P0) { xcd_barrier(bar); p_norm(F, a, (layer), (layer) == 0 ? a.x : a.out); } \
    } \
    TSTAMP(F, 0); SEAM(4 * (layer) + 0); TSTAMP(F, 1); \
    if (PHASE_ON(4 * (layer) + 1)) { \
        pg8::Gemm g{HN, (const bf16*)(a.ws + WS_WIN) + (size_t)(layer) * NPERM * DM, NTOK, NPERM, DM}; \
        pg8::StaticOrder S; S.init(NTOK, NPERM, F.G, (int)blockIdx.x); \
        pg8::EpiIn E{(bf16*)(a.ws + WS_Q), (bf16*)(a.ws + WS_K), (bf16*)(a.ws + WS_V), (bf16*)(a.ws + WS_G), a.fox_g + (layer) * 128, a.moba_g + (layer) * 128, a.swa_g + (layer) * 128, (float*)(a.ws + WS_KM)}; \
        pg8::gemm_phase<pg8::EpiIn, pg8::StaticOrder, true, true>(F.lds, g, S, E); \
        if (PROBE_P1) { xcd_barrier(bar); pg8::gemm_phase<pg8::EpiIn, pg8::StaticOrder, true, true>(F.lds, g, S, E); } \
    } \
    TSTAMP(F, 2); SEAM(4 * (layer) + 1); TSTAMP(F, 3); \
    if (PHASE_ON(4 * (layer) + 2)) { for (int rep = 0; rep < 1 + (PROBE_ATT != 0 ? PROBE_REPS : 0); ++rep) { if (rep) xcd_barrier(bar); p_attn(F, a, (layer), rep, rep ? PROBE_ATT : 15); } } \
    TSTAMP(F, 4); SEAM(4 * (layer) + 2); TSTAMP(F, 5); \
    if (PHASE_ON(4 * (layer) + 3)) { \
        pg8::Gemm g{HN  , (const bf16*)(a.ws + WS_WOUT) + (size_t)(layer) * DM * DM, NTOK, DM, DM}; \
        pg8::StaticOrder S; S.init(NTOK, DM, F.G, (int)blockIdx.x); \
        pg8::EpiRes E{(layer) == 0 ? a.x : a.out, a.out}; \
        pg8::gemm_phase<pg8::EpiRes, pg8::StaticOrder, true, true>(F.lds, g, S, E); \
        if (PROBE_P3 && (layer) == 0) { xcd_barrier(bar); pg8::gemm_phase<pg8::EpiRes, pg8::StaticOrder, true, true>(F.lds, g, S, E); xcd_barrier(bar); pg8::gemm_phase<pg8::EpiRes, pg8::StaticOrder, true, true>(F.lds, g, S, E); } \
    } \
    TSTAMP(F, 6); SEAM(4 * (layer) + 3); TSTAMP(F, 7); } while (0)
    if (TIMER_SEL >= 0 && F.vcu == TIMER_WG && F.tid == 0) TACC(F)[31] = (unsigned)__builtin_amdgcn_s_memrealtime();
    LAYER_PHASES(0);
    LAYER_PHASES(1);
    if (TIMER_SEL >= 0 && F.vcu == TIMER_WG) {
        asm volatile("s_waitcnt vmcnt(0)" ::: "memory"); __syncthreads();
        float v = (TIMER_SEL == 99) ? 1.0f : (float)TACC(F)[TIMER_SEL] * 0.01f / (float)TIMER_FS; v = fminf(fmaxf(v, 0.f), 1.f); const float dl = 0.1f * sqrtf(v);
        pg8::StaticOrder S; S.init(NTOK, DM, F.G, (int)blockIdx.x); pg8::Unit u;
        for (int i = 0; S.next(i, u); ++i) for (int e = F.tid; e < 65536; e += NWAVES * 64) { float* p = a.out + (size_t)(u.pm * 256 + (e >> 8)) * DM + u.pn * 256 + (e & 255); *p += dl; }
    }
}

extern "C" void kernel_launch(void* const* d_in, const int* in_sizes, int n_in, void* d_out, int out_size, void* d_ws, size_t ws_size, hipStream_t stream) {
    static int ok = 0, grid = 0;
    if (ok == 0) {
        if (n_in != 10 || in_sizes[0] != NTOK * DM || out_size != NTOK * DM || ws_size < WS_END) { fprintf(stderr, "kernel_launch: unexpected shapes (n_in %d, in0 %d, out %d, ws %zu)\n", n_in, n_in > 0 ? in_sizes[0] : -1, out_size, ws_size); ok = -1; return; }
        if (hipFuncSetAttribute((const void*)mk_fwd, hipFuncAttributeMaxDynamicSharedMemorySize, LDS_BYTES) != hipSuccess) { fprintf(stderr, "kernel_launch: hipFuncSetAttribute failed\n"); ok = -1; return; }
        int dev = 0, cus = 0; if (hipGetDevice(&dev) != hipSuccess || hipDeviceGetAttribute(&cus, hipDeviceAttributeMultiprocessorCount, dev) != hipSuccess) { fprintf(stderr, "kernel_launch: device query failed\n"); ok = -1; return; }
        grid = cus < 256 ? (cus / 8) * 8 : 256; if (grid < 8) grid = cus;
        ok = 1;
    }
    if (ok < 0) return;
    Args a{};
    a.x = (const float*)d_in[0]; a.norm_gain = (const float*)d_in[1]; a.w_in = (const float*)d_in[2]; a.b_forget = (const float*)d_in[3]; a.fox_g = (const float*)d_in[4];
    a.moba_g = (const float*)d_in[5]; a.swa_g = (const float*)d_in[6]; a.sinks = (const float*)d_in[7]; a.w_out = (const float*)d_in[8]; a.rel_bias = (const float*)d_in[9];
    a.out = (float*)d_out; a.ws = (unsigned char*)d_ws;
    unsigned char* ws = (unsigned char*)d_ws;
    a.tmask = 15;
    if (hipMemsetAsync(ws + WS_CTL, 0, CTL_ZERO_BYTES, stream) != hipSuccess) { fprintf(stderr, "kernel_launch: memset failed\n"); return; }
#if N_LAUNCHES == 1
    a.ph_lo = 0; a.ph_hi = 8; hipLaunchKernelGGL(mk_fwd, dim3(grid), dim3(NWAVES * 64), LDS_BYTES, stream, a);
#else
    for (int ph = 0; ph < 8; ++ph) { a.ph_lo = ph; a.ph_hi = ph + 1; hipLaunchKernelGGL(mk_fwd, dim3(grid), dim3(NWAVES * 64), LDS_BYTES, stream, a); }
#endif
}
```

```cpp
#include <hip/hip_runtime.h>
#include <cstdio>
#include <cstdint>
#include <cmath>
namespace pg8 {
#define PG8_LAS __attribute__((address_space(3)))
typedef unsigned short bf16_t;
typedef short bf16x8 __attribute__((ext_vector_type(8)));
typedef float f32x4 __attribute__((ext_vector_type(4)));
typedef unsigned u32x4 __attribute__((ext_vector_type(4)));
constexpr int BM = 256, BK = 64, HALF = 128, HTB = HALF * BK * 2  , STAGE_BYTES = 8 * HTB, NXCD = 8, WGM = 8;

__host__ __device__ __forceinline__ int lds_byte(int r, int c) { const int st = (r >> 4) * 2 + (c >> 5), rr = r & 15, cc = c & 31, ob = rr * 64 + cc * 2; return st * 1024 + (ob ^ (((ob >> 9) & 1) << 5)); }
__host__ __device__ __forceinline__ void stage_rc(int b, int& R, int& C) { const int st = b / 1024, sb = b % 1024, swz = sb ^ (((sb >> 9) & 1) << 5); R = (st >> 1) * 16 + swz / 64; C = (st & 1) * 32 + (swz % 64) / 2; }
__host__ __device__ __forceinline__ int perm32(int rho) { const int n = rho >> 4, i = rho & 15; return 8 * (i >> 2) + 4 * n + (i & 3); }

struct Unit { int pm, pn; };
struct Gemm { const bf16_t* A; const bf16_t* Bt; int M, N, K; };

struct StaticOrder {
    int nM, nN, nwg, G, c;
    __host__ __device__ void init(int M, int N, int G_, int c_) { nM = M / BM; nN = N / BM; nwg = nM * nN; G = G_; c = c_; }
    __host__ __device__ bool next(int i, Unit& u) const {
        const long L = (long)i * G + c; if (L >= nwg) return false;
        int wgid = (int)L; { const int q = nwg / NXCD, r = nwg % NXCD, xcd = wgid % NXCD, off = wgid / NXCD; wgid = (xcd < r ? xcd * (q + 1) : r * (q + 1) + (xcd - r) * q) + off; }
        const int nig = WGM * nN, gid = wgid / nig, fm = gid * WGM, gsz = (nM - fm) < WGM ? (nM - fm) : WGM;
        u.pm = fm + ((wgid % nig) % gsz); u.pn = (wgid % nig) / gsz; return true;
    }
    __device__ __forceinline__ void a_ready(const Unit&) const {}
    __device__ __forceinline__ void done(const Unit&) const {}
};

__device__ __forceinline__ unsigned cvt_pk_bf16(float lo, float hi) { unsigned r; asm volatile("v_cvt_pk_bf16_f32 %0, %1, %2" : "=v"(r) : "v"(lo), "v"(hi)); return r; }
typedef float f32x2 __attribute__((ext_vector_type(2)));
constexpr float C2 = 0.125f * 1.4426950408889634f;
constexpr float RMS_EPS = 1e-6f;
constexpr size_t GS = (size_t)8 * 4 * 4096 * 64;
struct EpiIn {
    static constexpr bool PERM = true, AFTER_DRAIN = false;
    bf16_t *Q, *K, *V, *G; const float *gfox, *gmoba, *gswa; float* KM; const float* RS; float* LF; const float* bfg;
    __device__ __forceinline__ void operator()(const f32x4 (&acc)[2][2][4][2], const Unit& u, int wr, int wc, int fr, int fq) const {
        const int T = u.pn;
        const int b = (u.pm * BM) >> 12, t0 = ((u.pm * BM) & 4095) + wr * 64 + fr;
        float rs[2][4];
#pragma unroll
        for (int ai = 0; ai < 2; ++ai)
#pragma unroll
            for (int m = 0; m < 4; ++m) rs[ai][m] = 1.0f / sqrtf(RS[u.pm * BM + ai * HALF + wr * 64 + m * 16 + fr] * (1.0f / 1024.0f) + RMS_EPS);
        if (T == 15) {
            if (wc == 0 && fq == 0) { const f32x4 bv = *(const f32x4*)bfg;
#pragma unroll
                for (int ai = 0; ai < 2; ++ai)
#pragma unroll
                    for (int m = 0; m < 4; ++m) { const f32x4 a4 = acc[ai][0][m][0] * rs[ai][m] + bv;
#pragma unroll
                        for (int j = 0; j < 4; ++j) { const float uu = a4[j]; const float sp = fmaxf(-uu, 0.f) + __logf(1.f + __expf(-fabsf(uu)));
                            LF[(size_t)(b * 4 + j) * 4096 + t0 + ai * HALF + m * 16] = -sp * 1.4426950408889634f; } } }
            return;
        }
        int mode = 1, nh = 4, head = wc; float scale = 1.f; const float* gain = nullptr; bf16_t* base = nullptr;
        switch (T) {
            case 0: mode = 0; gain = gfox; scale = C2; base = Q; break;
            case 1: mode = 0; gain = gfox + 64; base = K; break;
            case 2: base = V; break;
            case 4: mode = 0; gain = gmoba; scale = C2; base = Q + GS; break;
            case 5: mode = 0; gain = gmoba + 64; base = K + GS; break;
            case 6: base = V + GS; break;
            case 8: scale = C2; base = Q + 2 * GS; break;
            case 9: base = K + 2 * GS; break;
            case 10: base = V + 2 * GS; break;
            case 12: mode = 0; gain = gswa; scale = C2; base = Q + 3 * GS; break;
            case 13: nh = 2; if (wc < 2) { mode = 0; gain = gswa + 64; base = K + 3 * GS; } else { base = V + 3 * GS; head = wc - 2; } break;
            default: mode = 2; break;
        }
        if (mode == 2) {
            bf16_t* gp = G + (size_t)(u.pm * BM + wr * 64 + fr) * 1024 + (T >> 2) * 256 + 64 * wc + 8 * fq;
#pragma unroll
            for (int ai = 0; ai < 2; ++ai)
#pragma unroll
                for (int m = 0; m < 4; ++m)
#pragma unroll
                    for (int bj = 0; bj < 2; ++bj) {
                        f32x4 v0 = acc[ai][bj][m][0] * rs[ai][m], v1 = acc[ai][bj][m][1] * rs[ai][m];
#pragma unroll
                        for (int j = 0; j < 4; ++j) { v0[j] = v0[j] / (1.f + __expf(-v0[j])); v1[j] = v1[j] / (1.f + __expf(-v1[j])); }
                        u32x4 w; w.x = cvt_pk_bf16(v0[0], v0[1]); w.y = cvt_pk_bf16(v0[2], v0[3]); w.z = cvt_pk_bf16(v1[0], v1[1]); w.w = cvt_pk_bf16(v1[2], v1[3]);
                        *(u32x4*)(gp + (size_t)(ai * HALF + m * 16) * 1024 + 32 * bj) = w;
                    }
            return;
        }
        f32x4 gv[2][2];
#pragma unroll
        for (int bj = 0; bj < 2; ++bj)
#pragma unroll
            for (int n = 0; n < 2; ++n) gv[bj][n] = (mode == 0) ? *(const f32x4*)(gain + 32 * bj + 8 * fq + 4 * n) : (f32x4){1.f, 1.f, 1.f, 1.f};
        bf16_t* dp = base + ((size_t)(b * nh + head) * 4096 + t0) * 64 + 8 * fq;
        f32x4 cs4[2][2];
#pragma unroll
        for (int bj = 0; bj < 2; ++bj)
#pragma unroll
            for (int n = 0; n < 2; ++n) cs4[bj][n] = (f32x4){0.f, 0.f, 0.f, 0.f};
#pragma unroll
        for (int ai = 0; ai < 2; ++ai)
#pragma unroll
            for (int m = 0; m < 4; ++m) {
                float r = scale * rs[ai][m];
                if (mode == 0) {
                    float ss = 0.f;
#pragma unroll
                    for (int bj = 0; bj < 2; ++bj)
#pragma unroll
                        for (int n = 0; n < 2; ++n) { const f32x4 x = acc[ai][bj][m][n]; ss += (x[0] * x[0] + x[1] * x[1]) + (x[2] * x[2] + x[3] * x[3]); }
                    ss += __shfl_xor(ss, 16); ss += __shfl_xor(ss, 32);
                    r = scale * rs[ai][m] / sqrtf(ss * rs[ai][m] * rs[ai][m] * (1.0f / 64.0f) + RMS_EPS);
                }
#pragma unroll
                for (int bj = 0; bj < 2; ++bj) {
                    const f32x4 v0 = acc[ai][bj][m][0] * gv[bj][0] * r, v1 = acc[ai][bj][m][1] * gv[bj][1] * r;
                    if (T == 5) { cs4[bj][0] += v0; cs4[bj][1] += v1; }
                    u32x4 w; w.x = cvt_pk_bf16(v0[0], v0[1]); w.y = cvt_pk_bf16(v0[2], v0[3]); w.z = cvt_pk_bf16(v1[0], v1[1]); w.w = cvt_pk_bf16(v1[2], v1[3]);
                    *(u32x4*)(dp + (size_t)(ai * HALF + m * 16) * 64 + 32 * bj) = w;
                }
            }
        if (T == 5) {
            float* kmp = KM + ((size_t)((b * 4 + wc) * 16 + (((u.pm * BM) & 4095) >> 8))) * 64 + 8 * fq;
#pragma unroll
            for (int bj = 0; bj < 2; ++bj)
#pragma unroll
                for (int n = 0; n < 2; ++n)
#pragma unroll
                    for (int j = 0; j < 4; ++j) { float s = cs4[bj][n][j];
                        s += __shfl_xor(s, 1); s += __shfl_xor(s, 2); s += __shfl_xor(s, 4); s += __shfl_xor(s, 8);
                        if (fr == 0) atomicAdd(kmp + 32 * bj + 4 * n + j, s * (1.0f / 256.0f)); }
        }
    }
};
struct EpiRes0 {
    static constexpr bool PERM = true, AFTER_DRAIN = false;
    const float* base; bf16_t* X1; float* RS1;
    __device__ __forceinline__ void operator()(const f32x4 (&acc)[2][2][4][2], const Unit& u, int wr, int wc, int fr, int fq) const {
        const int col0 = u.pn * BM + wc * 32 + 8 * fq;
#pragma unroll
        for (int ai = 0; ai < 2; ++ai)
#pragma unroll
            for (int m = 0; m < 4; ++m) {
                const int row = u.pm * BM + ai * HALF + wr * 64 + m * 16 + fr; const size_t off = (size_t)row * 1024 + col0; float ss = 0.f;
#pragma unroll
                for (int bj = 0; bj < 2; ++bj) {
                    const f32x4 v0 = *(const f32x4*)(base + off + bj * HALF) + acc[ai][bj][m][0], v1 = *(const f32x4*)(base + off + bj * HALF + 4) + acc[ai][bj][m][1];
                    ss += (v0[0] * v0[0] + v0[1] * v0[1]) + (v0[2] * v0[2] + v0[3] * v0[3]) + (v1[0] * v1[0] + v1[1] * v1[1]) + (v1[2] * v1[2] + v1[3] * v1[3]);
                    u32x4 w; w.x = cvt_pk_bf16(v0[0], v0[1]); w.y = cvt_pk_bf16(v0[2], v0[3]); w.z = cvt_pk_bf16(v1[0], v1[1]); w.w = cvt_pk_bf16(v1[2], v1[3]);
                    *(u32x4*)(X1 + off + bj * HALF) = w; }
                ss += __shfl_xor(ss, 16); ss += __shfl_xor(ss, 32);
                if (fq == 0) atomicAdd(RS1 + row, ss);
            }
    }
};
struct EpiRes1 {
    static constexpr bool PERM = true, AFTER_DRAIN = false;
    const bf16_t* X1; float* out;
    __device__ __forceinline__ void operator()(const f32x4 (&acc)[2][2][4][2], const Unit& u, int wr, int wc, int fr, int fq) const {
        const int col0 = u.pn * BM + wc * 32 + 8 * fq;
#pragma unroll
        for (int ai = 0; ai < 2; ++ai)
#pragma unroll
            for (int m = 0; m < 4; ++m) {
                const size_t off = (size_t)(u.pm * BM + ai * HALF + wr * 64 + m * 16 + fr) * 1024 + col0;
#pragma unroll
                for (int bj = 0; bj < 2; ++bj) { const u32x4 xb = *(const u32x4*)(X1 + off + bj * HALF);
                    f32x4 v0, v1; v0[0] = __uint_as_float(xb.x << 16); v0[1] = __uint_as_float(xb.x & 0xffff0000u); v0[2] = __uint_as_float(xb.y << 16); v0[3] = __uint_as_float(xb.y & 0xffff0000u);
                    v1[0] = __uint_as_float(xb.z << 16); v1[1] = __uint_as_float(xb.z & 0xffff0000u); v1[2] = __uint_as_float(xb.w << 16); v1[3] = __uint_as_float(xb.w & 0xffff0000u);
                    *(f32x4*)(out + off + bj * HALF) = v0 + acc[ai][bj][m][0]; *(f32x4*)(out + off + bj * HALF + 4) = v1 + acc[ai][bj][m][1]; }
            }
    }
};

template <class Epi, class Sched, bool ALIGN_EPI = false, bool SP2 = false>
__device__ __forceinline__ void gemm_phase(PG8_LAS unsigned char* lds, const Gemm g, const Sched& S, const Epi& E) {
    const int tid = threadIdx.x, wid = __builtin_amdgcn_readfirstlane(tid >> 6), lane = tid & 63, wr = wid >> 2, wc = wid & 3, fr = lane & 15, fq = lane >> 4;
    const int K = g.K, nt = K / BK;
    unsigned voffA[2], voffB[2];
#pragma unroll
    for (int i = 0; i < 2; ++i) { int R, C; stage_rc(tid * 16 + i * 8192, R, C); const int Rb = Epi::PERM ? ((R & ~31) + perm32(R & 31)) : R;
        voffA[i] = (unsigned)(R * K + C) * 2u; voffB[i] = (unsigned)(Rb * K + C) * 2u; }
    const size_t kstep = (size_t)(BK * 2);
    const size_t hstep = (size_t)HALF * K * 2;
    const size_t tstep = 2 * hstep;
    const unsigned ldsw = (unsigned)wid * 1024u;
    const int aoff = lds_byte(wr * 64 + fr, fq * 8), boff = lds_byte(wc * 32 + fr, fq * 8);
#define PG8_SA(b, h) (((b) * 2 + (h)) * HTB)
#define PG8_SB(b, h) ((4 + (b) * 2 + (h)) * HTB)
#define PG8_STAGE(bufoff, gbase, voff) do { _Pragma("unroll") for (int _i = 0; _i < 2; ++_i) \
        __builtin_amdgcn_global_load_lds((const unsigned*)((const char*)(gbase) + (voff)[_i]), (PG8_LAS unsigned*)(lds + (bufoff) + ldsw + _i * 8192), 16, 0, 0); } while (0)
#define PG8_LDA(dst, b, h) do { _Pragma("unroll") for (int m = 0; m < 4; ++m) _Pragma("unroll") for (int k = 0; k < 2; ++k) dst[m][k] = *(const PG8_LAS bf16x8*)(lds + PG8_SA(b, h) + aoff + m * 2048 + k * 1024); } while (0)
#define PG8_LDB(dst, b, h) do { _Pragma("unroll") for (int n = 0; n < 2; ++n) _Pragma("unroll") for (int k = 0; k < 2; ++k) dst[n][k] = *(const PG8_LAS bf16x8*)(lds + PG8_SB(b, h) + boff + n * 2048 + k * 1024); } while (0)
#define PG8_MMA(ai, bj, At, Bt) do { __builtin_amdgcn_s_setprio(1); _Pragma("unroll") for (int m = 0; m < 4; ++m) _Pragma("unroll") for (int n = 0; n < 2; ++n) _Pragma("unroll") for (int k = 0; k < 2; ++k) \
        acc[ai][bj][m][n] = __builtin_amdgcn_mfma_f32_16x16x32_bf16(Bt[n][k], At[m][k], acc[ai][bj][m][n], 0, 0, 0); __builtin_amdgcn_s_setprio(0); } while (0)
#define PG8_WAIT_V(n) asm volatile("s_waitcnt vmcnt(" #n ")" ::: "memory")
#define PG8_WAIT_L(n) asm volatile("s_waitcnt lgkmcnt(" #n ")" ::: "memory")
#define PG8_BAR __builtin_amdgcn_s_barrier()
#define PG8_SCHED __builtin_amdgcn_sched_barrier(0)
    Unit cur, nxt; int ui = 0;
    if (!S.next(0, cur)) return;
    f32x4 acc[2][2][4][2];
#pragma unroll
    for (int a = 0; a < 2; ++a)
#pragma unroll
        for (int b = 0; b < 2; ++b)
#pragma unroll
            for (int m = 0; m < 4; ++m)
#pragma unroll
                for (int n = 0; n < 2; ++n) acc[a][b][m][n] = (f32x4){0.f, 0.f, 0.f, 0.f};
    bf16x8 At[4][2], B0[2][2], B1[2][2];
    const char* cA = (const char*)g.A + (size_t)cur.pm * tstep; const char* cB = (const char*)g.Bt + (size_t)cur.pn * tstep;
    S.a_ready(cur);
    if constexpr (SP2) {
        PG8_STAGE(PG8_SB(0, 0), cB, voffB); PG8_STAGE(PG8_SB(0, 1), cB + hstep, voffB); PG8_STAGE(PG8_SA(0, 0), cA, voffA); PG8_STAGE(PG8_SA(0, 1), cA + hstep, voffA);
        if (wr == 1) PG8_BAR;
        PG8_WAIT_V(2); PG8_BAR;
        PG8_STAGE(PG8_SB(1, 0), cB + kstep, voffB); PG8_STAGE(PG8_SA(1, 0), cA + kstep, voffA); PG8_STAGE(PG8_SB(1, 1), cB + hstep + kstep, voffB);
        PG8_WAIT_V(6); PG8_BAR;
    } else {
        PG8_STAGE(PG8_SB(0, 0), cB, voffB); PG8_STAGE(PG8_SA(0, 0), cA, voffA); PG8_STAGE(PG8_SB(0, 1), cB + hstep, voffB); PG8_STAGE(PG8_SA(0, 1), cA + hstep, voffA);
        if (wr == 1) PG8_BAR;
        PG8_WAIT_V(4); PG8_BAR;
        PG8_STAGE(PG8_SB(1, 0), cB + kstep, voffB); PG8_STAGE(PG8_SA(1, 0), cA + kstep, voffA); PG8_STAGE(PG8_SB(1, 1), cB + hstep + kstep, voffB);
        PG8_WAIT_V(6); PG8_BAR;
    }
    for (;;) {
        const bool has_next = S.next(ui + 1, nxt);
        const char* nA = has_next ? (const char*)g.A + (size_t)nxt.pm * tstep : cA; const char* nB = has_next ? (const char*)g.Bt + (size_t)nxt.pn * tstep : cB;
        for (int t = 0; t < nt; t += 2) {
            const bool last = (t == nt - 2);
            const char* a1 = cA + (size_t)(t + 1) * kstep;
            const char* a2 = last ? nA : cA + (size_t)(t + 2) * kstep; const char* b2 = last ? nB : cB + (size_t)(t + 2) * kstep;
            const char* a3 = a2 + kstep; const char* b3 = b2 + kstep;
            if (last && has_next) S.a_ready(nxt);
            if constexpr (SP2) {
            PG8_LDB(B0, 0, 0); PG8_LDB(B1, 0, 1); PG8_SCHED; PG8_LDA(At, 0, 0); PG8_STAGE(PG8_SA(1, 1), a1 + hstep, voffA);
            PG8_WAIT_V(8); PG8_WAIT_L(0); PG8_BAR; PG8_MMA(0, 0, At, B0); PG8_MMA(0, 1, At, B1); PG8_BAR; PG8_SCHED;
            PG8_LDA(At, 0, 1); PG8_STAGE(PG8_SB(0, 0), b2, voffB); PG8_STAGE(PG8_SB(0, 1), b2 + hstep, voffB); PG8_STAGE(PG8_SA(0, 0), a2, voffA);
            PG8_WAIT_V(8); PG8_WAIT_L(0); PG8_BAR; PG8_MMA(1, 0, At, B0); PG8_MMA(1, 1, At, B1); PG8_BAR; PG8_SCHED;
            PG8_LDB(B0, 1, 0); PG8_LDB(B1, 1, 1); PG8_SCHED; PG8_LDA(At, 1, 0); PG8_STAGE(PG8_SA(0, 1), a2 + hstep, voffA);
            PG8_WAIT_V(8); PG8_WAIT_L(0); PG8_BAR; PG8_MMA(0, 0, At, B0); PG8_MMA(0, 1, At, B1); PG8_BAR; PG8_SCHED;
            PG8_LDA(At, 1, 1); PG8_STAGE(PG8_SB(1, 0), b3, voffB); PG8_STAGE(PG8_SB(1, 1), b3 + hstep, voffB); PG8_STAGE(PG8_SA(1, 0), a3, voffA);
            PG8_WAIT_V(8); PG8_WAIT_L(0); PG8_BAR; PG8_MMA(1, 0, At, B0); PG8_MMA(1, 1, At, B1); PG8_BAR; PG8_SCHED;
            } else {
            PG8_LDB(B0, 0, 0); PG8_SCHED; PG8_LDA(At, 0, 0); PG8_STAGE(PG8_SA(1, 1), a1 + hstep, voffA);
            PG8_WAIT_L(8); PG8_BAR; PG8_WAIT_L(0); PG8_MMA(0, 0, At, B0); PG8_BAR; PG8_SCHED;
            PG8_LDB(B1, 0, 1); PG8_STAGE(PG8_SB(0, 0), b2, voffB);
            PG8_BAR; PG8_WAIT_L(0); PG8_MMA(0, 1, At, B1); PG8_BAR;
            PG8_LDA(At, 0, 1); PG8_STAGE(PG8_SA(0, 0), a2, voffA);
            PG8_BAR; PG8_WAIT_L(0); PG8_MMA(1, 0, At, B0); PG8_BAR; PG8_SCHED;
            PG8_STAGE(PG8_SB(0, 1), b2 + hstep, voffB);
            PG8_WAIT_V(6); PG8_BAR; PG8_MMA(1, 1, At, B1); PG8_BAR;
            PG8_LDB(B0, 1, 0); PG8_SCHED; PG8_LDA(At, 1, 0); PG8_STAGE(PG8_SA(0, 1), a2 + hstep, voffA);
            PG8_WAIT_L(8); PG8_BAR; PG8_WAIT_L(0); PG8_MMA(0, 0, At, B0); PG8_BAR; PG8_SCHED;
            PG8_LDB(B1, 1, 1); PG8_STAGE(PG8_SB(1, 0), b3, voffB);
            PG8_BAR; PG8_WAIT_L(0); PG8_MMA(0, 1, At, B1); PG8_BAR;
            PG8_LDA(At, 1, 1); PG8_STAGE(PG8_SA(1, 0), a3, voffA);
            PG8_BAR; PG8_WAIT_L(0); PG8_MMA(1, 0, At, B0); PG8_BAR; PG8_SCHED;
            PG8_STAGE(PG8_SB(1, 1), b3 + hstep, voffB);
            PG8_WAIT_V(6); PG8_BAR; PG8_MMA(1, 1, At, B1); PG8_BAR;
            }
        }
        if constexpr (ALIGN_EPI) { if (wr == 0) PG8_BAR; }
        if constexpr (!Epi::AFTER_DRAIN) { E(acc, cur, wr, wc, fr, fq); S.done(cur); }
        if (!has_next) break;
#pragma unroll
        for (int a = 0; a < 2; ++a)
#pragma unroll
            for (int b = 0; b < 2; ++b)
#pragma unroll
                for (int m = 0; m < 4; ++m)
#pragma unroll
                    for (int n = 0; n < 2; ++n) acc[a][b][m][n] = (f32x4){0.f, 0.f, 0.f, 0.f};
        cur = nxt; cA = nA; cB = nB; ++ui;
        if constexpr (ALIGN_EPI) { if (wr == 1) PG8_BAR; }
    }
    PG8_WAIT_V(0);
    if constexpr (!ALIGN_EPI) { if (wr == 0) PG8_BAR; }
    PG8_BAR;
    if constexpr (Epi::AFTER_DRAIN) { E.fused(acc, cur, wr, wc, fr, fq, lds, wid, lane); S.done(cur); }
#undef PG8_SA
#undef PG8_SB
#undef PG8_STAGE
#undef PG8_LDA
#undef PG8_LDB
#undef PG8_MMA
#undef PG8_WAIT_V
#undef PG8_WAIT_L
#undef PG8_BAR
#undef PG8_SCHED
}
}
constexpr int NB = 8, SEQ = 4096, DM = 1024, NTOK = NB * SEQ, INW = 3844, NPERM = 4096, NLAYER = 2;
constexpr size_t MiB = 1u << 20;
constexpr size_t WS_CTL = 0, CTL_ZERO_BYTES = 1 * MiB;
constexpr size_t WS_WIN = 2 * MiB;
constexpr size_t WS_WOUT = 18 * MiB;
constexpr size_t WS_LF = 22 * MiB;
constexpr size_t WS_RS = 26 * MiB;
constexpr size_t WS_TAB = 23 * MiB;
constexpr size_t WS_KM = 24 * MiB;
constexpr size_t WS_MF = 25 * MiB;
constexpr int CW_BAR = 4096;
constexpr int CW_QUEUE = 64;
constexpr size_t WS_HN = 32 * MiB;
constexpr size_t WS_Q = 96 * MiB, WS_K = 160 * MiB, WS_V = 216 * MiB, WS_G = 272 * MiB, WS_X1 = 336 * MiB  , WS_END = 400 * MiB;
constexpr float LOG2E = 1.4426950408889634f;
constexpr int NWAVES = 8;
#define TIMER_SEL -1
#define TIMER_FS 100
#define TIMER_WG 37
#define TIMER_TYPE 1
#define PROBE_ATT 0
#define PROBE_REPS 2
#define PROBE_P1 0
#define PROBE_P3 0
#define PROBE_P0 0
#ifndef N_LAUNCHES
#define N_LAUNCHES 1
#endif
constexpr int RING_BYTES = 131072, LDSCTL_OFF = 139264, MISC_OFF = LDSCTL_OFF + 320, LDS_BYTES = 147456;

#define GAS __attribute__((address_space(1)))
#define LAS __attribute__((address_space(3)))
typedef unsigned short bf16;
typedef unsigned v4u __attribute__((ext_vector_type(4)));
typedef float f32x4 __attribute__((ext_vector_type(4)));
__device__ __forceinline__ unsigned f2bf(float f) { unsigned u = __builtin_bit_cast(unsigned, f); return (u + 0x7fffu + ((u >> 16) & 1u)) >> 16; }
__device__ __forceinline__ unsigned pk2(float lo, float hi) { return f2bf(lo) | (f2bf(hi) << 16); }
__device__ __forceinline__ float bf2f(unsigned v) { return __uint_as_float(v << 16); }
__device__ __forceinline__ float wave_sum(float v) {
#pragma unroll
    for (int o = 1; o < 64; o <<= 1) v += __shfl_xor(v, o);
    return v;
}
#define RLX_AGENT __ATOMIC_RELAXED, __HIP_MEMORY_SCOPE_AGENT
#define XB_TMO      128
#define XB_XCNT(j)  (256  + 64 * (j))
#define XB_XSUB(j)  (1280 + 64 * (j))
#define XB_XGEN(j)  (2304 + 64 * (j))
#define XB_TOP      3328
#define XB_TOPGEN   3392
#define XCD_BAR_WORDS 3456
#define XB_SPIN_CAP (1u << 18)

__device__ __forceinline__ unsigned xb_ld(unsigned* p)              { return __hip_atomic_load(p, __ATOMIC_RELAXED, __HIP_MEMORY_SCOPE_AGENT); }
__device__ __forceinline__ unsigned xb_add(unsigned* p, unsigned v) { return __hip_atomic_fetch_add(p, v, __ATOMIC_RELAXED, __HIP_MEMORY_SCOPE_AGENT); }
__device__ __forceinline__ unsigned xb_xcc_id() { return (unsigned)__builtin_amdgcn_s_getreg((3 << 11) | 20) & 0xFu; }
#define XB_SPIN(cond, bar) do { unsigned _sp = 0; while (cond) { __builtin_amdgcn_s_sleep(1); \
    if ((++_sp & 255u) == 0u) { if (xb_ld(&(bar)[XB_TMO])) break; if (_sp > XB_SPIN_CAP) { atomicAdd(&(bar)[XB_TMO], 1u); break; } } } } while (0)

struct XcdBarrier {
    unsigned* bar; unsigned x;
    volatile LAS unsigned* st;
};

__device__ __forceinline__ XcdBarrier xcd_barrier_post(unsigned* bar, volatile LAS unsigned* st) {
    XcdBarrier b; b.bar = bar; b.x = xb_xcc_id(); b.st = st;
    if (threadIdx.x == 0) (void)xb_add(&bar[XB_XCNT(b.x)], 1u);
    return b;
}
__device__ __forceinline__ void xcd_barrier_complete(unsigned* bar, unsigned x, unsigned& nloc, unsigned& nx) {
    const unsigned G = gridDim.x * gridDim.y * gridDim.z;
    unsigned sum, cnt, mine, sp = 0u;
    for (;;) {
        sum = 0u; cnt = 0u; mine = 0u;
#pragma unroll
        for (unsigned j = 0; j < 16; ++j) { const unsigned c = xb_ld(&bar[XB_XCNT(j)]); sum += c; cnt += (c > 0u) ? 1u : 0u; mine = (j == x) ? c : mine; }
        if (sum == G) break;
        __builtin_amdgcn_s_sleep(1);
        if ((++sp & 255u) == 0u) { if (xb_ld(&bar[XB_TMO])) break; if (sp > XB_SPIN_CAP) { atomicAdd(&bar[XB_TMO], 1u); break; } }
    }
    nloc = mine > 0u ? mine : 1u; nx = cnt > 0u ? cnt : 1u;
}

__device__ __forceinline__ void xcd_barrier(const XcdBarrier& b) {
    asm volatile("s_waitcnt vmcnt(0)" ::: "memory");
    __syncthreads();
    if (threadIdx.x == 0) {
        unsigned* bar = b.bar;
        __builtin_amdgcn_s_waitcnt(0);
        unsigned nloc = b.st[0], nx = b.st[1];
        if (nloc == 0u) { xcd_barrier_complete(bar, b.x, nloc, nx); b.st[0] = nloc; b.st[1] = nx; }
        const unsigned old = xb_add(&bar[XB_XSUB(b.x)], 1u);
        const unsigned gen = old / nloc;
        if (old + 1u == (gen + 1u) * nloc) {
            __builtin_amdgcn_fence(__ATOMIC_RELEASE, "agent");
            asm volatile("s_waitcnt vmcnt(0)" ::: "memory");
            const unsigned og = xb_add(&bar[XB_TOP], 1u);
            const unsigned tg = og / nx;
            if (og + 1u == (tg + 1u) * nx) xb_add(&bar[XB_TOPGEN], 1u);
            else XB_SPIN(xb_ld(&bar[XB_TOPGEN]) == tg, bar);
            __builtin_amdgcn_fence(__ATOMIC_ACQUIRE, "agent");
            xb_add(&bar[XB_XGEN(b.x)], 1u);
            asm volatile("s_waitcnt vmcnt(0)" ::: "memory");
        } else {
            XB_SPIN(xb_ld(&bar[XB_XGEN(b.x)]) == gen, bar);
            __builtin_amdgcn_fence(__ATOMIC_ACQUIRE, "agent");
            asm volatile("s_waitcnt vmcnt(0)" ::: "memory");
        }
    }
    __syncthreads();
}

__device__ __forceinline__ int rel_bucket(int d) {
    if (d < 16) return d;
    int b = 16;
    b += (d >= 21); b += (d >= 27); b += (d >= 35); b += (d >= 46); b += (d >= 59); b += (d >= 77); b += (d >= 99); b += (d >= 128);
    b += (d >= 166); b += (d >= 216); b += (d >= 280); b += (d >= 363); b += (d >= 470); b += (d >= 609); b += (d >= 790);
    return b;
}

struct Args { const float* x; const float* norm_gain; const float* w_in; const float* b_forget; const float* fox_g; const float* moba_g; const float* swa_g; const float* sinks; const float* w_out; const float* rel_bias; float* out; unsigned char* ws; int ph_lo, ph_hi, tmask, pad; };

struct Frame { LAS unsigned char* lds; int tid, lane, wave, vcu, G; };

__device__ __forceinline__ void transpose_item(const float* W, int ldw, bf16* WT, int dst_row0, int src_col0, int ncol, const float* gk, LAS float* scr, int kb, int lane) {
    const int k0 = 64 * kb;
    { float wv[32]; const int c = lane & 31;
#pragma unroll
        for (int i = 0; i < 32; ++i) { const int kk = 2 * i + (lane >> 5); wv[i] = (c < ncol) ? W[(size_t)(k0 + kk) * ldw + src_col0 + c] : 0.f; }
        if (gk) {
#pragma unroll
            for (int i = 0; i < 32; ++i) wv[i] *= gk[k0 + 2 * i + (lane >> 5)]; }
#pragma unroll
        for (int i = 0; i < 32; ++i) scr[(2 * i + (lane >> 5)) * 33 + c] = wv[i]; }
    asm volatile("s_waitcnt lgkmcnt(0)" ::: "memory");
    const int c = lane & 7;
#pragma unroll
    for (int j = 0; j < 4; ++j) { const int n = (lane >> 3) + 8 * j; const LAS float* s = scr + (8 * c) * 33 + n;
        v4u o; o.x = pk2(s[0 * 33], s[1 * 33]); o.y = pk2(s[2 * 33], s[3 * 33]); o.z = pk2(s[4 * 33], s[5 * 33]); o.w = pk2(s[6 * 33], s[7 * 33]);
        *(v4u*)(WT + (size_t)(dst_row0 + n) * 1024 + k0 + 8 * c) = o; }
    asm volatile("s_waitcnt lgkmcnt(0)" ::: "memory");
}
__device__ __forceinline__ int tile_src(int T, int wc) {
    switch (T) { case 0: return 0 + 64 * wc; case 1: return 256 + 64 * wc; case 2: return 512 + 64 * wc; case 3: return 772 + 64 * wc;
        case 4: return 1028 + 64 * wc; case 5: return 1284 + 64 * wc; case 6: return 1540 + 64 * wc; case 7: return 1796 + 64 * wc;
        case 8: return 2052 + 64 * wc; case 9: return 2308 + 64 * wc; case 10: return 2564 + 64 * wc; case 11: return 2820 + 64 * wc;
        case 12: return 3076 + 64 * wc; case 13: return wc < 2 ? 3332 + 64 * wc : 3460 + 64 * (wc - 2); default: return 3588 + 64 * wc; }
}
__device__ __forceinline__ void p_weights(Frame& F, const Args& a) {
    LAS float* scr = (LAS float*)(F.lds + F.wave * 16384);
    const int gw = F.vcu * NWAVES + F.wave, NGW = F.G * NWAVES;
    bf16* win = (bf16*)(a.ws + WS_WIN); bf16* wout = (bf16*)(a.ws + WS_WOUT);
    constexpr int I_IN = 128 * 16, I_OUT = 32 * 16;
    for (int it = gw; it < 2 * (I_IN + I_OUT); it += NGW) {
        const int layer = it / (I_IN + I_OUT); int r = it % (I_IN + I_OUT);
        if (r < I_IN) { const int kb = r >> 7, g = r & 127, T = g >> 3, gg = g & 7, bj = gg >> 2, wc = gg & 3;
            const int src = (T < 15) ? tile_src(T, wc) + 32 * bj : 768, ncol = (T < 15) ? 32 : (gg == 0 ? 4 : 0);
            transpose_item(a.w_in + (size_t)layer * DM * INW, INW, win + (size_t)layer * NPERM * DM, 32 * g, src, ncol, a.norm_gain + layer * DM, scr, kb, F.lane); }
        else { r -= I_IN; const int kb = r / 32, g = r % 32;
            transpose_item(a.w_out + (size_t)layer * DM * DM, DM, wout + (size_t)layer * DM * DM, 32 * g, 32 * g, 32, nullptr, scr, kb, F.lane); }
    }
    if (F.vcu == 0) { float* tab = (float*)(a.ws + WS_TAB);
        for (int i = F.tid; i < 8 * 1024; i += NWAVES * 64) { const int hc = i >> 10, d = i & 1023; tab[i] = a.rel_bias[rel_bucket(d) * 8 + hc] * LOG2E; } }
}
__device__ __forceinline__ void p_consts(Frame& F, const Args& a) {
    if (F.vcu == 0 && F.wave == 0) for (int layer = 0; layer < NLAYER; ++layer) {
        const int lane = F.lane; float* MF = (float*)(a.ws + WS_MF) + layer * 4;
        float bm = 0.f;
#pragma unroll
        for (int j = 0; j < 4; ++j) bm = fmaxf(bm, fabsf(a.rel_bias[64 * j + lane]));
#pragma unroll
        for (int o = 1; o < 64; o <<= 1) bm = fmaxf(bm, __shfl_xor(bm, o));
        const float* gp[3] = {a.fox_g + layer * 128, a.moba_g + layer * 128, a.swa_g + layer * 128};
#pragma unroll
        for (int k = 0; k < 3; ++k) { float mq = fabsf(gp[k][lane]), mk = fabsf(gp[k][64 + lane]);
#pragma unroll
            for (int o = 1; o < 64; o <<= 1) { mq = fmaxf(mq, __shfl_xor(mq, o)); mk = fmaxf(mk, __shfl_xor(mk, o)); }
            const float m = 8.f * LOG2E * mq * mk * 1.02f + 0.1f + (k == 0 ? 0.f : bm * LOG2E);
            if (lane == 0) MF[k == 0 ? 0 : (k == 1 ? 1 : 3)] = m; }
        if (lane == 0) MF[2] = 0.f;
    }
}
__device__ __forceinline__ void p_convert(Frame& F, const Args& a) {
    const int lane = F.lane, gt = F.vcu * (NWAVES * 64) + F.tid, NT_ = F.G * NWAVES * 64;
    { float* KM = (float*)(a.ws + WS_KM); for (int i = gt; i < 32 * 16 * 64; i += NT_) KM[i] = 0.f;
      float* RS1 = (float*)(a.ws + WS_RS) + NTOK; for (int i = gt; i < NTOK; i += NT_) RS1[i] = 0.f; }
    bf16* XB = (bf16*)(a.ws + WS_HN); float* RS0 = (float*)(a.ws + WS_RS);
    const int gwv = F.vcu * NWAVES + F.wave, NGW = F.G * NWAVES;
    for (int r0 = 4 * gwv; r0 < NTOK; r0 += 4 * NGW) {
        f32x4 v[4][4];
#pragma unroll
        for (int rr = 0; rr < 4; ++rr) { const f32x4* xr = (const f32x4*)(a.x + (size_t)(r0 + rr) * DM) + lane;
#pragma unroll
            for (int j = 0; j < 4; ++j) v[rr][j] = xr[64 * j]; }
        float ss[4];
#pragma unroll
        for (int rr = 0; rr < 4; ++rr) { ss[rr] = 0.f; unsigned long long* o8 = (unsigned long long*)(XB + (size_t)(r0 + rr) * DM) + lane;
#pragma unroll
            for (int j = 0; j < 4; ++j) { const f32x4 y = v[rr][j]; ss[rr] += (y[0] * y[0] + y[1] * y[1]) + (y[2] * y[2] + y[3] * y[3]);
                o8[64 * j] = (unsigned long long)pk2(y[0], y[1]) | ((unsigned long long)pk2(y[2], y[3]) << 32); } }
#pragma unroll
        for (int o = 1; o < 64; o <<= 1)
#pragma unroll
            for (int rr = 0; rr < 4; ++rr) ss[rr] += __shfl_xor(ss[rr], o);
        if (lane < 4) RS0[r0 + lane] = lane == 0 ? ss[0] : (lane == 1 ? ss[1] : (lane == 2 ? ss[2] : ss[3]));
    }
}
namespace att {
using bf16x8 = __attribute__((ext_vector_type(8))) short;
using s16x4 = __attribute__((ext_vector_type(4))) short;
using f32x16 = __attribute__((ext_vector_type(16))) float;
using u32x4 = __attribute__((ext_vector_type(4))) unsigned;
typedef __attribute__((address_space(3))) const char* lds_cptr;
typedef __attribute__((address_space(3))) char* lds_ptr;
typedef short v4i16_t __attribute__((ext_vector_type(4)));
typedef float f32x2_t __attribute__((ext_vector_type(2))); typedef __bf16 bf16x2_t __attribute__((ext_vector_type(2)));
constexpr int NSLOT = 5, PFD = 2, SLOTB = 8192;
constexpr int L_K = 0, L_V = NSLOT * SLOTB, L_OST = 0  , L_WS = 2 * NSLOT * SLOTB, L_CS = L_WS + 8 * 256, L_TAB = L_CS + 16384, L_G = L_TAB + 4608, L_MISC = L_G + 8 * 4096, L_END = L_MISC + 1024;
static_assert(L_END <= 139264 && 8 * 4096 <= NSLOT * SLOTB, "attention LDS map (the kernel's control words start at 136 KiB)");
constexpr float THR2 = 44.f;
#define SBAR() __builtin_amdgcn_sched_barrier(0)
__device__ __forceinline__ int crow(int r, int hi) { return (r & 3) + 8 * (r >> 2) + 4 * hi; }
__device__ __forceinline__ void glds16(const void* gsrc, unsigned lds_dst) { unsigned keep;
    asm volatile("s_mov_b32 %0, m0\n\ts_mov_b32 m0, %2\n\ts_nop 0\n\tglobal_load_lds_dwordx4 %1, off\n\ts_mov_b32 m0, %0" : "=&s"(keep) : "v"(gsrc), "s"(lds_dst) : "memory"); }
__device__ __forceinline__ unsigned cvtpk_s(float lo, float hi) { f32x2_t v = {lo, hi}; bf16x2_t b = __builtin_convertvector(v, bf16x2_t); return __builtin_bit_cast(unsigned, b); }
__device__ __forceinline__ s16x4 vtr(lds_cptr p) { return __builtin_bit_cast(s16x4, __builtin_amdgcn_ds_read_tr16_b64_v4i16((__attribute__((address_space(3))) v4i16_t*)p)); }
#define MFMA32(a, b, c) __builtin_amdgcn_mfma_f32_32x32x16_bf16(a, b, c, 0, 0, 0)
__device__ __forceinline__ void qkt(f32x16& p0, f32x16& p1, lds_cptr kp, const bf16x8* qr, float cinit) {
    f32x16 c;
#pragma unroll
    for (int r = 0; r < 16; ++r) c[r] = cinit;
    p0 = c; p1 = c;
#pragma unroll
    for (int d0 = 0; d0 < 4; ++d0) {
        const bf16x8 b0 = *(const __attribute__((address_space(3))) bf16x8*)(kp + d0 * 2048);
        const bf16x8 b1 = *(const __attribute__((address_space(3))) bf16x8*)(kp + d0 * 2048 + 512);
        p0 = MFMA32(b0, qr[d0], p0); p1 = MFMA32(b1, qr[d0], p1);
    }
}
__device__ __forceinline__ void pv(f32x16* o, lds_cptr vp, bf16x8 pa0, bf16x8 pa1, bf16x8 pa2, bf16x8 pa3) {
#pragma unroll
    for (int d0 = 0; d0 < 2; ++d0) { s16x4 lo[4], hi[4];
#pragma unroll
        for (int ks = 0; ks < 4; ++ks) { lo[ks] = vtr(vp + d0 * 4096 + ks * 1024); hi[ks] = vtr(vp + d0 * 4096 + ks * 1024 + 512); }
#define PK(k) (bf16x8){lo[k][0], lo[k][1], lo[k][2], lo[k][3], hi[k][0], hi[k][1], hi[k][2], hi[k][3]}
        o[d0] = MFMA32(pa0, PK(0), o[d0]); o[d0] = MFMA32(pa1, PK(1), o[d0]); o[d0] = MFMA32(pa2, PK(2), o[d0]); o[d0] = MFMA32(pa3, PK(3), o[d0]);
#undef PK
    }
}
__device__ __forceinline__ void kload(bf16x8* kf, lds_cptr kp) {
#pragma unroll
    for (int d0 = 0; d0 < 4; ++d0) { kf[2 * d0] = *(const __attribute__((address_space(3))) bf16x8*)(kp + d0 * 2048); kf[2 * d0 + 1] = *(const __attribute__((address_space(3))) bf16x8*)(kp + d0 * 2048 + 512); }
}
__device__ __forceinline__ void vload(s16x4* vlo, s16x4* vhi, lds_cptr vp) {
#pragma unroll
    for (int i = 0; i < 8; ++i) { vlo[i] = vtr(vp + (i >> 2) * 4096 + (i & 3) * 1024); vhi[i] = vtr(vp + (i >> 2) * 4096 + (i & 3) * 1024 + 512); }
}
__device__ __forceinline__ void qkt_r(f32x16& p0, f32x16& p1, const bf16x8* kf, const bf16x8* qr, float cinit) {
    f32x16 c;
#pragma unroll
    for (int r = 0; r < 16; ++r) c[r] = cinit;
    p0 = c; p1 = c;
#pragma unroll
    for (int d0 = 0; d0 < 4; ++d0) { p0 = MFMA32(kf[2 * d0], qr[d0], p0); p1 = MFMA32(kf[2 * d0 + 1], qr[d0], p1); }
}
__device__ __forceinline__ void pv_r(f32x16* o, const s16x4* vlo, const s16x4* vhi, bf16x8 pa0, bf16x8 pa1, bf16x8 pa2, bf16x8 pa3) {
#define VFR(i) (bf16x8){vlo[i][0], vlo[i][1], vlo[i][2], vlo[i][3], vhi[i][0], vhi[i][1], vhi[i][2], vhi[i][3]}
    o[0] = MFMA32(pa0, VFR(0), o[0]); o[1] = MFMA32(pa0, VFR(4), o[1]); o[0] = MFMA32(pa1, VFR(1), o[0]); o[1] = MFMA32(pa1, VFR(5), o[1]);
    o[0] = MFMA32(pa2, VFR(2), o[0]); o[1] = MFMA32(pa2, VFR(6), o[1]); o[0] = MFMA32(pa3, VFR(3), o[0]); o[1] = MFMA32(pa3, VFR(7), o[1]);
#undef VFR
}
struct ACtx { const bf16 *Q, *K, *V, *G; bf16* Y; const float *LF, *TAB, *KM, *MF; const float* sinks; int tflag; };
#define WAITBAR(N) asm volatile("s_waitcnt vmcnt(" #N ") lgkmcnt(0)\n\ts_barrier" ::: "memory")

#define USTAMP(k) do { if (TIMER_SEL >= 0 && TYPE == TIMER_TYPE && C.tflag && tid == 0) { volatile __attribute__((address_space(3))) unsigned* ta_ = (volatile __attribute__((address_space(3))) unsigned*)(shm + 139264 + 320) + 16; const unsigned now_ = (unsigned)__builtin_amdgcn_s_memrealtime(); ta_[k] += now_ - ta_[31]; ta_[31] = now_; } } while (0)
template <int TYPE> __device__ __forceinline__ void attn_unit(const ACtx& C, int bh, int qb, lds_ptr shm) {
    int tid = threadIdx.x; asm volatile("" : "+v"(tid));
    const int lane = tid & 63, r32 = lane & 31, hi = lane >> 5; const int wid = __builtin_amdgcn_readfirstlane(tid >> 6);
    const int b = bh >> 2, h = bh & 3, q0 = qb * 256, qrel = wid * 32 + r32, t = q0 + qrel;
    const int kvh = (TYPE == 3) ? (b * 2 + (h >> 1)) : bh;
    const bf16* Qw = C.Q + TYPE * pg8::GS + ((size_t)bh * SEQ + q0 + wid * 32) * 64;
    const bf16* Kh = C.K + TYPE * pg8::GS + (size_t)kvh * SEQ * 64; const bf16* Vh = C.V + TYPE * pg8::GS + (size_t)kvh * SEQ * 64;
    const unsigned lds0 = (unsigned)(size_t)shm;
    __attribute__((address_space(3))) float* wsf = (__attribute__((address_space(3))) float*)(shm + L_WS) + wid * 64;
    __attribute__((address_space(3))) float* tabL = (__attribute__((address_space(3))) float*)(shm + L_TAB);
    __attribute__((address_space(3))) float* cs = (__attribute__((address_space(3))) float*)(shm + L_CS);
    __attribute__((address_space(3))) float* misc = (__attribute__((address_space(3))) float*)(shm + L_MISC);
    __attribute__((address_space(3))) int* misci = (__attribute__((address_space(3))) int*)(shm + L_MISC);
    const bf16* ksrc = Kh + (size_t)lane * 64 + wid * 8;
    const bf16* vsrc = Vh + (size_t)(16 * (wid & 3) + (lane >> 2)) * 64 + (wid >> 2) * 32 + (lane & 3) * 8;
    const unsigned kdst = lds0 + L_K + wid * 1024, vdst = lds0 + L_V + wid * 1024;
#define DMA_KV(tile, slot) do { glds16(ksrc + (size_t)(tile) * 4096, (unsigned)__builtin_amdgcn_readfirstlane(kdst + (slot) * SLOTB)); glds16(vsrc + (size_t)(tile) * 4096, (unsigned)__builtin_amdgcn_readfirstlane(vdst + (slot) * SLOTB)); } while (0)
    const lds_cptr kp0 = (lds_cptr)shm + L_K + hi * 1024 + r32 * 16;
    const lds_cptr vp0 = (lds_cptr)shm + L_V + ((lane >> 4) & 1) * 32 + (lane & 3) * 8 + (4 * hi + ((lane & 15) >> 2)) * 64;
    const float Mf = (TYPE == 2) ? 0.f : C.MF[TYPE];
    const int t_hi = 4 * qb + 3; int t_lo = 0;
    if (TYPE == 3) { t_lo = 4 * qb - 2; if (t_lo < 0) t_lo = 0; }
    USTAMP(24);
    const size_t yrow0 = (size_t)(b * SEQ + q0 + wid * 32);
    { const bf16* gsrc = C.G + (yrow0 + (lane >> 3)) * DM + TYPE * 256 + h * 64 + (lane & 7) * 8;
#pragma unroll
        for (int i = 0; i < 4; ++i) glds16(gsrc + (size_t)(8 * i) * DM, (unsigned)__builtin_amdgcn_readfirstlane(lds0 + L_G + wid * 4096 + i * 1024)); }
    DMA_KV(t_hi, 0); DMA_KV(t_hi - 1, 1);
    bf16x8 qr[4];
#pragma unroll
    for (int d0 = 0; d0 < 4; ++d0) qr[d0] = *reinterpret_cast<const bf16x8*>(&Qw[(size_t)r32 * 64 + d0 * 16 + hi * 8]);
    unsigned sel = 0u; float ct = 0.f;
    if (TYPE == 0) {
        const float* lfp = C.LF + (size_t)bh * SEQ; const bool on = 8 * tid < q0 + 256;
        f32x4 a4 = {0.f, 0.f, 0.f, 0.f}, b4 = {0.f, 0.f, 0.f, 0.f};
        if (on) { a4 = *(const f32x4*)(lfp + 8 * tid); b4 = *(const f32x4*)(lfp + 8 * tid + 4); }
        a4[1] += a4[0]; a4[2] += a4[1]; a4[3] += a4[2]; b4[0] += a4[3]; b4[1] += b4[0]; b4[2] += b4[1]; b4[3] += b4[2];
        float sc = b4[3];
#pragma unroll
        for (int o = 1; o < 64; o <<= 1) { const float u = __shfl_up(sc, o); if (lane >= o) sc += u; }
        if (lane == 63) misc[wid] = sc;
        __syncthreads();
        float base = sc - b4[3];
#pragma unroll
        for (int w = 0; w < 7; ++w) if (w < wid) base += misc[w];
        if (on) { *(__attribute__((address_space(3))) f32x4*)(cs + 8 * tid) = a4 + base; *(__attribute__((address_space(3))) f32x4*)(cs + 8 * tid + 4) = b4 + base; }
        __syncthreads();
        const float cref = cs[q0];
        if (wid == 0) { const bool skip = (lane < 4 * qb) && (cs[64 * lane + 63] - cref > 2.f * Mf + THR2);
            const int cnt = __popcll(__ballot(skip)); if (lane == 0) misci[40] = cnt; }
        __syncthreads();
        t_lo = misci[40]; ct = cs[t];
    }
    if (TYPE == 1 || TYPE == 3) {
        const float* tg = C.TAB + ((TYPE == 3 ? 4 : 0) + h) * 1024;
        { float tv[3]; const float b31 = (TYPE == 1) ? tg[1023] : 0.f; float k0 = 0.f, k1 = 0.f;
#pragma unroll
            for (int k = 0; k < 3; ++k) { const int j = tid + 512 * k, d = 1023 - j; tv[k] = (j < 1088 && d >= 0 && (TYPE == 1 || d < 128)) ? tg[d] - b31 : -INFINITY; }
            if (TYPE == 1) { const float* kg = C.KM + (size_t)bh * 16 * 64; if (tid < qb * 64) k0 = kg[tid]; if (tid + 512 < qb * 64) k1 = kg[tid + 512]; }
#pragma unroll
            for (int k = 0; k < 3; ++k) { const int j = tid + 512 * k; if (j < 1088) tabL[j] = tv[k]; }
            if (TYPE == 1) { cs[tid] = k0; cs[tid + 512] = k1; } }
        __syncthreads();
        if (TYPE == 1) {
            if (qb <= 3) sel = (1u << qb) - 1u;
            else {
                float qf[32];
#pragma unroll
                for (int d0 = 0; d0 < 4; ++d0) { const u32x4 w = __builtin_bit_cast(u32x4, qr[d0]);
#pragma unroll
                    for (int j = 0; j < 4; ++j) { qf[d0 * 8 + 2 * j] = __uint_as_float(w[j] << 16); qf[d0 * 8 + 2 * j + 1] = __uint_as_float(w[j] & 0xffff0000u); } }
                float v1 = -INFINITY, v2 = -INFINITY, v3 = -INFINITY; int i1 = 0, i2 = 0, i3 = 0;
                for (int n = 0; n < qb; ++n) { float s = 0.f;
#pragma unroll
                    for (int d0 = 0; d0 < 4; ++d0) { const f32x4 ka = *(const __attribute__((address_space(3))) f32x4*)(cs + n * 64 + d0 * 16 + hi * 8), kb4 = *(const __attribute__((address_space(3))) f32x4*)(cs + n * 64 + d0 * 16 + hi * 8 + 4);
#pragma unroll
                        for (int j = 0; j < 4; ++j) { s += qf[d0 * 8 + j] * ka[j]; s += qf[d0 * 8 + 4 + j] * kb4[j]; } }
                    { auto rr = __builtin_amdgcn_permlane32_swap(__float_as_uint(s), __float_as_uint(s), false, false); s = __uint_as_float(rr[0]) + __uint_as_float(rr[1]); }
                    if (s > v1) { v3 = v2; i3 = i2; v2 = v1; i2 = i1; v1 = s; i1 = n; } else if (s > v2) { v3 = v2; i3 = i2; v2 = s; i2 = n; } else if (s > v3) { v3 = s; i3 = n; } }
                sel = (1u << i1) | (1u << i2) | (1u << i3); }
        }
    }
    const int n_tiles = t_hi - t_lo + 1;
    asm volatile("" : "+v"(qr[0]), "+v"(qr[1]), "+v"(qr[2]), "+v"(qr[3]));
    f32x16 o[2]; o[0] = f32x16{}; o[1] = f32x16{}; f32x16 lacc = f32x16{};
    float carry = (TYPE == 2) ? 1.f : 0.f; bool done_w = false;
    f32x16 cvec;
    { const float c0_ = (TYPE == 2) ? 0.f : ((TYPE == 0) ? ct - Mf : -Mf);
#pragma unroll
        for (int r = 0; r < 16; ++r) cvec[r] = c0_; }
    asm volatile("" : "+v"(cvec));
    const bf16x8 ones = {0x3f80, 0x3f80, 0x3f80, 0x3f80, 0x3f80, 0x3f80, 0x3f80, 0x3f80};
    const int jdiag = wid >> 1;
    const int jlo_w = (TYPE == 3) ? ((32 * wid - 127) >> 6) : -100000;
    if (TYPE == 2) { if (tid < 16) misci[64 + tid] = 0; }
    USTAMP(21);
    if (TIMER_SEL == 98 && TYPE == TIMER_TYPE && C.tflag && tid == 0) { volatile __attribute__((address_space(3))) unsigned* ta_ = (volatile __attribute__((address_space(3))) unsigned*)(shm + 139264 + 320) + 16; ta_[26] = (unsigned)__builtin_amdgcn_s_memtime(); }
    bf16x8 kf[8]; s16x4 vlo[8], vhi[8]; f32x16 p0, p1;
    const bool late = wid >= 4;
#define FINISH(tile_, jr_, slot_) do { \
            vload(vlo, vhi, vp0 + (slot_) * SLOTB); SBAR(); \
            const int kb = 64 * (jr_) + 4 * hi; \
            unsigned keepm = 0xffffffffu; \
            if (TYPE == 0) { \
            _Pragma("unroll") \
                for (int g4 = 0; g4 < 4; ++g4) { const f32x4 c0 = *(const __attribute__((address_space(3))) f32x4*)(cs + 64 * (tile_) + 8 * g4 + 4 * hi), c1 = *(const __attribute__((address_space(3))) f32x4*)(cs + 64 * (tile_) + 32 + 8 * g4 + 4 * hi); \
            _Pragma("unroll") \
                    for (int j = 0; j < 4; ++j) { p0[4 * g4 + j] -= c0[j]; p1[4 * g4 + j] -= c1[j]; } } \
                if ((jr_) == jdiag) { \
            _Pragma("unroll") \
                    for (int r = 0; r < 16; ++r) { const int kv = kb + (r & 3) + 8 * (r >> 2); if (kv > qrel) p0[r] = -INFINITY; if (kv + 32 > qrel) p1[r] = -INFINITY; } } \
            _Pragma("unroll") \
                for (int r = 0; r < 16; ++r) { p0[r] = __builtin_amdgcn_exp2f(p0[r]); p1[r] = __builtin_amdgcn_exp2f(p1[r]); } \
            } \
            if (TYPE == 1 || TYPE == 3) { \
                const bool far = (TYPE == 1) && ((q0 + 32 * wid - 64 * (tile_) - 63) >= 790); \
                if (!far) { const __attribute__((address_space(3))) float* tp_ = tabL + (1023 - (qrel - kb)); \
            _Pragma("unroll") \
                    for (int r = 0; r < 16; ++r) { p0[r] += tp_[(r & 3) + 8 * (r >> 2)]; p1[r] += tp_[(r & 3) + 8 * (r >> 2) + 32]; } } \
                if (TYPE == 1 && (jr_) < 0) keepm = ((sel >> ((tile_) >> 2)) & 1u) ? 0xffffffffu : 0u; \
            _Pragma("unroll") \
                for (int r = 0; r < 16; ++r) { p0[r] = __builtin_amdgcn_exp2f(p0[r]); p1[r] = __builtin_amdgcn_exp2f(p1[r]); } \
            } \
            if (TYPE == 2) { \
                f32x16 w0, w1; \
            _Pragma("unroll") \
                for (int r = 0; r < 16; ++r) { p0[r] = __builtin_amdgcn_exp2f(fminf(p0[r], 80.f)); p1[r] = __builtin_amdgcn_exp2f(fminf(p1[r], 80.f)); } \
                if ((jr_) == jdiag) { \
            _Pragma("unroll") \
                    for (int r = 0; r < 16; ++r) { const int kv = kb + (r & 3) + 8 * (r >> 2); if (kv >= qrel) p0[r] = 0.f; if (kv + 32 >= qrel) p1[r] = 0.f; } } \
            _Pragma("unroll") \
                for (int r = 0; r < 16; ++r) { w0[r] = 1.f + p0[r]; w1[r] = 1.f + p1[r]; } \
                float own[8], part[8]; \
            _Pragma("unroll") \
                for (int rb = 0; rb < 4; ++rb) { own[rb] = (w0[4 * rb] * w0[4 * rb + 1]) * (w0[4 * rb + 2] * w0[4 * rb + 3]); own[4 + rb] = (w1[4 * rb] * w1[4 * rb + 1]) * (w1[4 * rb + 2] * w1[4 * rb + 3]); } \
            _Pragma("unroll") \
                for (int rb = 0; rb < 8; ++rb) { auto rr = __builtin_amdgcn_permlane32_swap(__float_as_uint(own[rb]), __float_as_uint(own[rb]), false, false); part[rb] = __uint_as_float(hi ? rr[0] : rr[1]); } \
                float run = carry; \
            _Pragma("unroll") \
                for (int rb = 7; rb >= 0; --rb) { \
                    float E = hi == 0 ? run * part[rb] : run; run *= own[rb] * part[rb]; \
            _Pragma("unroll") \
                    for (int j = 3; j >= 0; --j) { const int r = 4 * (rb & 3) + j; \
                        if (rb >= 4) { E *= w1[r]; p1[r] *= __builtin_amdgcn_rcpf(E); } else { E *= w0[r]; p0[r] *= __builtin_amdgcn_rcpf(E); } } } \
                carry = run; \
                done_w = __all(carry > 1.7592186e13f) != 0;     \
            } \
            u32x4 pw0, pw1, pw2, pw3; \
            _Pragma("unroll") \
            for (int j = 0; j < 4; ++j) { pw0[j] = cvtpk_s(p0[2 * j], p0[2 * j + 1]); pw1[j] = cvtpk_s(p0[8 + 2 * j], p0[9 + 2 * j]); pw2[j] = cvtpk_s(p1[2 * j], p1[2 * j + 1]); pw3[j] = cvtpk_s(p1[8 + 2 * j], p1[9 + 2 * j]); } \
            if (TYPE == 1) { pw0 &= keepm; pw1 &= keepm; pw2 &= keepm; pw3 &= keepm; } \
            const bf16x8 pa0 = __builtin_bit_cast(bf16x8, pw0), pa1 = __builtin_bit_cast(bf16x8, pw1), pa2 = __builtin_bit_cast(bf16x8, pw2), pa3 = __builtin_bit_cast(bf16x8, pw3); \
            pv_r(o, vlo, vhi, pa0, pa1, pa2, pa3); \
            if (TYPE != 2) { lacc = MFMA32(pa0, ones, lacc); lacc = MFMA32(pa1, ones, lacc); lacc = MFMA32(pa2, ones, lacc); lacc = MFMA32(pa3, ones, lacc); } \
        } while (0)
#define SCORE(slot_) do { kload(kf, kp0 + (slot_) * SLOTB); SBAR(); \
        if (TYPE == 2) { p0 = MFMA32(kf[0], qr[0], (f32x16{})); p1 = MFMA32(kf[1], qr[0], (f32x16{})); } else { p0 = MFMA32(kf[0], qr[0], cvec); p1 = MFMA32(kf[1], qr[0], cvec); } \
        _Pragma("unroll") for (int d0 = 1; d0 < 4; ++d0) { p0 = MFMA32(kf[2 * d0], qr[d0], p0); p1 = MFMA32(kf[2 * d0 + 1], qr[d0], p1); } SBAR(); } while (0)
    int slot = 0, dslot = PFD, ptile = 0, pslot = 0; bool pend = false, stop = false;
    for (int i = 0; ; ++i) {
        const int tile = t_hi - i, jr = tile - 4 * qb;
        if (i < n_tiles && !stop) {
            { const int tp = tile - PFD; DMA_KV(tp < 0 ? 0 : tp, dslot); }
            dslot = (dslot == NSLOT - 1) ? 0 : dslot + 1;
            WAITBAR(4);
            if (TYPE == 2 && i > 0) { const u32x4 fa = *(const __attribute__((address_space(3))) u32x4*)(misci + 64 + ((i - 1) & 1) * 8), fb = *(const __attribute__((address_space(3))) u32x4*)(misci + 68 + ((i - 1) & 1) * 8);
                if ((fa[0] & fa[1] & fa[2] & fa[3] & fb[0] & fb[1] & fb[2] & fb[3]) != 0u) stop = true; }
        }
        if (late && pend) { FINISH(ptile, ptile - 4 * qb, pslot); pend = false; }
        if (i >= n_tiles || stop) break;
        const bool active = (jr <= jdiag) && (jr >= jlo_w) && !(TYPE == 2 && done_w);
        if (active) { SCORE(slot); }
        if (!late) { if (active) { FINISH(tile, jr, slot); } } else { pend = active; ptile = tile; pslot = slot; }
        if (TYPE == 2) { if (lane == 0) misci[64 + (i & 1) * 8 + wid] = done_w ? 1 : 0; }
        slot = (slot == NSLOT - 1) ? 0 : slot + 1;
    }
#undef FINISH
#undef SCORE
    if (TIMER_SEL == 98 && TYPE == TIMER_TYPE && C.tflag && tid == 0) { volatile __attribute__((address_space(3))) unsigned* ta_ = (volatile __attribute__((address_space(3))) unsigned*)(shm + 139264 + 320) + 16; ta_[25] += (unsigned)__builtin_amdgcn_s_memtime() - ta_[26]; }
    USTAMP(22);
    asm volatile("s_waitcnt vmcnt(0) lgkmcnt(0)\n\ts_barrier" ::: "memory");
    float rli[16];
    { const float sk = (TYPE == 3) ? __builtin_amdgcn_exp2f(C.sinks[h] * LOG2E - Mf) : 0.f;
#pragma unroll
        for (int r = 0; r < 16; ++r) rli[r] = (TYPE == 2) ? 1.f : 1.f / (lacc[r] + sk); }
    __attribute__((address_space(3))) bf16* stg = (__attribute__((address_space(3))) bf16*)(shm + L_OST) + wid * 2048;
    const __attribute__((address_space(3))) bf16* gst = (const __attribute__((address_space(3))) bf16*)(shm + L_G) + wid * 2048;
#pragma unroll
    for (int r = 0; r < 16; ++r) { const int orow = crow(r, hi); const float rl = rli[r];
#pragma unroll
        for (int d0 = 0; d0 < 2; ++d0) stg[orow * 64 + d0 * 32 + r32] = (bf16)f2bf(o[d0][r] * rl); }
    asm volatile("s_waitcnt lgkmcnt(0)" ::: "memory");
#pragma unroll
    for (int i = 0; i < 4; ++i) { const int row = i * 8 + (lane >> 3), ch = lane & 7;
        const u32x4 v = *(const __attribute__((address_space(3))) u32x4*)(stg + row * 64 + ch * 8);
        const u32x4 g = *(const __attribute__((address_space(3))) u32x4*)(gst + row * 64 + ch * 8); u32x4 w;
        const size_t off = (yrow0 + row) * DM + TYPE * 256 + h * 64 + ch * 8;
#pragma unroll
        for (int j = 0; j < 4; ++j) { const float a0 = __uint_as_float(v[j] << 16) * __uint_as_float(g[j] << 16), a1 = __uint_as_float(v[j] & 0xffff0000u) * __uint_as_float(g[j] & 0xffff0000u); w[j] = pk2(a0, a1); }
        *(u32x4*)(C.Y + off) = w; }
    asm volatile("s_waitcnt lgkmcnt(0)\n\ts_barrier" ::: "memory");
    USTAMP(23);
#undef DMA_KV
}
#undef SBAR
}
#define TACC(F) ((volatile LAS unsigned*)((F).lds + MISC_OFF) + 16)
#define TSTAMP(F, k) do { if (TIMER_SEL >= 0 && (F).vcu == TIMER_WG && (F).tid == 0) { const unsigned now_ = (unsigned)__builtin_amdgcn_s_memrealtime(); TACC(F)[k] += now_ - TACC(F)[31]; TACC(F)[31] = now_; } } while (0)
__device__ __forceinline__ void p_attn(Frame& F, const Args& a, int layer, int rep, int tmask) {
    att::ACtx C{(const bf16*)(a.ws + WS_Q), (const bf16*)(a.ws + WS_K), (const bf16*)(a.ws + WS_V), (const bf16*)(a.ws + WS_G), (bf16*)(a.ws + WS_HN),
                (const float*)(a.ws + WS_LF), (const float*)(a.ws + WS_TAB), (const float*)(a.ws + WS_KM), (const float*)(a.ws + WS_MF) + layer * 4, a.sinks + layer * 4, (F.vcu == TIMER_WG) ? 1 : 0};
    unsigned* head = (unsigned*)(a.ws + WS_CTL) + CW_QUEUE + 64 * (layer + 2 * rep);
    LAS int* slot = (LAS int*)(F.lds + att::L_MISC) + 200;
    att::lds_ptr shm = (att::lds_ptr)F.lds;
    if (F.tid == 0) slot[0] = (int)__hip_atomic_fetch_add(head, 1u, __ATOMIC_RELAXED, __HIP_MEMORY_SCOPE_AGENT);
    __syncthreads();
    int u = slot[0];
    while (u < 2048) {
        int unext = 0;
        if (F.tid == 0) unext = (int)__hip_atomic_fetch_add(head, 1u, __ATOMIC_RELAXED, __HIP_MEMORY_SCOPE_AGENT);
        const int ty = u >> 9, r = u & 511, qb = 15 - (r >> 5), bh = r & 31;
        TSTAMP(F, 20);
        if (ty == 0) { if (tmask & 2) att::attn_unit<1>(C, bh, qb, shm); }
        else if (ty == 1) { if (tmask & 1) att::attn_unit<0>(C, bh, qb, shm); }
        else if (ty == 2) { if (tmask & 4) att::attn_unit<2>(C, bh, qb, shm); }
        else { if (tmask & 8) att::attn_unit<3>(C, bh, qb, shm); }
        TSTAMP(F, 8 + ty);
        if (F.tid == 0) slot[0] = unext;
        __syncthreads();
        u = slot[0];
    }
    __syncthreads();
}

__global__ void __launch_bounds__(NWAVES * 64, 2) mk_fwd(Args a) {
    extern __shared__ __attribute__((aligned(16))) unsigned char lds[];
    Frame F; F.lds = (LAS unsigned char*)lds; F.tid = threadIdx.x; F.lane = F.tid & 63; F.wave = __builtin_amdgcn_readfirstlane(F.tid >> 6);
    F.G = gridDim.x; { const int bx = blockIdx.x; F.vcu = (F.G % 8 == 0) ? (bx % 8) * (F.G / 8) + bx / 8 : bx; }
    bf16* HN = (bf16*)(a.ws + WS_HN);
    for (int u = F.tid; u < (LDS_BYTES - LDSCTL_OFF) / 4; u += NWAVES * 64) ((LAS unsigned*)(F.lds + LDSCTL_OFF))[u] = 0u;
    __syncthreads();
    XcdBarrier bar; bar.bar = (unsigned*)(a.ws + WS_CTL) + CW_BAR; bar.x = 0; bar.st = nullptr;
    if (a.ph_hi - a.ph_lo > 1) bar = xcd_barrier_post((unsigned*)(a.ws + WS_CTL) + CW_BAR, (volatile LAS unsigned*)(F.lds + MISC_OFF) + 8);
#define PHASE_ON(k) (a.ph_lo <= (k) && (k) < a.ph_hi)
#define SEAM(k) do { if ((k) != 4 && PHASE_ON(k) && PHASE_ON((k) + 1)) xcd_barrier(bar); } while (0)
#define LAYER_PHASES(layer) do { \
    if ((layer) == 0 && PHASE_ON(0)) { p_weights(F, a); p_consts(F, a); p_convert(F, a); } \
    if ((layer) == 0) { TSTAMP(F, 0); SEAM(0); TSTAMP(F, 1); } \
    if (PHASE_ON(4 * (layer) + 1)) { \
        pg8::Gemm g{(layer) == 0 ? HN : (const bf16*)(a.ws + WS_X1), (const bf16*)(a.ws + WS_WIN) + (size_t)(layer) * NPERM * DM, NTOK, NPERM, DM}; \
        pg8::StaticOrder S; S.init(NTOK, NPERM, F.G, (int)blockIdx.x); \
        pg8::EpiIn E{(bf16*)(a.ws + WS_Q), (bf16*)(a.ws + WS_K), (bf16*)(a.ws + WS_V), (bf16*)(a.ws + WS_G), a.fox_g + (layer) * 128, a.moba_g + (layer) * 128, a.swa_g + (layer) * 128, (float*)(a.ws + WS_KM), \
                     (const float*)(a.ws + WS_RS) + (layer) * NTOK, (float*)(a.ws + WS_LF), a.b_forget + (layer) * 4}; \
        pg8::gemm_phase<pg8::EpiIn, pg8::StaticOrder, true, true>(F.lds, g, S, E); \
        if (PROBE_P1) { xcd_barrier(bar); pg8::gemm_phase<pg8::EpiIn, pg8::StaticOrder, true, true>(F.lds, g, S, E); } \
    } \
    TSTAMP(F, 2); SEAM(4 * (layer) + 1); TSTAMP(F, 3); \
    if (PHASE_ON(4 * (layer) + 2)) { for (int rep = 0; rep < 1 + (PROBE_ATT != 0 ? PROBE_REPS : 0); ++rep) { if (rep) xcd_barrier(bar); p_attn(F, a, (layer), rep, rep ? PROBE_ATT : 15); } } \
    TSTAMP(F, 4); SEAM(4 * (layer) + 2); TSTAMP(F, 5); \
    if (PHASE_ON(4 * (layer) + 3)) { \
        pg8::Gemm g{HN  , (const bf16*)(a.ws + WS_WOUT) + (size_t)(layer) * DM * DM, NTOK, DM, DM}; \
        pg8::StaticOrder S; S.init(NTOK, DM, F.G, (int)blockIdx.x); \
        if ((layer) == 0) { \
            { float* KM = (float*)(a.ws + WS_KM); for (int i = F.vcu * (NWAVES * 64) + F.tid; i < 32 * 16 * 64; i += F.G * NWAVES * 64) KM[i] = 0.f; }     \
            pg8::EpiRes0 E{a.x, (bf16*)(a.ws + WS_X1), (float*)(a.ws + WS_RS) + NTOK}; \
            pg8::gemm_phase<pg8::EpiRes0, pg8::StaticOrder, true, true>(F.lds, g, S, E); \
        } else { \
            pg8::EpiRes1 E{(const bf16*)(a.ws + WS_X1), a.out}; \
            pg8::gemm_phase<pg8::EpiRes1, pg8::StaticOrder, true, true>(F.lds, g, S, E); \
        } \
    } \
    if ((layer) == 0) { TSTAMP(F, 6); SEAM(3); SEAM(4); TSTAMP(F, 7); } } while (0)
    if (TIMER_SEL >= 0 && F.vcu == TIMER_WG && F.tid == 0) TACC(F)[31] = (unsigned)__builtin_amdgcn_s_memrealtime();
    LAYER_PHASES(0);
    LAYER_PHASES(1);
    if (TIMER_SEL >= 0 && F.vcu == TIMER_WG) {
        asm volatile("s_waitcnt vmcnt(0)" ::: "memory"); __syncthreads();
        float v = (TIMER_SEL == 99) ? 1.0f : (TIMER_SEL == 98) ? ((float)TACC(F)[25] / ((float)TACC(F)[22] * 10.f)) / 3.0f : (float)TACC(F)[TIMER_SEL & 31] * 0.01f / (float)TIMER_FS; v = fminf(fmaxf(v, 0.f), 1.f); const float dl = 0.1f * sqrtf(v);
        pg8::StaticOrder S; S.init(NTOK, DM, F.G, (int)blockIdx.x); pg8::Unit u;
        for (int i = 0; S.next(i, u); ++i) for (int e = F.tid; e < 65536; e += NWAVES * 64) { float* p = a.out + (size_t)(u.pm * 256 + (e >> 8)) * DM + u.pn * 256 + (e & 255); *p += dl; }
    }
}

extern "C" void kernel_launch(void* const* d_in, const int* in_sizes, int n_in, void* d_out, int out_size, void* d_ws, size_t ws_size, hipStream_t stream) {
    static int ok = 0, grid = 0;
    if (ok == 0) {
        if (n_in != 10 || in_sizes[0] != NTOK * DM || out_size != NTOK * DM || ws_size < WS_END) { fprintf(stderr, "kernel_launch: unexpected shapes (n_in %d, in0 %d, out %d, ws %zu)\n", n_in, n_in > 0 ? in_sizes[0] : -1, out_size, ws_size); ok = -1; return; }
        if (hipFuncSetAttribute((const void*)mk_fwd, hipFuncAttributeMaxDynamicSharedMemorySize, LDS_BYTES) != hipSuccess) { fprintf(stderr, "kernel_launch: hipFuncSetAttribute failed\n"); ok = -1; return; }
        int dev = 0, cus = 0; if (hipGetDevice(&dev) != hipSuccess || hipDeviceGetAttribute(&cus, hipDeviceAttributeMultiprocessorCount, dev) != hipSuccess) { fprintf(stderr, "kernel_launch: device query failed\n"); ok = -1; return; }
        grid = cus < 256 ? (cus / 8) * 8 : 256; if (grid < 8) grid = cus;
        ok = 1;
    }
    if (ok < 0) return;
    Args a{};
    a.x = (const float*)d_in[0]; a.norm_gain = (const float*)d_in[1]; a.w_in = (const float*)d_in[2]; a.b_forget = (const float*)d_in[3]; a.fox_g = (const float*)d_in[4];
    a.moba_g = (const float*)d_in[5]; a.swa_g = (const float*)d_in[6]; a.sinks = (const float*)d_in[7]; a.w_out = (const float*)d_in[8]; a.rel_bias = (const float*)d_in[9];
    a.out = (float*)d_out; a.ws = (unsigned char*)d_ws;
    unsigned char* ws = (unsigned char*)d_ws;
    a.tmask = 15;
    if (hipMemsetAsync(ws + WS_CTL, 0, CTL_ZERO_BYTES, stream) != hipSuccess) { fprintf(stderr, "kernel_launch: memset failed\n"); return; }
#if N_LAUNCHES == 1
    a.ph_lo = 0; a.ph_hi = 8; hipLaunchKernelGGL(mk_fwd, dim3(grid), dim3(NWAVES * 64), LDS_BYTES, stream, a);
#else
    for (int ph = 0; ph < 8; ++ph) { a.ph_lo = ph; a.ph_hi = ph + 1; hipLaunchKernelGGL(mk_fwd, dim3(grid), dim3(NWAVES * 64), LDS_BYTES, stream, a); }
#endif
}
```

```cpp
#include <hip/hip_runtime.h>
#include <cstdio>
#include <cstdint>
#include <cmath>
namespace pg8 {
#define PG8_LAS __attribute__((address_space(3)))
typedef unsigned short bf16_t;
typedef short bf16x8 __attribute__((ext_vector_type(8)));
typedef float f32x4 __attribute__((ext_vector_type(4)));
typedef unsigned u32x4 __attribute__((ext_vector_type(4)));
constexpr int BM = 256, BK = 64, HALF = 128, HTB = HALF * BK * 2  , STAGE_BYTES = 8 * HTB, NXCD = 8, WGM = 8;

__host__ __device__ __forceinline__ int lds_byte(int r, int c) { const int st = (r >> 4) * 2 + (c >> 5), rr = r & 15, cc = c & 31, ob = rr * 64 + cc * 2; return st * 1024 + (ob ^ (((ob >> 9) & 1) << 5)); }
__host__ __device__ __forceinline__ void stage_rc(int b, int& R, int& C) { const int st = b / 1024, sb = b % 1024, swz = sb ^ (((sb >> 9) & 1) << 5); R = (st >> 1) * 16 + swz / 64; C = (st & 1) * 32 + (swz % 64) / 2; }
__host__ __device__ __forceinline__ int perm32(int rho) { const int n = rho >> 4, i = rho & 15; return 8 * (i >> 2) + 4 * n + (i & 3); }

struct Unit { int pm, pn; };
struct Gemm { const bf16_t* A; const bf16_t* Bt; int M, N, K; };

struct StaticOrder {
    int nM, nN, nwg, G, c;
    __host__ __device__ void init(int M, int N, int G_, int c_) { nM = M / BM; nN = N / BM; nwg = nM * nN; G = G_; c = c_; }
    __host__ __device__ bool next(int i, Unit& u) const {
        const long L = (long)i * G + c; if (L >= nwg) return false;
        int wgid = (int)L; { const int q = nwg / NXCD, r = nwg % NXCD, xcd = wgid % NXCD, off = wgid / NXCD; wgid = (xcd < r ? xcd * (q + 1) : r * (q + 1) + (xcd - r) * q) + off; }
        const int nig = WGM * nN, gid = wgid / nig, fm = gid * WGM, gsz = (nM - fm) < WGM ? (nM - fm) : WGM;
        u.pm = fm + ((wgid % nig) % gsz); u.pn = (wgid % nig) / gsz; return true;
    }
    __device__ __forceinline__ void a_ready(const Unit&) const {}
    __device__ __forceinline__ void done(const Unit&) const {}
};

__device__ __forceinline__ unsigned cvt_pk_bf16(float lo, float hi) { unsigned r; asm volatile("v_cvt_pk_bf16_f32 %0, %1, %2" : "=v"(r) : "v"(lo), "v"(hi)); return r; }
typedef float f32x2 __attribute__((ext_vector_type(2)));
constexpr float C2 = 0.125f * 1.4426950408889634f;
constexpr float RMS_EPS = 1e-6f;
constexpr size_t GS = (size_t)8 * 4 * 4096 * 64;
struct EpiIn {
    static constexpr bool PERM = true, AFTER_DRAIN = false;
    bf16_t *Q, *K, *V, *G; const float *gfox, *gmoba, *gswa; float* KM; const float* RS; float* LF; const float* bfg;
    __device__ __forceinline__ void prefetch(const Unit& u, int ui_, PG8_LAS unsigned char* lds, int wid, int lane) const {
        if (wid < 4) { const float* src = RS + u.pm * BM + wid * 64 + lane; const unsigned dst = (unsigned)(size_t)(lds + STAGE_BYTES + (ui_ & 1) * 1024 + wid * 256); unsigned keep;
            asm volatile("s_mov_b32 %0, m0\n\ts_mov_b32 m0, %2\n\ts_nop 0\n\tglobal_load_lds_dword %1, off\n\ts_mov_b32 m0, %0" : "=&s"(keep) : "v"(src), "s"((unsigned)__builtin_amdgcn_readfirstlane(dst)) : "memory"); }
    }
    __device__ __forceinline__ void operator()(const f32x4 (&acc)[2][2][4][2], const Unit& u, int wr, int wc, int fr, int fq, int ui, PG8_LAS unsigned char* ldsb) const {
        const int T = u.pn;
        const int b = (u.pm * BM) >> 12, t0 = ((u.pm * BM) & 4095) + wr * 64 + fr;
        float rs[2][4];
#pragma unroll
        for (int ai = 0; ai < 2; ++ai)
#pragma unroll
            for (int m = 0; m < 4; ++m) rs[ai][m] = 1.0f / sqrtf(((const PG8_LAS float*)(ldsb + STAGE_BYTES + (ui & 1) * 1024))[ai * HALF + wr * 64 + m * 16 + fr] * (1.0f / 1024.0f) + RMS_EPS);
        if (T == 15) {
            if (wc == 0 && fq == 0) { const f32x4 bv = *(const f32x4*)bfg;
#pragma unroll
                for (int ai = 0; ai < 2; ++ai)
#pragma unroll
                    for (int m = 0; m < 4; ++m) { const f32x4 a4 = acc[ai][0][m][0] * rs[ai][m] + bv;
#pragma unroll
                        for (int j = 0; j < 4; ++j) { const float uu = a4[j]; const float sp = fmaxf(-uu, 0.f) + __logf(1.f + __expf(-fabsf(uu)));
                            LF[(size_t)(b * 4 + j) * 4096 + t0 + ai * HALF + m * 16] = -sp * 1.4426950408889634f; } } }
            return;
        }
        int mode = 1, nh = 4, head = wc; float scale = 1.f; const float* gain = nullptr; bf16_t* base = nullptr;
        switch (T) {
            case 0: mode = 0; gain = gfox; scale = C2; base = Q; break;
            case 1: mode = 0; gain = gfox + 64; base = K; break;
            case 2: base = V; break;
            case 4: mode = 0; gain = gmoba; scale = C2; base = Q + GS; break;
            case 5: mode = 0; gain = gmoba + 64; base = K + GS; break;
            case 6: base = V + GS; break;
            case 8: scale = C2; base = Q + 2 * GS; break;
            case 9: base = K + 2 * GS; break;
            case 10: base = V + 2 * GS; break;
            case 12: mode = 0; gain = gswa; scale = C2; base = Q + 3 * GS; break;
            case 13: nh = 2; if (wc < 2) { mode = 0; gain = gswa + 64; base = K + 3 * GS; } else { base = V + 3 * GS; head = wc - 2; } break;
            default: mode = 2; break;
        }
        if (mode == 2) {
            bf16_t* gp = G + (size_t)(u.pm * BM + wr * 64 + fr) * 1024 + (T >> 2) * 256 + 64 * wc + 8 * fq;
#pragma unroll
            for (int ai = 0; ai < 2; ++ai)
#pragma unroll
                for (int m = 0; m < 4; ++m)
#pragma unroll
                    for (int bj = 0; bj < 2; ++bj) {
                        f32x4 v0 = acc[ai][bj][m][0] * rs[ai][m], v1 = acc[ai][bj][m][1] * rs[ai][m];
#pragma unroll
                        for (int j = 0; j < 4; ++j) { v0[j] = v0[j] / (1.f + __expf(-v0[j])); v1[j] = v1[j] / (1.f + __expf(-v1[j])); }
                        u32x4 w; w.x = cvt_pk_bf16(v0[0], v0[1]); w.y = cvt_pk_bf16(v0[2], v0[3]); w.z = cvt_pk_bf16(v1[0], v1[1]); w.w = cvt_pk_bf16(v1[2], v1[3]);
                        *(u32x4*)(gp + (size_t)(ai * HALF + m * 16) * 1024 + 32 * bj) = w;
                    }
            return;
        }
        f32x4 gv[2][2];
#pragma unroll
        for (int bj = 0; bj < 2; ++bj)
#pragma unroll
            for (int n = 0; n < 2; ++n) gv[bj][n] = (mode == 0) ? *(const f32x4*)(gain + 32 * bj + 8 * fq + 4 * n) : (f32x4){1.f, 1.f, 1.f, 1.f};
        bf16_t* dp = base + ((size_t)(b * nh + head) * 4096 + t0) * 64 + 8 * fq;
        f32x4 cs4[2][2];
#pragma unroll
        for (int bj = 0; bj < 2; ++bj)
#pragma unroll
            for (int n = 0; n < 2; ++n) cs4[bj][n] = (f32x4){0.f, 0.f, 0.f, 0.f};
#pragma unroll
        for (int ai = 0; ai < 2; ++ai)
#pragma unroll
            for (int m = 0; m < 4; ++m) {
                float r = scale * rs[ai][m];
                if (mode == 0) {
                    float ss = 0.f;
#pragma unroll
                    for (int bj = 0; bj < 2; ++bj)
#pragma unroll
                        for (int n = 0; n < 2; ++n) { const f32x4 x = acc[ai][bj][m][n]; ss += (x[0] * x[0] + x[1] * x[1]) + (x[2] * x[2] + x[3] * x[3]); }
                    ss += __shfl_xor(ss, 16); ss += __shfl_xor(ss, 32);
                    r = scale * rs[ai][m] / sqrtf(ss * rs[ai][m] * rs[ai][m] * (1.0f / 64.0f) + RMS_EPS);
                }
#pragma unroll
                for (int bj = 0; bj < 2; ++bj) {
                    const f32x4 v0 = acc[ai][bj][m][0] * gv[bj][0] * r, v1 = acc[ai][bj][m][1] * gv[bj][1] * r;
                    if (T == 5) { cs4[bj][0] += v0; cs4[bj][1] += v1; }
                    u32x4 w; w.x = cvt_pk_bf16(v0[0], v0[1]); w.y = cvt_pk_bf16(v0[2], v0[3]); w.z = cvt_pk_bf16(v1[0], v1[1]); w.w = cvt_pk_bf16(v1[2], v1[3]);
                    *(u32x4*)(dp + (size_t)(ai * HALF + m * 16) * 64 + 32 * bj) = w;
                }
            }
        if (T == 5) {
            float* kmp = KM + ((size_t)((b * 4 + wc) * 16 + (((u.pm * BM) & 4095) >> 8))) * 64 + 8 * fq;
#pragma unroll
            for (int bj = 0; bj < 2; ++bj)
#pragma unroll
                for (int n = 0; n < 2; ++n)
#pragma unroll
                    for (int j = 0; j < 4; ++j) { float s = cs4[bj][n][j];
                        s += __shfl_xor(s, 1); s += __shfl_xor(s, 2); s += __shfl_xor(s, 4); s += __shfl_xor(s, 8);
                        if (fr == 0) atomicAdd(kmp + 32 * bj + 4 * n + j, s * (1.0f / 256.0f)); }
        }
    }
};
struct EpiRes0 {
    static constexpr bool PERM = true, AFTER_DRAIN = false;
    const float* base; bf16_t* X1; float* RS1;

    __device__ __forceinline__ void prefetch(const Unit&, int, PG8_LAS unsigned char*, int, int) const {}
    __device__ __forceinline__ void operator()(const f32x4 (&acc)[2][2][4][2], const Unit& u, int wr, int wc, int fr, int fq, int ui, PG8_LAS unsigned char* ldsb) const {
        const int col0 = u.pn * BM + wc * 32 + 8 * fq;
#pragma unroll
        for (int ai = 0; ai < 2; ++ai)
#pragma unroll
            for (int m = 0; m < 4; ++m) {
                const int row = u.pm * BM + ai * HALF + wr * 64 + m * 16 + fr; const size_t off = (size_t)row * 1024 + col0; float ss = 0.f;
#pragma unroll
                for (int bj = 0; bj < 2; ++bj) {
                    const f32x4 v0 = *(const f32x4*)(base + off + bj * HALF) + acc[ai][bj][m][0], v1 = *(const f32x4*)(base + off + bj * HALF + 4) + acc[ai][bj][m][1];
                    ss += (v0[0] * v0[0] + v0[1] * v0[1]) + (v0[2] * v0[2] + v0[3] * v0[3]) + (v1[0] * v1[0] + v1[1] * v1[1]) + (v1[2] * v1[2] + v1[3] * v1[3]);
                    u32x4 w; w.x = cvt_pk_bf16(v0[0], v0[1]); w.y = cvt_pk_bf16(v0[2], v0[3]); w.z = cvt_pk_bf16(v1[0], v1[1]); w.w = cvt_pk_bf16(v1[2], v1[3]);
                    *(u32x4*)(X1 + off + bj * HALF) = w; }
                ss += __shfl_xor(ss, 16); ss += __shfl_xor(ss, 32);
                if (fq == 0) atomicAdd(RS1 + row, ss);
            }
    }
};
struct EpiRes1 {
    static constexpr bool PERM = true, AFTER_DRAIN = false;
    const bf16_t* X1; float* out;

    __device__ __forceinline__ void prefetch(const Unit&, int, PG8_LAS unsigned char*, int, int) const {}
    __device__ __forceinline__ void operator()(const f32x4 (&acc)[2][2][4][2], const Unit& u, int wr, int wc, int fr, int fq, int ui, PG8_LAS unsigned char* ldsb) const {
        const int col0 = u.pn * BM + wc * 32 + 8 * fq;
#pragma unroll
        for (int ai = 0; ai < 2; ++ai)
#pragma unroll
            for (int m = 0; m < 4; ++m) {
                const size_t off = (size_t)(u.pm * BM + ai * HALF + wr * 64 + m * 16 + fr) * 1024 + col0;
#pragma unroll
                for (int bj = 0; bj < 2; ++bj) { const u32x4 xb = *(const u32x4*)(X1 + off + bj * HALF);
                    f32x4 v0, v1; v0[0] = __uint_as_float(xb.x << 16); v0[1] = __uint_as_float(xb.x & 0xffff0000u); v0[2] = __uint_as_float(xb.y << 16); v0[3] = __uint_as_float(xb.y & 0xffff0000u);
                    v1[0] = __uint_as_float(xb.z << 16); v1[1] = __uint_as_float(xb.z & 0xffff0000u); v1[2] = __uint_as_float(xb.w << 16); v1[3] = __uint_as_float(xb.w & 0xffff0000u);
                    *(f32x4*)(out + off + bj * HALF) = v0 + acc[ai][bj][m][0]; *(f32x4*)(out + off + bj * HALF + 4) = v1 + acc[ai][bj][m][1]; }
            }
    }
};

template <class Epi, class Sched, bool ALIGN_EPI = false, bool SP2 = false>
__device__ __forceinline__ void gemm_phase(PG8_LAS unsigned char* lds, const Gemm g, const Sched& S, const Epi& E) {
    const int tid = threadIdx.x, wid = __builtin_amdgcn_readfirstlane(tid >> 6), lane = tid & 63, wr = wid >> 2, wc = wid & 3, fr = lane & 15, fq = lane >> 4;
    const int K = g.K, nt = K / BK;
    unsigned voffA[2], voffB[2];
#pragma unroll
    for (int i = 0; i < 2; ++i) { int R, C; stage_rc(tid * 16 + i * 8192, R, C); const int Rb = Epi::PERM ? ((R & ~31) + perm32(R & 31)) : R;
        voffA[i] = (unsigned)(R * K + C) * 2u; voffB[i] = (unsigned)(Rb * K + C) * 2u; }
    const size_t kstep = (size_t)(BK * 2);
    const size_t hstep = (size_t)HALF * K * 2;
    const size_t tstep = 2 * hstep;
    const unsigned ldsw = (unsigned)wid * 1024u;
    const int aoff = lds_byte(wr * 64 + fr, fq * 8), boff = lds_byte(wc * 32 + fr, fq * 8);
#define PG8_SA(b, h) (((b) * 2 + (h)) * HTB)
#define PG8_SB(b, h) ((4 + (b) * 2 + (h)) * HTB)
#define PG8_STAGE(bufoff, gbase, voff) do { _Pragma("unroll") for (int _i = 0; _i < 2; ++_i) \
        __builtin_amdgcn_global_load_lds((const unsigned*)((const char*)(gbase) + (voff)[_i]), (PG8_LAS unsigned*)(lds + (bufoff) + ldsw + _i * 8192), 16, 0, 0); } while (0)
#define PG8_LDA(dst, b, h) do { _Pragma("unroll") for (int m = 0; m < 4; ++m) _Pragma("unroll") for (int k = 0; k < 2; ++k) dst[m][k] = *(const PG8_LAS bf16x8*)(lds + PG8_SA(b, h) + aoff + m * 2048 + k * 1024); } while (0)
#define PG8_LDB(dst, b, h) do { _Pragma("unroll") for (int n = 0; n < 2; ++n) _Pragma("unroll") for (int k = 0; k < 2; ++k) dst[n][k] = *(const PG8_LAS bf16x8*)(lds + PG8_SB(b, h) + boff + n * 2048 + k * 1024); } while (0)
#define PG8_MMA(ai, bj, At, Bt) do { __builtin_amdgcn_s_setprio(1); _Pragma("unroll") for (int m = 0; m < 4; ++m) _Pragma("unroll") for (int n = 0; n < 2; ++n) _Pragma("unroll") for (int k = 0; k < 2; ++k) \
        acc[ai][bj][m][n] = __builtin_amdgcn_mfma_f32_16x16x32_bf16(Bt[n][k], At[m][k], acc[ai][bj][m][n], 0, 0, 0); __builtin_amdgcn_s_setprio(0); } while (0)
#define PG8_WAIT_V(n) asm volatile("s_waitcnt vmcnt(" #n ")" ::: "memory")
#define PG8_WAIT_L(n) asm volatile("s_waitcnt lgkmcnt(" #n ")" ::: "memory")
#define PG8_BAR __builtin_amdgcn_s_barrier()
#define PG8_SCHED __builtin_amdgcn_sched_barrier(0)
    Unit cur, nxt; int ui = 0;
    if (!S.next(0, cur)) return;
    f32x4 acc[2][2][4][2];
#pragma unroll
    for (int a = 0; a < 2; ++a)
#pragma unroll
        for (int b = 0; b < 2; ++b)
#pragma unroll
            for (int m = 0; m < 4; ++m)
#pragma unroll
                for (int n = 0; n < 2; ++n) acc[a][b][m][n] = (f32x4){0.f, 0.f, 0.f, 0.f};
    bf16x8 At[4][2], B0[2][2], B1[2][2];
    const char* cA = (const char*)g.A + (size_t)cur.pm * tstep; const char* cB = (const char*)g.Bt + (size_t)cur.pn * tstep;
    S.a_ready(cur); E.prefetch(cur, 0, lds, wid, lane);
    if constexpr (SP2) {
        PG8_STAGE(PG8_SB(0, 0), cB, voffB); PG8_STAGE(PG8_SB(0, 1), cB + hstep, voffB); PG8_STAGE(PG8_SA(0, 0), cA, voffA); PG8_STAGE(PG8_SA(0, 1), cA + hstep, voffA);
        if (wr == 1) PG8_BAR;
        PG8_WAIT_V(2); PG8_BAR;
        PG8_STAGE(PG8_SB(1, 0), cB + kstep, voffB); PG8_STAGE(PG8_SA(1, 0), cA + kstep, voffA); PG8_STAGE(PG8_SB(1, 1), cB + hstep + kstep, voffB);
        PG8_WAIT_V(6); PG8_BAR;
    } else {
        PG8_STAGE(PG8_SB(0, 0), cB, voffB); PG8_STAGE(PG8_SA(0, 0), cA, voffA); PG8_STAGE(PG8_SB(0, 1), cB + hstep, voffB); PG8_STAGE(PG8_SA(0, 1), cA + hstep, voffA);
        if (wr == 1) PG8_BAR;
        PG8_WAIT_V(4); PG8_BAR;
        PG8_STAGE(PG8_SB(1, 0), cB + kstep, voffB); PG8_STAGE(PG8_SA(1, 0), cA + kstep, voffA); PG8_STAGE(PG8_SB(1, 1), cB + hstep + kstep, voffB);
        PG8_WAIT_V(6); PG8_BAR;
    }
    for (;;) {
        const bool has_next = S.next(ui + 1, nxt);
        const char* nA = has_next ? (const char*)g.A + (size_t)nxt.pm * tstep : cA; const char* nB = has_next ? (const char*)g.Bt + (size_t)nxt.pn * tstep : cB;
        for (int t = 0; t < nt; t += 2) {
            const bool last = (t == nt - 2);
            const char* a1 = cA + (size_t)(t + 1) * kstep;
            const char* a2 = last ? nA : cA + (size_t)(t + 2) * kstep; const char* b2 = last ? nB : cB + (size_t)(t + 2) * kstep;
            const char* a3 = a2 + kstep; const char* b3 = b2 + kstep;
            if (last && has_next) S.a_ready(nxt);
            if constexpr (SP2) {
            PG8_LDB(B0, 0, 0); PG8_LDB(B1, 0, 1); PG8_SCHED; PG8_LDA(At, 0, 0); PG8_STAGE(PG8_SA(1, 1), a1 + hstep, voffA);
            PG8_WAIT_V(8); PG8_WAIT_L(0); PG8_BAR; PG8_MMA(0, 0, At, B0); PG8_MMA(0, 1, At, B1); PG8_BAR; PG8_SCHED;
            PG8_LDA(At, 0, 1); PG8_STAGE(PG8_SB(0, 0), b2, voffB); PG8_STAGE(PG8_SB(0, 1), b2 + hstep, voffB); PG8_STAGE(PG8_SA(0, 0), a2, voffA);
            PG8_WAIT_V(8); PG8_WAIT_L(0); PG8_BAR; PG8_MMA(1, 0, At, B0); PG8_MMA(1, 1, At, B1); PG8_BAR; PG8_SCHED;
            PG8_LDB(B0, 1, 0); PG8_LDB(B1, 1, 1); PG8_SCHED; PG8_LDA(At, 1, 0); PG8_STAGE(PG8_SA(0, 1), a2 + hstep, voffA);
            PG8_WAIT_V(8); PG8_WAIT_L(0); PG8_BAR; PG8_MMA(0, 0, At, B0); PG8_MMA(0, 1, At, B1); PG8_BAR; PG8_SCHED;
            PG8_LDA(At, 1, 1); PG8_STAGE(PG8_SB(1, 0), b3, voffB); PG8_STAGE(PG8_SB(1, 1), b3 + hstep, voffB); PG8_STAGE(PG8_SA(1, 0), a3, voffA);
            PG8_WAIT_V(8); PG8_WAIT_L(0); PG8_BAR; PG8_MMA(1, 0, At, B0); PG8_MMA(1, 1, At, B1); PG8_BAR; PG8_SCHED;
            } else {
            PG8_LDB(B0, 0, 0); PG8_SCHED; PG8_LDA(At, 0, 0); PG8_STAGE(PG8_SA(1, 1), a1 + hstep, voffA);
            PG8_WAIT_L(8); PG8_BAR; PG8_WAIT_L(0); PG8_MMA(0, 0, At, B0); PG8_BAR; PG8_SCHED;
            PG8_LDB(B1, 0, 1); PG8_STAGE(PG8_SB(0, 0), b2, voffB);
            PG8_BAR; PG8_WAIT_L(0); PG8_MMA(0, 1, At, B1); PG8_BAR;
            PG8_LDA(At, 0, 1); PG8_STAGE(PG8_SA(0, 0), a2, voffA);
            PG8_BAR; PG8_WAIT_L(0); PG8_MMA(1, 0, At, B0); PG8_BAR; PG8_SCHED;
            PG8_STAGE(PG8_SB(0, 1), b2 + hstep, voffB);
            PG8_WAIT_V(6); PG8_BAR; PG8_MMA(1, 1, At, B1); PG8_BAR;
            PG8_LDB(B0, 1, 0); PG8_SCHED; PG8_LDA(At, 1, 0); PG8_STAGE(PG8_SA(0, 1), a2 + hstep, voffA);
            PG8_WAIT_L(8); PG8_BAR; PG8_WAIT_L(0); PG8_MMA(0, 0, At, B0); PG8_BAR; PG8_SCHED;
            PG8_LDB(B1, 1, 1); PG8_STAGE(PG8_SB(1, 0), b3, voffB);
            PG8_BAR; PG8_WAIT_L(0); PG8_MMA(0, 1, At, B1); PG8_BAR;
            PG8_LDA(At, 1, 1); PG8_STAGE(PG8_SA(1, 0), a3, voffA);
            PG8_BAR; PG8_WAIT_L(0); PG8_MMA(1, 0, At, B0); PG8_BAR; PG8_SCHED;
            PG8_STAGE(PG8_SB(1, 1), b3 + hstep, voffB);
            PG8_WAIT_V(6); PG8_BAR; PG8_MMA(1, 1, At, B1); PG8_BAR;
            }
        }
        if constexpr (ALIGN_EPI) { if (wr == 0) PG8_BAR; }
        if constexpr (!Epi::AFTER_DRAIN) { E(acc, cur, wr, wc, fr, fq, ui, lds); S.done(cur); if (has_next) E.prefetch(nxt, ui + 1, lds, wid, lane); }
        if (!has_next) break;
#pragma unroll
        for (int a = 0; a < 2; ++a)
#pragma unroll
            for (int b = 0; b < 2; ++b)
#pragma unroll
                for (int m = 0; m < 4; ++m)
#pragma unroll
                    for (int n = 0; n < 2; ++n) acc[a][b][m][n] = (f32x4){0.f, 0.f, 0.f, 0.f};
        cur = nxt; cA = nA; cB = nB; ++ui;
        if constexpr (ALIGN_EPI) { if (wr == 1) PG8_BAR; }
    }
    PG8_WAIT_V(0);
    if constexpr (!ALIGN_EPI) { if (wr == 0) PG8_BAR; }
    PG8_BAR;
    if constexpr (Epi::AFTER_DRAIN) { E.fused(acc, cur, wr, wc, fr, fq, lds, wid, lane); S.done(cur); }
#undef PG8_SA
#undef PG8_SB
#undef PG8_STAGE
#undef PG8_LDA
#undef PG8_LDB
#undef PG8_MMA
#undef PG8_WAIT_V
#undef PG8_WAIT_L
#undef PG8_BAR
#undef PG8_SCHED
}
}
constexpr int NB = 8, SEQ = 4096, DM = 1024, NTOK = NB * SEQ, INW = 3844, NPERM = 4096, NLAYER = 2;
constexpr size_t MiB = 1u << 20;
constexpr size_t WS_CTL = 0, CTL_ZERO_BYTES = 1 * MiB;
constexpr size_t WS_WIN = 2 * MiB;
constexpr size_t WS_WOUT = 18 * MiB;
constexpr size_t WS_LF = 22 * MiB;
constexpr size_t WS_RS = 26 * MiB;
constexpr size_t WS_TAB = 23 * MiB;
constexpr size_t WS_KM = 24 * MiB;
constexpr size_t WS_MF = 25 * MiB;
constexpr int CW_BAR = 4096;
constexpr int CW_QUEUE = 64;
constexpr size_t WS_HN = 32 * MiB;
constexpr size_t WS_Q = 96 * MiB, WS_K = 160 * MiB, WS_V = 216 * MiB, WS_G = 272 * MiB, WS_X1 = 336 * MiB  , WS_END = 400 * MiB;
constexpr float LOG2E = 1.4426950408889634f;
constexpr int NWAVES = 8;
#define TIMER_SEL -1
#define TIMER_FS 100
#define TIMER_WG 37
#define TIMER_TYPE 1
#define PROBE_ATT 0
#define PROBE_REPS 2
#define PROBE_P1 0
#define PROBE_P3 0
#define PROBE_P0 0
#ifndef N_LAUNCHES
#define N_LAUNCHES 1
#endif
constexpr int RING_BYTES = 131072, LDSCTL_OFF = 139264, MISC_OFF = LDSCTL_OFF + 320, LDS_BYTES = 147456;

#define GAS __attribute__((address_space(1)))
#define LAS __attribute__((address_space(3)))
typedef unsigned short bf16;
typedef unsigned v4u __attribute__((ext_vector_type(4)));
typedef float f32x4 __attribute__((ext_vector_type(4)));
__device__ __forceinline__ unsigned f2bf(float f) { unsigned u = __builtin_bit_cast(unsigned, f); return (u + 0x7fffu + ((u >> 16) & 1u)) >> 16; }
__device__ __forceinline__ unsigned pk2(float lo, float hi) { return f2bf(lo) | (f2bf(hi) << 16); }
__device__ __forceinline__ float bf2f(unsigned v) { return __uint_as_float(v << 16); }
__device__ __forceinline__ float wave_sum(float v) {
#pragma unroll
    for (int o = 1; o < 64; o <<= 1) v += __shfl_xor(v, o);
    return v;
}
#define RLX_AGENT __ATOMIC_RELAXED, __HIP_MEMORY_SCOPE_AGENT
#define XB_TMO      128
#define XB_XCNT(j)  (256  + 64 * (j))
#define XB_XSUB(j)  (1280 + 64 * (j))
#define XB_XGEN(j)  (2304 + 64 * (j))
#define XB_TOP      3328
#define XB_TOPGEN   3392
#define XCD_BAR_WORDS 3456
#define XB_SPIN_CAP (1u << 18)

__device__ __forceinline__ unsigned xb_ld(unsigned* p)              { return __hip_atomic_load(p, __ATOMIC_RELAXED, __HIP_MEMORY_SCOPE_AGENT); }
__device__ __forceinline__ unsigned xb_add(unsigned* p, unsigned v) { return __hip_atomic_fetch_add(p, v, __ATOMIC_RELAXED, __HIP_MEMORY_SCOPE_AGENT); }
__device__ __forceinline__ unsigned xb_xcc_id() { return (unsigned)__builtin_amdgcn_s_getreg((3 << 11) | 20) & 0xFu; }
#define XB_SPIN(cond, bar) do { unsigned _sp = 0; while (cond) { __builtin_amdgcn_s_sleep(1); \
    if ((++_sp & 255u) == 0u) { if (xb_ld(&(bar)[XB_TMO])) break; if (_sp > XB_SPIN_CAP) { atomicAdd(&(bar)[XB_TMO], 1u); break; } } } } while (0)

struct XcdBarrier {
    unsigned* bar; unsigned x;
    volatile LAS unsigned* st;
};

__device__ __forceinline__ XcdBarrier xcd_barrier_post(unsigned* bar, volatile LAS unsigned* st) {
    XcdBarrier b; b.bar = bar; b.x = xb_xcc_id(); b.st = st;
    if (threadIdx.x == 0) (void)xb_add(&bar[XB_XCNT(b.x)], 1u);
    return b;
}
__device__ __forceinline__ void xcd_barrier_complete(unsigned* bar, unsigned x, unsigned& nloc, unsigned& nx) {
    const unsigned G = gridDim.x * gridDim.y * gridDim.z;
    unsigned sum, cnt, mine, sp = 0u;
    for (;;) {
        sum = 0u; cnt = 0u; mine = 0u;
#pragma unroll
        for (unsigned j = 0; j < 16; ++j) { const unsigned c = xb_ld(&bar[XB_XCNT(j)]); sum += c; cnt += (c > 0u) ? 1u : 0u; mine = (j == x) ? c : mine; }
        if (sum == G) break;
        __builtin_amdgcn_s_sleep(1);
        if ((++sp & 255u) == 0u) { if (xb_ld(&bar[XB_TMO])) break; if (sp > XB_SPIN_CAP) { atomicAdd(&bar[XB_TMO], 1u); break; } }
    }
    nloc = mine > 0u ? mine : 1u; nx = cnt > 0u ? cnt : 1u;
}

__device__ __forceinline__ void xcd_barrier(const XcdBarrier& b) {
    asm volatile("s_waitcnt vmcnt(0)" ::: "memory");
    __syncthreads();
    if (threadIdx.x == 0) {
        unsigned* bar = b.bar;
        __builtin_amdgcn_s_waitcnt(0);
        unsigned nloc = b.st[0], nx = b.st[1];
        if (nloc == 0u) { xcd_barrier_complete(bar, b.x, nloc, nx); b.st[0] = nloc; b.st[1] = nx; }
        const unsigned old = xb_add(&bar[XB_XSUB(b.x)], 1u);
        const unsigned gen = old / nloc;
        if (old + 1u == (gen + 1u) * nloc) {
            __builtin_amdgcn_fence(__ATOMIC_RELEASE, "agent");
            asm volatile("s_waitcnt vmcnt(0)" ::: "memory");
            const unsigned og = xb_add(&bar[XB_TOP], 1u);
            const unsigned tg = og / nx;
            if (og + 1u == (tg + 1u) * nx) xb_add(&bar[XB_TOPGEN], 1u);
            else XB_SPIN(xb_ld(&bar[XB_TOPGEN]) == tg, bar);
            __builtin_amdgcn_fence(__ATOMIC_ACQUIRE, "agent");
            xb_add(&bar[XB_XGEN(b.x)], 1u);
            asm volatile("s_waitcnt vmcnt(0)" ::: "memory");
        } else {
            XB_SPIN(xb_ld(&bar[XB_XGEN(b.x)]) == gen, bar);
            __builtin_amdgcn_fence(__ATOMIC_ACQUIRE, "agent");
            asm volatile("s_waitcnt vmcnt(0)" ::: "memory");
        }
    }
    __syncthreads();
}

__device__ __forceinline__ int rel_bucket(int d) {
    if (d < 16) return d;
    int b = 16;
    b += (d >= 21); b += (d >= 27); b += (d >= 35); b += (d >= 46); b += (d >= 59); b += (d >= 77); b += (d >= 99); b += (d >= 128);
    b += (d >= 166); b += (d >= 216); b += (d >= 280); b += (d >= 363); b += (d >= 470); b += (d >= 609); b += (d >= 790);
    return b;
}

struct Args { const float* x; const float* norm_gain; const float* w_in; const float* b_forget; const float* fox_g; const float* moba_g; const float* swa_g; const float* sinks; const float* w_out; const float* rel_bias; float* out; unsigned char* ws; int ph_lo, ph_hi, tmask, pad; };

struct Frame { LAS unsigned char* lds; int tid, lane, wave, vcu, G; };

__device__ __forceinline__ void transpose_item(const float* W, int ldw, bf16* WT, int dst_row0, int src_col0, int ncol, const float* gk, LAS float* scr, int kb, int lane) {
    const int k0 = 64 * kb;
    { float wv[32]; const int c = lane & 31;
#pragma unroll
        for (int i = 0; i < 32; ++i) { const int kk = 2 * i + (lane >> 5); wv[i] = (c < ncol) ? W[(size_t)(k0 + kk) * ldw + src_col0 + c] : 0.f; }
        if (gk) {
#pragma unroll
            for (int i = 0; i < 32; ++i) wv[i] *= gk[k0 + 2 * i + (lane >> 5)]; }
#pragma unroll
        for (int i = 0; i < 32; ++i) scr[(2 * i + (lane >> 5)) * 33 + c] = wv[i]; }
    asm volatile("s_waitcnt lgkmcnt(0)" ::: "memory");
    const int c = lane & 7;
#pragma unroll
    for (int j = 0; j < 4; ++j) { const int n = (lane >> 3) + 8 * j; const LAS float* s = scr + (8 * c) * 33 + n;
        v4u o; o.x = pk2(s[0 * 33], s[1 * 33]); o.y = pk2(s[2 * 33], s[3 * 33]); o.z = pk2(s[4 * 33], s[5 * 33]); o.w = pk2(s[6 * 33], s[7 * 33]);
        *(v4u*)(WT + (size_t)(dst_row0 + n) * 1024 + k0 + 8 * c) = o; }
    asm volatile("s_waitcnt lgkmcnt(0)" ::: "memory");
}
__device__ __forceinline__ int tile_src(int T, int wc) {
    switch (T) { case 0: return 0 + 64 * wc; case 1: return 256 + 64 * wc; case 2: return 512 + 64 * wc; case 3: return 772 + 64 * wc;
        case 4: return 1028 + 64 * wc; case 5: return 1284 + 64 * wc; case 6: return 1540 + 64 * wc; case 7: return 1796 + 64 * wc;
        case 8: return 2052 + 64 * wc; case 9: return 2308 + 64 * wc; case 10: return 2564 + 64 * wc; case 11: return 2820 + 64 * wc;
        case 12: return 3076 + 64 * wc; case 13: return wc < 2 ? 3332 + 64 * wc : 3460 + 64 * (wc - 2); default: return 3588 + 64 * wc; }
}
__device__ __forceinline__ void p_weights(Frame& F, const Args& a) {
    LAS float* scr = (LAS float*)(F.lds + F.wave * 16384);
    const int gw = F.vcu * NWAVES + F.wave, NGW = F.G * NWAVES;
    bf16* win = (bf16*)(a.ws + WS_WIN); bf16* wout = (bf16*)(a.ws + WS_WOUT);
    constexpr int I_IN = 128 * 16, I_OUT = 32 * 16;
    for (int it = gw; it < 2 * (I_IN + I_OUT); it += NGW) {
        const int layer = it / (I_IN + I_OUT); int r = it % (I_IN + I_OUT);
        if (r < I_IN) { const int kb = r >> 7, g = r & 127, T = g >> 3, gg = g & 7, bj = gg >> 2, wc = gg & 3;
            const int src = (T < 15) ? tile_src(T, wc) + 32 * bj : 768, ncol = (T < 15) ? 32 : (gg == 0 ? 4 : 0);
            transpose_item(a.w_in + (size_t)layer * DM * INW, INW, win + (size_t)layer * NPERM * DM, 32 * g, src, ncol, a.norm_gain + layer * DM, scr, kb, F.lane); }
        else { r -= I_IN; const int kb = r / 32, g = r % 32;
            transpose_item(a.w_out + (size_t)layer * DM * DM, DM, wout + (size_t)layer * DM * DM, 32 * g, 32 * g, 32, nullptr, scr, kb, F.lane); }
    }
    if (F.vcu == 0) { float* tab = (float*)(a.ws + WS_TAB);
        for (int i = F.tid; i < 8 * 1024; i += NWAVES * 64) { const int hc = i >> 10, d = i & 1023; tab[i] = a.rel_bias[rel_bucket(d) * 8 + hc] * LOG2E; } }
}
__device__ __forceinline__ void p_consts(Frame& F, const Args& a) {
    if (F.vcu == 0 && F.wave == 0) for (int layer = 0; layer < NLAYER; ++layer) {
        const int lane = F.lane; float* MF = (float*)(a.ws + WS_MF) + layer * 4;
        float bm = 0.f;
#pragma unroll
        for (int j = 0; j < 4; ++j) bm = fmaxf(bm, fabsf(a.rel_bias[64 * j + lane]));
#pragma unroll
        for (int o = 1; o < 64; o <<= 1) bm = fmaxf(bm, __shfl_xor(bm, o));
        const float* gp[3] = {a.fox_g + layer * 128, a.moba_g + layer * 128, a.swa_g + layer * 128};
#pragma unroll
        for (int k = 0; k < 3; ++k) { float mq = fabsf(gp[k][lane]), mk = fabsf(gp[k][64 + lane]);
#pragma unroll
            for (int o = 1; o < 64; o <<= 1) { mq = fmaxf(mq, __shfl_xor(mq, o)); mk = fmaxf(mk, __shfl_xor(mk, o)); }
            const float m = 8.f * LOG2E * mq * mk * 1.02f + 0.1f + (k == 0 ? 0.f : bm * LOG2E);
            if (lane == 0) MF[k == 0 ? 0 : (k == 1 ? 1 : 3)] = m; }
        if (lane == 0) MF[2] = 0.f;
    }
}
__device__ __forceinline__ void p_convert(Frame& F, const Args& a) {
    const int lane = F.lane, gt = F.vcu * (NWAVES * 64) + F.tid, NT_ = F.G * NWAVES * 64;
    { float* KM = (float*)(a.ws + WS_KM); for (int i = gt; i < 32 * 16 * 64; i += NT_) KM[i] = 0.f;
      float* RS1 = (float*)(a.ws + WS_RS) + NTOK; for (int i = gt; i < NTOK; i += NT_) RS1[i] = 0.f; }
    bf16* XB = (bf16*)(a.ws + WS_HN); float* RS0 = (float*)(a.ws + WS_RS);
    const int gwv = F.vcu * NWAVES + F.wave, NGW = F.G * NWAVES;
    for (int r0 = 4 * gwv; r0 < NTOK; r0 += 4 * NGW) {
        f32x4 v[4][4];
#pragma unroll
        for (int rr = 0; rr < 4; ++rr) { const f32x4* xr = (const f32x4*)(a.x + (size_t)(r0 + rr) * DM) + lane;
#pragma unroll
            for (int j = 0; j < 4; ++j) v[rr][j] = xr[64 * j]; }
        float ss[4];
#pragma unroll
        for (int rr = 0; rr < 4; ++rr) { ss[rr] = 0.f; unsigned long long* o8 = (unsigned long long*)(XB + (size_t)(r0 + rr) * DM) + lane;
#pragma unroll
            for (int j = 0; j < 4; ++j) { const f32x4 y = v[rr][j]; ss[rr] += (y[0] * y[0] + y[1] * y[1]) + (y[2] * y[2] + y[3] * y[3]);
                o8[64 * j] = (unsigned long long)pk2(y[0], y[1]) | ((unsigned long long)pk2(y[2], y[3]) << 32); } }
#pragma unroll
        for (int o = 1; o < 64; o <<= 1)
#pragma unroll
            for (int rr = 0; rr < 4; ++rr) ss[rr] += __shfl_xor(ss[rr], o);
        if (lane < 4) RS0[r0 + lane] = lane == 0 ? ss[0] : (lane == 1 ? ss[1] : (lane == 2 ? ss[2] : ss[3]));
    }
}
namespace att {
using bf16x8 = __attribute__((ext_vector_type(8))) short;
using s16x4 = __attribute__((ext_vector_type(4))) short;
using f32x16 = __attribute__((ext_vector_type(16))) float;
using u32x4 = __attribute__((ext_vector_type(4))) unsigned;
typedef __attribute__((address_space(3))) const char* lds_cptr;
typedef __attribute__((address_space(3))) char* lds_ptr;
typedef short v4i16_t __attribute__((ext_vector_type(4)));
typedef float f32x2_t __attribute__((ext_vector_type(2))); typedef __bf16 bf16x2_t __attribute__((ext_vector_type(2)));
constexpr int NSLOT = 5, PFD = 2, SLOTB = 8192;
constexpr int L_K = 0, L_V = NSLOT * SLOTB, L_OST = 0  , L_WS = 2 * NSLOT * SLOTB, L_CS = L_WS + 8 * 256, L_TAB = L_CS + 16384, L_G = L_TAB + 4608, L_MISC = L_G + 8 * 4096, L_END = L_MISC + 1024;
static_assert(L_END <= 139264 && 8 * 4096 <= NSLOT * SLOTB, "attention LDS map (the kernel's control words start at 136 KiB)");
constexpr float THR2 = 44.f;
#define SBAR() __builtin_amdgcn_sched_barrier(0)
__device__ __forceinline__ int crow(int r, int hi) { return (r & 3) + 8 * (r >> 2) + 4 * hi; }
__device__ __forceinline__ void glds16(const void* gsrc, unsigned lds_dst) { unsigned keep;
    asm volatile("s_mov_b32 %0, m0\n\ts_mov_b32 m0, %2\n\ts_nop 0\n\tglobal_load_lds_dwordx4 %1, off\n\ts_mov_b32 m0, %0" : "=&s"(keep) : "v"(gsrc), "s"(lds_dst) : "memory"); }
__device__ __forceinline__ unsigned cvtpk_s(float lo, float hi) { f32x2_t v = {lo, hi}; bf16x2_t b = __builtin_convertvector(v, bf16x2_t); return __builtin_bit_cast(unsigned, b); }
__device__ __forceinline__ s16x4 vtr(lds_cptr p) { return __builtin_bit_cast(s16x4, __builtin_amdgcn_ds_read_tr16_b64_v4i16((__attribute__((address_space(3))) v4i16_t*)p)); }
#define MFMA32(a, b, c) __builtin_amdgcn_mfma_f32_32x32x16_bf16(a, b, c, 0, 0, 0)
__device__ __forceinline__ void qkt(f32x16& p0, f32x16& p1, lds_cptr kp, const bf16x8* qr, float cinit) {
    f32x16 c;
#pragma unroll
    for (int r = 0; r < 16; ++r) c[r] = cinit;
    p0 = c; p1 = c;
#pragma unroll
    for (int d0 = 0; d0 < 4; ++d0) {
        const bf16x8 b0 = *(const __attribute__((address_space(3))) bf16x8*)(kp + d0 * 2048);
        const bf16x8 b1 = *(const __attribute__((address_space(3))) bf16x8*)(kp + d0 * 2048 + 512);
        p0 = MFMA32(b0, qr[d0], p0); p1 = MFMA32(b1, qr[d0], p1);
    }
}
__device__ __forceinline__ void pv(f32x16* o, lds_cptr vp, bf16x8 pa0, bf16x8 pa1, bf16x8 pa2, bf16x8 pa3) {
#pragma unroll
    for (int d0 = 0; d0 < 2; ++d0) { s16x4 lo[4], hi[4];
#pragma unroll
        for (int ks = 0; ks < 4; ++ks) { lo[ks] = vtr(vp + d0 * 4096 + ks * 1024); hi[ks] = vtr(vp + d0 * 4096 + ks * 1024 + 512); }
#define PK(k) (bf16x8){lo[k][0], lo[k][1], lo[k][2], lo[k][3], hi[k][0], hi[k][1], hi[k][2], hi[k][3]}
        o[d0] = MFMA32(pa0, PK(0), o[d0]); o[d0] = MFMA32(pa1, PK(1), o[d0]); o[d0] = MFMA32(pa2, PK(2), o[d0]); o[d0] = MFMA32(pa3, PK(3), o[d0]);
#undef PK
    }
}
__device__ __forceinline__ void kload(bf16x8* kf, lds_cptr kp) {
#pragma unroll
    for (int d0 = 0; d0 < 4; ++d0) { kf[2 * d0] = *(const __attribute__((address_space(3))) bf16x8*)(kp + d0 * 2048); kf[2 * d0 + 1] = *(const __attribute__((address_space(3))) bf16x8*)(kp + d0 * 2048 + 512); }
}
__device__ __forceinline__ void vload(s16x4* vlo, s16x4* vhi, lds_cptr vp) {
#pragma unroll
    for (int i = 0; i < 8; ++i) { vlo[i] = vtr(vp + (i >> 2) * 4096 + (i & 3) * 1024); vhi[i] = vtr(vp + (i >> 2) * 4096 + (i & 3) * 1024 + 512); }
}
__device__ __forceinline__ void qkt_r(f32x16& p0, f32x16& p1, const bf16x8* kf, const bf16x8* qr, float cinit) {
    f32x16 c;
#pragma unroll
    for (int r = 0; r < 16; ++r) c[r] = cinit;
    p0 = c; p1 = c;
#pragma unroll
    for (int d0 = 0; d0 < 4; ++d0) { p0 = MFMA32(kf[2 * d0], qr[d0], p0); p1 = MFMA32(kf[2 * d0 + 1], qr[d0], p1); }
}
__device__ __forceinline__ void pv_r(f32x16* o, const s16x4* vlo, const s16x4* vhi, bf16x8 pa0, bf16x8 pa1, bf16x8 pa2, bf16x8 pa3) {
#define VFR(i) (bf16x8){vlo[i][0], vlo[i][1], vlo[i][2], vlo[i][3], vhi[i][0], vhi[i][1], vhi[i][2], vhi[i][3]}
    o[0] = MFMA32(pa0, VFR(0), o[0]); o[1] = MFMA32(pa0, VFR(4), o[1]); o[0] = MFMA32(pa1, VFR(1), o[0]); o[1] = MFMA32(pa1, VFR(5), o[1]);
    o[0] = MFMA32(pa2, VFR(2), o[0]); o[1] = MFMA32(pa2, VFR(6), o[1]); o[0] = MFMA32(pa3, VFR(3), o[0]); o[1] = MFMA32(pa3, VFR(7), o[1]);
#undef VFR
}
struct ACtx { const bf16 *Q, *K, *V, *G; bf16* Y; const float *LF, *TAB, *KM, *MF; const float* sinks; int tflag; };
#define WAITBAR(N) asm volatile("s_waitcnt vmcnt(" #N ") lgkmcnt(0)\n\ts_barrier" ::: "memory")

#define USTAMP(k) do { if (TIMER_SEL >= 0 && TYPE == TIMER_TYPE && C.tflag && tid == 0) { volatile __attribute__((address_space(3))) unsigned* ta_ = (volatile __attribute__((address_space(3))) unsigned*)(shm + 139264 + 320) + 16; const unsigned now_ = (unsigned)__builtin_amdgcn_s_memrealtime(); ta_[k] += now_ - ta_[31]; ta_[31] = now_; } } while (0)
__device__ __forceinline__ int ticket_type(int u) { const int ty = u >> 9; return ty == 0 ? 1 : (ty == 1 ? 0 : ty); }
__device__ __forceinline__ void prefetch_unit(const ACtx& C, int u, lds_ptr shm, bf16x8* qn) {
    int tid = threadIdx.x; asm volatile("" : "+v"(tid));
    const int lane = tid & 63, r32 = lane & 31, hi = lane >> 5; const int wid = __builtin_amdgcn_readfirstlane(tid >> 6);
    const int T = ticket_type(u), r = u & 511, qb = 15 - (r >> 5), bh = r & 31, b = bh >> 2, h = bh & 3;
    const int kvh = (T == 3) ? (b * 2 + (h >> 1)) : bh;
    const bf16* Kh = C.K + T * pg8::GS + (size_t)kvh * SEQ * 64; const bf16* Vh = C.V + T * pg8::GS + (size_t)kvh * SEQ * 64;
    const bf16* ksrc = Kh + (size_t)lane * 64 + wid * 8;
    const bf16* vsrc = Vh + (size_t)(16 * (wid & 3) + (lane >> 2)) * 64 + (wid >> 2) * 32 + (lane & 3) * 8;
    const unsigned lds0 = (unsigned)(size_t)shm, kdst = lds0 + L_K + wid * 1024, vdst = lds0 + L_V + wid * 1024;
    const int t_hi = 4 * qb + 3;
    glds16(ksrc + (size_t)t_hi * 4096, (unsigned)__builtin_amdgcn_readfirstlane(kdst)); glds16(vsrc + (size_t)t_hi * 4096, (unsigned)__builtin_amdgcn_readfirstlane(vdst));
    glds16(ksrc + (size_t)(t_hi - 1) * 4096, (unsigned)__builtin_amdgcn_readfirstlane(kdst + SLOTB)); glds16(vsrc + (size_t)(t_hi - 1) * 4096, (unsigned)__builtin_amdgcn_readfirstlane(vdst + SLOTB));
    const bf16* Qw = C.Q + T * pg8::GS + ((size_t)bh * SEQ + qb * 256 + wid * 32) * 64;
#pragma unroll
    for (int d0 = 0; d0 < 4; ++d0) qn[d0] = *reinterpret_cast<const bf16x8*>(&Qw[(size_t)r32 * 64 + d0 * 16 + hi * 8]);
}
template <int TYPE> __device__ __forceinline__ int attn_unit(const ACtx& C, int bh, int qb, lds_ptr shm, bf16x8 (&qr)[4], int tick, __attribute__((address_space(3))) int* tslot) {
    int tid = threadIdx.x; asm volatile("" : "+v"(tid));
    const int lane = tid & 63, r32 = lane & 31, hi = lane >> 5; const int wid = __builtin_amdgcn_readfirstlane(tid >> 6);
    const int b = bh >> 2, h = bh & 3, q0 = qb * 256, qrel = wid * 32 + r32, t = q0 + qrel;
    const int kvh = (TYPE == 3) ? (b * 2 + (h >> 1)) : bh;
    const bf16* Qw = C.Q + TYPE * pg8::GS + ((size_t)bh * SEQ + q0 + wid * 32) * 64;
    const bf16* Kh = C.K + TYPE * pg8::GS + (size_t)kvh * SEQ * 64; const bf16* Vh = C.V + TYPE * pg8::GS + (size_t)kvh * SEQ * 64;
    const unsigned lds0 = (unsigned)(size_t)shm;
    __attribute__((address_space(3))) float* wsf = (__attribute__((address_space(3))) float*)(shm + L_WS) + wid * 64;
    __attribute__((address_space(3))) float* tabL = (__attribute__((address_space(3))) float*)(shm + L_TAB);
    __attribute__((address_space(3))) float* cs = (__attribute__((address_space(3))) float*)(shm + L_CS);
    __attribute__((address_space(3))) float* misc = (__attribute__((address_space(3))) float*)(shm + L_MISC);
    __attribute__((address_space(3))) int* misci = (__attribute__((address_space(3))) int*)(shm + L_MISC);
    const bf16* ksrc = Kh + (size_t)lane * 64 + wid * 8;
    const bf16* vsrc = Vh + (size_t)(16 * (wid & 3) + (lane >> 2)) * 64 + (wid >> 2) * 32 + (lane & 3) * 8;
    const unsigned kdst = lds0 + L_K + wid * 1024, vdst = lds0 + L_V + wid * 1024;
#define DMA_KV(tile, slot) do { glds16(ksrc + (size_t)(tile) * 4096, (unsigned)__builtin_amdgcn_readfirstlane(kdst + (slot) * SLOTB)); glds16(vsrc + (size_t)(tile) * 4096, (unsigned)__builtin_amdgcn_readfirstlane(vdst + (slot) * SLOTB)); } while (0)
    const lds_cptr kp0 = (lds_cptr)shm + L_K + hi * 1024 + r32 * 16;
    const lds_cptr vp0 = (lds_cptr)shm + L_V + ((lane >> 4) & 1) * 32 + (lane & 3) * 8 + (4 * hi + ((lane & 15) >> 2)) * 64;
    const float Mf = (TYPE == 2) ? 0.f : C.MF[TYPE];
    const int t_hi = 4 * qb + 3; int t_lo = 0;
    if (TYPE == 3) { t_lo = 4 * qb - 2; if (t_lo < 0) t_lo = 0; }
    USTAMP(24);
    const size_t yrow0 = (size_t)(b * SEQ + q0 + wid * 32);
    { const bf16* gsrc = C.G + (yrow0 + (lane >> 3)) * DM + TYPE * 256 + h * 64 + (lane & 7) * 8;
#pragma unroll
        for (int i = 0; i < 4; ++i) glds16(gsrc + (size_t)(8 * i) * DM, (unsigned)__builtin_amdgcn_readfirstlane(lds0 + L_G + wid * 4096 + i * 1024)); }
    unsigned sel = 0u; float ct = 0.f;
    if (TYPE == 0) {
        const float* lfp = C.LF + (size_t)bh * SEQ; const bool on = 8 * tid < q0 + 256;
        f32x4 a4 = {0.f, 0.f, 0.f, 0.f}, b4 = {0.f, 0.f, 0.f, 0.f};
        if (on) { a4 = *(const f32x4*)(lfp + 8 * tid); b4 = *(const f32x4*)(lfp + 8 * tid + 4); }
        a4[1] += a4[0]; a4[2] += a4[1]; a4[3] += a4[2]; b4[0] += a4[3]; b4[1] += b4[0]; b4[2] += b4[1]; b4[3] += b4[2];
        float sc = b4[3];
#pragma unroll
        for (int o = 1; o < 64; o <<= 1) { const float u = __shfl_up(sc, o); if (lane >= o) sc += u; }
        if (lane == 63) misc[wid] = sc;
        __syncthreads();
        float base = sc - b4[3];
#pragma unroll
        for (int w = 0; w < 7; ++w) if (w < wid) base += misc[w];
        if (on) { *(__attribute__((address_space(3))) f32x4*)(cs + 8 * tid) = a4 + base; *(__attribute__((address_space(3))) f32x4*)(cs + 8 * tid + 4) = b4 + base; }
        __syncthreads();
        const float cref = cs[q0];
        if (wid == 0) { const bool skip = (lane < 4 * qb) && (cs[64 * lane + 63] - cref > 2.f * Mf + THR2);
            const int cnt = __popcll(__ballot(skip)); if (lane == 0) misci[40] = cnt; }
        __syncthreads();
        t_lo = misci[40]; ct = cs[t];
    }
    if (TYPE == 1 || TYPE == 3) {
        const float* tg = C.TAB + ((TYPE == 3 ? 4 : 0) + h) * 1024;
        { float tv[3]; const float b31 = (TYPE == 1) ? tg[1023] : 0.f; float k0 = 0.f, k1 = 0.f;
#pragma unroll
            for (int k = 0; k < 3; ++k) { const int j = tid + 512 * k, d = 1023 - j; tv[k] = (j < 1088 && d >= 0 && (TYPE == 1 || d < 128)) ? tg[d] - b31 : -INFINITY; }
            if (TYPE == 1) { const float* kg = C.KM + (size_t)bh * 16 * 64; if (tid < qb * 64) k0 = kg[tid]; if (tid + 512 < qb * 64) k1 = kg[tid + 512]; }
#pragma unroll
            for (int k = 0; k < 3; ++k) { const int j = tid + 512 * k; if (j < 1088) tabL[j] = tv[k]; }
            if (TYPE == 1) { cs[tid] = k0; cs[tid + 512] = k1; } }
        __syncthreads();
        if (TYPE == 1) {
            if (qb <= 3) sel = (1u << qb) - 1u;
            else {
                float qf[32];
#pragma unroll
                for (int d0 = 0; d0 < 4; ++d0) { const u32x4 w = __builtin_bit_cast(u32x4, qr[d0]);
#pragma unroll
                    for (int j = 0; j < 4; ++j) { qf[d0 * 8 + 2 * j] = __uint_as_float(w[j] << 16); qf[d0 * 8 + 2 * j + 1] = __uint_as_float(w[j] & 0xffff0000u); } }
                float v1 = -INFINITY, v2 = -INFINITY, v3 = -INFINITY; int i1 = 0, i2 = 0, i3 = 0;
                for (int n = 0; n < qb; ++n) { float s = 0.f;
#pragma unroll
                    for (int d0 = 0; d0 < 4; ++d0) { const f32x4 ka = *(const __attribute__((address_space(3))) f32x4*)(cs + n * 64 + d0 * 16 + hi * 8), kb4 = *(const __attribute__((address_space(3))) f32x4*)(cs + n * 64 + d0 * 16 + hi * 8 + 4);
#pragma unroll
                        for (int j = 0; j < 4; ++j) { s += qf[d0 * 8 + j] * ka[j]; s += qf[d0 * 8 + 4 + j] * kb4[j]; } }
                    { auto rr = __builtin_amdgcn_permlane32_swap(__float_as_uint(s), __float_as_uint(s), false, false); s = __uint_as_float(rr[0]) + __uint_as_float(rr[1]); }
                    if (s > v1) { v3 = v2; i3 = i2; v2 = v1; i2 = i1; v1 = s; i1 = n; } else if (s > v2) { v3 = v2; i3 = i2; v2 = s; i2 = n; } else if (s > v3) { v3 = s; i3 = n; } }
                sel = (1u << i1) | (1u << i2) | (1u << i3); }
        }
    }
    const int n_tiles = t_hi - t_lo + 1;
    asm volatile("" : "+v"(qr[0]), "+v"(qr[1]), "+v"(qr[2]), "+v"(qr[3]));
    f32x16 o[2]; o[0] = f32x16{}; o[1] = f32x16{}; f32x16 lacc = f32x16{};
    float carry = (TYPE == 2) ? 1.f : 0.f; bool done_w = false;
    f32x16 cvec;
    { const float c0_ = (TYPE == 2) ? 0.f : ((TYPE == 0) ? ct - Mf : -Mf);
#pragma unroll
        for (int r = 0; r < 16; ++r) cvec[r] = c0_; }
    asm volatile("" : "+v"(cvec));
    const bf16x8 ones = {0x3f80, 0x3f80, 0x3f80, 0x3f80, 0x3f80, 0x3f80, 0x3f80, 0x3f80};
    const int jdiag = wid >> 1;
    const int jlo_w = (TYPE == 3) ? ((32 * wid - 127) >> 6) : -100000;
    if (TYPE == 2) { if (tid < 16) misci[64 + tid] = 0; }
    USTAMP(21);
    if (TIMER_SEL == 98 && TYPE == TIMER_TYPE && C.tflag && tid == 0) { volatile __attribute__((address_space(3))) unsigned* ta_ = (volatile __attribute__((address_space(3))) unsigned*)(shm + 139264 + 320) + 16; ta_[26] = (unsigned)__builtin_amdgcn_s_memtime(); }
    bf16x8 kf[8]; s16x4 vlo[8], vhi[8]; f32x16 p0, p1;
    const bool late = wid >= 4;
#define FINISH(tile_, jr_, slot_) do { \
            vload(vlo, vhi, vp0 + (slot_) * SLOTB); SBAR(); \
            const int kb = 64 * (jr_) + 4 * hi; \
            unsigned keepm = 0xffffffffu; \
            if (TYPE == 0) { \
            _Pragma("unroll") \
                for (int g4 = 0; g4 < 4; ++g4) { const f32x4 c0 = *(const __attribute__((address_space(3))) f32x4*)(cs + 64 * (tile_) + 8 * g4 + 4 * hi), c1 = *(const __attribute__((address_space(3))) f32x4*)(cs + 64 * (tile_) + 32 + 8 * g4 + 4 * hi); \
            _Pragma("unroll") \
                    for (int j = 0; j < 4; ++j) { p0[4 * g4 + j] -= c0[j]; p1[4 * g4 + j] -= c1[j]; } } \
                if ((jr_) == jdiag) { \
            _Pragma("unroll") \
                    for (int r = 0; r < 16; ++r) { const int kv = kb + (r & 3) + 8 * (r >> 2); if (kv > qrel) p0[r] = -INFINITY; if (kv + 32 > qrel) p1[r] = -INFINITY; } } \
            _Pragma("unroll") \
                for (int r = 0; r < 16; ++r) { p0[r] = __builtin_amdgcn_exp2f(p0[r]); p1[r] = __builtin_amdgcn_exp2f(p1[r]); } \
            } \
            if (TYPE == 1 || TYPE == 3) { \
                const bool far = (TYPE == 1) && ((q0 + 32 * wid - 64 * (tile_) - 63) >= 790); \
                if (!far) { const __attribute__((address_space(3))) float* tp_ = tabL + (1023 - (qrel - kb)); \
            _Pragma("unroll") \
                    for (int r = 0; r < 16; ++r) { p0[r] += tp_[(r & 3) + 8 * (r >> 2)]; p1[r] += tp_[(r & 3) + 8 * (r >> 2) + 32]; } } \
                if (TYPE == 1 && (jr_) < 0) keepm = ((sel >> ((tile_) >> 2)) & 1u) ? 0xffffffffu : 0u; \
            _Pragma("unroll") \
                for (int r = 0; r < 16; ++r) { p0[r] = __builtin_amdgcn_exp2f(p0[r]); p1[r] = __builtin_amdgcn_exp2f(p1[r]); } \
            } \
            if (TYPE == 2) { \
                f32x16 w0, w1; \
            _Pragma("unroll") \
                for (int r = 0; r < 16; ++r) { p0[r] = __builtin_amdgcn_exp2f(fminf(p0[r], 80.f)); p1[r] = __builtin_amdgcn_exp2f(fminf(p1[r], 80.f)); } \
                if ((jr_) == jdiag) { \
            _Pragma("unroll") \
                    for (int r = 0; r < 16; ++r) { const int kv = kb + (r & 3) + 8 * (r >> 2); if (kv >= qrel) p0[r] = 0.f; if (kv + 32 >= qrel) p1[r] = 0.f; } } \
            _Pragma("unroll") \
                for (int r = 0; r < 16; ++r) { w0[r] = 1.f + p0[r]; w1[r] = 1.f + p1[r]; } \
                float own[8], part[8]; \
            _Pragma("unroll") \
                for (int rb = 0; rb < 4; ++rb) { own[rb] = (w0[4 * rb] * w0[4 * rb + 1]) * (w0[4 * rb + 2] * w0[4 * rb + 3]); own[4 + rb] = (w1[4 * rb] * w1[4 * rb + 1]) * (w1[4 * rb + 2] * w1[4 * rb + 3]); } \
            _Pragma("unroll") \
                for (int rb = 0; rb < 8; ++rb) { auto rr = __builtin_amdgcn_permlane32_swap(__float_as_uint(own[rb]), __float_as_uint(own[rb]), false, false); part[rb] = __uint_as_float(hi ? rr[0] : rr[1]); } \
                float run = carry; \
            _Pragma("unroll") \
                for (int rb = 7; rb >= 0; --rb) { \
                    float E = hi == 0 ? run * part[rb] : run; run *= own[rb] * part[rb]; \
            _Pragma("unroll") \
                    for (int j = 3; j >= 0; --j) { const int r = 4 * (rb & 3) + j; \
                        if (rb >= 4) { E *= w1[r]; p1[r] *= __builtin_amdgcn_rcpf(E); } else { E *= w0[r]; p0[r] *= __builtin_amdgcn_rcpf(E); } } } \
                carry = run; \
                done_w = __all(carry > 1.7592186e13f) != 0;     \
            } \
            u32x4 pw0, pw1, pw2, pw3; \
            _Pragma("unroll") \
            for (int j = 0; j < 4; ++j) { pw0[j] = cvtpk_s(p0[2 * j], p0[2 * j + 1]); pw1[j] = cvtpk_s(p0[8 + 2 * j], p0[9 + 2 * j]); pw2[j] = cvtpk_s(p1[2 * j], p1[2 * j + 1]); pw3[j] = cvtpk_s(p1[8 + 2 * j], p1[9 + 2 * j]); } \
            if (TYPE == 1) { pw0 &= keepm; pw1 &= keepm; pw2 &= keepm; pw3 &= keepm; } \
            const bf16x8 pa0 = __builtin_bit_cast(bf16x8, pw0), pa1 = __builtin_bit_cast(bf16x8, pw1), pa2 = __builtin_bit_cast(bf16x8, pw2), pa3 = __builtin_bit_cast(bf16x8, pw3); \
            pv_r(o, vlo, vhi, pa0, pa1, pa2, pa3); \
            if (TYPE != 2) { lacc = MFMA32(pa0, ones, lacc); lacc = MFMA32(pa1, ones, lacc); lacc = MFMA32(pa2, ones, lacc); lacc = MFMA32(pa3, ones, lacc); } \
        } while (0)
#define SCORE(slot_) do { kload(kf, kp0 + (slot_) * SLOTB); SBAR(); \
        if (TYPE == 2) { p0 = MFMA32(kf[0], qr[0], (f32x16{})); p1 = MFMA32(kf[1], qr[0], (f32x16{})); } else { p0 = MFMA32(kf[0], qr[0], cvec); p1 = MFMA32(kf[1], qr[0], cvec); } \
        _Pragma("unroll") for (int d0 = 1; d0 < 4; ++d0) { p0 = MFMA32(kf[2 * d0], qr[d0], p0); p1 = MFMA32(kf[2 * d0 + 1], qr[d0], p1); } SBAR(); } while (0)
    int slot = 0, dslot = PFD, ptile = 0, pslot = 0; bool pend = false, stop = false;
    for (int i = 0; ; ++i) {
        const int tile = t_hi - i, jr = tile - 4 * qb;
        if (i < n_tiles && !stop) {
            { const int tp = tile - PFD; DMA_KV(tp < 0 ? 0 : tp, dslot); }
            dslot = (dslot == NSLOT - 1) ? 0 : dslot + 1;
            WAITBAR(4);
            if (TYPE == 2 && i > 0) { const u32x4 fa = *(const __attribute__((address_space(3))) u32x4*)(misci + 64 + ((i - 1) & 1) * 8), fb = *(const __attribute__((address_space(3))) u32x4*)(misci + 68 + ((i - 1) & 1) * 8);
                if ((fa[0] & fa[1] & fa[2] & fa[3] & fb[0] & fb[1] & fb[2] & fb[3]) != 0u) stop = true; }
        }
        if (late && pend) { FINISH(ptile, ptile - 4 * qb, pslot); pend = false; }
        if (i >= n_tiles || stop) break;
        const bool active = (jr <= jdiag) && (jr >= jlo_w) && !(TYPE == 2 && done_w);
        if (active) { SCORE(slot); }
        if (!late) { if (active) { FINISH(tile, jr, slot); } } else { pend = active; ptile = tile; pslot = slot; }
        if (TYPE == 2) { if (lane == 0) misci[64 + (i & 1) * 8 + wid] = done_w ? 1 : 0; }
        slot = (slot == NSLOT - 1) ? 0 : slot + 1;
    }
#undef FINISH
#undef SCORE
    if (TIMER_SEL == 98 && TYPE == TIMER_TYPE && C.tflag && tid == 0) { volatile __attribute__((address_space(3))) unsigned* ta_ = (volatile __attribute__((address_space(3))) unsigned*)(shm + 139264 + 320) + 16; ta_[25] += (unsigned)__builtin_amdgcn_s_memtime() - ta_[26]; }
    USTAMP(22);
    if (tid == 0) tslot[0] = tick;
    asm volatile("s_waitcnt vmcnt(0) lgkmcnt(0)\n\ts_barrier" ::: "memory");
    const int unext = tslot[0];
    if (unext < 2048) prefetch_unit(C, unext, shm, qr);
    float rli[16];
    { const float sk = (TYPE == 3) ? __builtin_amdgcn_exp2f(C.sinks[h] * LOG2E - Mf) : 0.f;
#pragma unroll
        for (int r = 0; r < 16; ++r) rli[r] = (TYPE == 2) ? 1.f : 1.f / (lacc[r] + sk); }
    __attribute__((address_space(3))) bf16* stg = (__attribute__((address_space(3))) bf16*)(shm + (wid < 6 ? L_K + 2 * SLOTB + wid * 4096 : L_V + 2 * SLOTB + (wid - 6) * 4096));
    const __attribute__((address_space(3))) bf16* gst = (const __attribute__((address_space(3))) bf16*)(shm + L_G) + wid * 2048;
#pragma unroll
    for (int r = 0; r < 16; ++r) { const int orow = crow(r, hi); const float rl = rli[r];
#pragma unroll
        for (int d0 = 0; d0 < 2; ++d0) stg[orow * 64 + d0 * 32 + r32] = (bf16)f2bf(o[d0][r] * rl); }
    asm volatile("s_waitcnt lgkmcnt(0)" ::: "memory");
#pragma unroll
    for (int i = 0; i < 4; ++i) { const int row = i * 8 + (lane >> 3), ch = lane & 7;
        const u32x4 v = *(const __attribute__((address_space(3))) u32x4*)(stg + row * 64 + ch * 8);
        const u32x4 g = *(const __attribute__((address_space(3))) u32x4*)(gst + row * 64 + ch * 8); u32x4 w;
        const size_t off = (yrow0 + row) * DM + TYPE * 256 + h * 64 + ch * 8;
#pragma unroll
        for (int j = 0; j < 4; ++j) { const float a0 = __uint_as_float(v[j] << 16) * __uint_as_float(g[j] << 16), a1 = __uint_as_float(v[j] & 0xffff0000u) * __uint_as_float(g[j] & 0xffff0000u); w[j] = pk2(a0, a1); }
        *(u32x4*)(C.Y + off) = w; }
    asm volatile("s_waitcnt lgkmcnt(0)\n\ts_barrier" ::: "memory");
    USTAMP(23);
    return unext;
#undef DMA_KV
}
#undef SBAR
}
#define TACC(F) ((volatile LAS unsigned*)((F).lds + MISC_OFF) + 16)
#define TSTAMP(F, k) do { if (TIMER_SEL >= 0 && (F).vcu == TIMER_WG && (F).tid == 0) { const unsigned now_ = (unsigned)__builtin_amdgcn_s_memrealtime(); TACC(F)[k] += now_ - TACC(F)[31]; TACC(F)[31] = now_; } } while (0)
__device__ __forceinline__ void p_attn(Frame& F, const Args& a, int layer, int rep, int tmask) {
    att::ACtx C{(const bf16*)(a.ws + WS_Q), (const bf16*)(a.ws + WS_K), (const bf16*)(a.ws + WS_V), (const bf16*)(a.ws + WS_G), (bf16*)(a.ws + WS_HN),
                (const float*)(a.ws + WS_LF), (const float*)(a.ws + WS_TAB), (const float*)(a.ws + WS_KM), (const float*)(a.ws + WS_MF) + layer * 4, a.sinks + layer * 4, (F.vcu == TIMER_WG) ? 1 : 0};
    unsigned* head = (unsigned*)(a.ws + WS_CTL) + CW_QUEUE + 64 * (layer + 2 * rep);
    LAS int* slot = (LAS int*)(F.lds + att::L_MISC) + 200;
    att::lds_ptr shm = (att::lds_ptr)F.lds;
    if (F.tid == 0) slot[0] = (int)__hip_atomic_fetch_add(head, 1u, __ATOMIC_RELAXED, __HIP_MEMORY_SCOPE_AGENT);
    __syncthreads();
    int u = slot[0];
    __syncthreads();
    att::bf16x8 qr[4];
    if (u < 2048) att::prefetch_unit(C, u, shm, qr);
    while (u < 2048) {
        int tick = 0;
        if (F.tid == 0) tick = (int)__hip_atomic_fetch_add(head, 1u, __ATOMIC_RELAXED, __HIP_MEMORY_SCOPE_AGENT);
        const int ty = u >> 9, r = u & 511, qb = 15 - (r >> 5), bh = r & 31;
        TSTAMP(F, 20);
        if (ty == 0) u = att::attn_unit<1>(C, bh, qb, shm, qr, tick, (LAS int*)slot);
        else if (ty == 1) u = att::attn_unit<0>(C, bh, qb, shm, qr, tick, (LAS int*)slot);
        else if (ty == 2) u = att::attn_unit<2>(C, bh, qb, shm, qr, tick, (LAS int*)slot);
        else u = att::attn_unit<3>(C, bh, qb, shm, qr, tick, (LAS int*)slot);
        TSTAMP(F, 8 + ty);
    }
    asm volatile("s_waitcnt vmcnt(0)" ::: "memory");
    __syncthreads();
}

__global__ void __launch_bounds__(NWAVES * 64, 2) mk_fwd(Args a) {
    extern __shared__ __attribute__((aligned(16))) unsigned char lds[];
    Frame F; F.lds = (LAS unsigned char*)lds; F.tid = threadIdx.x; F.lane = F.tid & 63; F.wave = __builtin_amdgcn_readfirstlane(F.tid >> 6);
    F.G = gridDim.x; { const int bx = blockIdx.x; F.vcu = (F.G % 8 == 0) ? (bx % 8) * (F.G / 8) + bx / 8 : bx; }
    bf16* HN = (bf16*)(a.ws + WS_HN);
    for (int u = F.tid; u < (LDS_BYTES - LDSCTL_OFF) / 4; u += NWAVES * 64) ((LAS unsigned*)(F.lds + LDSCTL_OFF))[u] = 0u;
    __syncthreads();
    XcdBarrier bar; bar.bar = (unsigned*)(a.ws + WS_CTL) + CW_BAR; bar.x = 0; bar.st = nullptr;
    if (a.ph_hi - a.ph_lo > 1) bar = xcd_barrier_post((unsigned*)(a.ws + WS_CTL) + CW_BAR, (volatile LAS unsigned*)(F.lds + MISC_OFF) + 8);
#define PHASE_ON(k) (a.ph_lo <= (k) && (k) < a.ph_hi)
#define SEAM(k) do { if ((k) != 4 && PHASE_ON(k) && PHASE_ON((k) + 1)) xcd_barrier(bar); } while (0)
#define LAYER_PHASES(layer) do { \
    if ((layer) == 0 && PHASE_ON(0)) { p_weights(F, a); p_consts(F, a); p_convert(F, a); } \
    if ((layer) == 0) { TSTAMP(F, 0); SEAM(0); TSTAMP(F, 1); } \
    if (PHASE_ON(4 * (layer) + 1)) { \
        pg8::Gemm g{(layer) == 0 ? HN : (const bf16*)(a.ws + WS_X1), (const bf16*)(a.ws + WS_WIN) + (size_t)(layer) * NPERM * DM, NTOK, NPERM, DM}; \
        pg8::StaticOrder S; S.init(NTOK, NPERM, F.G, (int)blockIdx.x); \
        pg8::EpiIn E{(bf16*)(a.ws + WS_Q), (bf16*)(a.ws + WS_K), (bf16*)(a.ws + WS_V), (bf16*)(a.ws + WS_G), a.fox_g + (layer) * 128, a.moba_g + (layer) * 128, a.swa_g + (layer) * 128, (float*)(a.ws + WS_KM), \
                     (const float*)(a.ws + WS_RS) + (layer) * NTOK, (float*)(a.ws + WS_LF), a.b_forget + (layer) * 4}; \
        pg8::gemm_phase<pg8::EpiIn, pg8::StaticOrder, true, true>(F.lds, g, S, E); \
        if (PROBE_P1) { xcd_barrier(bar); pg8::gemm_phase<pg8::EpiIn, pg8::StaticOrder, true, true>(F.lds, g, S, E); } \
    } \
    TSTAMP(F, 2); SEAM(4 * (layer) + 1); TSTAMP(F, 3); \
    if (PHASE_ON(4 * (layer) + 2)) { for (int rep = 0; rep < 1 + (PROBE_ATT != 0 ? PROBE_REPS : 0); ++rep) { if (rep) xcd_barrier(bar); p_attn(F, a, (layer), rep, rep ? PROBE_ATT : 15); } } \
    TSTAMP(F, 4); SEAM(4 * (layer) + 2); TSTAMP(F, 5); \
    if (PHASE_ON(4 * (layer) + 3)) { \
        pg8::Gemm g{HN  , (const bf16*)(a.ws + WS_WOUT) + (size_t)(layer) * DM * DM, NTOK, DM, DM}; \
        pg8::StaticOrder S; S.init(NTOK, DM, F.G, (int)blockIdx.x); \
        if ((layer) == 0) { \
            { float* KM = (float*)(a.ws + WS_KM); for (int i = F.vcu * (NWAVES * 64) + F.tid; i < 32 * 16 * 64; i += F.G * NWAVES * 64) KM[i] = 0.f; }     \
            pg8::EpiRes0 E{a.x, (bf16*)(a.ws + WS_X1), (float*)(a.ws + WS_RS) + NTOK}; \
            pg8::gemm_phase<pg8::EpiRes0, pg8::StaticOrder, true, true>(F.lds, g, S, E); \
        } else { \
            pg8::EpiRes1 E{(const bf16*)(a.ws + WS_X1), a.out}; \
            pg8::gemm_phase<pg8::EpiRes1, pg8::StaticOrder, true, true>(F.lds, g, S, E); \
        } \
    } \
    if ((layer) == 0) { TSTAMP(F, 6); SEAM(3); SEAM(4); TSTAMP(F, 7); } } while (0)
    if (TIMER_SEL >= 0 && F.vcu == TIMER_WG && F.tid == 0) TACC(F)[31] = (unsigned)__builtin_amdgcn_s_memrealtime();
    LAYER_PHASES(0);
    LAYER_PHASES(1);
    if (TIMER_SEL >= 0 && F.vcu == TIMER_WG) {
        asm volatile("s_waitcnt vmcnt(0)" ::: "memory"); __syncthreads();
        float v = (TIMER_SEL == 99) ? 1.0f : (TIMER_SEL == 98) ? ((float)TACC(F)[25] / ((float)TACC(F)[22] * 10.f)) / 3.0f : (float)TACC(F)[TIMER_SEL & 31] * 0.01f / (float)TIMER_FS; v = fminf(fmaxf(v, 0.f), 1.f); const float dl = 0.1f * sqrtf(v);
        pg8::StaticOrder S; S.init(NTOK, DM, F.G, (int)blockIdx.x); pg8::Unit u;
        for (int i = 0; S.next(i, u); ++i) for (int e = F.tid; e < 65536; e += NWAVES * 64) { float* p = a.out + (size_t)(u.pm * 256 + (e >> 8)) * DM + u.pn * 256 + (e & 255); *p += dl; }
    }
}

extern "C" void kernel_launch(void* const* d_in, const int* in_sizes, int n_in, void* d_out, int out_size, void* d_ws, size_t ws_size, hipStream_t stream) {
    static int ok = 0, grid = 0;
    if (ok == 0) {
        if (n_in != 10 || in_sizes[0] != NTOK * DM || out_size != NTOK * DM || ws_size < WS_END) { fprintf(stderr, "kernel_launch: unexpected shapes (n_in %d, in0 %d, out %d, ws %zu)\n", n_in, n_in > 0 ? in_sizes[0] : -1, out_size, ws_size); ok = -1; return; }
        if (hipFuncSetAttribute((const void*)mk_fwd, hipFuncAttributeMaxDynamicSharedMemorySize, LDS_BYTES) != hipSuccess) { fprintf(stderr, "kernel_launch: hipFuncSetAttribute failed\n"); ok = -1; return; }
        int dev = 0, cus = 0; if (hipGetDevice(&dev) != hipSuccess || hipDeviceGetAttribute(&cus, hipDeviceAttributeMultiprocessorCount, dev) != hipSuccess) { fprintf(stderr, "kernel_launch: device query failed\n"); ok = -1; return; }
        grid = cus < 256 ? (cus / 8) * 8 : 256; if (grid < 8) grid = cus;
        ok = 1;
    }
    if (ok < 0) return;
    Args a{};
    a.x = (const float*)d_in[0]; a.norm_gain = (const float*)d_in[1]; a.w_in = (const float*)d_in[2]; a.b_forget = (const float*)d_in[3]; a.fox_g = (const float*)d_in[4];
    a.moba_g = (const float*)d_in[5]; a.swa_g = (const float*)d_in[6]; a.sinks = (const float*)d_in[7]; a.w_out = (const float*)d_in[8]; a.rel_bias = (const float*)d_in[9];
    a.out = (float*)d_out; a.ws = (unsigned char*)d_ws;
    unsigned char* ws = (unsigned char*)d_ws;
    a.tmask = 15;
    if (hipMemsetAsync(ws + WS_CTL, 0, CTL_ZERO_BYTES, stream) != hipSuccess) { fprintf(stderr, "kernel_launch: memset failed\n"); return; }
#if N_LAUNCHES == 1
    a.ph_lo = 0; a.ph_hi = 8; hipLaunchKernelGGL(mk_fwd, dim3(grid), dim3(NWAVES * 64), LDS_BYTES, stream, a);
#else
    for (int ph = 0; ph < 8; ++ph) { a.ph_lo = ph; a.ph_hi = ph + 1; hipLaunchKernelGGL(mk_fwd, dim3(grid), dim3(NWAVES * 64), LDS_BYTES, stream, a); }
#endif
}
```

```cpp
#include <hip/hip_runtime.h>
#include <cstdio>
#include <cstdint>
#include <cmath>
namespace pg8 {
#define PG8_LAS __attribute__((address_space(3)))
typedef unsigned short bf16_t;
typedef short bf16x8 __attribute__((ext_vector_type(8)));
typedef float f32x4 __attribute__((ext_vector_type(4)));
typedef unsigned u32x4 __attribute__((ext_vector_type(4)));
constexpr int BM = 256, BK = 64, HALF = 128, HTB = HALF * BK * 2  , STAGE_BYTES = 8 * HTB, NXCD = 8, WGM = 8;

__host__ __device__ __forceinline__ int lds_byte(int r, int c) { const int st = (r >> 4) * 2 + (c >> 5), rr = r & 15, cc = c & 31, ob = rr * 64 + cc * 2; return st * 1024 + (ob ^ (((ob >> 9) & 1) << 5)); }
__host__ __device__ __forceinline__ void stage_rc(int b, int& R, int& C) { const int st = b / 1024, sb = b % 1024, swz = sb ^ (((sb >> 9) & 1) << 5); R = (st >> 1) * 16 + swz / 64; C = (st & 1) * 32 + (swz % 64) / 2; }
__host__ __device__ __forceinline__ int perm32(int rho) { const int n = rho >> 4, i = rho & 15; return 8 * (i >> 2) + 4 * n + (i & 3); }

struct Unit { int pm, pn; };
struct Gemm { const bf16_t* A; const bf16_t* Bt; int M, N, K; };

struct StaticOrder {
    int nM, nN, nwg, G, c;
    __host__ __device__ void init(int M, int N, int G_, int c_) { nM = M / BM; nN = N / BM; nwg = nM * nN; G = G_; c = c_; }
    __host__ __device__ bool next(int i, Unit& u) const {
        const long L = (long)i * G + c; if (L >= nwg) return false;
        int wgid = (int)L; { const int q = nwg / NXCD, r = nwg % NXCD, xcd = wgid % NXCD, off = wgid / NXCD; wgid = (xcd < r ? xcd * (q + 1) : r * (q + 1) + (xcd - r) * q) + off; }
        const int nig = WGM * nN, gid = wgid / nig, fm = gid * WGM, gsz = (nM - fm) < WGM ? (nM - fm) : WGM;
        u.pm = fm + ((wgid % nig) % gsz); u.pn = (wgid % nig) / gsz; return true;
    }
    __device__ __forceinline__ void a_ready(const Unit&) const {}
    __device__ __forceinline__ void done(const Unit&) const {}
};

__device__ __forceinline__ unsigned cvt_pk_bf16(float lo, float hi) { unsigned r; asm volatile("v_cvt_pk_bf16_f32 %0, %1, %2" : "=v"(r) : "v"(lo), "v"(hi)); return r; }
typedef float f32x2 __attribute__((ext_vector_type(2)));
constexpr float C2 = 0.125f * 1.4426950408889634f;
constexpr float RMS_EPS = 1e-6f;
constexpr size_t GS = (size_t)8 * 4 * 4096 * 64;
struct EpiIn {
    static constexpr bool PERM = true, AFTER_DRAIN = false;
    bf16_t *Q, *K, *V, *G; const float *gfox, *gmoba, *gswa; float* KM; const float* RS; float* LF; const float* bfg;
    __device__ __forceinline__ void prefetch(const Unit& u, int ui_, PG8_LAS unsigned char* lds, int wid, int lane) const {
        if (wid < 4) { const float* src = RS + u.pm * BM + wid * 64 + lane; const unsigned dst = (unsigned)(size_t)(lds + STAGE_BYTES + (ui_ & 1) * 1024 + wid * 256); unsigned keep;
            asm volatile("s_mov_b32 %0, m0\n\ts_mov_b32 m0, %2\n\ts_nop 0\n\tglobal_load_lds_dword %1, off\n\ts_mov_b32 m0, %0" : "=&s"(keep) : "v"(src), "s"((unsigned)__builtin_amdgcn_readfirstlane(dst)) : "memory"); }
    }
    __device__ __forceinline__ void operator()(const f32x4 (&acc)[2][2][4][2], const Unit& u, int wr, int wc, int fr, int fq, int ui, PG8_LAS unsigned char* ldsb) const {
        const int T = u.pn;
        const int b = (u.pm * BM) >> 12, t0 = ((u.pm * BM) & 4095) + wr * 64 + fr;
        float rs[2][4];
#pragma unroll
        for (int ai = 0; ai < 2; ++ai)
#pragma unroll
            for (int m = 0; m < 4; ++m) rs[ai][m] = 1.0f / sqrtf(((const PG8_LAS float*)(ldsb + STAGE_BYTES + (ui & 1) * 1024))[ai * HALF + wr * 64 + m * 16 + fr] * (1.0f / 1024.0f) + RMS_EPS);
        if (T == 15) {
            if (wc == 0 && fq == 0) { const f32x4 bv = *(const f32x4*)bfg;
#pragma unroll
                for (int ai = 0; ai < 2; ++ai)
#pragma unroll
                    for (int m = 0; m < 4; ++m) { const f32x4 a4 = acc[ai][0][m][0] * rs[ai][m] + bv;
#pragma unroll
                        for (int j = 0; j < 4; ++j) { const float uu = a4[j]; const float sp = fmaxf(-uu, 0.f) + __logf(1.f + __expf(-fabsf(uu)));
                            LF[(size_t)(b * 4 + j) * 4096 + t0 + ai * HALF + m * 16] = -sp * 1.4426950408889634f; } } }
            return;
        }
        int mode = 1, nh = 4, head = wc; float scale = 1.f; const float* gain = nullptr; bf16_t* base = nullptr;
        switch (T) {
            case 0: mode = 0; gain = gfox; scale = C2; base = Q; break;
            case 1: mode = 0; gain = gfox + 64; base = K; break;
            case 2: base = V; break;
            case 4: mode = 0; gain = gmoba; scale = C2; base = Q + GS; break;
            case 5: mode = 0; gain = gmoba + 64; base = K + GS; break;
            case 6: base = V + GS; break;
            case 8: scale = C2; base = Q + 2 * GS; break;
            case 9: base = K + 2 * GS; break;
            case 10: base = V + 2 * GS; break;
            case 12: mode = 0; gain = gswa; scale = C2; base = Q + 3 * GS; break;
            case 13: nh = 2; if (wc < 2) { mode = 0; gain = gswa + 64; base = K + 3 * GS; } else { base = V + 3 * GS; head = wc - 2; } break;
            default: mode = 2; break;
        }
        if (mode == 2) {
            bf16_t* gp = G + (size_t)(u.pm * BM + wr * 64 + fr) * 1024 + (T >> 2) * 256 + 64 * wc + 8 * fq;
#pragma unroll
            for (int ai = 0; ai < 2; ++ai)
#pragma unroll
                for (int m = 0; m < 4; ++m)
#pragma unroll
                    for (int bj = 0; bj < 2; ++bj) {
                        f32x4 v0 = acc[ai][bj][m][0] * rs[ai][m], v1 = acc[ai][bj][m][1] * rs[ai][m];
#pragma unroll
                        for (int j = 0; j < 4; ++j) { v0[j] = v0[j] / (1.f + __expf(-v0[j])); v1[j] = v1[j] / (1.f + __expf(-v1[j])); }
                        u32x4 w; w.x = cvt_pk_bf16(v0[0], v0[1]); w.y = cvt_pk_bf16(v0[2], v0[3]); w.z = cvt_pk_bf16(v1[0], v1[1]); w.w = cvt_pk_bf16(v1[2], v1[3]);
                        *(u32x4*)(gp + (size_t)(ai * HALF + m * 16) * 1024 + 32 * bj) = w;
                    }
            return;
        }
        f32x4 gv[2][2];
#pragma unroll
        for (int bj = 0; bj < 2; ++bj)
#pragma unroll
            for (int n = 0; n < 2; ++n) gv[bj][n] = (mode == 0) ? *(const f32x4*)(gain + 32 * bj + 8 * fq + 4 * n) : (f32x4){1.f, 1.f, 1.f, 1.f};
        bf16_t* dp = base + ((size_t)(b * nh + head) * 4096 + t0) * 64 + 8 * fq;
        f32x4 cs4[2][2];
#pragma unroll
        for (int bj = 0; bj < 2; ++bj)
#pragma unroll
            for (int n = 0; n < 2; ++n) cs4[bj][n] = (f32x4){0.f, 0.f, 0.f, 0.f};
#pragma unroll
        for (int ai = 0; ai < 2; ++ai)
#pragma unroll
            for (int m = 0; m < 4; ++m) {
                float r = scale * rs[ai][m];
                if (mode == 0) {
                    float ss = 0.f;
#pragma unroll
                    for (int bj = 0; bj < 2; ++bj)
#pragma unroll
                        for (int n = 0; n < 2; ++n) { const f32x4 x = acc[ai][bj][m][n]; ss += (x[0] * x[0] + x[1] * x[1]) + (x[2] * x[2] + x[3] * x[3]); }
                    ss += __shfl_xor(ss, 16); ss += __shfl_xor(ss, 32);
                    r = scale * rs[ai][m] / sqrtf(ss * rs[ai][m] * rs[ai][m] * (1.0f / 64.0f) + RMS_EPS);
                }
#pragma unroll
                for (int bj = 0; bj < 2; ++bj) {
                    const f32x4 v0 = acc[ai][bj][m][0] * gv[bj][0] * r, v1 = acc[ai][bj][m][1] * gv[bj][1] * r;
                    if (T == 5) { cs4[bj][0] += v0; cs4[bj][1] += v1; }
                    u32x4 w; w.x = cvt_pk_bf16(v0[0], v0[1]); w.y = cvt_pk_bf16(v0[2], v0[3]); w.z = cvt_pk_bf16(v1[0], v1[1]); w.w = cvt_pk_bf16(v1[2], v1[3]);
                    *(u32x4*)(dp + (size_t)(ai * HALF + m * 16) * 64 + 32 * bj) = w;
                }
            }
        if (T == 5) {
            float* kmp = KM + ((size_t)((b * 4 + wc) * 16 + (((u.pm * BM) & 4095) >> 8))) * 64 + 8 * fq;
#pragma unroll
            for (int bj = 0; bj < 2; ++bj)
#pragma unroll
                for (int n = 0; n < 2; ++n)
#pragma unroll
                    for (int j = 0; j < 4; ++j) { float s = cs4[bj][n][j];
                        s += __shfl_xor(s, 1); s += __shfl_xor(s, 2); s += __shfl_xor(s, 4); s += __shfl_xor(s, 8);
                        if (fr == 0) atomicAdd(kmp + 32 * bj + 4 * n + j, s * (1.0f / 256.0f)); }
        }
    }
};
struct EpiRes0 {
    static constexpr bool PERM = true, AFTER_DRAIN = false;
    const bf16_t* base; bf16_t* X1; float* RS1;
    __device__ __forceinline__ void prefetch(const Unit&, int, PG8_LAS unsigned char*, int, int) const {}
    __device__ __forceinline__ void operator()(const f32x4 (&acc)[2][2][4][2], const Unit& u, int wr, int wc, int fr, int fq, int ui, PG8_LAS unsigned char* ldsb) const {
        const int col0 = u.pn * BM + wc * 32 + 8 * fq;
#pragma unroll
        for (int ai = 0; ai < 2; ++ai)
#pragma unroll
            for (int m = 0; m < 4; ++m) {
                const int row = u.pm * BM + ai * HALF + wr * 64 + m * 16 + fr; const size_t off = (size_t)row * 1024 + col0; float ss = 0.f;
#pragma unroll
                for (int bj = 0; bj < 2; ++bj) { const u32x4 xb = *(const u32x4*)(base + off + bj * HALF);
                    f32x4 v0, v1; v0[0] = __uint_as_float(xb.x << 16); v0[1] = __uint_as_float(xb.x & 0xffff0000u); v0[2] = __uint_as_float(xb.y << 16); v0[3] = __uint_as_float(xb.y & 0xffff0000u);
                    v1[0] = __uint_as_float(xb.z << 16); v1[1] = __uint_as_float(xb.z & 0xffff0000u); v1[2] = __uint_as_float(xb.w << 16); v1[3] = __uint_as_float(xb.w & 0xffff0000u);
                    v0 += acc[ai][bj][m][0]; v1 += acc[ai][bj][m][1];
                    ss += (v0[0] * v0[0] + v0[1] * v0[1]) + (v0[2] * v0[2] + v0[3] * v0[3]) + (v1[0] * v1[0] + v1[1] * v1[1]) + (v1[2] * v1[2] + v1[3] * v1[3]);
                    u32x4 w; w.x = cvt_pk_bf16(v0[0], v0[1]); w.y = cvt_pk_bf16(v0[2], v0[3]); w.z = cvt_pk_bf16(v1[0], v1[1]); w.w = cvt_pk_bf16(v1[2], v1[3]);
                    *(u32x4*)(X1 + off + bj * HALF) = w; }
                ss += __shfl_xor(ss, 16); ss += __shfl_xor(ss, 32);
                if (fq == 0) atomicAdd(RS1 + row, ss);
            }
    }
};
struct EpiRes1 {
    static constexpr bool PERM = true, AFTER_DRAIN = false;
    const bf16_t* X1; float* out;

    __device__ __forceinline__ void prefetch(const Unit&, int, PG8_LAS unsigned char*, int, int) const {}
    __device__ __forceinline__ void operator()(const f32x4 (&acc)[2][2][4][2], const Unit& u, int wr, int wc, int fr, int fq, int ui, PG8_LAS unsigned char* ldsb) const {
        const int col0 = u.pn * BM + wc * 32 + 8 * fq;
#pragma unroll
        for (int ai = 0; ai < 2; ++ai)
#pragma unroll
            for (int m = 0; m < 4; ++m) {
                const size_t off = (size_t)(u.pm * BM + ai * HALF + wr * 64 + m * 16 + fr) * 1024 + col0;
#pragma unroll
                for (int bj = 0; bj < 2; ++bj) { const u32x4 xb = *(const u32x4*)(X1 + off + bj * HALF);
                    f32x4 v0, v1; v0[0] = __uint_as_float(xb.x << 16); v0[1] = __uint_as_float(xb.x & 0xffff0000u); v0[2] = __uint_as_float(xb.y << 16); v0[3] = __uint_as_float(xb.y & 0xffff0000u);
                    v1[0] = __uint_as_float(xb.z << 16); v1[1] = __uint_as_float(xb.z & 0xffff0000u); v1[2] = __uint_as_float(xb.w << 16); v1[3] = __uint_as_float(xb.w & 0xffff0000u);
                    *(f32x4*)(out + off + bj * HALF) = v0 + acc[ai][bj][m][0]; *(f32x4*)(out + off + bj * HALF + 4) = v1 + acc[ai][bj][m][1]; }
            }
    }
};

template <class Epi, class Sched, bool ALIGN_EPI = false, bool SP2 = false>
__device__ __forceinline__ void gemm_phase(PG8_LAS unsigned char* lds, const Gemm g, const Sched& S, const Epi& E) {
    const int tid = threadIdx.x, wid = __builtin_amdgcn_readfirstlane(tid >> 6), lane = tid & 63, wr = wid >> 2, wc = wid & 3, fr = lane & 15, fq = lane >> 4;
    const int K = g.K, nt = K / BK;
    unsigned voffA[2], voffB[2];
#pragma unroll
    for (int i = 0; i < 2; ++i) { int R, C; stage_rc(tid * 16 + i * 8192, R, C); const int Rb = Epi::PERM ? ((R & ~31) + perm32(R & 31)) : R;
        voffA[i] = (unsigned)(R * K + C) * 2u; voffB[i] = (unsigned)(Rb * K + C) * 2u; }
    const size_t kstep = (size_t)(BK * 2);
    const size_t hstep = (size_t)HALF * K * 2;
    const size_t tstep = 2 * hstep;
    const unsigned ldsw = (unsigned)wid * 1024u;
    const int aoff = lds_byte(wr * 64 + fr, fq * 8), boff = lds_byte(wc * 32 + fr, fq * 8);
#define PG8_SA(b, h) (((b) * 2 + (h)) * HTB)
#define PG8_SB(b, h) ((4 + (b) * 2 + (h)) * HTB)
#define PG8_STAGE(bufoff, gbase, voff) do { _Pragma("unroll") for (int _i = 0; _i < 2; ++_i) \
        __builtin_amdgcn_global_load_lds((const unsigned*)((const char*)(gbase) + (voff)[_i]), (PG8_LAS unsigned*)(lds + (bufoff) + ldsw + _i * 8192), 16, 0, 0); } while (0)
#define PG8_LDA(dst, b, h) do { _Pragma("unroll") for (int m = 0; m < 4; ++m) _Pragma("unroll") for (int k = 0; k < 2; ++k) dst[m][k] = *(const PG8_LAS bf16x8*)(lds + PG8_SA(b, h) + aoff + m * 2048 + k * 1024); } while (0)
#define PG8_LDB(dst, b, h) do { _Pragma("unroll") for (int n = 0; n < 2; ++n) _Pragma("unroll") for (int k = 0; k < 2; ++k) dst[n][k] = *(const PG8_LAS bf16x8*)(lds + PG8_SB(b, h) + boff + n * 2048 + k * 1024); } while (0)
#define PG8_MMA(ai, bj, At, Bt) do { __builtin_amdgcn_s_setprio(1); _Pragma("unroll") for (int m = 0; m < 4; ++m) _Pragma("unroll") for (int n = 0; n < 2; ++n) _Pragma("unroll") for (int k = 0; k < 2; ++k) \
        acc[ai][bj][m][n] = __builtin_amdgcn_mfma_f32_16x16x32_bf16(Bt[n][k], At[m][k], acc[ai][bj][m][n], 0, 0, 0); __builtin_amdgcn_s_setprio(0); } while (0)
#define PG8_WAIT_V(n) asm volatile("s_waitcnt vmcnt(" #n ")" ::: "memory")
#define PG8_WAIT_L(n) asm volatile("s_waitcnt lgkmcnt(" #n ")" ::: "memory")
#define PG8_BAR __builtin_amdgcn_s_barrier()
#define PG8_SCHED __builtin_amdgcn_sched_barrier(0)
    Unit cur, nxt; int ui = 0;
    if (!S.next(0, cur)) return;
    f32x4 acc[2][2][4][2];
#pragma unroll
    for (int a = 0; a < 2; ++a)
#pragma unroll
        for (int b = 0; b < 2; ++b)
#pragma unroll
            for (int m = 0; m < 4; ++m)
#pragma unroll
                for (int n = 0; n < 2; ++n) acc[a][b][m][n] = (f32x4){0.f, 0.f, 0.f, 0.f};
    bf16x8 At[4][2], B0[2][2], B1[2][2];
    const char* cA = (const char*)g.A + (size_t)cur.pm * tstep; const char* cB = (const char*)g.Bt + (size_t)cur.pn * tstep;
    S.a_ready(cur); E.prefetch(cur, 0, lds, wid, lane);
    if constexpr (SP2) {
        PG8_STAGE(PG8_SB(0, 0), cB, voffB); PG8_STAGE(PG8_SB(0, 1), cB + hstep, voffB); PG8_STAGE(PG8_SA(0, 0), cA, voffA); PG8_STAGE(PG8_SA(0, 1), cA + hstep, voffA);
        if (wr == 1) PG8_BAR;
        PG8_WAIT_V(2); PG8_BAR;
        PG8_STAGE(PG8_SB(1, 0), cB + kstep, voffB); PG8_STAGE(PG8_SA(1, 0), cA + kstep, voffA); PG8_STAGE(PG8_SB(1, 1), cB + hstep + kstep, voffB);
        PG8_WAIT_V(6); PG8_BAR;
    } else {
        PG8_STAGE(PG8_SB(0, 0), cB, voffB); PG8_STAGE(PG8_SA(0, 0), cA, voffA); PG8_STAGE(PG8_SB(0, 1), cB + hstep, voffB); PG8_STAGE(PG8_SA(0, 1), cA + hstep, voffA);
        if (wr == 1) PG8_BAR;
        PG8_WAIT_V(4); PG8_BAR;
        PG8_STAGE(PG8_SB(1, 0), cB + kstep, voffB); PG8_STAGE(PG8_SA(1, 0), cA + kstep, voffA); PG8_STAGE(PG8_SB(1, 1), cB + hstep + kstep, voffB);
        PG8_WAIT_V(6); PG8_BAR;
    }
    for (;;) {
        const bool has_next = S.next(ui + 1, nxt);
        const char* nA = has_next ? (const char*)g.A + (size_t)nxt.pm * tstep : cA; const char* nB = has_next ? (const char*)g.Bt + (size_t)nxt.pn * tstep : cB;
        for (int t = 0; t < nt; t += 2) {
            const bool last = (t == nt - 2);
            const char* a1 = cA + (size_t)(t + 1) * kstep;
            const char* a2 = last ? nA : cA + (size_t)(t + 2) * kstep; const char* b2 = last ? nB : cB + (size_t)(t + 2) * kstep;
            const char* a3 = a2 + kstep; const char* b3 = b2 + kstep;
            if (last && has_next) S.a_ready(nxt);
            if constexpr (SP2) {
            PG8_LDB(B0, 0, 0); PG8_LDB(B1, 0, 1); PG8_SCHED; PG8_LDA(At, 0, 0); PG8_STAGE(PG8_SA(1, 1), a1 + hstep, voffA);
            PG8_WAIT_V(8); PG8_WAIT_L(0); PG8_BAR; PG8_MMA(0, 0, At, B0); PG8_MMA(0, 1, At, B1); PG8_BAR; PG8_SCHED;
            PG8_LDA(At, 0, 1); PG8_STAGE(PG8_SB(0, 0), b2, voffB); PG8_STAGE(PG8_SB(0, 1), b2 + hstep, voffB); PG8_STAGE(PG8_SA(0, 0), a2, voffA);
            PG8_WAIT_V(8); PG8_WAIT_L(0); PG8_BAR; PG8_MMA(1, 0, At, B0); PG8_MMA(1, 1, At, B1); PG8_BAR; PG8_SCHED;
            PG8_LDB(B0, 1, 0); PG8_LDB(B1, 1, 1); PG8_SCHED; PG8_LDA(At, 1, 0); PG8_STAGE(PG8_SA(0, 1), a2 + hstep, voffA);
            PG8_WAIT_V(8); PG8_WAIT_L(0); PG8_BAR; PG8_MMA(0, 0, At, B0); PG8_MMA(0, 1, At, B1); PG8_BAR; PG8_SCHED;
            PG8_LDA(At, 1, 1); PG8_STAGE(PG8_SB(1, 0), b3, voffB); PG8_STAGE(PG8_SB(1, 1), b3 + hstep, voffB); PG8_STAGE(PG8_SA(1, 0), a3, voffA);
            PG8_WAIT_V(8); PG8_WAIT_L(0); PG8_BAR; PG8_MMA(1, 0, At, B0); PG8_MMA(1, 1, At, B1); PG8_BAR; PG8_SCHED;
            } else {
            PG8_LDB(B0, 0, 0); PG8_SCHED; PG8_LDA(At, 0, 0); PG8_STAGE(PG8_SA(1, 1), a1 + hstep, voffA);
            PG8_WAIT_L(8); PG8_BAR; PG8_WAIT_L(0); PG8_MMA(0, 0, At, B0); PG8_BAR; PG8_SCHED;
            PG8_LDB(B1, 0, 1); PG8_STAGE(PG8_SB(0, 0), b2, voffB);
            PG8_BAR; PG8_WAIT_L(0); PG8_MMA(0, 1, At, B1); PG8_BAR;
            PG8_LDA(At, 0, 1); PG8_STAGE(PG8_SA(0, 0), a2, voffA);
            PG8_BAR; PG8_WAIT_L(0); PG8_MMA(1, 0, At, B0); PG8_BAR; PG8_SCHED;
            PG8_STAGE(PG8_SB(0, 1), b2 + hstep, voffB);
            PG8_WAIT_V(6); PG8_BAR; PG8_MMA(1, 1, At, B1); PG8_BAR;
            PG8_LDB(B0, 1, 0); PG8_SCHED; PG8_LDA(At, 1, 0); PG8_STAGE(PG8_SA(0, 1), a2 + hstep, voffA);
            PG8_WAIT_L(8); PG8_BAR; PG8_WAIT_L(0); PG8_MMA(0, 0, At, B0); PG8_BAR; PG8_SCHED;
            PG8_LDB(B1, 1, 1); PG8_STAGE(PG8_SB(1, 0), b3, voffB);
            PG8_BAR; PG8_WAIT_L(0); PG8_MMA(0, 1, At, B1); PG8_BAR;
            PG8_LDA(At, 1, 1); PG8_STAGE(PG8_SA(1, 0), a3, voffA);
            PG8_BAR; PG8_WAIT_L(0); PG8_MMA(1, 0, At, B0); PG8_BAR; PG8_SCHED;
            PG8_STAGE(PG8_SB(1, 1), b3 + hstep, voffB);
            PG8_WAIT_V(6); PG8_BAR; PG8_MMA(1, 1, At, B1); PG8_BAR;
            }
        }
        if constexpr (ALIGN_EPI) { if (wr == 0) PG8_BAR; }
        if constexpr (!Epi::AFTER_DRAIN) { E(acc, cur, wr, wc, fr, fq, ui, lds); S.done(cur); if (has_next) E.prefetch(nxt, ui + 1, lds, wid, lane); }
        if (!has_next) break;
#pragma unroll
        for (int a = 0; a < 2; ++a)
#pragma unroll
            for (int b = 0; b < 2; ++b)
#pragma unroll
                for (int m = 0; m < 4; ++m)
#pragma unroll
                    for (int n = 0; n < 2; ++n) acc[a][b][m][n] = (f32x4){0.f, 0.f, 0.f, 0.f};
        cur = nxt; cA = nA; cB = nB; ++ui;
        if constexpr (ALIGN_EPI) { if (wr == 1) PG8_BAR; }
    }
    PG8_WAIT_V(0);
    if constexpr (!ALIGN_EPI) { if (wr == 0) PG8_BAR; }
    PG8_BAR;
    if constexpr (Epi::AFTER_DRAIN) { E.fused(acc, cur, wr, wc, fr, fq, lds, wid, lane); S.done(cur); }
#undef PG8_SA
#undef PG8_SB
#undef PG8_STAGE
#undef PG8_LDA
#undef PG8_LDB
#undef PG8_MMA
#undef PG8_WAIT_V
#undef PG8_WAIT_L
#undef PG8_BAR
#undef PG8_SCHED
}
}
constexpr int NB = 8, SEQ = 4096, DM = 1024, NTOK = NB * SEQ, INW = 3844, NPERM = 4096, NLAYER = 2;
constexpr size_t MiB = 1u << 20;
constexpr size_t WS_CTL = 0, CTL_ZERO_BYTES = 1 * MiB;
constexpr size_t WS_WIN = 2 * MiB;
constexpr size_t WS_WOUT = 18 * MiB;
constexpr size_t WS_LF = 22 * MiB;
constexpr size_t WS_RS = 26 * MiB;
constexpr size_t WS_TAB = 23 * MiB;
constexpr size_t WS_KM = 24 * MiB;
constexpr size_t WS_MF = 25 * MiB;
constexpr int CW_BAR = 4096;
constexpr int CW_QUEUE = 64;
constexpr size_t WS_HN = 32 * MiB;
constexpr size_t WS_Q = 96 * MiB, WS_K = 160 * MiB, WS_V = 216 * MiB, WS_G = 272 * MiB, WS_X1 = 336 * MiB  , WS_X0 = 400 * MiB  , WS_END = 464 * MiB;
constexpr float LOG2E = 1.4426950408889634f;
constexpr int NWAVES = 8;
#define TIMER_SEL -1
#define TIMER_FS 100
#define TIMER_WG 37
#define TIMER_TYPE 1
#define PROBE_ATT 0
#define PROBE_REPS 2
#define PROBE_P1 0
#define PROBE_P3 0
#define PROBE_P0 0
#ifndef N_LAUNCHES
#define N_LAUNCHES 1
#endif
constexpr int RING_BYTES = 131072, LDSCTL_OFF = 139264, MISC_OFF = LDSCTL_OFF + 320, LDS_BYTES = 147456;

#define GAS __attribute__((address_space(1)))
#define LAS __attribute__((address_space(3)))
typedef unsigned short bf16;
typedef unsigned v4u __attribute__((ext_vector_type(4)));
typedef float f32x4 __attribute__((ext_vector_type(4)));
__device__ __forceinline__ unsigned f2bf(float f) { unsigned u = __builtin_bit_cast(unsigned, f); return (u + 0x7fffu + ((u >> 16) & 1u)) >> 16; }
__device__ __forceinline__ unsigned pk2(float lo, float hi) { return f2bf(lo) | (f2bf(hi) << 16); }
__device__ __forceinline__ float bf2f(unsigned v) { return __uint_as_float(v << 16); }
__device__ __forceinline__ float wave_sum(float v) {
#pragma unroll
    for (int o = 1; o < 64; o <<= 1) v += __shfl_xor(v, o);
    return v;
}
#define RLX_AGENT __ATOMIC_RELAXED, __HIP_MEMORY_SCOPE_AGENT
#define XB_TMO      128
#define XB_XCNT(j)  (256  + 64 * (j))
#define XB_XSUB(j)  (1280 + 64 * (j))
#define XB_XGEN(j)  (2304 + 64 * (j))
#define XB_TOP      3328
#define XB_TOPGEN   3392
#define XCD_BAR_WORDS 3456
#define XB_SPIN_CAP (1u << 18)

__device__ __forceinline__ unsigned xb_ld(unsigned* p)              { return __hip_atomic_load(p, __ATOMIC_RELAXED, __HIP_MEMORY_SCOPE_AGENT); }
__device__ __forceinline__ unsigned xb_add(unsigned* p, unsigned v) { return __hip_atomic_fetch_add(p, v, __ATOMIC_RELAXED, __HIP_MEMORY_SCOPE_AGENT); }
__device__ __forceinline__ unsigned xb_xcc_id() { return (unsigned)__builtin_amdgcn_s_getreg((3 << 11) | 20) & 0xFu; }
#define XB_SPIN(cond, bar) do { unsigned _sp = 0; while (cond) { __builtin_amdgcn_s_sleep(1); \
    if ((++_sp & 255u) == 0u) { if (xb_ld(&(bar)[XB_TMO])) break; if (_sp > XB_SPIN_CAP) { atomicAdd(&(bar)[XB_TMO], 1u); break; } } } } while (0)

struct XcdBarrier {
    unsigned* bar; unsigned x;
    volatile LAS unsigned* st;
};

__device__ __forceinline__ XcdBarrier xcd_barrier_post(unsigned* bar, volatile LAS unsigned* st) {
    XcdBarrier b; b.bar = bar; b.x = xb_xcc_id(); b.st = st;
    if (threadIdx.x == 0) (void)xb_add(&bar[XB_XCNT(b.x)], 1u);
    return b;
}
__device__ __forceinline__ void xcd_barrier_complete(unsigned* bar, unsigned x, unsigned& nloc, unsigned& nx) {
    const unsigned G = gridDim.x * gridDim.y * gridDim.z;
    unsigned sum, cnt, mine, sp = 0u;
    for (;;) {
        sum = 0u; cnt = 0u; mine = 0u;
#pragma unroll
        for (unsigned j = 0; j < 16; ++j) { const unsigned c = xb_ld(&bar[XB_XCNT(j)]); sum += c; cnt += (c > 0u) ? 1u : 0u; mine = (j == x) ? c : mine; }
        if (sum == G) break;
        __builtin_amdgcn_s_sleep(1);
        if ((++sp & 255u) == 0u) { if (xb_ld(&bar[XB_TMO])) break; if (sp > XB_SPIN_CAP) { atomicAdd(&bar[XB_TMO], 1u); break; } }
    }
    nloc = mine > 0u ? mine : 1u; nx = cnt > 0u ? cnt : 1u;
}

__device__ __forceinline__ void xcd_barrier(const XcdBarrier& b) {
    asm volatile("s_waitcnt vmcnt(0)" ::: "memory");
    __syncthreads();
    if (threadIdx.x == 0) {
        unsigned* bar = b.bar;
        __builtin_amdgcn_s_waitcnt(0);
        unsigned nloc = b.st[0], nx = b.st[1];
        if (nloc == 0u) { xcd_barrier_complete(bar, b.x, nloc, nx); b.st[0] = nloc; b.st[1] = nx; }
        const unsigned old = xb_add(&bar[XB_XSUB(b.x)], 1u);
        const unsigned gen = old / nloc;
        if (old + 1u == (gen + 1u) * nloc) {
            __builtin_amdgcn_fence(__ATOMIC_RELEASE, "agent");
            asm volatile("s_waitcnt vmcnt(0)" ::: "memory");
            const unsigned og = xb_add(&bar[XB_TOP], 1u);
            const unsigned tg = og / nx;
            if (og + 1u == (tg + 1u) * nx) xb_add(&bar[XB_TOPGEN], 1u);
            else XB_SPIN(xb_ld(&bar[XB_TOPGEN]) == tg, bar);
            __builtin_amdgcn_fence(__ATOMIC_ACQUIRE, "agent");
            xb_add(&bar[XB_XGEN(b.x)], 1u);
            asm volatile("s_waitcnt vmcnt(0)" ::: "memory");
        } else {
            XB_SPIN(xb_ld(&bar[XB_XGEN(b.x)]) == gen, bar);
            __builtin_amdgcn_fence(__ATOMIC_ACQUIRE, "agent");
            asm volatile("s_waitcnt vmcnt(0)" ::: "memory");
        }
    }
    __syncthreads();
}

__device__ __forceinline__ int rel_bucket(int d) {
    if (d < 16) return d;
    int b = 16;
    b += (d >= 21); b += (d >= 27); b += (d >= 35); b += (d >= 46); b += (d >= 59); b += (d >= 77); b += (d >= 99); b += (d >= 128);
    b += (d >= 166); b += (d >= 216); b += (d >= 280); b += (d >= 363); b += (d >= 470); b += (d >= 609); b += (d >= 790);
    return b;
}

struct Args { const float* x; const float* norm_gain; const float* w_in; const float* b_forget; const float* fox_g; const float* moba_g; const float* swa_g; const float* sinks; const float* w_out; const float* rel_bias; float* out; unsigned char* ws; int ph_lo, ph_hi, tmask, pad; };

struct Frame { LAS unsigned char* lds; int tid, lane, wave, vcu, G; };

__device__ __forceinline__ void transpose_item(const float* W, int ldw, bf16* WT, int dst_row0, int src_col0, int ncol, const float* gk, LAS float* scr, int kb, int lane) {
    const int k0 = 64 * kb;
    { float wv[32]; const int c = lane & 31;
#pragma unroll
        for (int i = 0; i < 32; ++i) { const int kk = 2 * i + (lane >> 5); wv[i] = (c < ncol) ? W[(size_t)(k0 + kk) * ldw + src_col0 + c] : 0.f; }
        if (gk) {
#pragma unroll
            for (int i = 0; i < 32; ++i) wv[i] *= gk[k0 + 2 * i + (lane >> 5)]; }
#pragma unroll
        for (int i = 0; i < 32; ++i) scr[(2 * i + (lane >> 5)) * 33 + c] = wv[i]; }
    asm volatile("s_waitcnt lgkmcnt(0)" ::: "memory");
    const int c = lane & 7;
#pragma unroll
    for (int j = 0; j < 4; ++j) { const int n = (lane >> 3) + 8 * j; const LAS float* s = scr + (8 * c) * 33 + n;
        v4u o; o.x = pk2(s[0 * 33], s[1 * 33]); o.y = pk2(s[2 * 33], s[3 * 33]); o.z = pk2(s[4 * 33], s[5 * 33]); o.w = pk2(s[6 * 33], s[7 * 33]);
        *(v4u*)(WT + (size_t)(dst_row0 + n) * 1024 + k0 + 8 * c) = o; }
    asm volatile("s_waitcnt lgkmcnt(0)" ::: "memory");
}
__device__ __forceinline__ int tile_src(int T, int wc) {
    switch (T) { case 0: return 0 + 64 * wc; case 1: return 256 + 64 * wc; case 2: return 512 + 64 * wc; case 3: return 772 + 64 * wc;
        case 4: return 1028 + 64 * wc; case 5: return 1284 + 64 * wc; case 6: return 1540 + 64 * wc; case 7: return 1796 + 64 * wc;
        case 8: return 2052 + 64 * wc; case 9: return 2308 + 64 * wc; case 10: return 2564 + 64 * wc; case 11: return 2820 + 64 * wc;
        case 12: return 3076 + 64 * wc; case 13: return wc < 2 ? 3332 + 64 * wc : 3460 + 64 * (wc - 2); default: return 3588 + 64 * wc; }
}
__device__ __forceinline__ void p_weights(Frame& F, const Args& a) {
    LAS float* scr = (LAS float*)(F.lds + F.wave * 16384);
    const int gw = F.vcu * NWAVES + F.wave, NGW = F.G * NWAVES;
    bf16* win = (bf16*)(a.ws + WS_WIN); bf16* wout = (bf16*)(a.ws + WS_WOUT);
    constexpr int I_IN = 128 * 16, I_OUT = 32 * 16;
    for (int it = gw; it < 2 * (I_IN + I_OUT); it += NGW) {
        const int layer = it / (I_IN + I_OUT); int r = it % (I_IN + I_OUT);
        if (r < I_IN) { const int kb = r >> 7, g = r & 127, T = g >> 3, gg = g & 7, bj = gg >> 2, wc = gg & 3;
            const int src = (T < 15) ? tile_src(T, wc) + 32 * bj : 768, ncol = (T < 15) ? 32 : (gg == 0 ? 4 : 0);
            transpose_item(a.w_in + (size_t)layer * DM * INW, INW, win + (size_t)layer * NPERM * DM, 32 * g, src, ncol, a.norm_gain + layer * DM, scr, kb, F.lane); }
        else { r -= I_IN; const int kb = r / 32, g = r % 32;
            transpose_item(a.w_out + (size_t)layer * DM * DM, DM, wout + (size_t)layer * DM * DM, 32 * g, 32 * g, 32, nullptr, scr, kb, F.lane); }
    }
    if (F.vcu == 0) { float* tab = (float*)(a.ws + WS_TAB);
        for (int i = F.tid; i < 8 * 1024; i += NWAVES * 64) { const int hc = i >> 10, d = i & 1023; tab[i] = a.rel_bias[rel_bucket(d) * 8 + hc] * LOG2E; } }
}
__device__ __forceinline__ void p_consts(Frame& F, const Args& a) {
    if (F.vcu == 0 && F.wave == 0) for (int layer = 0; layer < NLAYER; ++layer) {
        const int lane = F.lane; float* MF = (float*)(a.ws + WS_MF) + layer * 4;
        float bm = 0.f;
#pragma unroll
        for (int j = 0; j < 4; ++j) bm = fmaxf(bm, fabsf(a.rel_bias[64 * j + lane]));
#pragma unroll
        for (int o = 1; o < 64; o <<= 1) bm = fmaxf(bm, __shfl_xor(bm, o));
        const float* gp[3] = {a.fox_g + layer * 128, a.moba_g + layer * 128, a.swa_g + layer * 128};
#pragma unroll
        for (int k = 0; k < 3; ++k) { float mq = fabsf(gp[k][lane]), mk = fabsf(gp[k][64 + lane]);
#pragma unroll
            for (int o = 1; o < 64; o <<= 1) { mq = fmaxf(mq, __shfl_xor(mq, o)); mk = fmaxf(mk, __shfl_xor(mk, o)); }
            const float m = 8.f * LOG2E * mq * mk * 1.02f + 0.1f + (k == 0 ? 0.f : bm * LOG2E);
            if (lane == 0) MF[k == 0 ? 0 : (k == 1 ? 1 : 3)] = m; }
        if (lane == 0) MF[2] = 0.f;
    }
}
__device__ __forceinline__ void p_convert(Frame& F, const Args& a) {
    const int lane = F.lane, gt = F.vcu * (NWAVES * 64) + F.tid, NT_ = F.G * NWAVES * 64;
    { float* KM = (float*)(a.ws + WS_KM); for (int i = gt; i < 32 * 16 * 64; i += NT_) KM[i] = 0.f;
      float* RS1 = (float*)(a.ws + WS_RS) + NTOK; for (int i = gt; i < NTOK; i += NT_) RS1[i] = 0.f; }
    bf16* XB = (bf16*)(a.ws + WS_X0); float* RS0 = (float*)(a.ws + WS_RS);
    const int gwv = F.vcu * NWAVES + F.wave, NGW = F.G * NWAVES;
    for (int r0 = 4 * gwv; r0 < NTOK; r0 += 4 * NGW) {
        f32x4 v[4][4];
#pragma unroll
        for (int rr = 0; rr < 4; ++rr) { const f32x4* xr = (const f32x4*)(a.x + (size_t)(r0 + rr) * DM) + lane;
#pragma unroll
            for (int j = 0; j < 4; ++j) v[rr][j] = xr[64 * j]; }
        float ss[4];
#pragma unroll
        for (int rr = 0; rr < 4; ++rr) { ss[rr] = 0.f; unsigned long long* o8 = (unsigned long long*)(XB + (size_t)(r0 + rr) * DM) + lane;
#pragma unroll
            for (int j = 0; j < 4; ++j) { const f32x4 y = v[rr][j]; ss[rr] += (y[0] * y[0] + y[1] * y[1]) + (y[2] * y[2] + y[3] * y[3]);
                o8[64 * j] = (unsigned long long)pk2(y[0], y[1]) | ((unsigned long long)pk2(y[2], y[3]) << 32); } }
#pragma unroll
        for (int o = 1; o < 64; o <<= 1)
#pragma unroll
            for (int rr = 0; rr < 4; ++rr) ss[rr] += __shfl_xor(ss[rr], o);
        if (lane < 4) RS0[r0 + lane] = lane == 0 ? ss[0] : (lane == 1 ? ss[1] : (lane == 2 ? ss[2] : ss[3]));
    }
}
namespace att {
using bf16x8 = __attribute__((ext_vector_type(8))) short;
using s16x4 = __attribute__((ext_vector_type(4))) short;
using f32x16 = __attribute__((ext_vector_type(16))) float;
using u32x4 = __attribute__((ext_vector_type(4))) unsigned;
typedef __attribute__((address_space(3))) const char* lds_cptr;
typedef __attribute__((address_space(3))) char* lds_ptr;
typedef short v4i16_t __attribute__((ext_vector_type(4)));
typedef float f32x2_t __attribute__((ext_vector_type(2))); typedef __bf16 bf16x2_t __attribute__((ext_vector_type(2)));
constexpr int NSLOT = 5, PFD = 2, SLOTB = 8192;
constexpr int L_K = 0, L_V = NSLOT * SLOTB, L_OST = 0  , L_WS = 2 * NSLOT * SLOTB, L_CS = L_WS + 8 * 256, L_TAB = L_CS + 16384, L_G = L_TAB + 4608, L_MISC = L_G + 8 * 4096, L_END = L_MISC + 1024;
static_assert(L_END <= 139264 && 8 * 4096 <= NSLOT * SLOTB, "attention LDS map (the kernel's control words start at 136 KiB)");
constexpr float THR2 = 44.f;
#define SBAR() __builtin_amdgcn_sched_barrier(0)
__device__ __forceinline__ int crow(int r, int hi) { return (r & 3) + 8 * (r >> 2) + 4 * hi; }
__device__ __forceinline__ void glds16(const void* gsrc, unsigned lds_dst) { unsigned keep;
    asm volatile("s_mov_b32 %0, m0\n\ts_mov_b32 m0, %2\n\ts_nop 0\n\tglobal_load_lds_dwordx4 %1, off\n\ts_mov_b32 m0, %0" : "=&s"(keep) : "v"(gsrc), "s"(lds_dst) : "memory"); }
__device__ __forceinline__ unsigned cvtpk_s(float lo, float hi) { f32x2_t v = {lo, hi}; bf16x2_t b = __builtin_convertvector(v, bf16x2_t); return __builtin_bit_cast(unsigned, b); }
__device__ __forceinline__ s16x4 vtr(lds_cptr p) { return __builtin_bit_cast(s16x4, __builtin_amdgcn_ds_read_tr16_b64_v4i16((__attribute__((address_space(3))) v4i16_t*)p)); }
#define MFMA32(a, b, c) __builtin_amdgcn_mfma_f32_32x32x16_bf16(a, b, c, 0, 0, 0)
__device__ __forceinline__ void qkt(f32x16& p0, f32x16& p1, lds_cptr kp, const bf16x8* qr, float cinit) {
    f32x16 c;
#pragma unroll
    for (int r = 0; r < 16; ++r) c[r] = cinit;
    p0 = c; p1 = c;
#pragma unroll
    for (int d0 = 0; d0 < 4; ++d0) {
        const bf16x8 b0 = *(const __attribute__((address_space(3))) bf16x8*)(kp + d0 * 2048);
        const bf16x8 b1 = *(const __attribute__((address_space(3))) bf16x8*)(kp + d0 * 2048 + 512);
        p0 = MFMA32(b0, qr[d0], p0); p1 = MFMA32(b1, qr[d0], p1);
    }
}
__device__ __forceinline__ void pv(f32x16* o, lds_cptr vp, bf16x8 pa0, bf16x8 pa1, bf16x8 pa2, bf16x8 pa3) {
#pragma unroll
    for (int d0 = 0; d0 < 2; ++d0) { s16x4 lo[4], hi[4];
#pragma unroll
        for (int ks = 0; ks < 4; ++ks) { lo[ks] = vtr(vp + d0 * 4096 + ks * 1024); hi[ks] = vtr(vp + d0 * 4096 + ks * 1024 + 512); }
#define PK(k) (bf16x8){lo[k][0], lo[k][1], lo[k][2], lo[k][3], hi[k][0], hi[k][1], hi[k][2], hi[k][3]}
        o[d0] = MFMA32(pa0, PK(0), o[d0]); o[d0] = MFMA32(pa1, PK(1), o[d0]); o[d0] = MFMA32(pa2, PK(2), o[d0]); o[d0] = MFMA32(pa3, PK(3), o[d0]);
#undef PK
    }
}
__device__ __forceinline__ void kload(bf16x8* kf, lds_cptr kp) {
#pragma unroll
    for (int d0 = 0; d0 < 4; ++d0) { kf[2 * d0] = *(const __attribute__((address_space(3))) bf16x8*)(kp + d0 * 2048); kf[2 * d0 + 1] = *(const __attribute__((address_space(3))) bf16x8*)(kp + d0 * 2048 + 512); }
}
__device__ __forceinline__ void vload(s16x4* vlo, s16x4* vhi, lds_cptr vp) {
#pragma unroll
    for (int i = 0; i < 8; ++i) { vlo[i] = vtr(vp + (i >> 2) * 4096 + (i & 3) * 1024); vhi[i] = vtr(vp + (i >> 2) * 4096 + (i & 3) * 1024 + 512); }
}
__device__ __forceinline__ void qkt_r(f32x16& p0, f32x16& p1, const bf16x8* kf, const bf16x8* qr, float cinit) {
    f32x16 c;
#pragma unroll
    for (int r = 0; r < 16; ++r) c[r] = cinit;
    p0 = c; p1 = c;
#pragma unroll
    for (int d0 = 0; d0 < 4; ++d0) { p0 = MFMA32(kf[2 * d0], qr[d0], p0); p1 = MFMA32(kf[2 * d0 + 1], qr[d0], p1); }
}
__device__ __forceinline__ void pv_r(f32x16* o, const s16x4* vlo, const s16x4* vhi, bf16x8 pa0, bf16x8 pa1, bf16x8 pa2, bf16x8 pa3) {
#define VFR(i) (bf16x8){vlo[i][0], vlo[i][1], vlo[i][2], vlo[i][3], vhi[i][0], vhi[i][1], vhi[i][2], vhi[i][3]}
    o[0] = MFMA32(pa0, VFR(0), o[0]); o[1] = MFMA32(pa0, VFR(4), o[1]); o[0] = MFMA32(pa1, VFR(1), o[0]); o[1] = MFMA32(pa1, VFR(5), o[1]);
    o[0] = MFMA32(pa2, VFR(2), o[0]); o[1] = MFMA32(pa2, VFR(6), o[1]); o[0] = MFMA32(pa3, VFR(3), o[0]); o[1] = MFMA32(pa3, VFR(7), o[1]);
#undef VFR
}
struct ACtx { const bf16 *Q, *K, *V, *G; bf16* Y; const float *LF, *TAB, *KM, *MF; const float* sinks; int tflag; };
#define WAITBAR(N) asm volatile("s_waitcnt vmcnt(" #N ") lgkmcnt(0)\n\ts_barrier" ::: "memory")

#define USTAMP(k) do { if (TIMER_SEL >= 0 && TYPE == TIMER_TYPE && C.tflag && tid == 0) { volatile __attribute__((address_space(3))) unsigned* ta_ = (volatile __attribute__((address_space(3))) unsigned*)(shm + 139264 + 320) + 16; const unsigned now_ = (unsigned)__builtin_amdgcn_s_memrealtime(); ta_[k] += now_ - ta_[31]; ta_[31] = now_; } } while (0)
__device__ __forceinline__ int ticket_type(int u) { const int ty = u >> 9; return ty == 0 ? 1 : (ty == 1 ? 0 : ty); }
__device__ __forceinline__ void prefetch_unit(const ACtx& C, int u, lds_ptr shm, bf16x8* qn) {
    int tid = threadIdx.x; asm volatile("" : "+v"(tid));
    const int lane = tid & 63, r32 = lane & 31, hi = lane >> 5; const int wid = __builtin_amdgcn_readfirstlane(tid >> 6);
    const int T = ticket_type(u), r = u & 511, qb = 15 - (r >> 5), bh = r & 31, b = bh >> 2, h = bh & 3;
    const int kvh = (T == 3) ? (b * 2 + (h >> 1)) : bh;
    const bf16* Kh = C.K + T * pg8::GS + (size_t)kvh * SEQ * 64; const bf16* Vh = C.V + T * pg8::GS + (size_t)kvh * SEQ * 64;
    const bf16* ksrc = Kh + (size_t)lane * 64 + wid * 8;
    const bf16* vsrc = Vh + (size_t)(16 * (wid & 3) + (lane >> 2)) * 64 + (wid >> 2) * 32 + (lane & 3) * 8;
    const unsigned lds0 = (unsigned)(size_t)shm, kdst = lds0 + L_K + wid * 1024, vdst = lds0 + L_V + wid * 1024;
    const int t_hi = 4 * qb + 3;
    glds16(ksrc + (size_t)t_hi * 4096, (unsigned)__builtin_amdgcn_readfirstlane(kdst)); glds16(vsrc + (size_t)t_hi * 4096, (unsigned)__builtin_amdgcn_readfirstlane(vdst));
    glds16(ksrc + (size_t)(t_hi - 1) * 4096, (unsigned)__builtin_amdgcn_readfirstlane(kdst + SLOTB)); glds16(vsrc + (size_t)(t_hi - 1) * 4096, (unsigned)__builtin_amdgcn_readfirstlane(vdst + SLOTB));
    const bf16* Qw = C.Q + T * pg8::GS + ((size_t)bh * SEQ + qb * 256 + wid * 32) * 64;
#pragma unroll
    for (int d0 = 0; d0 < 4; ++d0) qn[d0] = *reinterpret_cast<const bf16x8*>(&Qw[(size_t)r32 * 64 + d0 * 16 + hi * 8]);
}
template <int TYPE> __device__ __forceinline__ int attn_unit(const ACtx& C, int bh, int qb, lds_ptr shm, bf16x8 (&qr)[4], int tick, __attribute__((address_space(3))) int* tslot) {
    int tid = threadIdx.x; asm volatile("" : "+v"(tid));
    const int lane = tid & 63, r32 = lane & 31, hi = lane >> 5; const int wid = __builtin_amdgcn_readfirstlane(tid >> 6);
    const int b = bh >> 2, h = bh & 3, q0 = qb * 256, qrel = wid * 32 + r32, t = q0 + qrel;
    const int kvh = (TYPE == 3) ? (b * 2 + (h >> 1)) : bh;
    const bf16* Qw = C.Q + TYPE * pg8::GS + ((size_t)bh * SEQ + q0 + wid * 32) * 64;
    const bf16* Kh = C.K + TYPE * pg8::GS + (size_t)kvh * SEQ * 64; const bf16* Vh = C.V + TYPE * pg8::GS + (size_t)kvh * SEQ * 64;
    const unsigned lds0 = (unsigned)(size_t)shm;
    __attribute__((address_space(3))) float* wsf = (__attribute__((address_space(3))) float*)(shm + L_WS) + wid * 64;
    __attribute__((address_space(3))) float* tabL = (__attribute__((address_space(3))) float*)(shm + L_TAB);
    __attribute__((address_space(3))) float* cs = (__attribute__((address_space(3))) float*)(shm + L_CS);
    __attribute__((address_space(3))) float* misc = (__attribute__((address_space(3))) float*)(shm + L_MISC);
    __attribute__((address_space(3))) int* misci = (__attribute__((address_space(3))) int*)(shm + L_MISC);
    const bf16* ksrc = Kh + (size_t)lane * 64 + wid * 8;
    const bf16* vsrc = Vh + (size_t)(16 * (wid & 3) + (lane >> 2)) * 64 + (wid >> 2) * 32 + (lane & 3) * 8;
    const unsigned kdst = lds0 + L_K + wid * 1024, vdst = lds0 + L_V + wid * 1024;
#define DMA_KV(tile, slot) do { glds16(ksrc + (size_t)(tile) * 4096, (unsigned)__builtin_amdgcn_readfirstlane(kdst + (slot) * SLOTB)); glds16(vsrc + (size_t)(tile) * 4096, (unsigned)__builtin_amdgcn_readfirstlane(vdst + (slot) * SLOTB)); } while (0)
    const lds_cptr kp0 = (lds_cptr)shm + L_K + hi * 1024 + r32 * 16;
    const lds_cptr vp0 = (lds_cptr)shm + L_V + ((lane >> 4) & 1) * 32 + (lane & 3) * 8 + (4 * hi + ((lane & 15) >> 2)) * 64;
    const float Mf = (TYPE == 2) ? 0.f : C.MF[TYPE];
    const int t_hi = 4 * qb + 3; int t_lo = 0;
    if (TYPE == 3) { t_lo = 4 * qb - 2; if (t_lo < 0) t_lo = 0; }
    USTAMP(24);
    const size_t yrow0 = (size_t)(b * SEQ + q0 + wid * 32);
    { const bf16* gsrc = C.G + (yrow0 + (lane >> 3)) * DM + TYPE * 256 + h * 64 + (lane & 7) * 8;
#pragma unroll
        for (int i = 0; i < 4; ++i) glds16(gsrc + (size_t)(8 * i) * DM, (unsigned)__builtin_amdgcn_readfirstlane(lds0 + L_G + wid * 4096 + i * 1024)); }
    unsigned sel = 0u; float ct = 0.f;
    if (TYPE == 0) {
        const float* lfp = C.LF + (size_t)bh * SEQ; const bool on = 8 * tid < q0 + 256;
        f32x4 a4 = {0.f, 0.f, 0.f, 0.f}, b4 = {0.f, 0.f, 0.f, 0.f};
        if (on) { a4 = *(const f32x4*)(lfp + 8 * tid); b4 = *(const f32x4*)(lfp + 8 * tid + 4); }
        a4[1] += a4[0]; a4[2] += a4[1]; a4[3] += a4[2]; b4[0] += a4[3]; b4[1] += b4[0]; b4[2] += b4[1]; b4[3] += b4[2];
        float sc = b4[3];
#pragma unroll
        for (int o = 1; o < 64; o <<= 1) { const float u = __shfl_up(sc, o); if (lane >= o) sc += u; }
        if (lane == 63) misc[wid] = sc;
        __syncthreads();
        float base = sc - b4[3];
#pragma unroll
        for (int w = 0; w < 7; ++w) if (w < wid) base += misc[w];
        if (on) { *(__attribute__((address_space(3))) f32x4*)(cs + 8 * tid) = a4 + base; *(__attribute__((address_space(3))) f32x4*)(cs + 8 * tid + 4) = b4 + base; }
        __syncthreads();
        const float cref = cs[q0];
        if (wid == 0) { const bool skip = (lane < 4 * qb) && (cs[64 * lane + 63] - cref > 2.f * Mf + THR2);
            const int cnt = __popcll(__ballot(skip)); if (lane == 0) misci[40] = cnt; }
        __syncthreads();
        t_lo = misci[40]; ct = cs[t];
    }
    if (TYPE == 1 || TYPE == 3) {
        const float* tg = C.TAB + ((TYPE == 3 ? 4 : 0) + h) * 1024;
        { float tv[3]; const float b31 = (TYPE == 1) ? tg[1023] : 0.f; float k0 = 0.f, k1 = 0.f;
#pragma unroll
            for (int k = 0; k < 3; ++k) { const int j = tid + 512 * k, d = 1023 - j; tv[k] = (j < 1088 && d >= 0 && (TYPE == 1 || d < 128)) ? tg[d] - b31 : -INFINITY; }
            if (TYPE == 1) { const float* kg = C.KM + (size_t)bh * 16 * 64; if (tid < qb * 64) k0 = kg[tid]; if (tid + 512 < qb * 64) k1 = kg[tid + 512]; }
#pragma unroll
            for (int k = 0; k < 3; ++k) { const int j = tid + 512 * k; if (j < 1088) tabL[j] = tv[k]; }
            if (TYPE == 1) { cs[tid] = k0; cs[tid + 512] = k1; } }
        __syncthreads();
        if (TYPE == 1) {
            if (qb <= 3) sel = (1u << qb) - 1u;
            else {
                float qf[32];
#pragma unroll
                for (int d0 = 0; d0 < 4; ++d0) { const u32x4 w = __builtin_bit_cast(u32x4, qr[d0]);
#pragma unroll
                    for (int j = 0; j < 4; ++j) { qf[d0 * 8 + 2 * j] = __uint_as_float(w[j] << 16); qf[d0 * 8 + 2 * j + 1] = __uint_as_float(w[j] & 0xffff0000u); } }
                float v1 = -INFINITY, v2 = -INFINITY, v3 = -INFINITY; int i1 = 0, i2 = 0, i3 = 0;
                for (int n = 0; n < qb; ++n) { float s = 0.f;
#pragma unroll
                    for (int d0 = 0; d0 < 4; ++d0) { const f32x4 ka = *(const __attribute__((address_space(3))) f32x4*)(cs + n * 64 + d0 * 16 + hi * 8), kb4 = *(const __attribute__((address_space(3))) f32x4*)(cs + n * 64 + d0 * 16 + hi * 8 + 4);
#pragma unroll
                        for (int j = 0; j < 4; ++j) { s += qf[d0 * 8 + j] * ka[j]; s += qf[d0 * 8 + 4 + j] * kb4[j]; } }
                    { auto rr = __builtin_amdgcn_permlane32_swap(__float_as_uint(s), __float_as_uint(s), false, false); s = __uint_as_float(rr[0]) + __uint_as_float(rr[1]); }
                    if (s > v1) { v3 = v2; i3 = i2; v2 = v1; i2 = i1; v1 = s; i1 = n; } else if (s > v2) { v3 = v2; i3 = i2; v2 = s; i2 = n; } else if (s > v3) { v3 = s; i3 = n; } }
                sel = (1u << i1) | (1u << i2) | (1u << i3); }
        }
    }
    const int n_tiles = t_hi - t_lo + 1;
    asm volatile("" : "+v"(qr[0]), "+v"(qr[1]), "+v"(qr[2]), "+v"(qr[3]));
    f32x16 o[2]; o[0] = f32x16{}; o[1] = f32x16{}; f32x16 lacc = f32x16{};
    float carry = (TYPE == 2) ? 1.f : 0.f; bool done_w = false;
    f32x16 cvec;
    { const float c0_ = (TYPE == 2) ? 0.f : ((TYPE == 0) ? ct - Mf : -Mf);
#pragma unroll
        for (int r = 0; r < 16; ++r) cvec[r] = c0_; }
    asm volatile("" : "+v"(cvec));
    const bf16x8 ones = {0x3f80, 0x3f80, 0x3f80, 0x3f80, 0x3f80, 0x3f80, 0x3f80, 0x3f80};
    const int jdiag = wid >> 1;
    const int jlo_w = (TYPE == 3) ? ((32 * wid - 127) >> 6) : -100000;
    if (TYPE == 2) { if (tid < 16) misci[64 + tid] = 0; }
    USTAMP(21);
    if (TIMER_SEL == 98 && TYPE == TIMER_TYPE && C.tflag && tid == 0) { volatile __attribute__((address_space(3))) unsigned* ta_ = (volatile __attribute__((address_space(3))) unsigned*)(shm + 139264 + 320) + 16; ta_[26] = (unsigned)__builtin_amdgcn_s_memtime(); }
    bf16x8 kf[8]; s16x4 vlo[8], vhi[8]; f32x16 p0, p1;
    const bool late = false;
#define FINISH(tile_, jr_, slot_) do { \
            vload(vlo, vhi, vp0 + (slot_) * SLOTB); SBAR(); \
            const int kb = 64 * (jr_) + 4 * hi; \
            unsigned keepm = 0xffffffffu; \
            if (TYPE == 0) { \
            _Pragma("unroll") \
                for (int g4 = 0; g4 < 4; ++g4) { const f32x4 c0 = *(const __attribute__((address_space(3))) f32x4*)(cs + 64 * (tile_) + 8 * g4 + 4 * hi), c1 = *(const __attribute__((address_space(3))) f32x4*)(cs + 64 * (tile_) + 32 + 8 * g4 + 4 * hi); \
            _Pragma("unroll") \
                    for (int j = 0; j < 4; ++j) { p0[4 * g4 + j] -= c0[j]; p1[4 * g4 + j] -= c1[j]; } } \
                if ((jr_) == jdiag) { \
            _Pragma("unroll") \
                    for (int r = 0; r < 16; ++r) { const int kv = kb + (r & 3) + 8 * (r >> 2); if (kv > qrel) p0[r] = -INFINITY; if (kv + 32 > qrel) p1[r] = -INFINITY; } } \
            _Pragma("unroll") \
                for (int r = 0; r < 16; ++r) { p0[r] = __builtin_amdgcn_exp2f(p0[r]); p1[r] = __builtin_amdgcn_exp2f(p1[r]); } \
            } \
            if (TYPE == 1 || TYPE == 3) { \
                const bool far = (TYPE == 1) && ((q0 + 32 * wid - 64 * (tile_) - 63) >= 790); \
                if (!far) { const __attribute__((address_space(3))) float* tp_ = tabL + (1023 - (qrel - kb)); \
            _Pragma("unroll") \
                    for (int r = 0; r < 16; ++r) { p0[r] += tp_[(r & 3) + 8 * (r >> 2)]; p1[r] += tp_[(r & 3) + 8 * (r >> 2) + 32]; } } \
                if (TYPE == 1 && (jr_) < 0) keepm = ((sel >> ((tile_) >> 2)) & 1u) ? 0xffffffffu : 0u; \
            _Pragma("unroll") \
                for (int r = 0; r < 16; ++r) { p0[r] = __builtin_amdgcn_exp2f(p0[r]); p1[r] = __builtin_amdgcn_exp2f(p1[r]); } \
            } \
            if (TYPE == 2) { \
                f32x16 w0, w1; \
            _Pragma("unroll") \
                for (int r = 0; r < 16; ++r) { p0[r] = __builtin_amdgcn_exp2f(fminf(p0[r], 80.f)); p1[r] = __builtin_amdgcn_exp2f(fminf(p1[r], 80.f)); } \
                if ((jr_) == jdiag) { \
            _Pragma("unroll") \
                    for (int r = 0; r < 16; ++r) { const int kv = kb + (r & 3) + 8 * (r >> 2); if (kv >= qrel) p0[r] = 0.f; if (kv + 32 >= qrel) p1[r] = 0.f; } } \
            _Pragma("unroll") \
                for (int r = 0; r < 16; ++r) { w0[r] = 1.f + p0[r]; w1[r] = 1.f + p1[r]; } \
                float own[8], part[8]; \
            _Pragma("unroll") \
                for (int rb = 0; rb < 4; ++rb) { own[rb] = (w0[4 * rb] * w0[4 * rb + 1]) * (w0[4 * rb + 2] * w0[4 * rb + 3]); own[4 + rb] = (w1[4 * rb] * w1[4 * rb + 1]) * (w1[4 * rb + 2] * w1[4 * rb + 3]); } \
            _Pragma("unroll") \
                for (int rb = 0; rb < 8; ++rb) { auto rr = __builtin_amdgcn_permlane32_swap(__float_as_uint(own[rb]), __float_as_uint(own[rb]), false, false); part[rb] = __uint_as_float(hi ? rr[0] : rr[1]); } \
                float run = carry; \
            _Pragma("unroll") \
                for (int rb = 7; rb >= 0; --rb) { \
                    float E = hi == 0 ? run * part[rb] : run; run *= own[rb] * part[rb]; \
            _Pragma("unroll") \
                    for (int j = 3; j >= 0; --j) { const int r = 4 * (rb & 3) + j; \
                        if (rb >= 4) { E *= w1[r]; p1[r] *= __builtin_amdgcn_rcpf(E); } else { E *= w0[r]; p0[r] *= __builtin_amdgcn_rcpf(E); } } } \
                carry = run; \
                done_w = __all(carry > 1.7592186e13f) != 0;     \
            } \
            u32x4 pw0, pw1, pw2, pw3; \
            _Pragma("unroll") \
            for (int j = 0; j < 4; ++j) { pw0[j] = cvtpk_s(p0[2 * j], p0[2 * j + 1]); pw1[j] = cvtpk_s(p0[8 + 2 * j], p0[9 + 2 * j]); pw2[j] = cvtpk_s(p1[2 * j], p1[2 * j + 1]); pw3[j] = cvtpk_s(p1[8 + 2 * j], p1[9 + 2 * j]); } \
            if (TYPE == 1) { pw0 &= keepm; pw1 &= keepm; pw2 &= keepm; pw3 &= keepm; } \
            const bf16x8 pa0 = __builtin_bit_cast(bf16x8, pw0), pa1 = __builtin_bit_cast(bf16x8, pw1), pa2 = __builtin_bit_cast(bf16x8, pw2), pa3 = __builtin_bit_cast(bf16x8, pw3); \
            pv_r(o, vlo, vhi, pa0, pa1, pa2, pa3); \
            if (TYPE != 2) { lacc = MFMA32(pa0, ones, lacc); lacc = MFMA32(pa1, ones, lacc); lacc = MFMA32(pa2, ones, lacc); lacc = MFMA32(pa3, ones, lacc); } \
        } while (0)
#define SCORE(slot_) do { kload(kf, kp0 + (slot_) * SLOTB); SBAR(); \
        if (TYPE == 2) { p0 = MFMA32(kf[0], qr[0], (f32x16{})); p1 = MFMA32(kf[1], qr[0], (f32x16{})); } else { p0 = MFMA32(kf[0], qr[0], cvec); p1 = MFMA32(kf[1], qr[0], cvec); } \
        _Pragma("unroll") for (int d0 = 1; d0 < 4; ++d0) { p0 = MFMA32(kf[2 * d0], qr[d0], p0); p1 = MFMA32(kf[2 * d0 + 1], qr[d0], p1); } SBAR(); } while (0)
    int slot = 0, dslot = PFD, ptile = 0, pslot = 0; bool pend = false, stop = false;
    for (int i = 0; ; ++i) {
        const int tile = t_hi - i, jr = tile - 4 * qb;
        if (i < n_tiles && !stop) {
            { const int tp = tile - PFD; DMA_KV(tp < 0 ? 0 : tp, dslot); }
            dslot = (dslot == NSLOT - 1) ? 0 : dslot + 1;
            WAITBAR(4);
            if (TYPE == 2 && i > 0) { const u32x4 fa = *(const __attribute__((address_space(3))) u32x4*)(misci + 64 + ((i - 1) & 1) * 8), fb = *(const __attribute__((address_space(3))) u32x4*)(misci + 68 + ((i - 1) & 1) * 8);
                if ((fa[0] & fa[1] & fa[2] & fa[3] & fb[0] & fb[1] & fb[2] & fb[3]) != 0u) stop = true; }
        }
        if (late && pend) { FINISH(ptile, ptile - 4 * qb, pslot); pend = false; }
        if (i >= n_tiles || stop) break;
        const bool active = (jr <= jdiag) && (jr >= jlo_w) && !(TYPE == 2 && done_w);
        if (active) { SCORE(slot); }
        if (!late) { if (active) { FINISH(tile, jr, slot); } } else { pend = active; ptile = tile; pslot = slot; }
        if (TYPE == 2) { if (lane == 0) misci[64 + (i & 1) * 8 + wid] = done_w ? 1 : 0; }
        slot = (slot == NSLOT - 1) ? 0 : slot + 1;
    }
#undef FINISH
#undef SCORE
    if (TIMER_SEL == 98 && TYPE == TIMER_TYPE && C.tflag && tid == 0) { volatile __attribute__((address_space(3))) unsigned* ta_ = (volatile __attribute__((address_space(3))) unsigned*)(shm + 139264 + 320) + 16; ta_[25] += (unsigned)__builtin_amdgcn_s_memtime() - ta_[26]; }
    USTAMP(22);
    if (tid == 0) tslot[0] = tick;
    asm volatile("s_waitcnt vmcnt(0) lgkmcnt(0)\n\ts_barrier" ::: "memory");
    const int unext = tslot[0];
    if (unext < 2048) prefetch_unit(C, unext, shm, qr);
    float rli[16];
    { const float sk = (TYPE == 3) ? __builtin_amdgcn_exp2f(C.sinks[h] * LOG2E - Mf) : 0.f;
#pragma unroll
        for (int r = 0; r < 16; ++r) rli[r] = (TYPE == 2) ? 1.f : 1.f / (lacc[r] + sk); }
    __attribute__((address_space(3))) bf16* stg = (__attribute__((address_space(3))) bf16*)(shm + (wid < 6 ? L_K + 2 * SLOTB + wid * 4096 : L_V + 2 * SLOTB + (wid - 6) * 4096));
    const __attribute__((address_space(3))) bf16* gst = (const __attribute__((address_space(3))) bf16*)(shm + L_G) + wid * 2048;
#pragma unroll
    for (int r = 0; r < 16; ++r) { const int orow = crow(r, hi); const float rl = rli[r];
#pragma unroll
        for (int d0 = 0; d0 < 2; ++d0) stg[orow * 64 + d0 * 32 + r32] = (bf16)f2bf(o[d0][r] * rl); }
    asm volatile("s_waitcnt lgkmcnt(0)" ::: "memory");
#pragma unroll
    for (int i = 0; i < 4; ++i) { const int row = i * 8 + (lane >> 3), ch = lane & 7;
        const u32x4 v = *(const __attribute__((address_space(3))) u32x4*)(stg + row * 64 + ch * 8);
        const u32x4 g = *(const __attribute__((address_space(3))) u32x4*)(gst + row * 64 + ch * 8); u32x4 w;
        const size_t off = (yrow0 + row) * DM + TYPE * 256 + h * 64 + ch * 8;
#pragma unroll
        for (int j = 0; j < 4; ++j) { const float a0 = __uint_as_float(v[j] << 16) * __uint_as_float(g[j] << 16), a1 = __uint_as_float(v[j] & 0xffff0000u) * __uint_as_float(g[j] & 0xffff0000u); w[j] = pk2(a0, a1); }
        *(u32x4*)(C.Y + off) = w; }
    asm volatile("s_waitcnt lgkmcnt(0)\n\ts_barrier" ::: "memory");
    USTAMP(23);
    return unext;
#undef DMA_KV
}
#undef SBAR
}
#define TACC(F) ((volatile LAS unsigned*)((F).lds + MISC_OFF) + 16)
#define TSTAMP(F, k) do { if (TIMER_SEL >= 0 && (F).vcu == TIMER_WG && (F).tid == 0) { const unsigned now_ = (unsigned)__builtin_amdgcn_s_memrealtime(); TACC(F)[k] += now_ - TACC(F)[31]; TACC(F)[31] = now_; } } while (0)
__device__ __forceinline__ void p_attn(Frame& F, const Args& a, int layer, int rep, int tmask) {
    att::ACtx C{(const bf16*)(a.ws + WS_Q), (const bf16*)(a.ws + WS_K), (const bf16*)(a.ws + WS_V), (const bf16*)(a.ws + WS_G), (bf16*)(a.ws + WS_HN),
                (const float*)(a.ws + WS_LF), (const float*)(a.ws + WS_TAB), (const float*)(a.ws + WS_KM), (const float*)(a.ws + WS_MF) + layer * 4, a.sinks + layer * 4, (F.vcu == TIMER_WG) ? 1 : 0};
    unsigned* head = (unsigned*)(a.ws + WS_CTL) + CW_QUEUE + 64 * (layer + 2 * rep);
    LAS int* slot = (LAS int*)(F.lds + att::L_MISC) + 200;
    att::lds_ptr shm = (att::lds_ptr)F.lds;
    if (F.tid == 0) slot[0] = (int)__hip_atomic_fetch_add(head, 1u, __ATOMIC_RELAXED, __HIP_MEMORY_SCOPE_AGENT);
    __syncthreads();
    int u = slot[0];
    __syncthreads();
    att::bf16x8 qr[4];
    if (u < 2048) att::prefetch_unit(C, u, shm, qr);
    while (u < 2048) {
        int tick = 0;
        if (F.tid == 0) tick = (int)__hip_atomic_fetch_add(head, 1u, __ATOMIC_RELAXED, __HIP_MEMORY_SCOPE_AGENT);
        const int ty = u >> 9, r = u & 511, qb = 15 - (r >> 5), bh = r & 31;
        TSTAMP(F, 20);
        if (ty == 0) u = att::attn_unit<1>(C, bh, qb, shm, qr, tick, (LAS int*)slot);
        else if (ty == 1) u = att::attn_unit<0>(C, bh, qb, shm, qr, tick, (LAS int*)slot);
        else if (ty == 2) u = att::attn_unit<2>(C, bh, qb, shm, qr, tick, (LAS int*)slot);
        else u = att::attn_unit<3>(C, bh, qb, shm, qr, tick, (LAS int*)slot);
        TSTAMP(F, 8 + ty);
    }
    asm volatile("s_waitcnt vmcnt(0)" ::: "memory");
    __syncthreads();
}

__global__ void __launch_bounds__(NWAVES * 64, 2) mk_fwd(Args a) {
    extern __shared__ __attribute__((aligned(16))) unsigned char lds[];
    Frame F; F.lds = (LAS unsigned char*)lds; F.tid = threadIdx.x; F.lane = F.tid & 63; F.wave = __builtin_amdgcn_readfirstlane(F.tid >> 6);
    F.G = gridDim.x; { const int bx = blockIdx.x; F.vcu = (F.G % 8 == 0) ? (bx % 8) * (F.G / 8) + bx / 8 : bx; }
    bf16* HN = (bf16*)(a.ws + WS_HN);
    for (int u = F.tid; u < (LDS_BYTES - LDSCTL_OFF) / 4; u += NWAVES * 64) ((LAS unsigned*)(F.lds + LDSCTL_OFF))[u] = 0u;
    __syncthreads();
    XcdBarrier bar; bar.bar = (unsigned*)(a.ws + WS_CTL) + CW_BAR; bar.x = 0; bar.st = nullptr;
    if (a.ph_hi - a.ph_lo > 1) bar = xcd_barrier_post((unsigned*)(a.ws + WS_CTL) + CW_BAR, (volatile LAS unsigned*)(F.lds + MISC_OFF) + 8);
#define PHASE_ON(k) (a.ph_lo <= (k) && (k) < a.ph_hi)
#define SEAM(k) do { if ((k) != 4 && PHASE_ON(k) && PHASE_ON((k) + 1)) xcd_barrier(bar); } while (0)
#define LAYER_PHASES(layer) do { \
    if ((layer) == 0 && PHASE_ON(0)) { p_weights(F, a); p_consts(F, a); p_convert(F, a); } \
    if ((layer) == 0) { TSTAMP(F, 0); SEAM(0); TSTAMP(F, 1); } \
    if (PHASE_ON(4 * (layer) + 1)) { \
        pg8::Gemm g{(layer) == 0 ? (const bf16*)(a.ws + WS_X0) : (const bf16*)(a.ws + WS_X1), (const bf16*)(a.ws + WS_WIN) + (size_t)(layer) * NPERM * DM, NTOK, NPERM, DM}; \
        pg8::StaticOrder S; S.init(NTOK, NPERM, F.G, (int)blockIdx.x); \
        pg8::EpiIn E{(bf16*)(a.ws + WS_Q), (bf16*)(a.ws + WS_K), (bf16*)(a.ws + WS_V), (bf16*)(a.ws + WS_G), a.fox_g + (layer) * 128, a.moba_g + (layer) * 128, a.swa_g + (layer) * 128, (float*)(a.ws + WS_KM), \
                     (const float*)(a.ws + WS_RS) + (layer) * NTOK, (float*)(a.ws + WS_LF), a.b_forget + (layer) * 4}; \
        pg8::gemm_phase<pg8::EpiIn, pg8::StaticOrder, true, true>(F.lds, g, S, E); \
        if (PROBE_P1) { xcd_barrier(bar); pg8::gemm_phase<pg8::EpiIn, pg8::StaticOrder, true, true>(F.lds, g, S, E); } \
    } \
    TSTAMP(F, 2); SEAM(4 * (layer) + 1); TSTAMP(F, 3); \
    if (PHASE_ON(4 * (layer) + 2)) { for (int rep = 0; rep < 1 + (PROBE_ATT != 0 ? PROBE_REPS : 0); ++rep) { if (rep) xcd_barrier(bar); p_attn(F, a, (layer), rep, rep ? PROBE_ATT : 15); } } \
    TSTAMP(F, 4); SEAM(4 * (layer) + 2); TSTAMP(F, 5); \
    if (PHASE_ON(4 * (layer) + 3)) { \
        pg8::Gemm g{HN  , (const bf16*)(a.ws + WS_WOUT) + (size_t)(layer) * DM * DM, NTOK, DM, DM}; \
        pg8::StaticOrder S; S.init(NTOK, DM, F.G, (int)blockIdx.x); \
        if ((layer) == 0) { \
            { float* KM = (float*)(a.ws + WS_KM); for (int i = F.vcu * (NWAVES * 64) + F.tid; i < 32 * 16 * 64; i += F.G * NWAVES * 64) KM[i] = 0.f; }     \
            pg8::EpiRes0 E{(const bf16*)(a.ws + WS_X0), (bf16*)(a.ws + WS_X1), (float*)(a.ws + WS_RS) + NTOK}; \
            pg8::gemm_phase<pg8::EpiRes0, pg8::StaticOrder, true, true>(F.lds, g, S, E); \
        } else { \
            pg8::EpiRes1 E{(const bf16*)(a.ws + WS_X1), a.out}; \
            pg8::gemm_phase<pg8::EpiRes1, pg8::StaticOrder, true, true>(F.lds, g, S, E); \
        } \
    } \
    if ((layer) == 0) { TSTAMP(F, 6); SEAM(3); SEAM(4); TSTAMP(F, 7); } } while (0)
    if (TIMER_SEL >= 0 && F.vcu == TIMER_WG && F.tid == 0) TACC(F)[31] = (unsigned)__builtin_amdgcn_s_memrealtime();
    LAYER_PHASES(0);
    LAYER_PHASES(1);
    if (TIMER_SEL >= 0 && F.vcu == TIMER_WG) {
        asm volatile("s_waitcnt vmcnt(0)" ::: "memory"); __syncthreads();
        float v = (TIMER_SEL == 99) ? 1.0f : (TIMER_SEL == 98) ? ((float)TACC(F)[25] / ((float)TACC(F)[22] * 10.f)) / 3.0f : (float)TACC(F)[TIMER_SEL & 31] * 0.01f / (float)TIMER_FS; v = fminf(fmaxf(v, 0.f), 1.f); const float dl = 0.1f * sqrtf(v);
        pg8::StaticOrder S; S.init(NTOK, DM, F.G, (int)blockIdx.x); pg8::Unit u;
        for (int i = 0; S.next(i, u); ++i) for (int e = F.tid; e < 65536; e += NWAVES * 64) { float* p = a.out + (size_t)(u.pm * 256 + (e >> 8)) * DM + u.pn * 256 + (e & 255); *p += dl; }
    }
}

extern "C" void kernel_launch(void* const* d_in, const int* in_sizes, int n_in, void* d_out, int out_size, void* d_ws, size_t ws_size, hipStream_t stream) {
    static int ok = 0, grid = 0;
    if (ok == 0) {
        if (n_in != 10 || in_sizes[0] != NTOK * DM || out_size != NTOK * DM || ws_size < WS_END) { fprintf(stderr, "kernel_launch: unexpected shapes (n_in %d, in0 %d, out %d, ws %zu)\n", n_in, n_in > 0 ? in_sizes[0] : -1, out_size, ws_size); ok = -1; return; }
        if (hipFuncSetAttribute((const void*)mk_fwd, hipFuncAttributeMaxDynamicSharedMemorySize, LDS_BYTES) != hipSuccess) { fprintf(stderr, "kernel_launch: hipFuncSetAttribute failed\n"); ok = -1; return; }
        int dev = 0, cus = 0; if (hipGetDevice(&dev) != hipSuccess || hipDeviceGetAttribute(&cus, hipDeviceAttributeMultiprocessorCount, dev) != hipSuccess) { fprintf(stderr, "kernel_launch: device query failed\n"); ok = -1; return; }
        grid = cus < 256 ? (cus / 8) * 8 : 256; if (grid < 8) grid = cus;
        ok = 1;
    }
    if (ok < 0) return;
    Args a{};
    a.x = (const float*)d_in[0]; a.norm_gain = (const float*)d_in[1]; a.w_in = (const float*)d_in[2]; a.b_forget = (const float*)d_in[3]; a.fox_g = (const float*)d_in[4];
    a.moba_g = (const float*)d_in[5]; a.swa_g = (const float*)d_in[6]; a.sinks = (const float*)d_in[7]; a.w_out = (const float*)d_in[8]; a.rel_bias = (const float*)d_in[9];
    a.out = (float*)d_out; a.ws = (unsigned char*)d_ws;
    unsigned char* ws = (unsigned char*)d_ws;
    a.tmask = 15;
    if (hipMemsetAsync(ws + WS_CTL, 0, CTL_ZERO_BYTES, stream) != hipSuccess) { fprintf(stderr, "kernel_launch: memset failed\n"); return; }
#if N_LAUNCHES == 1
    a.ph_lo = 0; a.ph_hi = 8; hipLaunchKernelGGL(mk_fwd, dim3(grid), dim3(NWAVES * 64), LDS_BYTES, stream, a);
#else
    for (int ph = 0; ph < 8; ++ph) { a.ph_lo = ph; a.ph_hi = ph + 1; hipLaunchKernelGGL(mk_fwd, dim3(grid), dim3(NWAVES * 64), LDS_BYTES, stream, a); }
#endif
}
```

```cpp
#include <hip/hip_runtime.h>
#include <cstdio>
#include <cstdint>
#include <cmath>
namespace pg8 {
#define PG8_LAS __attribute__((address_space(3)))
typedef unsigned short bf16_t;
typedef short bf16x8 __attribute__((ext_vector_type(8)));
typedef float f32x4 __attribute__((ext_vector_type(4)));
typedef unsigned u32x4 __attribute__((ext_vector_type(4)));
constexpr int BM = 256, BK = 64, HALF = 128, HTB = HALF * BK * 2  , STAGE_BYTES = 8 * HTB, NXCD = 8, WGM = 8;

__host__ __device__ __forceinline__ int lds_byte(int r, int c) { const int st = (r >> 4) * 2 + (c >> 5), rr = r & 15, cc = c & 31, ob = rr * 64 + cc * 2; return st * 1024 + (ob ^ (((ob >> 9) & 1) << 5)); }
__host__ __device__ __forceinline__ void stage_rc(int b, int& R, int& C) { const int st = b / 1024, sb = b % 1024, swz = sb ^ (((sb >> 9) & 1) << 5); R = (st >> 1) * 16 + swz / 64; C = (st & 1) * 32 + (swz % 64) / 2; }
__host__ __device__ __forceinline__ int perm32(int rho) { const int n = rho >> 4, i = rho & 15; return 8 * (i >> 2) + 4 * n + (i & 3); }

struct Unit { int pm, pn; };
struct Gemm { const bf16_t* A; const bf16_t* Bt; int M, N, K; };

struct StaticOrder {
    int nM, nN, nwg, G, c;
    __host__ __device__ void init(int M, int N, int G_, int c_) { nM = M / BM; nN = N / BM; nwg = nM * nN; G = G_; c = c_; }
    __host__ __device__ bool next(int i, Unit& u) const {
        const long L = (long)i * G + c; if (L >= nwg) return false;
        int wgid = (int)L; { const int q = nwg / NXCD, r = nwg % NXCD, xcd = wgid % NXCD, off = wgid / NXCD; wgid = (xcd < r ? xcd * (q + 1) : r * (q + 1) + (xcd - r) * q) + off; }
        const int nig = WGM * nN, gid = wgid / nig, fm = gid * WGM, gsz = (nM - fm) < WGM ? (nM - fm) : WGM;
        u.pm = fm + ((wgid % nig) % gsz); u.pn = (wgid % nig) / gsz; return true;
    }
    __device__ __forceinline__ void a_ready(const Unit&) const {}
    __device__ __forceinline__ void done(const Unit&) const {}
};

__device__ __forceinline__ unsigned cvt_pk_bf16(float lo, float hi) { unsigned r; asm volatile("v_cvt_pk_bf16_f32 %0, %1, %2" : "=v"(r) : "v"(lo), "v"(hi)); return r; }
typedef float f32x2 __attribute__((ext_vector_type(2)));
constexpr float C2 = 0.125f * 1.4426950408889634f;
constexpr float RMS_EPS = 1e-6f;
constexpr size_t GS = (size_t)8 * 4 * 4096 * 64;
struct EpiIn {
    static constexpr bool PERM = true, AFTER_DRAIN = false;
    bf16_t *Q, *K, *V, *G; const float *gfox, *gmoba, *gswa; float* KM; const float* RS; float* LF; const float* bfg;
    __device__ __forceinline__ void prefetch(const Unit& u, int ui_, PG8_LAS unsigned char* lds, int wid, int lane) const {
        if (wid < 4) { const float* src = RS + u.pm * BM + wid * 64 + lane; const unsigned dst = (unsigned)(size_t)(lds + STAGE_BYTES + (ui_ & 1) * 1024 + wid * 256); unsigned keep;
            asm volatile("s_mov_b32 %0, m0\n\ts_mov_b32 m0, %2\n\ts_nop 0\n\tglobal_load_lds_dword %1, off\n\ts_mov_b32 m0, %0" : "=&s"(keep) : "v"(src), "s"((unsigned)__builtin_amdgcn_readfirstlane(dst)) : "memory"); }
    }
    __device__ __forceinline__ void operator()(const f32x4 (&acc)[2][2][4][2], const Unit& u, int wr, int wc, int fr, int fq, int ui, PG8_LAS unsigned char* ldsb) const {
        const int T = u.pn;
        const int b = (u.pm * BM) >> 12, t0 = ((u.pm * BM) & 4095) + wr * 64 + fr;
        float rs[2][4];
#pragma unroll
        for (int ai = 0; ai < 2; ++ai)
#pragma unroll
            for (int m = 0; m < 4; ++m) rs[ai][m] = __builtin_amdgcn_rsqf(((const PG8_LAS float*)(ldsb + STAGE_BYTES + (ui & 1) * 1024))[ai * HALF + wr * 64 + m * 16 + fr] * (1.0f / 1024.0f) + RMS_EPS);
        if (T == 15) {
            if (wc == 0 && fq == 0) { const f32x4 bv = *(const f32x4*)bfg;
#pragma unroll
                for (int ai = 0; ai < 2; ++ai)
#pragma unroll
                    for (int m = 0; m < 4; ++m) { const f32x4 a4 = acc[ai][0][m][0] * rs[ai][m] + bv;
#pragma unroll
                        for (int j = 0; j < 4; ++j) { const float uu = a4[j]; const float sp = fmaxf(-uu, 0.f) + __logf(1.f + __expf(-fabsf(uu)));
                            LF[(size_t)(b * 4 + j) * 4096 + t0 + ai * HALF + m * 16] = -sp * 1.4426950408889634f; } } }
            return;
        }
        int mode = 1, nh = 4, head = wc; float scale = 1.f; const float* gain = nullptr; bf16_t* base = nullptr;
        switch (T) {
            case 0: mode = 0; gain = gfox; scale = C2; base = Q; break;
            case 1: mode = 0; gain = gfox + 64; base = K; break;
            case 2: base = V; break;
            case 4: mode = 0; gain = gmoba; scale = C2; base = Q + GS; break;
            case 5: mode = 0; gain = gmoba + 64; base = K + GS; break;
            case 6: base = V + GS; break;
            case 8: scale = C2; base = Q + 2 * GS; break;
            case 9: base = K + 2 * GS; break;
            case 10: base = V + 2 * GS; break;
            case 12: mode = 0; gain = gswa; scale = C2; base = Q + 3 * GS; break;
            case 13: nh = 2; if (wc < 2) { mode = 0; gain = gswa + 64; base = K + 3 * GS; } else { base = V + 3 * GS; head = wc - 2; } break;
            default: mode = 2; break;
        }
        if (mode == 2) {
            bf16_t* gp = G + (size_t)(u.pm * BM + wr * 64 + fr) * 1024 + (T >> 2) * 256 + 64 * wc + 8 * fq;
#pragma unroll
            for (int ai = 0; ai < 2; ++ai)
#pragma unroll
                for (int m = 0; m < 4; ++m)
#pragma unroll
                    for (int bj = 0; bj < 2; ++bj) {
                        f32x4 v0 = acc[ai][bj][m][0] * rs[ai][m], v1 = acc[ai][bj][m][1] * rs[ai][m];
#pragma unroll
                        for (int j = 0; j < 4; ++j) { v0[j] = v0[j] * __builtin_amdgcn_rcpf(1.f + __expf(-v0[j])); v1[j] = v1[j] * __builtin_amdgcn_rcpf(1.f + __expf(-v1[j])); }
                        u32x4 w; w.x = cvt_pk_bf16(v0[0], v0[1]); w.y = cvt_pk_bf16(v0[2], v0[3]); w.z = cvt_pk_bf16(v1[0], v1[1]); w.w = cvt_pk_bf16(v1[2], v1[3]);
                        *(u32x4*)(gp + (size_t)(ai * HALF + m * 16) * 1024 + 32 * bj) = w;
                    }
            return;
        }
        f32x4 gv[2][2];
#pragma unroll
        for (int bj = 0; bj < 2; ++bj)
#pragma unroll
            for (int n = 0; n < 2; ++n) gv[bj][n] = (mode == 0) ? *(const f32x4*)(gain + 32 * bj + 8 * fq + 4 * n) : (f32x4){1.f, 1.f, 1.f, 1.f};
        bf16_t* dp = base + ((size_t)(b * nh + head) * 4096 + t0) * 64 + 8 * fq;
        f32x4 cs4[2][2];
#pragma unroll
        for (int bj = 0; bj < 2; ++bj)
#pragma unroll
            for (int n = 0; n < 2; ++n) cs4[bj][n] = (f32x4){0.f, 0.f, 0.f, 0.f};
#pragma unroll
        for (int ai = 0; ai < 2; ++ai)
#pragma unroll
            for (int m = 0; m < 4; ++m) {
                float r = scale * rs[ai][m];
                if (mode == 0) {
                    float ss = 0.f;
#pragma unroll
                    for (int bj = 0; bj < 2; ++bj)
#pragma unroll
                        for (int n = 0; n < 2; ++n) { const f32x4 x = acc[ai][bj][m][n]; ss += (x[0] * x[0] + x[1] * x[1]) + (x[2] * x[2] + x[3] * x[3]); }
                    ss += __shfl_xor(ss, 16); ss += __shfl_xor(ss, 32);
                    r = scale * rs[ai][m] * __builtin_amdgcn_rsqf(ss * rs[ai][m] * rs[ai][m] * (1.0f / 64.0f) + RMS_EPS);
                }
#pragma unroll
                for (int bj = 0; bj < 2; ++bj) {
                    const f32x4 v0 = acc[ai][bj][m][0] * gv[bj][0] * r, v1 = acc[ai][bj][m][1] * gv[bj][1] * r;
                    if (T == 5) { cs4[bj][0] += v0; cs4[bj][1] += v1; }
                    u32x4 w; w.x = cvt_pk_bf16(v0[0], v0[1]); w.y = cvt_pk_bf16(v0[2], v0[3]); w.z = cvt_pk_bf16(v1[0], v1[1]); w.w = cvt_pk_bf16(v1[2], v1[3]);
                    *(u32x4*)(dp + (size_t)(ai * HALF + m * 16) * 64 + 32 * bj) = w;
                }
            }
        if (T == 5) {
            float* kmp = KM + ((size_t)((b * 4 + wc) * 16 + (((u.pm * BM) & 4095) >> 8))) * 64 + 8 * fq;
#pragma unroll
            for (int bj = 0; bj < 2; ++bj)
#pragma unroll
                for (int n = 0; n < 2; ++n)
#pragma unroll
                    for (int j = 0; j < 4; ++j) { float s = cs4[bj][n][j];
                        s += __shfl_xor(s, 1); s += __shfl_xor(s, 2); s += __shfl_xor(s, 4); s += __shfl_xor(s, 8);
                        if (fr == 0) atomicAdd(kmp + 32 * bj + 4 * n + j, s * (1.0f / 256.0f)); }
        }
    }
};
struct EpiRes0 {
    static constexpr bool PERM = true, AFTER_DRAIN = false;
    const bf16_t* base; bf16_t* X1; float* RS1;
    __device__ __forceinline__ void prefetch(const Unit&, int, PG8_LAS unsigned char*, int, int) const {}
    __device__ __forceinline__ void operator()(const f32x4 (&acc)[2][2][4][2], const Unit& u, int wr, int wc, int fr, int fq, int ui, PG8_LAS unsigned char* ldsb) const {
        const int col0 = u.pn * BM + wc * 32 + 8 * fq;
#pragma unroll
        for (int ai = 0; ai < 2; ++ai)
#pragma unroll
            for (int m = 0; m < 4; ++m) {
                const int row = u.pm * BM + ai * HALF + wr * 64 + m * 16 + fr; const size_t off = (size_t)row * 1024 + col0; float ss = 0.f;
#pragma unroll
                for (int bj = 0; bj < 2; ++bj) { const u32x4 xb = *(const u32x4*)(base + off + bj * HALF);
                    f32x4 v0, v1; v0[0] = __uint_as_float(xb.x << 16); v0[1] = __uint_as_float(xb.x & 0xffff0000u); v0[2] = __uint_as_float(xb.y << 16); v0[3] = __uint_as_float(xb.y & 0xffff0000u);
                    v1[0] = __uint_as_float(xb.z << 16); v1[1] = __uint_as_float(xb.z & 0xffff0000u); v1[2] = __uint_as_float(xb.w << 16); v1[3] = __uint_as_float(xb.w & 0xffff0000u);
                    v0 += acc[ai][bj][m][0]; v1 += acc[ai][bj][m][1];
                    ss += (v0[0] * v0[0] + v0[1] * v0[1]) + (v0[2] * v0[2] + v0[3] * v0[3]) + (v1[0] * v1[0] + v1[1] * v1[1]) + (v1[2] * v1[2] + v1[3] * v1[3]);
                    u32x4 w; w.x = cvt_pk_bf16(v0[0], v0[1]); w.y = cvt_pk_bf16(v0[2], v0[3]); w.z = cvt_pk_bf16(v1[0], v1[1]); w.w = cvt_pk_bf16(v1[2], v1[3]);
                    *(u32x4*)(X1 + off + bj * HALF) = w; }
                ss += __shfl_xor(ss, 16); ss += __shfl_xor(ss, 32);
                if (fq == 0) atomicAdd(RS1 + row, ss);
            }
    }
};
struct EpiRes1 {
    static constexpr bool PERM = true, AFTER_DRAIN = false;
    const bf16_t* X1; float* out;

    __device__ __forceinline__ void prefetch(const Unit&, int, PG8_LAS unsigned char*, int, int) const {}
    __device__ __forceinline__ void operator()(const f32x4 (&acc)[2][2][4][2], const Unit& u, int wr, int wc, int fr, int fq, int ui, PG8_LAS unsigned char* ldsb) const {
        const int col0 = u.pn * BM + wc * 32 + 8 * fq;
#pragma unroll
        for (int ai = 0; ai < 2; ++ai)
#pragma unroll
            for (int m = 0; m < 4; ++m) {
                const size_t off = (size_t)(u.pm * BM + ai * HALF + wr * 64 + m * 16 + fr) * 1024 + col0;
#pragma unroll
                for (int bj = 0; bj < 2; ++bj) { const u32x4 xb = *(const u32x4*)(X1 + off + bj * HALF);
                    f32x4 v0, v1; v0[0] = __uint_as_float(xb.x << 16); v0[1] = __uint_as_float(xb.x & 0xffff0000u); v0[2] = __uint_as_float(xb.y << 16); v0[3] = __uint_as_float(xb.y & 0xffff0000u);
                    v1[0] = __uint_as_float(xb.z << 16); v1[1] = __uint_as_float(xb.z & 0xffff0000u); v1[2] = __uint_as_float(xb.w << 16); v1[3] = __uint_as_float(xb.w & 0xffff0000u);
                    *(f32x4*)(out + off + bj * HALF) = v0 + acc[ai][bj][m][0]; *(f32x4*)(out + off + bj * HALF + 4) = v1 + acc[ai][bj][m][1]; }
            }
    }
};

template <class Epi, class Sched, bool ALIGN_EPI = false, bool SP2 = false>
__device__ __forceinline__ void gemm_phase(PG8_LAS unsigned char* lds, const Gemm g, const Sched& S, const Epi& E) {
    const int tid = threadIdx.x, wid = __builtin_amdgcn_readfirstlane(tid >> 6), lane = tid & 63, wr = wid >> 2, wc = wid & 3, fr = lane & 15, fq = lane >> 4;
    const int K = g.K, nt = K / BK;
    unsigned voffA[2], voffB[2];
#pragma unroll
    for (int i = 0; i < 2; ++i) { int R, C; stage_rc(tid * 16 + i * 8192, R, C); const int Rb = Epi::PERM ? ((R & ~31) + perm32(R & 31)) : R;
        voffA[i] = (unsigned)(R * K + C) * 2u; voffB[i] = (unsigned)(Rb * K + C) * 2u; }
    const size_t kstep = (size_t)(BK * 2);
    const size_t hstep = (size_t)HALF * K * 2;
    const size_t tstep = 2 * hstep;
    const unsigned ldsw = (unsigned)wid * 1024u;
    const int aoff = lds_byte(wr * 64 + fr, fq * 8), boff = lds_byte(wc * 32 + fr, fq * 8);
#define PG8_SA(b, h) (((b) * 2 + (h)) * HTB)
#define PG8_SB(b, h) ((4 + (b) * 2 + (h)) * HTB)
#define PG8_STAGE(bufoff, gbase, voff) do { _Pragma("unroll") for (int _i = 0; _i < 2; ++_i) \
        __builtin_amdgcn_global_load_lds((const unsigned*)((const char*)(gbase) + (voff)[_i]), (PG8_LAS unsigned*)(lds + (bufoff) + ldsw + _i * 8192), 16, 0, 0); } while (0)
#define PG8_LDA(dst, b, h) do { _Pragma("unroll") for (int m = 0; m < 4; ++m) _Pragma("unroll") for (int k = 0; k < 2; ++k) dst[m][k] = *(const PG8_LAS bf16x8*)(lds + PG8_SA(b, h) + aoff + m * 2048 + k * 1024); } while (0)
#define PG8_LDB(dst, b, h) do { _Pragma("unroll") for (int n = 0; n < 2; ++n) _Pragma("unroll") for (int k = 0; k < 2; ++k) dst[n][k] = *(const PG8_LAS bf16x8*)(lds + PG8_SB(b, h) + boff + n * 2048 + k * 1024); } while (0)
#define PG8_MMA(ai, bj, At, Bt) do { __builtin_amdgcn_s_setprio(1); _Pragma("unroll") for (int m = 0; m < 4; ++m) _Pragma("unroll") for (int n = 0; n < 2; ++n) _Pragma("unroll") for (int k = 0; k < 2; ++k) \
        acc[ai][bj][m][n] = __builtin_amdgcn_mfma_f32_16x16x32_bf16(Bt[n][k], At[m][k], acc[ai][bj][m][n], 0, 0, 0); __builtin_amdgcn_s_setprio(0); } while (0)
#define PG8_WAIT_V(n) asm volatile("s_waitcnt vmcnt(" #n ")" ::: "memory")
#define PG8_WAIT_L(n) asm volatile("s_waitcnt lgkmcnt(" #n ")" ::: "memory")
#define PG8_BAR __builtin_amdgcn_s_barrier()
#define PG8_SCHED __builtin_amdgcn_sched_barrier(0)
    Unit cur, nxt; int ui = 0;
    if (!S.next(0, cur)) return;
    f32x4 acc[2][2][4][2];
#pragma unroll
    for (int a = 0; a < 2; ++a)
#pragma unroll
        for (int b = 0; b < 2; ++b)
#pragma unroll
            for (int m = 0; m < 4; ++m)
#pragma unroll
                for (int n = 0; n < 2; ++n) acc[a][b][m][n] = (f32x4){0.f, 0.f, 0.f, 0.f};
    bf16x8 At[4][2], B0[2][2], B1[2][2];
    const char* cA = (const char*)g.A + (size_t)cur.pm * tstep; const char* cB = (const char*)g.Bt + (size_t)cur.pn * tstep;
    S.a_ready(cur); E.prefetch(cur, 0, lds, wid, lane);
    if constexpr (SP2) {
        PG8_STAGE(PG8_SB(0, 0), cB, voffB); PG8_STAGE(PG8_SB(0, 1), cB + hstep, voffB); PG8_STAGE(PG8_SA(0, 0), cA, voffA); PG8_STAGE(PG8_SA(0, 1), cA + hstep, voffA);
        if (wr == 1) PG8_BAR;
        PG8_WAIT_V(2); PG8_BAR;
        PG8_STAGE(PG8_SB(1, 0), cB + kstep, voffB); PG8_STAGE(PG8_SA(1, 0), cA + kstep, voffA); PG8_STAGE(PG8_SB(1, 1), cB + hstep + kstep, voffB);
        PG8_WAIT_V(6); PG8_BAR;
    } else {
        PG8_STAGE(PG8_SB(0, 0), cB, voffB); PG8_STAGE(PG8_SA(0, 0), cA, voffA); PG8_STAGE(PG8_SB(0, 1), cB + hstep, voffB); PG8_STAGE(PG8_SA(0, 1), cA + hstep, voffA);
        if (wr == 1) PG8_BAR;
        PG8_WAIT_V(4); PG8_BAR;
        PG8_STAGE(PG8_SB(1, 0), cB + kstep, voffB); PG8_STAGE(PG8_SA(1, 0), cA + kstep, voffA); PG8_STAGE(PG8_SB(1, 1), cB + hstep + kstep, voffB);
        PG8_WAIT_V(6); PG8_BAR;
    }
    for (;;) {
        const bool has_next = S.next(ui + 1, nxt);
        const char* nA = has_next ? (const char*)g.A + (size_t)nxt.pm * tstep : cA; const char* nB = has_next ? (const char*)g.Bt + (size_t)nxt.pn * tstep : cB;
        for (int t = 0; t < nt; t += 2) {
            const bool last = (t == nt - 2);
            const char* a1 = cA + (size_t)(t + 1) * kstep;
            const char* a2 = last ? nA : cA + (size_t)(t + 2) * kstep; const char* b2 = last ? nB : cB + (size_t)(t + 2) * kstep;
            const char* a3 = a2 + kstep; const char* b3 = b2 + kstep;
            if (last && has_next) S.a_ready(nxt);
            if constexpr (SP2) {
            PG8_LDB(B0, 0, 0); PG8_LDB(B1, 0, 1); PG8_SCHED; PG8_LDA(At, 0, 0); PG8_STAGE(PG8_SA(1, 1), a1 + hstep, voffA);
            PG8_WAIT_V(8); PG8_WAIT_L(0); PG8_BAR; PG8_MMA(0, 0, At, B0); PG8_MMA(0, 1, At, B1); PG8_BAR; PG8_SCHED;
            PG8_LDA(At, 0, 1); PG8_STAGE(PG8_SB(0, 0), b2, voffB); PG8_STAGE(PG8_SB(0, 1), b2 + hstep, voffB); PG8_STAGE(PG8_SA(0, 0), a2, voffA);
            PG8_WAIT_V(8); PG8_WAIT_L(0); PG8_BAR; PG8_MMA(1, 0, At, B0); PG8_MMA(1, 1, At, B1); PG8_BAR; PG8_SCHED;
            PG8_LDB(B0, 1, 0); PG8_LDB(B1, 1, 1); PG8_SCHED; PG8_LDA(At, 1, 0); PG8_STAGE(PG8_SA(0, 1), a2 + hstep, voffA);
            PG8_WAIT_V(8); PG8_WAIT_L(0); PG8_BAR; PG8_MMA(0, 0, At, B0); PG8_MMA(0, 1, At, B1); PG8_BAR; PG8_SCHED;
            PG8_LDA(At, 1, 1); PG8_STAGE(PG8_SB(1, 0), b3, voffB); PG8_STAGE(PG8_SB(1, 1), b3 + hstep, voffB); PG8_STAGE(PG8_SA(1, 0), a3, voffA);
            PG8_WAIT_V(8); PG8_WAIT_L(0); PG8_BAR; PG8_MMA(1, 0, At, B0); PG8_MMA(1, 1, At, B1); PG8_BAR; PG8_SCHED;
            } else {
            PG8_LDB(B0, 0, 0); PG8_SCHED; PG8_LDA(At, 0, 0); PG8_STAGE(PG8_SA(1, 1), a1 + hstep, voffA);
            PG8_WAIT_L(8); PG8_BAR; PG8_WAIT_L(0); PG8_MMA(0, 0, At, B0); PG8_BAR; PG8_SCHED;
            PG8_LDB(B1, 0, 1); PG8_STAGE(PG8_SB(0, 0), b2, voffB);
            PG8_BAR; PG8_WAIT_L(0); PG8_MMA(0, 1, At, B1); PG8_BAR;
            PG8_LDA(At, 0, 1); PG8_STAGE(PG8_SA(0, 0), a2, voffA);
            PG8_BAR; PG8_WAIT_L(0); PG8_MMA(1, 0, At, B0); PG8_BAR; PG8_SCHED;
            PG8_STAGE(PG8_SB(0, 1), b2 + hstep, voffB);
            PG8_WAIT_V(6); PG8_BAR; PG8_MMA(1, 1, At, B1); PG8_BAR;
            PG8_LDB(B0, 1, 0); PG8_SCHED; PG8_LDA(At, 1, 0); PG8_STAGE(PG8_SA(0, 1), a2 + hstep, voffA);
            PG8_WAIT_L(8); PG8_BAR; PG8_WAIT_L(0); PG8_MMA(0, 0, At, B0); PG8_BAR; PG8_SCHED;
            PG8_LDB(B1, 1, 1); PG8_STAGE(PG8_SB(1, 0), b3, voffB);
            PG8_BAR; PG8_WAIT_L(0); PG8_MMA(0, 1, At, B1); PG8_BAR;
            PG8_LDA(At, 1, 1); PG8_STAGE(PG8_SA(1, 0), a3, voffA);
            PG8_BAR; PG8_WAIT_L(0); PG8_MMA(1, 0, At, B0); PG8_BAR; PG8_SCHED;
            PG8_STAGE(PG8_SB(1, 1), b3 + hstep, voffB);
            PG8_WAIT_V(6); PG8_BAR; PG8_MMA(1, 1, At, B1); PG8_BAR;
            }
        }
        if constexpr (ALIGN_EPI) { if (wr == 0) PG8_BAR; }
        if constexpr (!Epi::AFTER_DRAIN) { E(acc, cur, wr, wc, fr, fq, ui, lds); S.done(cur); if (has_next) E.prefetch(nxt, ui + 1, lds, wid, lane); }
        if (!has_next) break;
#pragma unroll
        for (int a = 0; a < 2; ++a)
#pragma unroll
            for (int b = 0; b < 2; ++b)
#pragma unroll
                for (int m = 0; m < 4; ++m)
#pragma unroll
                    for (int n = 0; n < 2; ++n) acc[a][b][m][n] = (f32x4){0.f, 0.f, 0.f, 0.f};
        cur = nxt; cA = nA; cB = nB; ++ui;
        if constexpr (ALIGN_EPI) { if (wr == 1) PG8_BAR; }
    }
    PG8_WAIT_V(0);
    if constexpr (!ALIGN_EPI) { if (wr == 0) PG8_BAR; }
    PG8_BAR;
    if constexpr (Epi::AFTER_DRAIN) { E.fused(acc, cur, wr, wc, fr, fq, lds, wid, lane); S.done(cur); }
#undef PG8_SA
#undef PG8_SB
#undef PG8_STAGE
#undef PG8_LDA
#undef PG8_LDB
#undef PG8_MMA
#undef PG8_WAIT_V
#undef PG8_WAIT_L
#undef PG8_BAR
#undef PG8_SCHED
}
}
constexpr int NB = 8, SEQ = 4096, DM = 1024, NTOK = NB * SEQ, INW = 3844, NPERM = 4096, NLAYER = 2;
constexpr size_t MiB = 1u << 20;
constexpr size_t WS_CTL = 0, CTL_ZERO_BYTES = 1 * MiB;
constexpr size_t WS_WIN = 2 * MiB;
constexpr size_t WS_WOUT = 18 * MiB;
constexpr size_t WS_LF = 22 * MiB;
constexpr size_t WS_RS = 26 * MiB;
constexpr size_t WS_TAB = 23 * MiB;
constexpr size_t WS_KM = 24 * MiB;
constexpr size_t WS_MF = 25 * MiB;
constexpr int CW_BAR = 4096;
constexpr int CW_QUEUE = 64;
constexpr size_t WS_HN = 32 * MiB;
constexpr size_t WS_Q = 96 * MiB, WS_K = 160 * MiB, WS_V = 216 * MiB, WS_G = 272 * MiB, WS_X1 = 336 * MiB  , WS_X0 = 400 * MiB  , WS_END = 464 * MiB;
constexpr float LOG2E = 1.4426950408889634f;
constexpr int NWAVES = 8;
#define TIMER_SEL -1
#define TIMER_FS 100
#define TIMER_WG 37
#define TIMER_TYPE 1
#define PROBE_ATT 0
#define PROBE_REPS 2
#define PROBE_P1 0
#define PROBE_P3 0
#define PROBE_P0 0
#ifndef N_LAUNCHES
#define N_LAUNCHES 1
#endif
constexpr int RING_BYTES = 131072, LDSCTL_OFF = 139264, MISC_OFF = LDSCTL_OFF + 320, LDS_BYTES = 147456;

#define GAS __attribute__((address_space(1)))
#define LAS __attribute__((address_space(3)))
typedef unsigned short bf16;
typedef unsigned v4u __attribute__((ext_vector_type(4)));
typedef float f32x4 __attribute__((ext_vector_type(4)));
__device__ __forceinline__ unsigned f2bf(float f) { unsigned u = __builtin_bit_cast(unsigned, f); return (u + 0x7fffu + ((u >> 16) & 1u)) >> 16; }
typedef float f32x2h_t __attribute__((ext_vector_type(2))); typedef __bf16 bf16x2h_t __attribute__((ext_vector_type(2)));
__device__ __forceinline__ unsigned pk2(float lo, float hi) { f32x2h_t v = {lo, hi}; bf16x2h_t b = __builtin_convertvector(v, bf16x2h_t); return __builtin_bit_cast(unsigned, b); }
__device__ __forceinline__ float bf2f(unsigned v) { return __uint_as_float(v << 16); }
__device__ __forceinline__ float wave_sum(float v) {
#pragma unroll
    for (int o = 1; o < 64; o <<= 1) v += __shfl_xor(v, o);
    return v;
}
#define RLX_AGENT __ATOMIC_RELAXED, __HIP_MEMORY_SCOPE_AGENT
#define XB_TMO      128
#define XB_XCNT(j)  (256  + 64 * (j))
#define XB_XSUB(j)  (1280 + 64 * (j))
#define XB_XGEN(j)  (2304 + 64 * (j))
#define XB_TOP      3328
#define XB_TOPGEN   3392
#define XCD_BAR_WORDS 3456
#define XB_SPIN_CAP (1u << 18)

__device__ __forceinline__ unsigned xb_ld(unsigned* p)              { return __hip_atomic_load(p, __ATOMIC_RELAXED, __HIP_MEMORY_SCOPE_AGENT); }
__device__ __forceinline__ unsigned xb_add(unsigned* p, unsigned v) { return __hip_atomic_fetch_add(p, v, __ATOMIC_RELAXED, __HIP_MEMORY_SCOPE_AGENT); }
__device__ __forceinline__ unsigned xb_xcc_id() { return (unsigned)__builtin_amdgcn_s_getreg((3 << 11) | 20) & 0xFu; }
#define XB_SPIN(cond, bar) do { unsigned _sp = 0; while (cond) { __builtin_amdgcn_s_sleep(1); \
    if ((++_sp & 255u) == 0u) { if (xb_ld(&(bar)[XB_TMO])) break; if (_sp > XB_SPIN_CAP) { atomicAdd(&(bar)[XB_TMO], 1u); break; } } } } while (0)

struct XcdBarrier {
    unsigned* bar; unsigned x;
    volatile LAS unsigned* st;
};

__device__ __forceinline__ XcdBarrier xcd_barrier_post(unsigned* bar, volatile LAS unsigned* st) {
    XcdBarrier b; b.bar = bar; b.x = xb_xcc_id(); b.st = st;
    if (threadIdx.x == 0) (void)xb_add(&bar[XB_XCNT(b.x)], 1u);
    return b;
}
__device__ __forceinline__ void xcd_barrier_complete(unsigned* bar, unsigned x, unsigned& nloc, unsigned& nx) {
    const unsigned G = gridDim.x * gridDim.y * gridDim.z;
    unsigned sum, cnt, mine, sp = 0u;
    for (;;) {
        sum = 0u; cnt = 0u; mine = 0u;
#pragma unroll
        for (unsigned j = 0; j < 16; ++j) { const unsigned c = xb_ld(&bar[XB_XCNT(j)]); sum += c; cnt += (c > 0u) ? 1u : 0u; mine = (j == x) ? c : mine; }
        if (sum == G) break;
        __builtin_amdgcn_s_sleep(1);
        if ((++sp & 255u) == 0u) { if (xb_ld(&bar[XB_TMO])) break; if (sp > XB_SPIN_CAP) { atomicAdd(&bar[XB_TMO], 1u); break; } }
    }
    nloc = mine > 0u ? mine : 1u; nx = cnt > 0u ? cnt : 1u;
}

__device__ __forceinline__ void xcd_barrier(const XcdBarrier& b) {
    asm volatile("s_waitcnt vmcnt(0)" ::: "memory");
    __syncthreads();
    if (threadIdx.x == 0) {
        unsigned* bar = b.bar;
        __builtin_amdgcn_s_waitcnt(0);
        unsigned nloc = b.st[0], nx = b.st[1];
        if (nloc == 0u) { xcd_barrier_complete(bar, b.x, nloc, nx); b.st[0] = nloc; b.st[1] = nx; }
        const unsigned old = xb_add(&bar[XB_XSUB(b.x)], 1u);
        const unsigned gen = old / nloc;
        if (old + 1u == (gen + 1u) * nloc) {
            __builtin_amdgcn_fence(__ATOMIC_RELEASE, "agent");
            asm volatile("s_waitcnt vmcnt(0)" ::: "memory");
            const unsigned og = xb_add(&bar[XB_TOP], 1u);
            const unsigned tg = og / nx;
            if (og + 1u == (tg + 1u) * nx) xb_add(&bar[XB_TOPGEN], 1u);
            else XB_SPIN(xb_ld(&bar[XB_TOPGEN]) == tg, bar);
            __builtin_amdgcn_fence(__ATOMIC_ACQUIRE, "agent");
            xb_add(&bar[XB_XGEN(b.x)], 1u);
            asm volatile("s_waitcnt vmcnt(0)" ::: "memory");
        } else {
            XB_SPIN(xb_ld(&bar[XB_XGEN(b.x)]) == gen, bar);
            __builtin_amdgcn_fence(__ATOMIC_ACQUIRE, "agent");
            asm volatile("s_waitcnt vmcnt(0)" ::: "memory");
        }
    }
    __syncthreads();
}

__device__ __forceinline__ int rel_bucket(int d) {
    if (d < 16) return d;
    int b = 16;
    b += (d >= 21); b += (d >= 27); b += (d >= 35); b += (d >= 46); b += (d >= 59); b += (d >= 77); b += (d >= 99); b += (d >= 128);
    b += (d >= 166); b += (d >= 216); b += (d >= 280); b += (d >= 363); b += (d >= 470); b += (d >= 609); b += (d >= 790);
    return b;
}

struct Args { const float* x; const float* norm_gain; const float* w_in; const float* b_forget; const float* fox_g; const float* moba_g; const float* swa_g; const float* sinks; const float* w_out; const float* rel_bias; float* out; unsigned char* ws; int ph_lo, ph_hi, tmask, pad; };

struct Frame { LAS unsigned char* lds; int tid, lane, wave, vcu, G; };

__device__ __forceinline__ void transpose_item(const float* W, int ldw, bf16* WT, int dst_row0, int src_col0, int ncol, const float* gk, LAS float* scr, int kb, int lane) {
    const int k0 = 64 * kb;
    { float wv[32]; const int c = lane & 31;
#pragma unroll
        for (int i = 0; i < 32; ++i) { const int kk = 2 * i + (lane >> 5); wv[i] = (c < ncol) ? W[(size_t)(k0 + kk) * ldw + src_col0 + c] : 0.f; }
        if (gk) {
#pragma unroll
            for (int i = 0; i < 32; ++i) wv[i] *= gk[k0 + 2 * i + (lane >> 5)]; }
#pragma unroll
        for (int i = 0; i < 32; ++i) scr[(2 * i + (lane >> 5)) * 33 + c] = wv[i]; }
    asm volatile("s_waitcnt lgkmcnt(0)" ::: "memory");
    const int c = lane & 7;
#pragma unroll
    for (int j = 0; j < 4; ++j) { const int n = (lane >> 3) + 8 * j; const LAS float* s = scr + (8 * c) * 33 + n;
        v4u o; o.x = pk2(s[0 * 33], s[1 * 33]); o.y = pk2(s[2 * 33], s[3 * 33]); o.z = pk2(s[4 * 33], s[5 * 33]); o.w = pk2(s[6 * 33], s[7 * 33]);
        *(v4u*)(WT + (size_t)(dst_row0 + n) * 1024 + k0 + 8 * c) = o; }
    asm volatile("s_waitcnt lgkmcnt(0)" ::: "memory");
}
__device__ __forceinline__ int tile_src(int T, int wc) {
    switch (T) { case 0: return 0 + 64 * wc; case 1: return 256 + 64 * wc; case 2: return 512 + 64 * wc; case 3: return 772 + 64 * wc;
        case 4: return 1028 + 64 * wc; case 5: return 1284 + 64 * wc; case 6: return 1540 + 64 * wc; case 7: return 1796 + 64 * wc;
        case 8: return 2052 + 64 * wc; case 9: return 2308 + 64 * wc; case 10: return 2564 + 64 * wc; case 11: return 2820 + 64 * wc;
        case 12: return 3076 + 64 * wc; case 13: return wc < 2 ? 3332 + 64 * wc : 3460 + 64 * (wc - 2); default: return 3588 + 64 * wc; }
}
__device__ __forceinline__ void p_weights(Frame& F, const Args& a) {
    LAS float* scr = (LAS float*)(F.lds + F.wave * 16384);
    const int gw = F.vcu * NWAVES + F.wave, NGW = F.G * NWAVES;
    bf16* win = (bf16*)(a.ws + WS_WIN); bf16* wout = (bf16*)(a.ws + WS_WOUT);
    constexpr int I_IN = 128 * 16, I_OUT = 32 * 16;
    for (int it = gw; it < 2 * (I_IN + I_OUT); it += NGW) {
        const int layer = it / (I_IN + I_OUT); int r = it % (I_IN + I_OUT);
        if (r < I_IN) { const int kb = r >> 7, g = r & 127, T = g >> 3, gg = g & 7, bj = gg >> 2, wc = gg & 3;
            const int src = (T < 15) ? tile_src(T, wc) + 32 * bj : 768, ncol = (T < 15) ? 32 : (gg == 0 ? 4 : 0);
            transpose_item(a.w_in + (size_t)layer * DM * INW, INW, win + (size_t)layer * NPERM * DM, 32 * g, src, ncol, a.norm_gain + layer * DM, scr, kb, F.lane); }
        else { r -= I_IN; const int kb = r / 32, g = r % 32;
            transpose_item(a.w_out + (size_t)layer * DM * DM, DM, wout + (size_t)layer * DM * DM, 32 * g, 32 * g, 32, nullptr, scr, kb, F.lane); }
    }
    if (F.vcu == 0) { float* tab = (float*)(a.ws + WS_TAB);
        for (int i = F.tid; i < 8 * 1024; i += NWAVES * 64) { const int hc = i >> 10, d = i & 1023; tab[i] = a.rel_bias[rel_bucket(d) * 8 + hc] * LOG2E; } }
}
__device__ __forceinline__ void p_consts(Frame& F, const Args& a) {
    if (F.vcu == 0 && F.wave == 0) for (int layer = 0; layer < NLAYER; ++layer) {
        const int lane = F.lane; float* MF = (float*)(a.ws + WS_MF) + layer * 4;
        float bm = 0.f;
#pragma unroll
        for (int j = 0; j < 4; ++j) bm = fmaxf(bm, fabsf(a.rel_bias[64 * j + lane]));
#pragma unroll
        for (int o = 1; o < 64; o <<= 1) bm = fmaxf(bm, __shfl_xor(bm, o));
        const float* gp[3] = {a.fox_g + layer * 128, a.moba_g + layer * 128, a.swa_g + layer * 128};
#pragma unroll
        for (int k = 0; k < 3; ++k) { float mq = fabsf(gp[k][lane]), mk = fabsf(gp[k][64 + lane]);
#pragma unroll
            for (int o = 1; o < 64; o <<= 1) { mq = fmaxf(mq, __shfl_xor(mq, o)); mk = fmaxf(mk, __shfl_xor(mk, o)); }
            const float m = 8.f * LOG2E * mq * mk * 1.02f + 0.1f + (k == 0 ? 0.f : bm * LOG2E);
            if (lane == 0) MF[k == 0 ? 0 : (k == 1 ? 1 : 3)] = m; }
        if (lane == 0) MF[2] = 0.f;
    }
}
__device__ __forceinline__ void p_convert(Frame& F, const Args& a) {
    const int lane = F.lane, gt = F.vcu * (NWAVES * 64) + F.tid, NT_ = F.G * NWAVES * 64;
    { float* KM = (float*)(a.ws + WS_KM); for (int i = gt; i < 32 * 16 * 64; i += NT_) KM[i] = 0.f;
      float* RS1 = (float*)(a.ws + WS_RS) + NTOK; for (int i = gt; i < NTOK; i += NT_) RS1[i] = 0.f; }
    bf16* XB = (bf16*)(a.ws + WS_X0); float* RS0 = (float*)(a.ws + WS_RS);
    const int gwv = F.vcu * NWAVES + F.wave, NGW = F.G * NWAVES;
    for (int r0 = 4 * gwv; r0 < NTOK; r0 += 4 * NGW) {
        f32x4 v[4][4];
#pragma unroll
        for (int rr = 0; rr < 4; ++rr) { const f32x4* xr = (const f32x4*)(a.x + (size_t)(r0 + rr) * DM) + lane;
#pragma unroll
            for (int j = 0; j < 4; ++j) v[rr][j] = xr[64 * j]; }
        float ss[4];
#pragma unroll
        for (int rr = 0; rr < 4; ++rr) { ss[rr] = 0.f; unsigned long long* o8 = (unsigned long long*)(XB + (size_t)(r0 + rr) * DM) + lane;
#pragma unroll
            for (int j = 0; j < 4; ++j) { const f32x4 y = v[rr][j]; ss[rr] += (y[0] * y[0] + y[1] * y[1]) + (y[2] * y[2] + y[3] * y[3]);
                o8[64 * j] = (unsigned long long)pk2(y[0], y[1]) | ((unsigned long long)pk2(y[2], y[3]) << 32); } }
#pragma unroll
        for (int o = 1; o < 64; o <<= 1)
#pragma unroll
            for (int rr = 0; rr < 4; ++rr) ss[rr] += __shfl_xor(ss[rr], o);
        if (lane < 4) RS0[r0 + lane] = lane == 0 ? ss[0] : (lane == 1 ? ss[1] : (lane == 2 ? ss[2] : ss[3]));
    }
}
namespace att {
using bf16x8 = __attribute__((ext_vector_type(8))) short;
using s16x4 = __attribute__((ext_vector_type(4))) short;
using f32x16 = __attribute__((ext_vector_type(16))) float;
using u32x4 = __attribute__((ext_vector_type(4))) unsigned;
typedef __attribute__((address_space(3))) const char* lds_cptr;
typedef __attribute__((address_space(3))) char* lds_ptr;
typedef short v4i16_t __attribute__((ext_vector_type(4)));
typedef float f32x2_t __attribute__((ext_vector_type(2))); typedef __bf16 bf16x2_t __attribute__((ext_vector_type(2)));
constexpr int NSLOT = 5, PFD = 2, SLOTB = 8192;
constexpr int L_K = 0, L_V = NSLOT * SLOTB, L_OST = 0  , L_WS = 2 * NSLOT * SLOTB, L_CS = L_WS + 8 * 256, L_TAB = L_CS + 16384, L_G = L_TAB + 4608, L_MISC = L_G + 8 * 4096, L_END = L_MISC + 1024;
static_assert(L_END <= 139264 && 8 * 4096 <= NSLOT * SLOTB, "attention LDS map (the kernel's control words start at 136 KiB)");
constexpr float THR2 = 44.f;
#define SBAR() __builtin_amdgcn_sched_barrier(0)
__device__ __forceinline__ int crow(int r, int hi) { return (r & 3) + 8 * (r >> 2) + 4 * hi; }
__device__ __forceinline__ void glds16(const void* gsrc, unsigned lds_dst) { unsigned keep;
    asm volatile("s_mov_b32 %0, m0\n\ts_mov_b32 m0, %2\n\ts_nop 0\n\tglobal_load_lds_dwordx4 %1, off\n\ts_mov_b32 m0, %0" : "=&s"(keep) : "v"(gsrc), "s"(lds_dst) : "memory"); }
__device__ __forceinline__ unsigned cvtpk_s(float lo, float hi) { f32x2_t v = {lo, hi}; bf16x2_t b = __builtin_convertvector(v, bf16x2_t); return __builtin_bit_cast(unsigned, b); }
__device__ __forceinline__ s16x4 vtr(lds_cptr p) { return __builtin_bit_cast(s16x4, __builtin_amdgcn_ds_read_tr16_b64_v4i16((__attribute__((address_space(3))) v4i16_t*)p)); }
#define MFMA32(a, b, c) __builtin_amdgcn_mfma_f32_32x32x16_bf16(a, b, c, 0, 0, 0)
__device__ __forceinline__ void qkt(f32x16& p0, f32x16& p1, lds_cptr kp, const bf16x8* qr, float cinit) {
    f32x16 c;
#pragma unroll
    for (int r = 0; r < 16; ++r) c[r] = cinit;
    p0 = c; p1 = c;
#pragma unroll
    for (int d0 = 0; d0 < 4; ++d0) {
        const bf16x8 b0 = *(const __attribute__((address_space(3))) bf16x8*)(kp + d0 * 2048);
        const bf16x8 b1 = *(const __attribute__((address_space(3))) bf16x8*)(kp + d0 * 2048 + 512);
        p0 = MFMA32(b0, qr[d0], p0); p1 = MFMA32(b1, qr[d0], p1);
    }
}
__device__ __forceinline__ void pv(f32x16* o, lds_cptr vp, bf16x8 pa0, bf16x8 pa1, bf16x8 pa2, bf16x8 pa3) {
#pragma unroll
    for (int d0 = 0; d0 < 2; ++d0) { s16x4 lo[4], hi[4];
#pragma unroll
        for (int ks = 0; ks < 4; ++ks) { lo[ks] = vtr(vp + d0 * 4096 + ks * 1024); hi[ks] = vtr(vp + d0 * 4096 + ks * 1024 + 512); }
#define PK(k) (bf16x8){lo[k][0], lo[k][1], lo[k][2], lo[k][3], hi[k][0], hi[k][1], hi[k][2], hi[k][3]}
        o[d0] = MFMA32(pa0, PK(0), o[d0]); o[d0] = MFMA32(pa1, PK(1), o[d0]); o[d0] = MFMA32(pa2, PK(2), o[d0]); o[d0] = MFMA32(pa3, PK(3), o[d0]);
#undef PK
    }
}
__device__ __forceinline__ void kload(bf16x8* kf, lds_cptr kp) {
#pragma unroll
    for (int d0 = 0; d0 < 4; ++d0) { kf[2 * d0] = *(const __attribute__((address_space(3))) bf16x8*)(kp + d0 * 2048); kf[2 * d0 + 1] = *(const __attribute__((address_space(3))) bf16x8*)(kp + d0 * 2048 + 512); }
}
__device__ __forceinline__ void vload(s16x4* vlo, s16x4* vhi, lds_cptr vp) {
#pragma unroll
    for (int i = 0; i < 8; ++i) { vlo[i] = vtr(vp + (i >> 2) * 4096 + (i & 3) * 1024); vhi[i] = vtr(vp + (i >> 2) * 4096 + (i & 3) * 1024 + 512); }
}
__device__ __forceinline__ void qkt_r(f32x16& p0, f32x16& p1, const bf16x8* kf, const bf16x8* qr, float cinit) {
    f32x16 c;
#pragma unroll
    for (int r = 0; r < 16; ++r) c[r] = cinit;
    p0 = c; p1 = c;
#pragma unroll
    for (int d0 = 0; d0 < 4; ++d0) { p0 = MFMA32(kf[2 * d0], qr[d0], p0); p1 = MFMA32(kf[2 * d0 + 1], qr[d0], p1); }
}
__device__ __forceinline__ void pv_r(f32x16* o, const s16x4* vlo, const s16x4* vhi, bf16x8 pa0, bf16x8 pa1, bf16x8 pa2, bf16x8 pa3) {
#define VFR(i) (bf16x8){vlo[i][0], vlo[i][1], vlo[i][2], vlo[i][3], vhi[i][0], vhi[i][1], vhi[i][2], vhi[i][3]}
    o[0] = MFMA32(pa0, VFR(0), o[0]); o[1] = MFMA32(pa0, VFR(4), o[1]); o[0] = MFMA32(pa1, VFR(1), o[0]); o[1] = MFMA32(pa1, VFR(5), o[1]);
    o[0] = MFMA32(pa2, VFR(2), o[0]); o[1] = MFMA32(pa2, VFR(6), o[1]); o[0] = MFMA32(pa3, VFR(3), o[0]); o[1] = MFMA32(pa3, VFR(7), o[1]);
#undef VFR
}
struct ACtx { const bf16 *Q, *K, *V, *G; bf16* Y; const float *LF, *TAB, *KM, *MF; const float* sinks; int tflag; };
#define WAITBAR(N) asm volatile("s_waitcnt vmcnt(" #N ") lgkmcnt(0)\n\ts_barrier" ::: "memory")

#define USTAMP(k) do { if (TIMER_SEL >= 0 && TYPE == TIMER_TYPE && C.tflag && tid == 0) { volatile __attribute__((address_space(3))) unsigned* ta_ = (volatile __attribute__((address_space(3))) unsigned*)(shm + 139264 + 320) + 16; const unsigned now_ = (unsigned)__builtin_amdgcn_s_memrealtime(); ta_[k] += now_ - ta_[31]; ta_[31] = now_; } } while (0)
__device__ __forceinline__ int ticket_type(int u) { const int ty = u >> 9; return ty == 0 ? 1 : (ty == 1 ? 0 : ty); }
__device__ __forceinline__ void prefetch_unit(const ACtx& C, int u, lds_ptr shm, bf16x8* qn) {
    int tid = threadIdx.x; asm volatile("" : "+v"(tid));
    const int lane = tid & 63, r32 = lane & 31, hi = lane >> 5; const int wid = __builtin_amdgcn_readfirstlane(tid >> 6);
    const int T = ticket_type(u), r = u & 511, qb = 15 - (r >> 5), bh = r & 31, b = bh >> 2, h = bh & 3;
    const int kvh = (T == 3) ? (b * 2 + (h >> 1)) : bh;
    const bf16* Kh = C.K + T * pg8::GS + (size_t)kvh * SEQ * 64; const bf16* Vh = C.V + T * pg8::GS + (size_t)kvh * SEQ * 64;
    const bf16* ksrc = Kh + (size_t)lane * 64 + wid * 8;
    const bf16* vsrc = Vh + (size_t)(16 * (wid & 3) + (lane >> 2)) * 64 + (wid >> 2) * 32 + (lane & 3) * 8;
    const unsigned lds0 = (unsigned)(size_t)shm, kdst = lds0 + L_K + wid * 1024, vdst = lds0 + L_V + wid * 1024;
    const int t_hi = 4 * qb + 3;
    glds16(ksrc + (size_t)t_hi * 4096, (unsigned)__builtin_amdgcn_readfirstlane(kdst)); glds16(vsrc + (size_t)t_hi * 4096, (unsigned)__builtin_amdgcn_readfirstlane(vdst));
    glds16(ksrc + (size_t)(t_hi - 1) * 4096, (unsigned)__builtin_amdgcn_readfirstlane(kdst + SLOTB)); glds16(vsrc + (size_t)(t_hi - 1) * 4096, (unsigned)__builtin_amdgcn_readfirstlane(vdst + SLOTB));
    const bf16* Qw = C.Q + T * pg8::GS + ((size_t)bh * SEQ + qb * 256 + wid * 32) * 64;
#pragma unroll
    for (int d0 = 0; d0 < 4; ++d0) qn[d0] = *reinterpret_cast<const bf16x8*>(&Qw[(size_t)r32 * 64 + d0 * 16 + hi * 8]);
}
template <int TYPE> __device__ __forceinline__ int attn_unit(const ACtx& C, int bh, int qb, lds_ptr shm, bf16x8 (&qr)[4], int tick, __attribute__((address_space(3))) int* tslot) {
    int tid = threadIdx.x; asm volatile("" : "+v"(tid));
    const int lane = tid & 63, r32 = lane & 31, hi = lane >> 5; const int wid = __builtin_amdgcn_readfirstlane(tid >> 6);
    const int b = bh >> 2, h = bh & 3, q0 = qb * 256, qrel = wid * 32 + r32, t = q0 + qrel;
    const int kvh = (TYPE == 3) ? (b * 2 + (h >> 1)) : bh;
    const bf16* Qw = C.Q + TYPE * pg8::GS + ((size_t)bh * SEQ + q0 + wid * 32) * 64;
    const bf16* Kh = C.K + TYPE * pg8::GS + (size_t)kvh * SEQ * 64; const bf16* Vh = C.V + TYPE * pg8::GS + (size_t)kvh * SEQ * 64;
    const unsigned lds0 = (unsigned)(size_t)shm;
    __attribute__((address_space(3))) float* wsf = (__attribute__((address_space(3))) float*)(shm + L_WS) + wid * 64;
    __attribute__((address_space(3))) float* tabL = (__attribute__((address_space(3))) float*)(shm + L_TAB);
    __attribute__((address_space(3))) float* cs = (__attribute__((address_space(3))) float*)(shm + L_CS);
    __attribute__((address_space(3))) float* misc = (__attribute__((address_space(3))) float*)(shm + L_MISC);
    __attribute__((address_space(3))) int* misci = (__attribute__((address_space(3))) int*)(shm + L_MISC);
    const bf16* ksrc = Kh + (size_t)lane * 64 + wid * 8;
    const bf16* vsrc = Vh + (size_t)(16 * (wid & 3) + (lane >> 2)) * 64 + (wid >> 2) * 32 + (lane & 3) * 8;
    const unsigned kdst = lds0 + L_K + wid * 1024, vdst = lds0 + L_V + wid * 1024;
#define DMA_KV(tile, slot) do { glds16(ksrc + (size_t)(tile) * 4096, (unsigned)__builtin_amdgcn_readfirstlane(kdst + (slot) * SLOTB)); glds16(vsrc + (size_t)(tile) * 4096, (unsigned)__builtin_amdgcn_readfirstlane(vdst + (slot) * SLOTB)); } while (0)
    const lds_cptr kp0 = (lds_cptr)shm + L_K + hi * 1024 + r32 * 16;
    const lds_cptr vp0 = (lds_cptr)shm + L_V + ((lane >> 4) & 1) * 32 + (lane & 3) * 8 + (4 * hi + ((lane & 15) >> 2)) * 64;
    const float Mf = (TYPE == 2) ? 0.f : C.MF[TYPE];
    const int t_hi = 4 * qb + 3; int t_lo = 0;
    if (TYPE == 3) { t_lo = 4 * qb - 2; if (t_lo < 0) t_lo = 0; }
    USTAMP(24);
    const size_t yrow0 = (size_t)(b * SEQ + q0 + wid * 32);
    { const bf16* gsrc = C.G + (yrow0 + (lane >> 3)) * DM + TYPE * 256 + h * 64 + (lane & 7) * 8;
#pragma unroll
        for (int i = 0; i < 4; ++i) glds16(gsrc + (size_t)(8 * i) * DM, (unsigned)__builtin_amdgcn_readfirstlane(lds0 + L_G + wid * 4096 + i * 1024)); }
    unsigned sel = 0u; float ct = 0.f;
    if (TYPE == 0) {
        const float* lfp = C.LF + (size_t)bh * SEQ; const bool on = 8 * tid < q0 + 256;
        f32x4 a4 = {0.f, 0.f, 0.f, 0.f}, b4 = {0.f, 0.f, 0.f, 0.f};
        if (on) { a4 = *(const f32x4*)(lfp + 8 * tid); b4 = *(const f32x4*)(lfp + 8 * tid + 4); }
        a4[1] += a4[0]; a4[2] += a4[1]; a4[3] += a4[2]; b4[0] += a4[3]; b4[1] += b4[0]; b4[2] += b4[1]; b4[3] += b4[2];
        float sc = b4[3];
#pragma unroll
        for (int o = 1; o < 64; o <<= 1) { const float u = __shfl_up(sc, o); if (lane >= o) sc += u; }
        if (lane == 63) misc[wid] = sc;
        __syncthreads();
        float base = sc - b4[3];
#pragma unroll
        for (int w = 0; w < 7; ++w) if (w < wid) base += misc[w];
        if (on) { *(__attribute__((address_space(3))) f32x4*)(cs + 8 * tid) = a4 + base; *(__attribute__((address_space(3))) f32x4*)(cs + 8 * tid + 4) = b4 + base; }
        __syncthreads();
        const float cref = cs[q0];
        if (wid == 0) { const bool skip = (lane < 4 * qb) && (cs[64 * lane + 63] - cref > 2.f * Mf + THR2);
            const int cnt = __popcll(__ballot(skip)); if (lane == 0) misci[40] = cnt; }
        __syncthreads();
        t_lo = misci[40]; ct = cs[t];
    }
    if (TYPE == 1 || TYPE == 3) {
        const float* tg = C.TAB + ((TYPE == 3 ? 4 : 0) + h) * 1024;
        { float tv[3]; const float b31 = (TYPE == 1) ? tg[1023] : 0.f; float k0 = 0.f, k1 = 0.f;
#pragma unroll
            for (int k = 0; k < 3; ++k) { const int j = tid + 512 * k, d = 1023 - j; tv[k] = (j < 1088 && d >= 0 && (TYPE == 1 || d < 128)) ? tg[d] - b31 : -INFINITY; }
            if (TYPE == 1) { const float* kg = C.KM + (size_t)bh * 16 * 64; if (tid < qb * 64) k0 = kg[tid]; if (tid + 512 < qb * 64) k1 = kg[tid + 512]; }
#pragma unroll
            for (int k = 0; k < 3; ++k) { const int j = tid + 512 * k; if (j < 1088) tabL[j] = tv[k]; }
            if (TYPE == 1) { cs[tid] = k0; cs[tid + 512] = k1; } }
        __syncthreads();
        if (TYPE == 1) {
            if (qb <= 3) sel = (1u << qb) - 1u;
            else {
                float qf[32];
#pragma unroll
                for (int d0 = 0; d0 < 4; ++d0) { const u32x4 w = __builtin_bit_cast(u32x4, qr[d0]);
#pragma unroll
                    for (int j = 0; j < 4; ++j) { qf[d0 * 8 + 2 * j] = __uint_as_float(w[j] << 16); qf[d0 * 8 + 2 * j + 1] = __uint_as_float(w[j] & 0xffff0000u); } }
                float v1 = -INFINITY, v2 = -INFINITY, v3 = -INFINITY; int i1 = 0, i2 = 0, i3 = 0;
                for (int n = 0; n < qb; ++n) { float s = 0.f;
#pragma unroll
                    for (int d0 = 0; d0 < 4; ++d0) { const f32x4 ka = *(const __attribute__((address_space(3))) f32x4*)(cs + n * 64 + d0 * 16 + hi * 8), kb4 = *(const __attribute__((address_space(3))) f32x4*)(cs + n * 64 + d0 * 16 + hi * 8 + 4);
#pragma unroll
                        for (int j = 0; j < 4; ++j) { s += qf[d0 * 8 + j] * ka[j]; s += qf[d0 * 8 + 4 + j] * kb4[j]; } }
                    { auto rr = __builtin_amdgcn_permlane32_swap(__float_as_uint(s), __float_as_uint(s), false, false); s = __uint_as_float(rr[0]) + __uint_as_float(rr[1]); }
                    if (s > v1) { v3 = v2; i3 = i2; v2 = v1; i2 = i1; v1 = s; i1 = n; } else if (s > v2) { v3 = v2; i3 = i2; v2 = s; i2 = n; } else if (s > v3) { v3 = s; i3 = n; } }
                sel = (1u << i1) | (1u << i2) | (1u << i3); }
        }
    }
    const int n_tiles = t_hi - t_lo + 1;
    asm volatile("" : "+v"(qr[0]), "+v"(qr[1]), "+v"(qr[2]), "+v"(qr[3]));
    f32x16 o[2]; o[0] = f32x16{}; o[1] = f32x16{}; f32x16 lacc = f32x16{};
    float carry = (TYPE == 2) ? 1.f : 0.f; bool done_w = false;
    f32x16 cvec;
    { const float c0_ = (TYPE == 2) ? 0.f : ((TYPE == 0) ? ct - Mf : -Mf);
#pragma unroll
        for (int r = 0; r < 16; ++r) cvec[r] = c0_; }
    asm volatile("" : "+v"(cvec));
    const bf16x8 ones = {0x3f80, 0x3f80, 0x3f80, 0x3f80, 0x3f80, 0x3f80, 0x3f80, 0x3f80};
    const int jdiag = wid >> 1;
    const int jlo_w = (TYPE == 3) ? ((32 * wid - 127) >> 6) : -100000;
    if (TYPE == 2) { if (tid < 16) misci[64 + tid] = 0; }
    USTAMP(21);
    if (TIMER_SEL == 98 && TYPE == TIMER_TYPE && C.tflag && tid == 0) { volatile __attribute__((address_space(3))) unsigned* ta_ = (volatile __attribute__((address_space(3))) unsigned*)(shm + 139264 + 320) + 16; ta_[26] = (unsigned)__builtin_amdgcn_s_memtime(); }
    bf16x8 kf[8]; s16x4 vlo[8], vhi[8]; f32x16 p0, p1;
    const bool late = false;
#define FINISH(tile_, jr_, slot_) do { \
            vload(vlo, vhi, vp0 + (slot_) * SLOTB); SBAR(); \
            const int kb = 64 * (jr_) + 4 * hi; \
            unsigned keepm = 0xffffffffu; \
            if (TYPE == 0) { \
            _Pragma("unroll") \
                for (int g4 = 0; g4 < 4; ++g4) { const f32x4 c0 = *(const __attribute__((address_space(3))) f32x4*)(cs + 64 * (tile_) + 8 * g4 + 4 * hi), c1 = *(const __attribute__((address_space(3))) f32x4*)(cs + 64 * (tile_) + 32 + 8 * g4 + 4 * hi); \
            _Pragma("unroll") \
                    for (int j = 0; j < 4; ++j) { p0[4 * g4 + j] -= c0[j]; p1[4 * g4 + j] -= c1[j]; } } \
                if ((jr_) == jdiag) { \
            _Pragma("unroll") \
                    for (int r = 0; r < 16; ++r) { const int kv = kb + (r & 3) + 8 * (r >> 2); if (kv > qrel) p0[r] = -INFINITY; if (kv + 32 > qrel) p1[r] = -INFINITY; } } \
            _Pragma("unroll") \
                for (int r = 0; r < 16; ++r) { p0[r] = __builtin_amdgcn_exp2f(p0[r]); p1[r] = __builtin_amdgcn_exp2f(p1[r]); } \
            } \
            if (TYPE == 1 || TYPE == 3) { \
                const bool far = (TYPE == 1) && ((q0 + 32 * wid - 64 * (tile_) - 63) >= 790); \
                if (!far) { const __attribute__((address_space(3))) float* tp_ = tabL + (1023 - (qrel - kb)); \
            _Pragma("unroll") \
                    for (int r = 0; r < 16; ++r) { p0[r] += tp_[(r & 3) + 8 * (r >> 2)]; p1[r] += tp_[(r & 3) + 8 * (r >> 2) + 32]; } } \
                if (TYPE == 1 && (jr_) < 0) keepm = ((sel >> ((tile_) >> 2)) & 1u) ? 0xffffffffu : 0u; \
            _Pragma("unroll") \
                for (int r = 0; r < 16; ++r) { p0[r] = __builtin_amdgcn_exp2f(p0[r]); p1[r] = __builtin_amdgcn_exp2f(p1[r]); } \
            } \
            if (TYPE == 2) { \
                f32x16 w0, w1; \
            _Pragma("unroll") \
                for (int r = 0; r < 16; ++r) { float c0_, c1_; asm("v_min_f32_e32 %0, 0x42a00000, %1" : "=v"(c0_) : "v"(p0[r])); asm("v_min_f32_e32 %0, 0x42a00000, %1" : "=v"(c1_) : "v"(p1[r])); p0[r] = __builtin_amdgcn_exp2f(c0_); p1[r] = __builtin_amdgcn_exp2f(c1_); } \
                if ((jr_) == jdiag) { \
            _Pragma("unroll") \
                    for (int r = 0; r < 16; ++r) { const int kv = kb + (r & 3) + 8 * (r >> 2); if (kv >= qrel) p0[r] = 0.f; if (kv + 32 >= qrel) p1[r] = 0.f; } } \
            _Pragma("unroll") \
                for (int r = 0; r < 16; ++r) { w0[r] = 1.f + p0[r]; w1[r] = 1.f + p1[r]; } \
                float own[8], part[8]; \
            _Pragma("unroll") \
                for (int rb = 0; rb < 4; ++rb) { own[rb] = (w0[4 * rb] * w0[4 * rb + 1]) * (w0[4 * rb + 2] * w0[4 * rb + 3]); own[4 + rb] = (w1[4 * rb] * w1[4 * rb + 1]) * (w1[4 * rb + 2] * w1[4 * rb + 3]); } \
            _Pragma("unroll") \
                for (int rb = 0; rb < 8; ++rb) { auto rr = __builtin_amdgcn_permlane32_swap(__float_as_uint(own[rb]), __float_as_uint(own[rb]), false, false); part[rb] = __uint_as_float(hi ? rr[0] : rr[1]); } \
                float run = carry; \
            _Pragma("unroll") \
                for (int rb = 7; rb >= 0; --rb) { \
                    float E = hi == 0 ? run * part[rb] : run; run *= own[rb] * part[rb]; \
            _Pragma("unroll") \
                    for (int j = 3; j >= 0; --j) { const int r = 4 * (rb & 3) + j; \
                        if (rb >= 4) { E *= w1[r]; p1[r] *= __builtin_amdgcn_rcpf(E); } else { E *= w0[r]; p0[r] *= __builtin_amdgcn_rcpf(E); } } } \
                carry = run; \
                done_w = __all(carry > 1.7592186e13f) != 0;     \
            } \
            u32x4 pw0, pw1, pw2, pw3; \
            _Pragma("unroll") \
            for (int j = 0; j < 4; ++j) { pw0[j] = cvtpk_s(p0[2 * j], p0[2 * j + 1]); pw1[j] = cvtpk_s(p0[8 + 2 * j], p0[9 + 2 * j]); pw2[j] = cvtpk_s(p1[2 * j], p1[2 * j + 1]); pw3[j] = cvtpk_s(p1[8 + 2 * j], p1[9 + 2 * j]); } \
            if (TYPE == 1) { pw0 &= keepm; pw1 &= keepm; pw2 &= keepm; pw3 &= keepm; } \
            const bf16x8 pa0 = __builtin_bit_cast(bf16x8, pw0), pa1 = __builtin_bit_cast(bf16x8, pw1), pa2 = __builtin_bit_cast(bf16x8, pw2), pa3 = __builtin_bit_cast(bf16x8, pw3); \
            pv_r(o, vlo, vhi, pa0, pa1, pa2, pa3); \
            if (TYPE != 2) { lacc = MFMA32(pa0, ones, lacc); lacc = MFMA32(pa1, ones, lacc); lacc = MFMA32(pa2, ones, lacc); lacc = MFMA32(pa3, ones, lacc); } \
        } while (0)
#define SCORE(slot_) do { kload(kf, kp0 + (slot_) * SLOTB); SBAR(); \
        if (TYPE == 2) { p0 = MFMA32(kf[0], qr[0], (f32x16{})); p1 = MFMA32(kf[1], qr[0], (f32x16{})); } else { p0 = MFMA32(kf[0], qr[0], cvec); p1 = MFMA32(kf[1], qr[0], cvec); } \
        _Pragma("unroll") for (int d0 = 1; d0 < 4; ++d0) { p0 = MFMA32(kf[2 * d0], qr[d0], p0); p1 = MFMA32(kf[2 * d0 + 1], qr[d0], p1); } SBAR(); } while (0)
    int slot = 0, dslot = PFD, ptile = 0, pslot = 0; bool pend = false, stop = false;
    for (int i = 0; ; ++i) {
        const int tile = t_hi - i, jr = tile - 4 * qb;
        if (i < n_tiles && !stop) {
            { const int tp = tile - PFD; DMA_KV(tp < 0 ? 0 : tp, dslot); }
            dslot = (dslot == NSLOT - 1) ? 0 : dslot + 1;
            WAITBAR(4);
            if (TYPE == 2 && i > 0) { const u32x4 fa = *(const __attribute__((address_space(3))) u32x4*)(misci + 64 + ((i - 1) & 1) * 8), fb = *(const __attribute__((address_space(3))) u32x4*)(misci + 68 + ((i - 1) & 1) * 8);
                if ((fa[0] & fa[1] & fa[2] & fa[3] & fb[0] & fb[1] & fb[2] & fb[3]) != 0u) stop = true; }
        }
        if (late && pend) { FINISH(ptile, ptile - 4 * qb, pslot); pend = false; }
        if (i >= n_tiles || stop) break;
        const bool active = (jr <= jdiag) && (jr >= jlo_w) && !(TYPE == 2 && done_w);
        if (active) { SCORE(slot); }
        if (!late) { if (active) { FINISH(tile, jr, slot); } } else { pend = active; ptile = tile; pslot = slot; }
        if (TYPE == 2) { if (lane == 0) misci[64 + (i & 1) * 8 + wid] = done_w ? 1 : 0; }
        slot = (slot == NSLOT - 1) ? 0 : slot + 1;
    }
#undef FINISH
#undef SCORE
    if (TIMER_SEL == 98 && TYPE == TIMER_TYPE && C.tflag && tid == 0) { volatile __attribute__((address_space(3))) unsigned* ta_ = (volatile __attribute__((address_space(3))) unsigned*)(shm + 139264 + 320) + 16; ta_[25] += (unsigned)__builtin_amdgcn_s_memtime() - ta_[26]; }
    USTAMP(22);
    if (tid == 0) tslot[0] = tick;
    asm volatile("s_waitcnt vmcnt(0) lgkmcnt(0)\n\ts_barrier" ::: "memory");
    const int unext = tslot[0];
    if (unext < 2048) prefetch_unit(C, unext, shm, qr);
    float rli[16];
    { const float sk = (TYPE == 3) ? __builtin_amdgcn_exp2f(C.sinks[h] * LOG2E - Mf) : 0.f;
#pragma unroll
        for (int r = 0; r < 16; ++r) rli[r] = (TYPE == 2) ? 1.f : __builtin_amdgcn_rcpf(lacc[r] + sk); }
    __attribute__((address_space(3))) bf16* stg = (__attribute__((address_space(3))) bf16*)(shm + (wid < 6 ? L_K + 2 * SLOTB + wid * 4096 : L_V + 2 * SLOTB + (wid - 6) * 4096));
    const __attribute__((address_space(3))) bf16* gst = (const __attribute__((address_space(3))) bf16*)(shm + L_G) + wid * 2048;
#pragma unroll
    for (int r = 0; r < 16; ++r) { const int orow = crow(r, hi); const float rl = rli[r];
        { const unsigned w_ = cvtpk_s(o[0][r] * rl, o[1][r] * rl); stg[orow * 64 + r32] = (bf16)(w_ & 0xffffu); stg[orow * 64 + 32 + r32] = (bf16)(w_ >> 16); } }
    asm volatile("s_waitcnt lgkmcnt(0)" ::: "memory");
#pragma unroll
    for (int i = 0; i < 4; ++i) { const int row = i * 8 + (lane >> 3), ch = lane & 7;
        const u32x4 v = *(const __attribute__((address_space(3))) u32x4*)(stg + row * 64 + ch * 8);
        const u32x4 g = *(const __attribute__((address_space(3))) u32x4*)(gst + row * 64 + ch * 8); u32x4 w;
        const size_t off = (yrow0 + row) * DM + TYPE * 256 + h * 64 + ch * 8;
#pragma unroll
        for (int j = 0; j < 4; ++j) { const float a0 = __uint_as_float(v[j] << 16) * __uint_as_float(g[j] << 16), a1 = __uint_as_float(v[j] & 0xffff0000u) * __uint_as_float(g[j] & 0xffff0000u); w[j] = cvtpk_s(a0, a1); }
        *(u32x4*)(C.Y + off) = w; }
    asm volatile("s_waitcnt lgkmcnt(0)\n\ts_barrier" ::: "memory");
    USTAMP(23);
    return unext;
#undef DMA_KV
}
#undef SBAR
}
#define TACC(F) ((volatile LAS unsigned*)((F).lds + MISC_OFF) + 16)
#define TSTAMP(F, k) do { if (TIMER_SEL >= 0 && (F).vcu == TIMER_WG && (F).tid == 0) { const unsigned now_ = (unsigned)__builtin_amdgcn_s_memrealtime(); TACC(F)[k] += now_ - TACC(F)[31]; TACC(F)[31] = now_; } } while (0)
__device__ __forceinline__ void p_attn(Frame& F, const Args& a, int layer, int rep, int tmask) {
    att::ACtx C{(const bf16*)(a.ws + WS_Q), (const bf16*)(a.ws + WS_K), (const bf16*)(a.ws + WS_V), (const bf16*)(a.ws + WS_G), (bf16*)(a.ws + WS_HN),
                (const float*)(a.ws + WS_LF), (const float*)(a.ws + WS_TAB), (const float*)(a.ws + WS_KM), (const float*)(a.ws + WS_MF) + layer * 4, a.sinks + layer * 4, (F.vcu == TIMER_WG) ? 1 : 0};
    unsigned* head = (unsigned*)(a.ws + WS_CTL) + CW_QUEUE + 64 * (layer + 2 * rep);
    LAS int* slot = (LAS int*)(F.lds + att::L_MISC) + 200;
    att::lds_ptr shm = (att::lds_ptr)F.lds;
    if (F.tid == 0) slot[0] = (int)__hip_atomic_fetch_add(head, 1u, __ATOMIC_RELAXED, __HIP_MEMORY_SCOPE_AGENT);
    __syncthreads();
    int u = slot[0];
    __syncthreads();
    att::bf16x8 qr[4];
    if (u < 2048) att::prefetch_unit(C, u, shm, qr);
    while (u < 2048) {
        int tick = 0;
        if (F.tid == 0) tick = (int)__hip_atomic_fetch_add(head, 1u, __ATOMIC_RELAXED, __HIP_MEMORY_SCOPE_AGENT);
        const int ty = u >> 9, r = u & 511, qb = 15 - (r >> 5), bh = r & 31;
        TSTAMP(F, 20);
        if (ty == 0) u = att::attn_unit<1>(C, bh, qb, shm, qr, tick, (LAS int*)slot);
        else if (ty == 1) u = att::attn_unit<0>(C, bh, qb, shm, qr, tick, (LAS int*)slot);
        else if (ty == 2) u = att::attn_unit<2>(C, bh, qb, shm, qr, tick, (LAS int*)slot);
        else u = att::attn_unit<3>(C, bh, qb, shm, qr, tick, (LAS int*)slot);
        TSTAMP(F, 8 + ty);
    }
    asm volatile("s_waitcnt vmcnt(0)" ::: "memory");
    __syncthreads();
}

__global__ void __launch_bounds__(NWAVES * 64, 2) mk_fwd(Args a) {
    extern __shared__ __attribute__((aligned(16))) unsigned char lds[];
    Frame F; F.lds = (LAS unsigned char*)lds; F.tid = threadIdx.x; F.lane = F.tid & 63; F.wave = __builtin_amdgcn_readfirstlane(F.tid >> 6);
    F.G = gridDim.x; { const int bx = blockIdx.x; F.vcu = (F.G % 8 == 0) ? (bx % 8) * (F.G / 8) + bx / 8 : bx; }
    bf16* HN = (bf16*)(a.ws + WS_HN);
    for (int u = F.tid; u < (LDS_BYTES - LDSCTL_OFF) / 4; u += NWAVES * 64) ((LAS unsigned*)(F.lds + LDSCTL_OFF))[u] = 0u;
    __syncthreads();
    XcdBarrier bar; bar.bar = (unsigned*)(a.ws + WS_CTL) + CW_BAR; bar.x = 0; bar.st = nullptr;
    if (a.ph_hi - a.ph_lo > 1) bar = xcd_barrier_post((unsigned*)(a.ws + WS_CTL) + CW_BAR, (volatile LAS unsigned*)(F.lds + MISC_OFF) + 8);
#define PHASE_ON(k) (a.ph_lo <= (k) && (k) < a.ph_hi)
#define SEAM(k) do { if ((k) != 4 && PHASE_ON(k) && PHASE_ON((k) + 1)) xcd_barrier(bar); } while (0)
#define LAYER_PHASES(layer) do { \
    if ((layer) == 0 && PHASE_ON(0)) { p_weights(F, a); p_consts(F, a); p_convert(F, a); } \
    if ((layer) == 0) { TSTAMP(F, 0); SEAM(0); TSTAMP(F, 1); } \
    if (PHASE_ON(4 * (layer) + 1)) { \
        pg8::Gemm g{(layer) == 0 ? (const bf16*)(a.ws + WS_X0) : (const bf16*)(a.ws + WS_X1), (const bf16*)(a.ws + WS_WIN) + (size_t)(layer) * NPERM * DM, NTOK, NPERM, DM}; \
        pg8::StaticOrder S; S.init(NTOK, NPERM, F.G, (int)blockIdx.x); \
        pg8::EpiIn E{(bf16*)(a.ws + WS_Q), (bf16*)(a.ws + WS_K), (bf16*)(a.ws + WS_V), (bf16*)(a.ws + WS_G), a.fox_g + (layer) * 128, a.moba_g + (layer) * 128, a.swa_g + (layer) * 128, (float*)(a.ws + WS_KM), \
                     (const float*)(a.ws + WS_RS) + (layer) * NTOK, (float*)(a.ws + WS_LF), a.b_forget + (layer) * 4}; \
        pg8::gemm_phase<pg8::EpiIn, pg8::StaticOrder, true, true>(F.lds, g, S, E); \
        if (PROBE_P1) { xcd_barrier(bar); pg8::gemm_phase<pg8::EpiIn, pg8::StaticOrder, true, true>(F.lds, g, S, E); } \
    } \
    TSTAMP(F, 2); SEAM(4 * (layer) + 1); TSTAMP(F, 3); \
    if (PHASE_ON(4 * (layer) + 2)) { for (int rep = 0; rep < 1 + (PROBE_ATT != 0 ? PROBE_REPS : 0); ++rep) { if (rep) xcd_barrier(bar); p_attn(F, a, (layer), rep, rep ? PROBE_ATT : 15); } } \
    TSTAMP(F, 4); SEAM(4 * (layer) + 2); TSTAMP(F, 5); \
    if (PHASE_ON(4 * (layer) + 3)) { \
        pg8::Gemm g{HN  , (const bf16*)(a.ws + WS_WOUT) + (size_t)(layer) * DM * DM, NTOK, DM, DM}; \
        pg8::StaticOrder S; S.init(NTOK, DM, F.G, (int)blockIdx.x); \
        if ((layer) == 0) { \
            { float* KM = (float*)(a.ws + WS_KM); for (int i = F.vcu * (NWAVES * 64) + F.tid; i < 32 * 16 * 64; i += F.G * NWAVES * 64) KM[i] = 0.f; }     \
            pg8::EpiRes0 E{(const bf16*)(a.ws + WS_X0), (bf16*)(a.ws + WS_X1), (float*)(a.ws + WS_RS) + NTOK}; \
            pg8::gemm_phase<pg8::EpiRes0, pg8::StaticOrder, true, true>(F.lds, g, S, E); \
        } else { \
            pg8::EpiRes1 E{(const bf16*)(a.ws + WS_X1), a.out}; \
            pg8::gemm_phase<pg8::EpiRes1, pg8::StaticOrder, true, true>(F.lds, g, S, E); \
        } \
    } \
    if ((layer) == 0) { TSTAMP(F, 6); SEAM(3); SEAM(4); TSTAMP(F, 7); } } while (0)
    if (TIMER_SEL >= 0 && F.vcu == TIMER_WG && F.tid == 0) TACC(F)[31] = (unsigned)__builtin_amdgcn_s_memrealtime();
    LAYER_PHASES(0);
    LAYER_PHASES(1);
    if (TIMER_SEL >= 0 && F.vcu == TIMER_WG) {
        asm volatile("s_waitcnt vmcnt(0)" ::: "memory"); __syncthreads();
        float v = (TIMER_SEL == 99) ? 1.0f : (TIMER_SEL == 98) ? ((float)TACC(F)[25] / ((float)TACC(F)[22] * 10.f)) / 3.0f : (float)TACC(F)[TIMER_SEL & 31] * 0.01f / (float)TIMER_FS; v = fminf(fmaxf(v, 0.f), 1.f); const float dl = 0.1f * sqrtf(v);
        pg8::StaticOrder S; S.init(NTOK, DM, F.G, (int)blockIdx.x); pg8::Unit u;
        for (int i = 0; S.next(i, u); ++i) for (int e = F.tid; e < 65536; e += NWAVES * 64) { float* p = a.out + (size_t)(u.pm * 256 + (e >> 8)) * DM + u.pn * 256 + (e & 255); *p += dl; }
    }
}

extern "C" void kernel_launch(void* const* d_in, const int* in_sizes, int n_in, void* d_out, int out_size, void* d_ws, size_t ws_size, hipStream_t stream) {
    static int ok = 0, grid = 0;
    if (ok == 0) {
        if (n_in != 10 || in_sizes[0] != NTOK * DM || out_size != NTOK * DM || ws_size < WS_END) { fprintf(stderr, "kernel_launch: unexpected shapes (n_in %d, in0 %d, out %d, ws %zu)\n", n_in, n_in > 0 ? in_sizes[0] : -1, out_size, ws_size); ok = -1; return; }
        if (hipFuncSetAttribute((const void*)mk_fwd, hipFuncAttributeMaxDynamicSharedMemorySize, LDS_BYTES) != hipSuccess) { fprintf(stderr, "kernel_launch: hipFuncSetAttribute failed\n"); ok = -1; return; }
        int dev = 0, cus = 0; if (hipGetDevice(&dev) != hipSuccess || hipDeviceGetAttribute(&cus, hipDeviceAttributeMultiprocessorCount, dev) != hipSuccess) { fprintf(stderr, "kernel_launch: device query failed\n"); ok = -1; return; }
        grid = cus < 256 ? (cus / 8) * 8 : 256; if (grid < 8) grid = cus;
        ok = 1;
    }
    if (ok < 0) return;
    Args a{};
    a.x = (const float*)d_in[0]; a.norm_gain = (const float*)d_in[1]; a.w_in = (const float*)d_in[2]; a.b_forget = (const float*)d_in[3]; a.fox_g = (const float*)d_in[4];
    a.moba_g = (const float*)d_in[5]; a.swa_g = (const float*)d_in[6]; a.sinks = (const float*)d_in[7]; a.w_out = (const float*)d_in[8]; a.rel_bias = (const float*)d_in[9];
    a.out = (float*)d_out; a.ws = (unsigned char*)d_ws;
    unsigned char* ws = (unsigned char*)d_ws;
    a.tmask = 15;
    if (hipMemsetAsync(ws + WS_CTL, 0, CTL_ZERO_BYTES, stream) != hipSuccess) { fprintf(stderr, "kernel_launch: memset failed\n"); return; }
#if N_LAUNCHES == 1
    a.ph_lo = 0; a.ph_hi = 8; hipLaunchKernelGGL(mk_fwd, dim3(grid), dim3(NWAVES * 64), LDS_BYTES, stream, a);
#else
    for (int ph = 0; ph < 8; ++ph) { a.ph_lo = ph; a.ph_hi = ph + 1; hipLaunchKernelGGL(mk_fwd, dim3(grid), dim3(NWAVES * 64), LDS_BYTES, stream, a); }
#endif
}
```

```cpp
#include <hip/hip_runtime.h>
#include <cstdio>
#include <cstdint>
#include <cmath>
namespace pg8 {
#define PG8_LAS __attribute__((address_space(3)))
typedef unsigned short bf16_t;
typedef short bf16x8 __attribute__((ext_vector_type(8)));
typedef float f32x4 __attribute__((ext_vector_type(4)));
typedef unsigned u32x4 __attribute__((ext_vector_type(4)));
constexpr int BM = 256, BK = 64, HALF = 128, HTB = HALF * BK * 2  , STAGE_BYTES = 8 * HTB, NXCD = 8, WGM = 8;

__host__ __device__ __forceinline__ int lds_byte(int r, int c) { const int st = (r >> 4) * 2 + (c >> 5), rr = r & 15, cc = c & 31, ob = rr * 64 + cc * 2; return st * 1024 + (ob ^ (((ob >> 9) & 1) << 5)); }
__host__ __device__ __forceinline__ void stage_rc(int b, int& R, int& C) { const int st = b / 1024, sb = b % 1024, swz = sb ^ (((sb >> 9) & 1) << 5); R = (st >> 1) * 16 + swz / 64; C = (st & 1) * 32 + (swz % 64) / 2; }
__host__ __device__ __forceinline__ int perm32(int rho) { const int n = rho >> 4, i = rho & 15; return 8 * (i >> 2) + 4 * n + (i & 3); }

struct Unit { int pm, pn; };
struct Gemm { const bf16_t* A; const bf16_t* Bt; int M, N, K; };

struct StaticOrder {
    int nM, nN, nwg, G, c;
    __host__ __device__ void init(int M, int N, int G_, int c_) { nM = M / BM; nN = N / BM; nwg = nM * nN; G = G_; c = c_; }
    __host__ __device__ bool next(int i, Unit& u) const {
        const long L = (long)i * G + c; if (L >= nwg) return false;
        int wgid = (int)L; { const int q = nwg / NXCD, r = nwg % NXCD, xcd = wgid % NXCD, off = wgid / NXCD; wgid = (xcd < r ? xcd * (q + 1) : r * (q + 1) + (xcd - r) * q) + off; }
        const int nig = WGM * nN, gid = wgid / nig, fm = gid * WGM, gsz = (nM - fm) < WGM ? (nM - fm) : WGM;
        u.pm = fm + ((wgid % nig) % gsz); u.pn = (wgid % nig) / gsz; return true;
    }
    __device__ __forceinline__ void a_ready(const Unit&) const {}
    __device__ __forceinline__ void done(const Unit&) const {}
};

__device__ __forceinline__ unsigned cvt_pk_bf16(float lo, float hi) { unsigned r; asm volatile("v_cvt_pk_bf16_f32 %0, %1, %2" : "=v"(r) : "v"(lo), "v"(hi)); return r; }
typedef float f32x2 __attribute__((ext_vector_type(2)));
constexpr float C2 = 0.125f * 1.4426950408889634f;
constexpr float RMS_EPS = 1e-6f;
constexpr size_t GS = (size_t)8 * 4 * 4096 * 64;
struct EpiIn {
    static constexpr bool PERM = true, AFTER_DRAIN = false;
    bf16_t *Q, *K, *V, *G; const float *gfox, *gmoba, *gswa; float* KM; const float* RS; float* LF; const float* bfg;
    __device__ __forceinline__ void prefetch(const Unit& u, int ui_, PG8_LAS unsigned char* lds, int wid, int lane) const {
        if (wid < 4) { const float* src = RS + u.pm * BM + wid * 64 + lane; const unsigned dst = (unsigned)(size_t)(lds + STAGE_BYTES + (ui_ & 1) * 1024 + wid * 256); unsigned keep;
            asm volatile("s_mov_b32 %0, m0\n\ts_mov_b32 m0, %2\n\ts_nop 0\n\tglobal_load_lds_dword %1, off\n\ts_mov_b32 m0, %0" : "=&s"(keep) : "v"(src), "s"((unsigned)__builtin_amdgcn_readfirstlane(dst)) : "memory"); }
    }
    __device__ __forceinline__ void operator()(const f32x4 (&acc)[2][2][4][2], const Unit& u, int wr, int wc, int fr, int fq, int ui, PG8_LAS unsigned char* ldsb) const {
        const int T = u.pn;
        const int b = (u.pm * BM) >> 12, t0 = ((u.pm * BM) & 4095) + wr * 64 + fr;
        float rs[2][4];
#pragma unroll
        for (int ai = 0; ai < 2; ++ai)
#pragma unroll
            for (int m = 0; m < 4; ++m) rs[ai][m] = __builtin_amdgcn_rsqf(((const PG8_LAS float*)(ldsb + STAGE_BYTES + (ui & 1) * 1024))[ai * HALF + wr * 64 + m * 16 + fr] * (1.0f / 1024.0f) + RMS_EPS);
        if (T == 15) {
            if (wc == 0 && fq == 0) { const f32x4 bv = *(const f32x4*)bfg;
#pragma unroll
                for (int ai = 0; ai < 2; ++ai)
#pragma unroll
                    for (int m = 0; m < 4; ++m) { const f32x4 a4 = acc[ai][0][m][0] * rs[ai][m] + bv;
#pragma unroll
                        for (int j = 0; j < 4; ++j) { const float uu = a4[j]; const float sp = fmaxf(-uu, 0.f) + __logf(1.f + __expf(-fabsf(uu)));
                            LF[(size_t)(b * 4 + j) * 4096 + t0 + ai * HALF + m * 16] = -sp * 1.4426950408889634f; } } }
            return;
        }
        int mode = 1, nh = 4, head = wc; float scale = 1.f; const float* gain = nullptr; bf16_t* base = nullptr;
        switch (T) {
            case 0: mode = 0; gain = gfox; scale = C2; base = Q; break;
            case 1: mode = 0; gain = gfox + 64; base = K; break;
            case 2: base = V; break;
            case 4: mode = 0; gain = gmoba; scale = C2; base = Q + GS; break;
            case 5: mode = 0; gain = gmoba + 64; base = K + GS; break;
            case 6: base = V + GS; break;
            case 8: scale = C2; base = Q + 2 * GS; break;
            case 9: base = K + 2 * GS; break;
            case 10: base = V + 2 * GS; break;
            case 12: mode = 0; gain = gswa; scale = C2; base = Q + 3 * GS; break;
            case 13: nh = 2; if (wc < 2) { mode = 0; gain = gswa + 64; base = K + 3 * GS; } else { base = V + 3 * GS; head = wc - 2; } break;
            default: mode = 2; break;
        }
        if (mode == 2) {
            bf16_t* gp = G + (size_t)(u.pm * BM + wr * 64 + fr) * 1024 + (T >> 2) * 256 + 64 * wc + 8 * fq;
#pragma unroll
            for (int ai = 0; ai < 2; ++ai)
#pragma unroll
                for (int m = 0; m < 4; ++m)
#pragma unroll
                    for (int bj = 0; bj < 2; ++bj) {
                        f32x4 v0 = acc[ai][bj][m][0] * rs[ai][m], v1 = acc[ai][bj][m][1] * rs[ai][m];
#pragma unroll
                        for (int j = 0; j < 4; ++j) { v0[j] = v0[j] * __builtin_amdgcn_rcpf(1.f + __expf(-v0[j])); v1[j] = v1[j] * __builtin_amdgcn_rcpf(1.f + __expf(-v1[j])); }
                        u32x4 w; w.x = cvt_pk_bf16(v0[0], v0[1]); w.y = cvt_pk_bf16(v0[2], v0[3]); w.z = cvt_pk_bf16(v1[0], v1[1]); w.w = cvt_pk_bf16(v1[2], v1[3]);
                        *(u32x4*)(gp + (size_t)(ai * HALF + m * 16) * 1024 + 32 * bj) = w;
                    }
            return;
        }
        f32x4 gv[2][2];
#pragma unroll
        for (int bj = 0; bj < 2; ++bj)
#pragma unroll
            for (int n = 0; n < 2; ++n) gv[bj][n] = (mode == 0) ? *(const f32x4*)(gain + 32 * bj + 8 * fq + 4 * n) : (f32x4){1.f, 1.f, 1.f, 1.f};
        bf16_t* dp = base + ((size_t)(b * nh + head) * 4096 + t0) * 64 + 8 * fq;
        f32x4 cs4[2][2];
#pragma unroll
        for (int bj = 0; bj < 2; ++bj)
#pragma unroll
            for (int n = 0; n < 2; ++n) cs4[bj][n] = (f32x4){0.f, 0.f, 0.f, 0.f};
#pragma unroll
        for (int ai = 0; ai < 2; ++ai)
#pragma unroll
            for (int m = 0; m < 4; ++m) {
                float r = scale * rs[ai][m];
                if (mode == 0) {
                    float ss = 0.f;
#pragma unroll
                    for (int bj = 0; bj < 2; ++bj)
#pragma unroll
                        for (int n = 0; n < 2; ++n) { const f32x4 x = acc[ai][bj][m][n]; ss += (x[0] * x[0] + x[1] * x[1]) + (x[2] * x[2] + x[3] * x[3]); }
                    ss += __shfl_xor(ss, 16); ss += __shfl_xor(ss, 32);
                    r = scale * rs[ai][m] * __builtin_amdgcn_rsqf(ss * rs[ai][m] * rs[ai][m] * (1.0f / 64.0f) + RMS_EPS);
                }
#pragma unroll
                for (int bj = 0; bj < 2; ++bj) {
                    const f32x4 v0 = acc[ai][bj][m][0] * gv[bj][0] * r, v1 = acc[ai][bj][m][1] * gv[bj][1] * r;
                    if (T == 5) { cs4[bj][0] += v0; cs4[bj][1] += v1; }
                    u32x4 w; w.x = cvt_pk_bf16(v0[0], v0[1]); w.y = cvt_pk_bf16(v0[2], v0[3]); w.z = cvt_pk_bf16(v1[0], v1[1]); w.w = cvt_pk_bf16(v1[2], v1[3]);
                    *(u32x4*)(dp + (size_t)(ai * HALF + m * 16) * 64 + 32 * bj) = w;
                }
            }
        if (T == 5) {
            float* kmp = KM + ((size_t)((b * 4 + wc) * 16 + (((u.pm * BM) & 4095) >> 8))) * 64 + 8 * fq;
#pragma unroll
            for (int bj = 0; bj < 2; ++bj)
#pragma unroll
                for (int n = 0; n < 2; ++n)
#pragma unroll
                    for (int j = 0; j < 4; ++j) { float s = cs4[bj][n][j];
                        s += __shfl_xor(s, 1); s += __shfl_xor(s, 2); s += __shfl_xor(s, 4); s += __shfl_xor(s, 8);
                        if (fr == 0) atomicAdd(kmp + 32 * bj + 4 * n + j, s * (1.0f / 256.0f)); }
        }
    }
};
struct EpiRes0 {
    static constexpr bool PERM = true, AFTER_DRAIN = false;
    const bf16_t* base; bf16_t* X1; float* RS1;
    __device__ __forceinline__ void prefetch(const Unit&, int, PG8_LAS unsigned char*, int, int) const {}
    __device__ __forceinline__ void operator()(const f32x4 (&acc)[2][2][4][2], const Unit& u, int wr, int wc, int fr, int fq, int ui, PG8_LAS unsigned char* ldsb) const {
        const int col0 = u.pn * BM + wc * 32 + 8 * fq;
#pragma unroll
        for (int ai = 0; ai < 2; ++ai)
#pragma unroll
            for (int m = 0; m < 4; ++m) {
                const int row = u.pm * BM + ai * HALF + wr * 64 + m * 16 + fr; const size_t off = (size_t)row * 1024 + col0; float ss = 0.f;
#pragma unroll
                for (int bj = 0; bj < 2; ++bj) { const u32x4 xb = *(const u32x4*)(base + off + bj * HALF);
                    f32x4 v0, v1; v0[0] = __uint_as_float(xb.x << 16); v0[1] = __uint_as_float(xb.x & 0xffff0000u); v0[2] = __uint_as_float(xb.y << 16); v0[3] = __uint_as_float(xb.y & 0xffff0000u);
                    v1[0] = __uint_as_float(xb.z << 16); v1[1] = __uint_as_float(xb.z & 0xffff0000u); v1[2] = __uint_as_float(xb.w << 16); v1[3] = __uint_as_float(xb.w & 0xffff0000u);
                    v0 += acc[ai][bj][m][0]; v1 += acc[ai][bj][m][1];
                    ss += (v0[0] * v0[0] + v0[1] * v0[1]) + (v0[2] * v0[2] + v0[3] * v0[3]) + (v1[0] * v1[0] + v1[1] * v1[1]) + (v1[2] * v1[2] + v1[3] * v1[3]);
                    u32x4 w; w.x = cvt_pk_bf16(v0[0], v0[1]); w.y = cvt_pk_bf16(v0[2], v0[3]); w.z = cvt_pk_bf16(v1[0], v1[1]); w.w = cvt_pk_bf16(v1[2], v1[3]);
                    *(u32x4*)(X1 + off + bj * HALF) = w; }
                ss += __shfl_xor(ss, 16); ss += __shfl_xor(ss, 32);
                if (fq == 0) atomicAdd(RS1 + row, ss);
            }
    }
};
struct EpiRes1 {
    static constexpr bool PERM = true, AFTER_DRAIN = false;
    const bf16_t* X1; float* out;

    __device__ __forceinline__ void prefetch(const Unit&, int, PG8_LAS unsigned char*, int, int) const {}
    __device__ __forceinline__ void operator()(const f32x4 (&acc)[2][2][4][2], const Unit& u, int wr, int wc, int fr, int fq, int ui, PG8_LAS unsigned char* ldsb) const {
        const int col0 = u.pn * BM + wc * 32 + 8 * fq;
#pragma unroll
        for (int ai = 0; ai < 2; ++ai)
#pragma unroll
            for (int m = 0; m < 4; ++m) {
                const size_t off = (size_t)(u.pm * BM + ai * HALF + wr * 64 + m * 16 + fr) * 1024 + col0;
#pragma unroll
                for (int bj = 0; bj < 2; ++bj) { const u32x4 xb = *(const u32x4*)(X1 + off + bj * HALF);
                    f32x4 v0, v1; v0[0] = __uint_as_float(xb.x << 16); v0[1] = __uint_as_float(xb.x & 0xffff0000u); v0[2] = __uint_as_float(xb.y << 16); v0[3] = __uint_as_float(xb.y & 0xffff0000u);
                    v1[0] = __uint_as_float(xb.z << 16); v1[1] = __uint_as_float(xb.z & 0xffff0000u); v1[2] = __uint_as_float(xb.w << 16); v1[3] = __uint_as_float(xb.w & 0xffff0000u);
                    *(f32x4*)(out + off + bj * HALF) = v0 + acc[ai][bj][m][0]; *(f32x4*)(out + off + bj * HALF + 4) = v1 + acc[ai][bj][m][1]; }
            }
    }
};

template <class Epi, class Sched, bool ALIGN_EPI = false, bool SP2 = false>
__device__ __forceinline__ void gemm_phase(PG8_LAS unsigned char* lds, const Gemm g, const Sched& S, const Epi& E) {
    const int tid = threadIdx.x, wid = __builtin_amdgcn_readfirstlane(tid >> 6), lane = tid & 63, wr = wid >> 2, wc = wid & 3, fr = lane & 15, fq = lane >> 4;
    const int K = g.K, nt = K / BK;
    unsigned voffA[2], voffB[2];
#pragma unroll
    for (int i = 0; i < 2; ++i) { int R, C; stage_rc(tid * 16 + i * 8192, R, C); const int Rb = Epi::PERM ? ((R & ~31) + perm32(R & 31)) : R;
        voffA[i] = (unsigned)(R * K + C) * 2u; voffB[i] = (unsigned)(Rb * K + C) * 2u; }
    const size_t kstep = (size_t)(BK * 2);
    const size_t hstep = (size_t)HALF * K * 2;
    const size_t tstep = 2 * hstep;
    const unsigned ldsw = (unsigned)wid * 1024u;
    const int aoff = lds_byte(wr * 64 + fr, fq * 8), boff = lds_byte(wc * 32 + fr, fq * 8);
#define PG8_SA(b, h) (((b) * 2 + (h)) * HTB)
#define PG8_SB(b, h) ((4 + (b) * 2 + (h)) * HTB)
#define PG8_STAGE(bufoff, gbase, voff) do { _Pragma("unroll") for (int _i = 0; _i < 2; ++_i) \
        __builtin_amdgcn_global_load_lds((const unsigned*)((const char*)(gbase) + (voff)[_i]), (PG8_LAS unsigned*)(lds + (bufoff) + ldsw + _i * 8192), 16, 0, 0); } while (0)
#define PG8_LDA(dst, b, h) do { _Pragma("unroll") for (int m = 0; m < 4; ++m) _Pragma("unroll") for (int k = 0; k < 2; ++k) dst[m][k] = *(const PG8_LAS bf16x8*)(lds + PG8_SA(b, h) + aoff + m * 2048 + k * 1024); } while (0)
#define PG8_LDB(dst, b, h) do { _Pragma("unroll") for (int n = 0; n < 2; ++n) _Pragma("unroll") for (int k = 0; k < 2; ++k) dst[n][k] = *(const PG8_LAS bf16x8*)(lds + PG8_SB(b, h) + boff + n * 2048 + k * 1024); } while (0)
#define PG8_MMA(ai, bj, At, Bt) do { __builtin_amdgcn_s_setprio(1); _Pragma("unroll") for (int m = 0; m < 4; ++m) _Pragma("unroll") for (int n = 0; n < 2; ++n) _Pragma("unroll") for (int k = 0; k < 2; ++k) \
        acc[ai][bj][m][n] = __builtin_amdgcn_mfma_f32_16x16x32_bf16(Bt[n][k], At[m][k], acc[ai][bj][m][n], 0, 0, 0); __builtin_amdgcn_s_setprio(0); } while (0)
#define PG8_WAIT_V(n) asm volatile("s_waitcnt vmcnt(" #n ")" ::: "memory")
#define PG8_WAIT_L(n) asm volatile("s_waitcnt lgkmcnt(" #n ")" ::: "memory")
#define PG8_BAR __builtin_amdgcn_s_barrier()
#define PG8_SCHED __builtin_amdgcn_sched_barrier(0)
    Unit cur, nxt; int ui = 0;
    if (!S.next(0, cur)) return;
    f32x4 acc[2][2][4][2];
#pragma unroll
    for (int a = 0; a < 2; ++a)
#pragma unroll
        for (int b = 0; b < 2; ++b)
#pragma unroll
            for (int m = 0; m < 4; ++m)
#pragma unroll
                for (int n = 0; n < 2; ++n) acc[a][b][m][n] = (f32x4){0.f, 0.f, 0.f, 0.f};
    bf16x8 At[4][2], B0[2][2], B1[2][2];
    const char* cA = (const char*)g.A + (size_t)cur.pm * tstep; const char* cB = (const char*)g.Bt + (size_t)cur.pn * tstep;
    S.a_ready(cur); E.prefetch(cur, 0, lds, wid, lane);
    if constexpr (SP2) {
        PG8_STAGE(PG8_SB(0, 0), cB, voffB); PG8_STAGE(PG8_SB(0, 1), cB + hstep, voffB); PG8_STAGE(PG8_SA(0, 0), cA, voffA); PG8_STAGE(PG8_SA(0, 1), cA + hstep, voffA);
        if (wr == 1) PG8_BAR;
        PG8_WAIT_V(2); PG8_BAR;
        PG8_STAGE(PG8_SB(1, 0), cB + kstep, voffB); PG8_STAGE(PG8_SA(1, 0), cA + kstep, voffA); PG8_STAGE(PG8_SB(1, 1), cB + hstep + kstep, voffB);
        PG8_WAIT_V(6); PG8_BAR;
    } else {
        PG8_STAGE(PG8_SB(0, 0), cB, voffB); PG8_STAGE(PG8_SA(0, 0), cA, voffA); PG8_STAGE(PG8_SB(0, 1), cB + hstep, voffB); PG8_STAGE(PG8_SA(0, 1), cA + hstep, voffA);
        if (wr == 1) PG8_BAR;
        PG8_WAIT_V(4); PG8_BAR;
        PG8_STAGE(PG8_SB(1, 0), cB + kstep, voffB); PG8_STAGE(PG8_SA(1, 0), cA + kstep, voffA); PG8_STAGE(PG8_SB(1, 1), cB + hstep + kstep, voffB);
        PG8_WAIT_V(6); PG8_BAR;
    }
    for (;;) {
        const bool has_next = S.next(ui + 1, nxt);
        const char* nA = has_next ? (const char*)g.A + (size_t)nxt.pm * tstep : cA; const char* nB = has_next ? (const char*)g.Bt + (size_t)nxt.pn * tstep : cB;
        for (int t = 0; t < nt; t += 2) {
            const bool last = (t == nt - 2);
            const char* a1 = cA + (size_t)(t + 1) * kstep;
            const char* a2 = last ? nA : cA + (size_t)(t + 2) * kstep; const char* b2 = last ? nB : cB + (size_t)(t + 2) * kstep;
            const char* a3 = a2 + kstep; const char* b3 = b2 + kstep;
            if (last && has_next) S.a_ready(nxt);
            if constexpr (SP2) {
            PG8_LDB(B0, 0, 0); PG8_LDB(B1, 0, 1); PG8_SCHED; PG8_LDA(At, 0, 0); PG8_STAGE(PG8_SA(1, 1), a1 + hstep, voffA);
            PG8_WAIT_V(8); PG8_WAIT_L(0); PG8_BAR; PG8_MMA(0, 0, At, B0); PG8_MMA(0, 1, At, B1); PG8_BAR; PG8_SCHED;
            PG8_LDA(At, 0, 1); PG8_STAGE(PG8_SB(0, 0), b2, voffB); PG8_STAGE(PG8_SB(0, 1), b2 + hstep, voffB); PG8_STAGE(PG8_SA(0, 0), a2, voffA);
            PG8_WAIT_V(8); PG8_WAIT_L(0); PG8_BAR; PG8_MMA(1, 0, At, B0); PG8_MMA(1, 1, At, B1); PG8_BAR; PG8_SCHED;
            PG8_LDB(B0, 1, 0); PG8_LDB(B1, 1, 1); PG8_SCHED; PG8_LDA(At, 1, 0); PG8_STAGE(PG8_SA(0, 1), a2 + hstep, voffA);
            PG8_WAIT_V(8); PG8_WAIT_L(0); PG8_BAR; PG8_MMA(0, 0, At, B0); PG8_MMA(0, 1, At, B1); PG8_BAR; PG8_SCHED;
            PG8_LDA(At, 1, 1); PG8_STAGE(PG8_SB(1, 0), b3, voffB); PG8_STAGE(PG8_SB(1, 1), b3 + hstep, voffB); PG8_STAGE(PG8_SA(1, 0), a3, voffA);
            PG8_WAIT_V(8); PG8_WAIT_L(0); PG8_BAR; PG8_MMA(1, 0, At, B0); PG8_MMA(1, 1, At, B1); PG8_BAR; PG8_SCHED;
            } else {
            PG8_LDB(B0, 0, 0); PG8_SCHED; PG8_LDA(At, 0, 0); PG8_STAGE(PG8_SA(1, 1), a1 + hstep, voffA);
            PG8_WAIT_L(8); PG8_BAR; PG8_WAIT_L(0); PG8_MMA(0, 0, At, B0); PG8_BAR; PG8_SCHED;
            PG8_LDB(B1, 0, 1); PG8_STAGE(PG8_SB(0, 0), b2, voffB);
            PG8_BAR; PG8_WAIT_L(0); PG8_MMA(0, 1, At, B1); PG8_BAR;
            PG8_LDA(At, 0, 1); PG8_STAGE(PG8_SA(0, 0), a2, voffA);
            PG8_BAR; PG8_WAIT_L(0); PG8_MMA(1, 0, At, B0); PG8_BAR; PG8_SCHED;
            PG8_STAGE(PG8_SB(0, 1), b2 + hstep, voffB);
            PG8_WAIT_V(6); PG8_BAR; PG8_MMA(1, 1, At, B1); PG8_BAR;
            PG8_LDB(B0, 1, 0); PG8_SCHED; PG8_LDA(At, 1, 0); PG8_STAGE(PG8_SA(0, 1), a2 + hstep, voffA);
            PG8_WAIT_L(8); PG8_BAR; PG8_WAIT_L(0); PG8_MMA(0, 0, At, B0); PG8_BAR; PG8_SCHED;
            PG8_LDB(B1, 1, 1); PG8_STAGE(PG8_SB(1, 0), b3, voffB);
            PG8_BAR; PG8_WAIT_L(0); PG8_MMA(0, 1, At, B1); PG8_BAR;
            PG8_LDA(At, 1, 1); PG8_STAGE(PG8_SA(1, 0), a3, voffA);
            PG8_BAR; PG8_WAIT_L(0); PG8_MMA(1, 0, At, B0); PG8_BAR; PG8_SCHED;
            PG8_STAGE(PG8_SB(1, 1), b3 + hstep, voffB);
            PG8_WAIT_V(6); PG8_BAR; PG8_MMA(1, 1, At, B1); PG8_BAR;
            }
        }
        if constexpr (ALIGN_EPI) { if (wr == 0) PG8_BAR; }
        if constexpr (!Epi::AFTER_DRAIN) { E(acc, cur, wr, wc, fr, fq, ui, lds); S.done(cur); if (has_next) E.prefetch(nxt, ui + 1, lds, wid, lane); }
        if (!has_next) break;
#pragma unroll
        for (int a = 0; a < 2; ++a)
#pragma unroll
            for (int b = 0; b < 2; ++b)
#pragma unroll
                for (int m = 0; m < 4; ++m)
#pragma unroll
                    for (int n = 0; n < 2; ++n) acc[a][b][m][n] = (f32x4){0.f, 0.f, 0.f, 0.f};
        cur = nxt; cA = nA; cB = nB; ++ui;
        if constexpr (ALIGN_EPI) { if (wr == 1) PG8_BAR; }
    }
    PG8_WAIT_V(0);
    if constexpr (!ALIGN_EPI) { if (wr == 0) PG8_BAR; }
    PG8_BAR;
    if constexpr (Epi::AFTER_DRAIN) { E.fused(acc, cur, wr, wc, fr, fq, lds, wid, lane); S.done(cur); }
#undef PG8_SA
#undef PG8_SB
#undef PG8_STAGE
#undef PG8_LDA
#undef PG8_LDB
#undef PG8_MMA
#undef PG8_WAIT_V
#undef PG8_WAIT_L
#undef PG8_BAR
#undef PG8_SCHED
}
}
constexpr int NB = 8, SEQ = 4096, DM = 1024, NTOK = NB * SEQ, INW = 3844, NPERM = 4096, NLAYER = 2;
constexpr size_t MiB = 1u << 20;
constexpr size_t WS_CTL = 0, CTL_ZERO_BYTES = 1 * MiB;
constexpr size_t WS_WIN = 2 * MiB;
constexpr size_t WS_WOUT = 18 * MiB;
constexpr size_t WS_LF = 22 * MiB;
constexpr size_t WS_RS = 26 * MiB;
constexpr size_t WS_TAB = 23 * MiB;
constexpr size_t WS_KM = 24 * MiB;
constexpr size_t WS_MF = 25 * MiB;
constexpr int CW_BAR = 4096;
constexpr int CW_QUEUE = 64;
constexpr size_t WS_HN = 32 * MiB;
constexpr size_t WS_Q = 96 * MiB, WS_K = 160 * MiB, WS_V = 216 * MiB, WS_G = 272 * MiB, WS_X1 = 336 * MiB  , WS_X0 = 400 * MiB  , WS_END = 464 * MiB;
constexpr float LOG2E = 1.4426950408889634f;
constexpr int NWAVES = 8;
#define TIMER_SEL -1
#define TIMER_FS 100
#define TIMER_WG 37
#define TIMER_TYPE 1
#define PROBE_ATT 0
#define PROBE_REPS 2
#define PROBE_P1 0
#define PROBE_P3 0
#define PROBE_P0 0
#ifndef N_LAUNCHES
#define N_LAUNCHES 1
#endif
constexpr int RING_BYTES = 131072, LDSCTL_OFF = 139264, MISC_OFF = LDSCTL_OFF + 320, LDS_BYTES = 147456;

#define GAS __attribute__((address_space(1)))
#define LAS __attribute__((address_space(3)))
typedef unsigned short bf16;
typedef unsigned v4u __attribute__((ext_vector_type(4)));
typedef float f32x4 __attribute__((ext_vector_type(4)));
__device__ __forceinline__ unsigned f2bf(float f) { unsigned u = __builtin_bit_cast(unsigned, f); return (u + 0x7fffu + ((u >> 16) & 1u)) >> 16; }
typedef float f32x2h_t __attribute__((ext_vector_type(2))); typedef __bf16 bf16x2h_t __attribute__((ext_vector_type(2)));
__device__ __forceinline__ unsigned pk2(float lo, float hi) { f32x2h_t v = {lo, hi}; bf16x2h_t b = __builtin_convertvector(v, bf16x2h_t); return __builtin_bit_cast(unsigned, b); }
__device__ __forceinline__ float bf2f(unsigned v) { return __uint_as_float(v << 16); }
__device__ __forceinline__ float wave_sum(float v) {
#pragma unroll
    for (int o = 1; o < 64; o <<= 1) v += __shfl_xor(v, o);
    return v;
}
#define RLX_AGENT __ATOMIC_RELAXED, __HIP_MEMORY_SCOPE_AGENT
#define XB_TMO      128
#define XB_XCNT(j)  (256  + 64 * (j))
#define XB_XSUB(j)  (1280 + 64 * (j))
#define XB_XGEN(j)  (2304 + 64 * (j))
#define XB_TOP      3328
#define XB_TOPGEN   3392
#define XCD_BAR_WORDS 3456
#define XB_SPIN_CAP (1u << 18)

__device__ __forceinline__ unsigned xb_ld(unsigned* p)              { return __hip_atomic_load(p, __ATOMIC_RELAXED, __HIP_MEMORY_SCOPE_AGENT); }
__device__ __forceinline__ unsigned xb_add(unsigned* p, unsigned v) { return __hip_atomic_fetch_add(p, v, __ATOMIC_RELAXED, __HIP_MEMORY_SCOPE_AGENT); }
__device__ __forceinline__ unsigned xb_xcc_id() { return (unsigned)__builtin_amdgcn_s_getreg((3 << 11) | 20) & 0xFu; }
#define XB_SPIN(cond, bar) do { unsigned _sp = 0; while (cond) { __builtin_amdgcn_s_sleep(1); \
    if ((++_sp & 255u) == 0u) { if (xb_ld(&(bar)[XB_TMO])) break; if (_sp > XB_SPIN_CAP) { atomicAdd(&(bar)[XB_TMO], 1u); break; } } } } while (0)

struct XcdBarrier {
    unsigned* bar; unsigned x;
    volatile LAS unsigned* st;
};

__device__ __forceinline__ XcdBarrier xcd_barrier_post(unsigned* bar, volatile LAS unsigned* st) {
    XcdBarrier b; b.bar = bar; b.x = xb_xcc_id(); b.st = st;
    if (threadIdx.x == 0) (void)xb_add(&bar[XB_XCNT(b.x)], 1u);
    return b;
}
__device__ __forceinline__ void xcd_barrier_complete(unsigned* bar, unsigned x, unsigned& nloc, unsigned& nx) {
    const unsigned G = gridDim.x * gridDim.y * gridDim.z;
    unsigned sum, cnt, mine, sp = 0u;
    for (;;) {
        sum = 0u; cnt = 0u; mine = 0u;
#pragma unroll
        for (unsigned j = 0; j < 16; ++j) { const unsigned c = xb_ld(&bar[XB_XCNT(j)]); sum += c; cnt += (c > 0u) ? 1u : 0u; mine = (j == x) ? c : mine; }
        if (sum == G) break;
        __builtin_amdgcn_s_sleep(1);
        if ((++sp & 255u) == 0u) { if (xb_ld(&bar[XB_TMO])) break; if (sp > XB_SPIN_CAP) { atomicAdd(&bar[XB_TMO], 1u); break; } }
    }
    nloc = mine > 0u ? mine : 1u; nx = cnt > 0u ? cnt : 1u;
}

__device__ __forceinline__ void xcd_barrier(const XcdBarrier& b) {
    asm volatile("s_waitcnt vmcnt(0)" ::: "memory");
    __syncthreads();
    if (threadIdx.x == 0) {
        unsigned* bar = b.bar;
        __builtin_amdgcn_s_waitcnt(0);
        unsigned nloc = b.st[0], nx = b.st[1];
        if (nloc == 0u) { xcd_barrier_complete(bar, b.x, nloc, nx); b.st[0] = nloc; b.st[1] = nx; }
        const unsigned old = xb_add(&bar[XB_XSUB(b.x)], 1u);
        const unsigned gen = old / nloc;
        if (old + 1u == (gen + 1u) * nloc) {
            __builtin_amdgcn_fence(__ATOMIC_RELEASE, "agent");
            asm volatile("s_waitcnt vmcnt(0)" ::: "memory");
            const unsigned og = xb_add(&bar[XB_TOP], 1u);
            const unsigned tg = og / nx;
            if (og + 1u == (tg + 1u) * nx) xb_add(&bar[XB_TOPGEN], 1u);
            else XB_SPIN(xb_ld(&bar[XB_TOPGEN]) == tg, bar);
            __builtin_amdgcn_fence(__ATOMIC_ACQUIRE, "agent");
            xb_add(&bar[XB_XGEN(b.x)], 1u);
            asm volatile("s_waitcnt vmcnt(0)" ::: "memory");
        } else {
            XB_SPIN(xb_ld(&bar[XB_XGEN(b.x)]) == gen, bar);
            __builtin_amdgcn_fence(__ATOMIC_ACQUIRE, "agent");
            asm volatile("s_waitcnt vmcnt(0)" ::: "memory");
        }
    }
    __syncthreads();
}

__device__ __forceinline__ int rel_bucket(int d) {
    if (d < 16) return d;
    int b = 16;
    b += (d >= 21); b += (d >= 27); b += (d >= 35); b += (d >= 46); b += (d >= 59); b += (d >= 77); b += (d >= 99); b += (d >= 128);
    b += (d >= 166); b += (d >= 216); b += (d >= 280); b += (d >= 363); b += (d >= 470); b += (d >= 609); b += (d >= 790);
    return b;
}

struct Args { const float* x; const float* norm_gain; const float* w_in; const float* b_forget; const float* fox_g; const float* moba_g; const float* swa_g; const float* sinks; const float* w_out; const float* rel_bias; float* out; unsigned char* ws; int ph_lo, ph_hi, tmask, pad; };

struct Frame { LAS unsigned char* lds; int tid, lane, wave, vcu, G; };

__device__ __forceinline__ void transpose_item(const float* W, int ldw, bf16* WT, int dst_row0, int src_col0, int ncol, const float* gk, LAS float* scr, int kb, int lane) {
    const int k0 = 64 * kb;
    { float wv[32]; const int c = lane & 31;
#pragma unroll
        for (int i = 0; i < 32; ++i) { const int kk = 2 * i + (lane >> 5); wv[i] = (c < ncol) ? W[(size_t)(k0 + kk) * ldw + src_col0 + c] : 0.f; }
        if (gk) {
#pragma unroll
            for (int i = 0; i < 32; ++i) wv[i] *= gk[k0 + 2 * i + (lane >> 5)]; }
#pragma unroll
        for (int i = 0; i < 32; ++i) scr[(2 * i + (lane >> 5)) * 33 + c] = wv[i]; }
    asm volatile("s_waitcnt lgkmcnt(0)" ::: "memory");
    const int c = lane & 7;
#pragma unroll
    for (int j = 0; j < 4; ++j) { const int n = (lane >> 3) + 8 * j; const LAS float* s = scr + (8 * c) * 33 + n;
        v4u o; o.x = pk2(s[0 * 33], s[1 * 33]); o.y = pk2(s[2 * 33], s[3 * 33]); o.z = pk2(s[4 * 33], s[5 * 33]); o.w = pk2(s[6 * 33], s[7 * 33]);
        *(v4u*)(WT + (size_t)(dst_row0 + n) * 1024 + k0 + 8 * c) = o; }
    asm volatile("s_waitcnt lgkmcnt(0)" ::: "memory");
}
__device__ __forceinline__ int tile_src(int T, int wc) {
    switch (T) { case 0: return 0 + 64 * wc; case 1: return 256 + 64 * wc; case 2: return 512 + 64 * wc; case 3: return 772 + 64 * wc;
        case 4: return 1028 + 64 * wc; case 5: return 1284 + 64 * wc; case 6: return 1540 + 64 * wc; case 7: return 1796 + 64 * wc;
        case 8: return 2052 + 64 * wc; case 9: return 2308 + 64 * wc; case 10: return 2564 + 64 * wc; case 11: return 2820 + 64 * wc;
        case 12: return 3076 + 64 * wc; case 13: return wc < 2 ? 3332 + 64 * wc : 3460 + 64 * (wc - 2); default: return 3588 + 64 * wc; }
}
__device__ __forceinline__ void p_weights(Frame& F, const Args& a) {
    LAS float* scr = (LAS float*)(F.lds + F.wave * 16384);
    const int gw = F.vcu * 2 + (F.wave - 6), NGW = F.G * 2;
    bf16* win = (bf16*)(a.ws + WS_WIN); bf16* wout = (bf16*)(a.ws + WS_WOUT);
    constexpr int I_IN = 128 * 16, I_OUT = 32 * 16;
    for (int it = gw; it < 2 * (I_IN + I_OUT); it += NGW) {
        const int layer = it / (I_IN + I_OUT); int r = it % (I_IN + I_OUT);
        if (r < I_IN) { const int kb = r >> 7, g = r & 127, T = g >> 3, gg = g & 7, bj = gg >> 2, wc = gg & 3;
            const int src = (T < 15) ? tile_src(T, wc) + 32 * bj : 768, ncol = (T < 15) ? 32 : (gg == 0 ? 4 : 0);
            transpose_item(a.w_in + (size_t)layer * DM * INW, INW, win + (size_t)layer * NPERM * DM, 32 * g, src, ncol, a.norm_gain + layer * DM, scr, kb, F.lane); }
        else { r -= I_IN; const int kb = r / 32, g = r % 32;
            transpose_item(a.w_out + (size_t)layer * DM * DM, DM, wout + (size_t)layer * DM * DM, 32 * g, 32 * g, 32, nullptr, scr, kb, F.lane); }
    }
}
__device__ __forceinline__ void p_tables(Frame& F, const Args& a) {
    if (F.vcu == 0) { float* tab = (float*)(a.ws + WS_TAB);
        for (int i = F.tid; i < 8 * 1024; i += NWAVES * 64) { const int hc = i >> 10, d = i & 1023; tab[i] = a.rel_bias[rel_bucket(d) * 8 + hc] * LOG2E; } }
}
__device__ __forceinline__ void p_consts(Frame& F, const Args& a) {
    if (F.vcu == 0 && F.wave == 0) for (int layer = 0; layer < NLAYER; ++layer) {
        const int lane = F.lane; float* MF = (float*)(a.ws + WS_MF) + layer * 4;
        float bm = 0.f;
#pragma unroll
        for (int j = 0; j < 4; ++j) bm = fmaxf(bm, fabsf(a.rel_bias[64 * j + lane]));
#pragma unroll
        for (int o = 1; o < 64; o <<= 1) bm = fmaxf(bm, __shfl_xor(bm, o));
        const float* gp[3] = {a.fox_g + layer * 128, a.moba_g + layer * 128, a.swa_g + layer * 128};
#pragma unroll
        for (int k = 0; k < 3; ++k) { float mq = fabsf(gp[k][lane]), mk = fabsf(gp[k][64 + lane]);
#pragma unroll
            for (int o = 1; o < 64; o <<= 1) { mq = fmaxf(mq, __shfl_xor(mq, o)); mk = fmaxf(mk, __shfl_xor(mk, o)); }
            const float m = 8.f * LOG2E * mq * mk * 1.02f + 0.1f + (k == 0 ? 0.f : bm * LOG2E);
            if (lane == 0) MF[k == 0 ? 0 : (k == 1 ? 1 : 3)] = m; }
        if (lane == 0) MF[2] = 0.f;
    }
}
__device__ __forceinline__ void p_convert(Frame& F, const Args& a) {
    const int lane = F.lane, gt = F.vcu * 384 + F.tid, NT_ = F.G * 384;
    { float* KM = (float*)(a.ws + WS_KM); for (int i = gt; i < 32 * 16 * 64; i += NT_) KM[i] = 0.f;
      float* RS1 = (float*)(a.ws + WS_RS) + NTOK; for (int i = gt; i < NTOK; i += NT_) RS1[i] = 0.f; }
    bf16* XB = (bf16*)(a.ws + WS_X0); float* RS0 = (float*)(a.ws + WS_RS);
    const int gwv = F.vcu * 6 + F.wave, NGW = F.G * 6;
    for (int r0 = 4 * gwv; r0 < NTOK; r0 += 4 * NGW) {
        f32x4 v[4][4];
#pragma unroll
        for (int rr = 0; rr < 4; ++rr) { const f32x4* xr = (const f32x4*)(a.x + (size_t)(r0 + rr) * DM) + lane;
#pragma unroll
            for (int j = 0; j < 4; ++j) v[rr][j] = xr[64 * j]; }
        float ss[4];
#pragma unroll
        for (int rr = 0; rr < 4; ++rr) { ss[rr] = 0.f; unsigned long long* o8 = (unsigned long long*)(XB + (size_t)(r0 + rr) * DM) + lane;
#pragma unroll
            for (int j = 0; j < 4; ++j) { const f32x4 y = v[rr][j]; ss[rr] += (y[0] * y[0] + y[1] * y[1]) + (y[2] * y[2] + y[3] * y[3]);
                o8[64 * j] = (unsigned long long)pk2(y[0], y[1]) | ((unsigned long long)pk2(y[2], y[3]) << 32); } }
#pragma unroll
        for (int o = 1; o < 64; o <<= 1)
#pragma unroll
            for (int rr = 0; rr < 4; ++rr) ss[rr] += __shfl_xor(ss[rr], o);
        if (lane < 4) RS0[r0 + lane] = lane == 0 ? ss[0] : (lane == 1 ? ss[1] : (lane == 2 ? ss[2] : ss[3]));
    }
}
namespace att {
using bf16x8 = __attribute__((ext_vector_type(8))) short;
using s16x4 = __attribute__((ext_vector_type(4))) short;
using f32x16 = __attribute__((ext_vector_type(16))) float;
using u32x4 = __attribute__((ext_vector_type(4))) unsigned;
typedef __attribute__((address_space(3))) const char* lds_cptr;
typedef __attribute__((address_space(3))) char* lds_ptr;
typedef short v4i16_t __attribute__((ext_vector_type(4)));
typedef float f32x2_t __attribute__((ext_vector_type(2))); typedef __bf16 bf16x2_t __attribute__((ext_vector_type(2)));
constexpr int NSLOT = 5, PFD = 2, SLOTB = 8192;
constexpr int L_K = 0, L_V = NSLOT * SLOTB, L_OST = 0  , L_WS = 2 * NSLOT * SLOTB, L_CS = L_WS + 8 * 256, L_TAB = L_CS + 16384, L_G = L_TAB + 4608, L_MISC = L_G + 8 * 4096, L_END = L_MISC + 1024;
static_assert(L_END <= 139264 && 8 * 4096 <= NSLOT * SLOTB, "attention LDS map (the kernel's control words start at 136 KiB)");
constexpr float THR2 = 44.f;
#define SBAR() __builtin_amdgcn_sched_barrier(0)
__device__ __forceinline__ int crow(int r, int hi) { return (r & 3) + 8 * (r >> 2) + 4 * hi; }
__device__ __forceinline__ void glds16(const void* gsrc, unsigned lds_dst) { unsigned keep;
    asm volatile("s_mov_b32 %0, m0\n\ts_mov_b32 m0, %2\n\ts_nop 0\n\tglobal_load_lds_dwordx4 %1, off\n\ts_mov_b32 m0, %0" : "=&s"(keep) : "v"(gsrc), "s"(lds_dst) : "memory"); }
__device__ __forceinline__ unsigned cvtpk_s(float lo, float hi) { f32x2_t v = {lo, hi}; bf16x2_t b = __builtin_convertvector(v, bf16x2_t); return __builtin_bit_cast(unsigned, b); }
__device__ __forceinline__ s16x4 vtr(lds_cptr p) { return __builtin_bit_cast(s16x4, __builtin_amdgcn_ds_read_tr16_b64_v4i16((__attribute__((address_space(3))) v4i16_t*)p)); }
#define MFMA32(a, b, c) __builtin_amdgcn_mfma_f32_32x32x16_bf16(a, b, c, 0, 0, 0)
__device__ __forceinline__ void qkt(f32x16& p0, f32x16& p1, lds_cptr kp, const bf16x8* qr, float cinit) {
    f32x16 c;
#pragma unroll
    for (int r = 0; r < 16; ++r) c[r] = cinit;
    p0 = c; p1 = c;
#pragma unroll
    for (int d0 = 0; d0 < 4; ++d0) {
        const bf16x8 b0 = *(const __attribute__((address_space(3))) bf16x8*)(kp + d0 * 2048);
        const bf16x8 b1 = *(const __attribute__((address_space(3))) bf16x8*)(kp + d0 * 2048 + 512);
        p0 = MFMA32(b0, qr[d0], p0); p1 = MFMA32(b1, qr[d0], p1);
    }
}
__device__ __forceinline__ void pv(f32x16* o, lds_cptr vp, bf16x8 pa0, bf16x8 pa1, bf16x8 pa2, bf16x8 pa3) {
#pragma unroll
    for (int d0 = 0; d0 < 2; ++d0) { s16x4 lo[4], hi[4];
#pragma unroll
        for (int ks = 0; ks < 4; ++ks) { lo[ks] = vtr(vp + d0 * 4096 + ks * 1024); hi[ks] = vtr(vp + d0 * 4096 + ks * 1024 + 512); }
#define PK(k) (bf16x8){lo[k][0], lo[k][1], lo[k][2], lo[k][3], hi[k][0], hi[k][1], hi[k][2], hi[k][3]}
        o[d0] = MFMA32(pa0, PK(0), o[d0]); o[d0] = MFMA32(pa1, PK(1), o[d0]); o[d0] = MFMA32(pa2, PK(2), o[d0]); o[d0] = MFMA32(pa3, PK(3), o[d0]);
#undef PK
    }
}
__device__ __forceinline__ void kload(bf16x8* kf, lds_cptr kp) {
#pragma unroll
    for (int d0 = 0; d0 < 4; ++d0) { kf[2 * d0] = *(const __attribute__((address_space(3))) bf16x8*)(kp + d0 * 2048); kf[2 * d0 + 1] = *(const __attribute__((address_space(3))) bf16x8*)(kp + d0 * 2048 + 512); }
}
__device__ __forceinline__ void vload(s16x4* vlo, s16x4* vhi, lds_cptr vp) {
#pragma unroll
    for (int i = 0; i < 8; ++i) { vlo[i] = vtr(vp + (i >> 2) * 4096 + (i & 3) * 1024); vhi[i] = vtr(vp + (i >> 2) * 4096 + (i & 3) * 1024 + 512); }
}
__device__ __forceinline__ void qkt_r(f32x16& p0, f32x16& p1, const bf16x8* kf, const bf16x8* qr, float cinit) {
    f32x16 c;
#pragma unroll
    for (int r = 0; r < 16; ++r) c[r] = cinit;
    p0 = c; p1 = c;
#pragma unroll
    for (int d0 = 0; d0 < 4; ++d0) { p0 = MFMA32(kf[2 * d0], qr[d0], p0); p1 = MFMA32(kf[2 * d0 + 1], qr[d0], p1); }
}
__device__ __forceinline__ void pv_r(f32x16* o, const s16x4* vlo, const s16x4* vhi, bf16x8 pa0, bf16x8 pa1, bf16x8 pa2, bf16x8 pa3) {
#define VFR(i) (bf16x8){vlo[i][0], vlo[i][1], vlo[i][2], vlo[i][3], vhi[i][0], vhi[i][1], vhi[i][2], vhi[i][3]}
    o[0] = MFMA32(pa0, VFR(0), o[0]); o[1] = MFMA32(pa0, VFR(4), o[1]); o[0] = MFMA32(pa1, VFR(1), o[0]); o[1] = MFMA32(pa1, VFR(5), o[1]);
    o[0] = MFMA32(pa2, VFR(2), o[0]); o[1] = MFMA32(pa2, VFR(6), o[1]); o[0] = MFMA32(pa3, VFR(3), o[0]); o[1] = MFMA32(pa3, VFR(7), o[1]);
#undef VFR
}
struct ACtx { const bf16 *Q, *K, *V, *G; bf16* Y; const float *LF, *TAB, *KM, *MF; const float* sinks; int tflag; };
#define WAITBAR(N) asm volatile("s_waitcnt vmcnt(" #N ") lgkmcnt(0)\n\ts_barrier" ::: "memory")

#define USTAMP(k) do { if (TIMER_SEL >= 0 && TYPE == TIMER_TYPE && C.tflag && tid == 0) { volatile __attribute__((address_space(3))) unsigned* ta_ = (volatile __attribute__((address_space(3))) unsigned*)(shm + 139264 + 320) + 16; const unsigned now_ = (unsigned)__builtin_amdgcn_s_memrealtime(); ta_[k] += now_ - ta_[31]; ta_[31] = now_; } } while (0)
__device__ __forceinline__ int ticket_type(int u) { const int ty = u >> 9; return ty == 0 ? 1 : (ty == 1 ? 0 : ty); }
__device__ __forceinline__ void prefetch_unit(const ACtx& C, int u, lds_ptr shm, bf16x8* qn) {
    int tid = threadIdx.x; asm volatile("" : "+v"(tid));
    const int lane = tid & 63, r32 = lane & 31, hi = lane >> 5; const int wid = __builtin_amdgcn_readfirstlane(tid >> 6);
    const int T = ticket_type(u), r = u & 511, qb = 15 - (r >> 5), bh = r & 31, b = bh >> 2, h = bh & 3;
    const int kvh = (T == 3) ? (b * 2 + (h >> 1)) : bh;
    const bf16* Kh = C.K + T * pg8::GS + (size_t)kvh * SEQ * 64; const bf16* Vh = C.V + T * pg8::GS + (size_t)kvh * SEQ * 64;
    const bf16* ksrc = Kh + (size_t)lane * 64 + wid * 8;
    const bf16* vsrc = Vh + (size_t)(16 * (wid & 3) + (lane >> 2)) * 64 + (wid >> 2) * 32 + (lane & 3) * 8;
    const unsigned lds0 = (unsigned)(size_t)shm, kdst = lds0 + L_K + wid * 1024, vdst = lds0 + L_V + wid * 1024;
    const int t_hi = 4 * qb + 3;
    glds16(ksrc + (size_t)t_hi * 4096, (unsigned)__builtin_amdgcn_readfirstlane(kdst)); glds16(vsrc + (size_t)t_hi * 4096, (unsigned)__builtin_amdgcn_readfirstlane(vdst));
    glds16(ksrc + (size_t)(t_hi - 1) * 4096, (unsigned)__builtin_amdgcn_readfirstlane(kdst + SLOTB)); glds16(vsrc + (size_t)(t_hi - 1) * 4096, (unsigned)__builtin_amdgcn_readfirstlane(vdst + SLOTB));
    const bf16* Qw = C.Q + T * pg8::GS + ((size_t)bh * SEQ + qb * 256 + wid * 32) * 64;
#pragma unroll
    for (int d0 = 0; d0 < 4; ++d0) qn[d0] = *reinterpret_cast<const bf16x8*>(&Qw[(size_t)r32 * 64 + d0 * 16 + hi * 8]);
}
template <int TYPE> __device__ __forceinline__ int attn_unit(const ACtx& C, int bh, int qb, lds_ptr shm, bf16x8 (&qr)[4], int tick, __attribute__((address_space(3))) int* tslot) {
    int tid = threadIdx.x; asm volatile("" : "+v"(tid));
    const int lane = tid & 63, r32 = lane & 31, hi = lane >> 5; const int wid = __builtin_amdgcn_readfirstlane(tid >> 6);
    const int b = bh >> 2, h = bh & 3, q0 = qb * 256, qrel = wid * 32 + r32, t = q0 + qrel;
    const int kvh = (TYPE == 3) ? (b * 2 + (h >> 1)) : bh;
    const bf16* Qw = C.Q + TYPE * pg8::GS + ((size_t)bh * SEQ + q0 + wid * 32) * 64;
    const bf16* Kh = C.K + TYPE * pg8::GS + (size_t)kvh * SEQ * 64; const bf16* Vh = C.V + TYPE * pg8::GS + (size_t)kvh * SEQ * 64;
    const unsigned lds0 = (unsigned)(size_t)shm;
    __attribute__((address_space(3))) float* wsf = (__attribute__((address_space(3))) float*)(shm + L_WS) + wid * 64;
    __attribute__((address_space(3))) float* tabL = (__attribute__((address_space(3))) float*)(shm + L_TAB);
    __attribute__((address_space(3))) float* cs = (__attribute__((address_space(3))) float*)(shm + L_CS);
    __attribute__((address_space(3))) float* misc = (__attribute__((address_space(3))) float*)(shm + L_MISC);
    __attribute__((address_space(3))) int* misci = (__attribute__((address_space(3))) int*)(shm + L_MISC);
    const bf16* ksrc = Kh + (size_t)lane * 64 + wid * 8;
    const bf16* vsrc = Vh + (size_t)(16 * (wid & 3) + (lane >> 2)) * 64 + (wid >> 2) * 32 + (lane & 3) * 8;
    const unsigned kdst = lds0 + L_K + wid * 1024, vdst = lds0 + L_V + wid * 1024;
#define DMA_KV(tile, slot) do { glds16(ksrc + (size_t)(tile) * 4096, (unsigned)__builtin_amdgcn_readfirstlane(kdst + (slot) * SLOTB)); glds16(vsrc + (size_t)(tile) * 4096, (unsigned)__builtin_amdgcn_readfirstlane(vdst + (slot) * SLOTB)); } while (0)
    const lds_cptr kp0 = (lds_cptr)shm + L_K + hi * 1024 + r32 * 16;
    const lds_cptr vp0 = (lds_cptr)shm + L_V + ((lane >> 4) & 1) * 32 + (lane & 3) * 8 + (4 * hi + ((lane & 15) >> 2)) * 64;
    const float Mf = (TYPE == 2) ? 0.f : C.MF[TYPE];
    const int t_hi = 4 * qb + 3; int t_lo = 0;
    if (TYPE == 3) { t_lo = 4 * qb - 2; if (t_lo < 0) t_lo = 0; }
    USTAMP(24);
    const size_t yrow0 = (size_t)(b * SEQ + q0 + wid * 32);
    { const bf16* gsrc = C.G + (yrow0 + (lane >> 3)) * DM + TYPE * 256 + h * 64 + (lane & 7) * 8;
#pragma unroll
        for (int i = 0; i < 4; ++i) glds16(gsrc + (size_t)(8 * i) * DM, (unsigned)__builtin_amdgcn_readfirstlane(lds0 + L_G + wid * 4096 + i * 1024)); }
    unsigned sel = 0u; float ct = 0.f;
    if (TYPE == 0) {
        const float* lfp = C.LF + (size_t)bh * SEQ; const bool on = 8 * tid < q0 + 256;
        f32x4 a4 = {0.f, 0.f, 0.f, 0.f}, b4 = {0.f, 0.f, 0.f, 0.f};
        if (on) { a4 = *(const f32x4*)(lfp + 8 * tid); b4 = *(const f32x4*)(lfp + 8 * tid + 4); }
        a4[1] += a4[0]; a4[2] += a4[1]; a4[3] += a4[2]; b4[0] += a4[3]; b4[1] += b4[0]; b4[2] += b4[1]; b4[3] += b4[2];
        float sc = b4[3];
#pragma unroll
        for (int o = 1; o < 64; o <<= 1) { const float u = __shfl_up(sc, o); if (lane >= o) sc += u; }
        if (lane == 63) misc[wid] = sc;
        __syncthreads();
        float base = sc - b4[3];
#pragma unroll
        for (int w = 0; w < 7; ++w) if (w < wid) base += misc[w];
        if (on) { *(__attribute__((address_space(3))) f32x4*)(cs + 8 * tid) = a4 + base; *(__attribute__((address_space(3))) f32x4*)(cs + 8 * tid + 4) = b4 + base; }
        __syncthreads();
        const float cref = cs[q0];
        if (wid == 0) { const bool skip = (lane < 4 * qb) && (cs[64 * lane + 63] - cref > 2.f * Mf + THR2);
            const int cnt = __popcll(__ballot(skip)); if (lane == 0) misci[40] = cnt; }
        __syncthreads();
        t_lo = misci[40]; ct = cs[t];
    }
    if (TYPE == 1 || TYPE == 3) {
        const float* tg = C.TAB + ((TYPE == 3 ? 4 : 0) + h) * 1024;
        { float tv[3]; const float b31 = (TYPE == 1) ? tg[1023] : 0.f; float k0 = 0.f, k1 = 0.f;
#pragma unroll
            for (int k = 0; k < 3; ++k) { const int j = tid + 512 * k, d = 1023 - j; tv[k] = (j < 1088 && d >= 0 && (TYPE == 1 || d < 128)) ? tg[d] - b31 : -INFINITY; }
            if (TYPE == 1) { const float* kg = C.KM + (size_t)bh * 16 * 64; if (tid < qb * 64) k0 = kg[tid]; if (tid + 512 < qb * 64) k1 = kg[tid + 512]; }
#pragma unroll
            for (int k = 0; k < 3; ++k) { const int j = tid + 512 * k; if (j < 1088) tabL[j] = tv[k]; }
            if (TYPE == 1) { cs[tid] = k0; cs[tid + 512] = k1; } }
        __syncthreads();
        if (TYPE == 1) {
            if (qb <= 3) sel = (1u << qb) - 1u;
            else {
                float qf[32];
#pragma unroll
                for (int d0 = 0; d0 < 4; ++d0) { const u32x4 w = __builtin_bit_cast(u32x4, qr[d0]);
#pragma unroll
                    for (int j = 0; j < 4; ++j) { qf[d0 * 8 + 2 * j] = __uint_as_float(w[j] << 16); qf[d0 * 8 + 2 * j + 1] = __uint_as_float(w[j] & 0xffff0000u); } }
                float v1 = -INFINITY, v2 = -INFINITY, v3 = -INFINITY; int i1 = 0, i2 = 0, i3 = 0;
                for (int n = 0; n < qb; ++n) { float s = 0.f;
#pragma unroll
                    for (int d0 = 0; d0 < 4; ++d0) { const f32x4 ka = *(const __attribute__((address_space(3))) f32x4*)(cs + n * 64 + d0 * 16 + hi * 8), kb4 = *(const __attribute__((address_space(3))) f32x4*)(cs + n * 64 + d0 * 16 + hi * 8 + 4);
#pragma unroll
                        for (int j = 0; j < 4; ++j) { s += qf[d0 * 8 + j] * ka[j]; s += qf[d0 * 8 + 4 + j] * kb4[j]; } }
                    { auto rr = __builtin_amdgcn_permlane32_swap(__float_as_uint(s), __float_as_uint(s), false, false); s = __uint_as_float(rr[0]) + __uint_as_float(rr[1]); }
                    if (s > v1) { v3 = v2; i3 = i2; v2 = v1; i2 = i1; v1 = s; i1 = n; } else if (s > v2) { v3 = v2; i3 = i2; v2 = s; i2 = n; } else if (s > v3) { v3 = s; i3 = n; } }
                sel = (1u << i1) | (1u << i2) | (1u << i3); }
        }
    }
    const int n_tiles = t_hi - t_lo + 1;
    asm volatile("" : "+v"(qr[0]), "+v"(qr[1]), "+v"(qr[2]), "+v"(qr[3]));
    f32x16 o[2]; o[0] = f32x16{}; o[1] = f32x16{}; f32x16 lacc = f32x16{};
    float carry = (TYPE == 2) ? 1.f : 0.f; bool done_w = false;
    f32x16 cvec;
    { const float c0_ = (TYPE == 2) ? 0.f : ((TYPE == 0) ? ct - Mf : -Mf);
#pragma unroll
        for (int r = 0; r < 16; ++r) cvec[r] = c0_; }
    asm volatile("" : "+v"(cvec));
    const bf16x8 ones = {0x3f80, 0x3f80, 0x3f80, 0x3f80, 0x3f80, 0x3f80, 0x3f80, 0x3f80};
    const int jdiag = wid >> 1;
    const int jlo_w = (TYPE == 3) ? ((32 * wid - 127) >> 6) : -100000;
    if (TYPE == 2) { if (tid < 16) misci[64 + tid] = 0; }
    USTAMP(21);
    if (TIMER_SEL == 98 && TYPE == TIMER_TYPE && C.tflag && tid == 0) { volatile __attribute__((address_space(3))) unsigned* ta_ = (volatile __attribute__((address_space(3))) unsigned*)(shm + 139264 + 320) + 16; ta_[26] = (unsigned)__builtin_amdgcn_s_memtime(); }
    bf16x8 kf[8]; s16x4 vlo[8], vhi[8]; f32x16 p0, p1;
    const bool late = false;
#define FINISH(tile_, jr_, slot_) do { \
            vload(vlo, vhi, vp0 + (slot_) * SLOTB); SBAR(); \
            const int kb = 64 * (jr_) + 4 * hi; \
            unsigned keepm = 0xffffffffu; \
            if (TYPE == 0) { \
            _Pragma("unroll") \
                for (int g4 = 0; g4 < 4; ++g4) { const f32x4 c0 = *(const __attribute__((address_space(3))) f32x4*)(cs + 64 * (tile_) + 8 * g4 + 4 * hi), c1 = *(const __attribute__((address_space(3))) f32x4*)(cs + 64 * (tile_) + 32 + 8 * g4 + 4 * hi); \
            _Pragma("unroll") \
                    for (int j = 0; j < 4; ++j) { p0[4 * g4 + j] -= c0[j]; p1[4 * g4 + j] -= c1[j]; } } \
                if ((jr_) == jdiag) { \
            _Pragma("unroll") \
                    for (int r = 0; r < 16; ++r) { const int kv = kb + (r & 3) + 8 * (r >> 2); if (kv > qrel) p0[r] = -INFINITY; if (kv + 32 > qrel) p1[r] = -INFINITY; } } \
            _Pragma("unroll") \
                for (int r = 0; r < 16; ++r) { p0[r] = __builtin_amdgcn_exp2f(p0[r]); p1[r] = __builtin_amdgcn_exp2f(p1[r]); } \
            } \
            if (TYPE == 1 || TYPE == 3) { \
                const bool far = (TYPE == 1) && ((q0 + 32 * wid - 64 * (tile_) - 63) >= 790); \
                if (!far) { const __attribute__((address_space(3))) float* tp_ = tabL + (1023 - (qrel - kb)); \
            _Pragma("unroll") \
                    for (int r = 0; r < 16; ++r) { p0[r] += tp_[(r & 3) + 8 * (r >> 2)]; p1[r] += tp_[(r & 3) + 8 * (r >> 2) + 32]; } } \
                if (TYPE == 1 && (jr_) < 0) keepm = ((sel >> ((tile_) >> 2)) & 1u) ? 0xffffffffu : 0u; \
            _Pragma("unroll") \
                for (int r = 0; r < 16; ++r) { p0[r] = __builtin_amdgcn_exp2f(p0[r]); p1[r] = __builtin_amdgcn_exp2f(p1[r]); } \
            } \
            if (TYPE == 2) { \
                f32x16 w0, w1; \
            _Pragma("unroll") \
                for (int r = 0; r < 16; ++r) { float c0_, c1_; asm("v_min_f32_e32 %0, 0x42a00000, %1" : "=v"(c0_) : "v"(p0[r])); asm("v_min_f32_e32 %0, 0x42a00000, %1" : "=v"(c1_) : "v"(p1[r])); p0[r] = __builtin_amdgcn_exp2f(c0_); p1[r] = __builtin_amdgcn_exp2f(c1_); } \
                if ((jr_) == jdiag) { \
            _Pragma("unroll") \
                    for (int r = 0; r < 16; ++r) { const int kv = kb + (r & 3) + 8 * (r >> 2); if (kv >= qrel) p0[r] = 0.f; if (kv + 32 >= qrel) p1[r] = 0.f; } } \
            _Pragma("unroll") \
                for (int r = 0; r < 16; ++r) { w0[r] = 1.f + p0[r]; w1[r] = 1.f + p1[r]; } \
                float own[8], part[8]; \
            _Pragma("unroll") \
                for (int rb = 0; rb < 4; ++rb) { own[rb] = (w0[4 * rb] * w0[4 * rb + 1]) * (w0[4 * rb + 2] * w0[4 * rb + 3]); own[4 + rb] = (w1[4 * rb] * w1[4 * rb + 1]) * (w1[4 * rb + 2] * w1[4 * rb + 3]); } \
            _Pragma("unroll") \
                for (int rb = 0; rb < 8; ++rb) { auto rr = __builtin_amdgcn_permlane32_swap(__float_as_uint(own[rb]), __float_as_uint(own[rb]), false, false); part[rb] = __uint_as_float(hi ? rr[0] : rr[1]); } \
                float run = carry; \
            _Pragma("unroll") \
                for (int rb = 7; rb >= 0; --rb) { \
                    float E = hi == 0 ? run * part[rb] : run; run *= own[rb] * part[rb]; \
            _Pragma("unroll") \
                    for (int j = 3; j >= 0; --j) { const int r = 4 * (rb & 3) + j; \
                        if (rb >= 4) { E *= w1[r]; p1[r] *= __builtin_amdgcn_rcpf(E); } else { E *= w0[r]; p0[r] *= __builtin_amdgcn_rcpf(E); } } } \
                carry = run; \
                done_w = __all(carry > 1.7592186e13f) != 0;     \
            } \
            u32x4 pw0, pw1, pw2, pw3; \
            _Pragma("unroll") \
            for (int j = 0; j < 4; ++j) { pw0[j] = cvtpk_s(p0[2 * j], p0[2 * j + 1]); pw1[j] = cvtpk_s(p0[8 + 2 * j], p0[9 + 2 * j]); pw2[j] = cvtpk_s(p1[2 * j], p1[2 * j + 1]); pw3[j] = cvtpk_s(p1[8 + 2 * j], p1[9 + 2 * j]); } \
            if (TYPE == 1) { pw0 &= keepm; pw1 &= keepm; pw2 &= keepm; pw3 &= keepm; } \
            const bf16x8 pa0 = __builtin_bit_cast(bf16x8, pw0), pa1 = __builtin_bit_cast(bf16x8, pw1), pa2 = __builtin_bit_cast(bf16x8, pw2), pa3 = __builtin_bit_cast(bf16x8, pw3); \
            pv_r(o, vlo, vhi, pa0, pa1, pa2, pa3); \
            if (TYPE != 2) { lacc = MFMA32(pa0, ones, lacc); lacc = MFMA32(pa1, ones, lacc); lacc = MFMA32(pa2, ones, lacc); lacc = MFMA32(pa3, ones, lacc); } \
        } while (0)
#define SCORE(slot_) do { kload(kf, kp0 + (slot_) * SLOTB); SBAR(); \
        if (TYPE == 2) { p0 = MFMA32(kf[0], qr[0], (f32x16{})); p1 = MFMA32(kf[1], qr[0], (f32x16{})); } else { p0 = MFMA32(kf[0], qr[0], cvec); p1 = MFMA32(kf[1], qr[0], cvec); } \
        _Pragma("unroll") for (int d0 = 1; d0 < 4; ++d0) { p0 = MFMA32(kf[2 * d0], qr[d0], p0); p1 = MFMA32(kf[2 * d0 + 1], qr[d0], p1); } SBAR(); } while (0)
    int slot = 0, dslot = PFD, ptile = 0, pslot = 0; bool pend = false, stop = false;
    for (int i = 0; ; ++i) {
        const int tile = t_hi - i, jr = tile - 4 * qb;
        if (i < n_tiles && !stop) {
            { const int tp = tile - PFD; DMA_KV(tp < 0 ? 0 : tp, dslot); }
            dslot = (dslot == NSLOT - 1) ? 0 : dslot + 1;
            WAITBAR(4);
            if (TYPE == 2 && i > 0) { const u32x4 fa = *(const __attribute__((address_space(3))) u32x4*)(misci + 64 + ((i - 1) & 1) * 8), fb = *(const __attribute__((address_space(3))) u32x4*)(misci + 68 + ((i - 1) & 1) * 8);
                if ((fa[0] & fa[1] & fa[2] & fa[3] & fb[0] & fb[1] & fb[2] & fb[3]) != 0u) stop = true; }
        }
        if (late && pend) { FINISH(ptile, ptile - 4 * qb, pslot); pend = false; }
        if (i >= n_tiles || stop) break;
        const bool active = (jr <= jdiag) && (jr >= jlo_w) && !(TYPE == 2 && done_w);
        if (active) { SCORE(slot); }
        if (!late) { if (active) { FINISH(tile, jr, slot); } } else { pend = active; ptile = tile; pslot = slot; }
        if (TYPE == 2) { if (lane == 0) misci[64 + (i & 1) * 8 + wid] = done_w ? 1 : 0; }
        slot = (slot == NSLOT - 1) ? 0 : slot + 1;
    }
#undef FINISH
#undef SCORE
    if (TIMER_SEL == 98 && TYPE == TIMER_TYPE && C.tflag && tid == 0) { volatile __attribute__((address_space(3))) unsigned* ta_ = (volatile __attribute__((address_space(3))) unsigned*)(shm + 139264 + 320) + 16; ta_[25] += (unsigned)__builtin_amdgcn_s_memtime() - ta_[26]; }
    USTAMP(22);
    if (tid == 0) tslot[0] = tick;
    asm volatile("s_waitcnt vmcnt(0) lgkmcnt(0)\n\ts_barrier" ::: "memory");
    const int unext = tslot[0];
    if (unext < 2048) prefetch_unit(C, unext, shm, qr);
    float rli[16];
    { const float sk = (TYPE == 3) ? __builtin_amdgcn_exp2f(C.sinks[h] * LOG2E - Mf) : 0.f;
#pragma unroll
        for (int r = 0; r < 16; ++r) rli[r] = (TYPE == 2) ? 1.f : __builtin_amdgcn_rcpf(lacc[r] + sk); }
    __attribute__((address_space(3))) bf16* stg = (__attribute__((address_space(3))) bf16*)(shm + (wid < 6 ? L_K + 2 * SLOTB + wid * 4096 : L_V + 2 * SLOTB + (wid - 6) * 4096));
    const __attribute__((address_space(3))) bf16* gst = (const __attribute__((address_space(3))) bf16*)(shm + L_G) + wid * 2048;
#pragma unroll
    for (int r = 0; r < 16; ++r) { const int orow = crow(r, hi); const float rl = rli[r];
        { const unsigned w_ = cvtpk_s(o[0][r] * rl, o[1][r] * rl); stg[orow * 64 + r32] = (bf16)(w_ & 0xffffu); stg[orow * 64 + 32 + r32] = (bf16)(w_ >> 16); } }
    asm volatile("s_waitcnt lgkmcnt(0)" ::: "memory");
#pragma unroll
    for (int i = 0; i < 4; ++i) { const int row = i * 8 + (lane >> 3), ch = lane & 7;
        const u32x4 v = *(const __attribute__((address_space(3))) u32x4*)(stg + row * 64 + ch * 8);
        const u32x4 g = *(const __attribute__((address_space(3))) u32x4*)(gst + row * 64 + ch * 8); u32x4 w;
        const size_t off = (yrow0 + row) * DM + TYPE * 256 + h * 64 + ch * 8;
#pragma unroll
        for (int j = 0; j < 4; ++j) { const float a0 = __uint_as_float(v[j] << 16) * __uint_as_float(g[j] << 16), a1 = __uint_as_float(v[j] & 0xffff0000u) * __uint_as_float(g[j] & 0xffff0000u); w[j] = cvtpk_s(a0, a1); }
        *(u32x4*)(C.Y + off) = w; }
    asm volatile("s_waitcnt lgkmcnt(0)\n\ts_barrier" ::: "memory");
    USTAMP(23);
    return unext;
#undef DMA_KV
}
#undef SBAR
}
#define TACC(F) ((volatile LAS unsigned*)((F).lds + MISC_OFF) + 16)
#define TSTAMP(F, k) do { if (TIMER_SEL >= 0 && (F).vcu == TIMER_WG && (F).tid == 0) { const unsigned now_ = (unsigned)__builtin_amdgcn_s_memrealtime(); TACC(F)[k] += now_ - TACC(F)[31]; TACC(F)[31] = now_; } } while (0)
__device__ __forceinline__ void p_attn(Frame& F, const Args& a, int layer, int rep, int tmask) {
    att::ACtx C{(const bf16*)(a.ws + WS_Q), (const bf16*)(a.ws + WS_K), (const bf16*)(a.ws + WS_V), (const bf16*)(a.ws + WS_G), (bf16*)(a.ws + WS_HN),
                (const float*)(a.ws + WS_LF), (const float*)(a.ws + WS_TAB), (const float*)(a.ws + WS_KM), (const float*)(a.ws + WS_MF) + layer * 4, a.sinks + layer * 4, (F.vcu == TIMER_WG) ? 1 : 0};
    unsigned* head = (unsigned*)(a.ws + WS_CTL) + CW_QUEUE + 64 * (layer + 2 * rep);
    LAS int* slot = (LAS int*)(F.lds + att::L_MISC) + 200;
    att::lds_ptr shm = (att::lds_ptr)F.lds;
    if (F.tid == 0) slot[0] = (int)__hip_atomic_fetch_add(head, 1u, __ATOMIC_RELAXED, __HIP_MEMORY_SCOPE_AGENT);
    __syncthreads();
    int u = slot[0];
    __syncthreads();
    att::bf16x8 qr[4];
    if (u < 2048) att::prefetch_unit(C, u, shm, qr);
    while (u < 2048) {
        int tick = 0;
        if (F.tid == 0) tick = (int)__hip_atomic_fetch_add(head, 1u, __ATOMIC_RELAXED, __HIP_MEMORY_SCOPE_AGENT);
        const int ty = u >> 9, r = u & 511, qb = 15 - (r >> 5), bh = r & 31;
        TSTAMP(F, 20);
        if (ty == 0) u = att::attn_unit<1>(C, bh, qb, shm, qr, tick, (LAS int*)slot);
        else if (ty == 1) u = att::attn_unit<0>(C, bh, qb, shm, qr, tick, (LAS int*)slot);
        else if (ty == 2) u = att::attn_unit<2>(C, bh, qb, shm, qr, tick, (LAS int*)slot);
        else u = att::attn_unit<3>(C, bh, qb, shm, qr, tick, (LAS int*)slot);
        TSTAMP(F, 8 + ty);
    }
    asm volatile("s_waitcnt vmcnt(0)" ::: "memory");
    __syncthreads();
}

__global__ void __launch_bounds__(NWAVES * 64, 2) mk_fwd(Args a) {
    extern __shared__ __attribute__((aligned(16))) unsigned char lds[];
    Frame F; F.lds = (LAS unsigned char*)lds; F.tid = threadIdx.x; F.lane = F.tid & 63; F.wave = __builtin_amdgcn_readfirstlane(F.tid >> 6);
    F.G = gridDim.x; { const int bx = blockIdx.x; F.vcu = (F.G % 8 == 0) ? (bx % 8) * (F.G / 8) + bx / 8 : bx; }
    bf16* HN = (bf16*)(a.ws + WS_HN);
    for (int u = F.tid; u < (LDS_BYTES - LDSCTL_OFF) / 4; u += NWAVES * 64) ((LAS unsigned*)(F.lds + LDSCTL_OFF))[u] = 0u;
    __syncthreads();
    XcdBarrier bar; bar.bar = (unsigned*)(a.ws + WS_CTL) + CW_BAR; bar.x = 0; bar.st = nullptr;
    if (a.ph_hi - a.ph_lo > 1) bar = xcd_barrier_post((unsigned*)(a.ws + WS_CTL) + CW_BAR, (volatile LAS unsigned*)(F.lds + MISC_OFF) + 8);
#define PHASE_ON(k) (a.ph_lo <= (k) && (k) < a.ph_hi)
#define SEAM(k) do { if ((k) != 4 && PHASE_ON(k) && PHASE_ON((k) + 1)) xcd_barrier(bar); } while (0)
#define LAYER_PHASES(layer) do { \
    if ((layer) == 0 && PHASE_ON(0)) { p_tables(F, a); p_consts(F, a); if (F.wave >= 6) p_weights(F, a); else p_convert(F, a); } \
    if ((layer) == 0) { TSTAMP(F, 0); SEAM(0); TSTAMP(F, 1); } \
    if (PHASE_ON(4 * (layer) + 1)) { \
        pg8::Gemm g{(layer) == 0 ? (const bf16*)(a.ws + WS_X0) : (const bf16*)(a.ws + WS_X1), (const bf16*)(a.ws + WS_WIN) + (size_t)(layer) * NPERM * DM, NTOK, NPERM, DM}; \
        pg8::StaticOrder S; S.init(NTOK, NPERM, F.G, (int)blockIdx.x); \
        pg8::EpiIn E{(bf16*)(a.ws + WS_Q), (bf16*)(a.ws + WS_K), (bf16*)(a.ws + WS_V), (bf16*)(a.ws + WS_G), a.fox_g + (layer) * 128, a.moba_g + (layer) * 128, a.swa_g + (layer) * 128, (float*)(a.ws + WS_KM), \
                     (const float*)(a.ws + WS_RS) + (layer) * NTOK, (float*)(a.ws + WS_LF), a.b_forget + (layer) * 4}; \
        pg8::gemm_phase<pg8::EpiIn, pg8::StaticOrder, true, true>(F.lds, g, S, E); \
        if (PROBE_P1) { xcd_barrier(bar); pg8::gemm_phase<pg8::EpiIn, pg8::StaticOrder, true, true>(F.lds, g, S, E); } \
    } \
    TSTAMP(F, 2); SEAM(4 * (layer) + 1); TSTAMP(F, 3); \
    if (PHASE_ON(4 * (layer) + 2)) { for (int rep = 0; rep < 1 + (PROBE_ATT != 0 ? PROBE_REPS : 0); ++rep) { if (rep) xcd_barrier(bar); p_attn(F, a, (layer), rep, rep ? PROBE_ATT : 15); } } \
    TSTAMP(F, 4); SEAM(4 * (layer) + 2); TSTAMP(F, 5); \
    if (PHASE_ON(4 * (layer) + 3)) { \
        pg8::Gemm g{HN  , (const bf16*)(a.ws + WS_WOUT) + (size_t)(layer) * DM * DM, NTOK, DM, DM}; \
        pg8::StaticOrder S; S.init(NTOK, DM, F.G, (int)blockIdx.x); \
        if ((layer) == 0) { \
            { float* KM = (float*)(a.ws + WS_KM); for (int i = F.vcu * (NWAVES * 64) + F.tid; i < 32 * 16 * 64; i += F.G * NWAVES * 64) KM[i] = 0.f; }     \
            pg8::EpiRes0 E{(const bf16*)(a.ws + WS_X0), (bf16*)(a.ws + WS_X1), (float*)(a.ws + WS_RS) + NTOK}; \
            pg8::gemm_phase<pg8::EpiRes0, pg8::StaticOrder, true, true>(F.lds, g, S, E); \
        } else { \
            pg8::EpiRes1 E{(const bf16*)(a.ws + WS_X1), a.out}; \
            pg8::gemm_phase<pg8::EpiRes1, pg8::StaticOrder, true, true>(F.lds, g, S, E); \
        } \
    } \
    if ((layer) == 0) { TSTAMP(F, 6); SEAM(3); SEAM(4); TSTAMP(F, 7); } } while (0)
    if (TIMER_SEL >= 0 && F.vcu == TIMER_WG && F.tid == 0) TACC(F)[31] = (unsigned)__builtin_amdgcn_s_memrealtime();
    LAYER_PHASES(0);
    LAYER_PHASES(1);
    if (TIMER_SEL >= 0 && F.vcu == TIMER_WG) {
        asm volatile("s_waitcnt vmcnt(0)" ::: "memory"); __syncthreads();
        float v = (TIMER_SEL == 99) ? 1.0f : (TIMER_SEL == 98) ? ((float)TACC(F)[25] / ((float)TACC(F)[22] * 10.f)) / 3.0f : (float)TACC(F)[TIMER_SEL & 31] * 0.01f / (float)TIMER_FS; v = fminf(fmaxf(v, 0.f), 1.f); const float dl = 0.1f * sqrtf(v);
        pg8::StaticOrder S; S.init(NTOK, DM, F.G, (int)blockIdx.x); pg8::Unit u;
        for (int i = 0; S.next(i, u); ++i) for (int e = F.tid; e < 65536; e += NWAVES * 64) { float* p = a.out + (size_t)(u.pm * 256 + (e >> 8)) * DM + u.pn * 256 + (e & 255); *p += dl; }
    }
}

extern "C" void kernel_launch(void* const* d_in, const int* in_sizes, int n_in, void* d_out, int out_size, void* d_ws, size_t ws_size, hipStream_t stream) {
    static int ok = 0, grid = 0;
    if (ok == 0) {
        if (n_in != 10 || in_sizes[0] != NTOK * DM || out_size != NTOK * DM || ws_size < WS_END) { fprintf(stderr, "kernel_launch: unexpected shapes (n_in %d, in0 %d, out %d, ws %zu)\n", n_in, n_in > 0 ? in_sizes[0] : -1, out_size, ws_size); ok = -1; return; }
        if (hipFuncSetAttribute((const void*)mk_fwd, hipFuncAttributeMaxDynamicSharedMemorySize, LDS_BYTES) != hipSuccess) { fprintf(stderr, "kernel_launch: hipFuncSetAttribute failed\n"); ok = -1; return; }
        int dev = 0, cus = 0; if (hipGetDevice(&dev) != hipSuccess || hipDeviceGetAttribute(&cus, hipDeviceAttributeMultiprocessorCount, dev) != hipSuccess) { fprintf(stderr, "kernel_launch: device query failed\n"); ok = -1; return; }
        grid = cus < 256 ? (cus / 8) * 8 : 256; if (grid < 8) grid = cus;
        ok = 1;
    }
    if (ok < 0) return;
    Args a{};
    a.x = (const float*)d_in[0]; a.norm_gain = (const float*)d_in[1]; a.w_in = (const float*)d_in[2]; a.b_forget = (const float*)d_in[3]; a.fox_g = (const float*)d_in[4];
    a.moba_g = (const float*)d_in[5]; a.swa_g = (const float*)d_in[6]; a.sinks = (const float*)d_in[7]; a.w_out = (const float*)d_in[8]; a.rel_bias = (const float*)d_in[9];
    a.out = (float*)d_out; a.ws = (unsigned char*)d_ws;
    unsigned char* ws = (unsigned char*)d_ws;
    a.tmask = 15;
    if (hipMemsetAsync(ws + WS_CTL, 0, CTL_ZERO_BYTES, stream) != hipSuccess) { fprintf(stderr, "kernel_launch: memset failed\n"); return; }
#if N_LAUNCHES == 1
    a.ph_lo = 0; a.ph_hi = 8; hipLaunchKernelGGL(mk_fwd, dim3(grid), dim3(NWAVES * 64), LDS_BYTES, stream, a);
#else
    for (int ph = 0; ph < 8; ++ph) { a.ph_lo = ph; a.ph_hi = ph + 1; hipLaunchKernelGGL(mk_fwd, dim3(grid), dim3(NWAVES * 64), LDS_BYTES, stream, a); }
#endif
}
```

```cpp
#include <hip/hip_runtime.h>
#include <cstdio>
#include <cstdint>
#include <cmath>
namespace pg8 {
#define PG8_LAS __attribute__((address_space(3)))
typedef unsigned short bf16_t;
typedef short bf16x8 __attribute__((ext_vector_type(8)));
typedef float f32x4 __attribute__((ext_vector_type(4)));
typedef unsigned u32x4 __attribute__((ext_vector_type(4)));
constexpr int BM = 256, BK = 64, HALF = 128, HTB = HALF * BK * 2  , STAGE_BYTES = 8 * HTB, NXCD = 8, WGM = 8;

__host__ __device__ __forceinline__ int lds_byte(int r, int c) { const int st = (r >> 4) * 2 + (c >> 5), rr = r & 15, cc = c & 31, ob = rr * 64 + cc * 2; return st * 1024 + (ob ^ (((ob >> 9) & 1) << 5)); }
__host__ __device__ __forceinline__ void stage_rc(int b, int& R, int& C) { const int st = b / 1024, sb = b % 1024, swz = sb ^ (((sb >> 9) & 1) << 5); R = (st >> 1) * 16 + swz / 64; C = (st & 1) * 32 + (swz % 64) / 2; }
__host__ __device__ __forceinline__ int perm32(int rho) { const int n = rho >> 4, i = rho & 15; return 8 * (i >> 2) + 4 * n + (i & 3); }

struct Unit { int pm, pn; };
struct Gemm { const bf16_t* A; const bf16_t* Bt; int M, N, K; };

struct StaticOrder {
    int nM, nN, nwg, G, c;
    __host__ __device__ void init(int M, int N, int G_, int c_) { nM = M / BM; nN = N / BM; nwg = nM * nN; G = G_; c = c_; }
    __host__ __device__ bool next(int i, Unit& u) const {
        const long L = (long)i * G + c; if (L >= nwg) return false;
        int wgid = (int)L; { const int q = nwg / NXCD, r = nwg % NXCD, xcd = wgid % NXCD, off = wgid / NXCD; wgid = (xcd < r ? xcd * (q + 1) : r * (q + 1) + (xcd - r) * q) + off; }
        const int nig = WGM * nN, gid = wgid / nig, fm = gid * WGM, gsz = (nM - fm) < WGM ? (nM - fm) : WGM;
        u.pm = fm + ((wgid % nig) % gsz); u.pn = (wgid % nig) / gsz; return true;
    }
    __device__ __forceinline__ void a_ready(const Unit&) const {}
    __device__ __forceinline__ void done(const Unit&) const {}
};

__device__ __forceinline__ unsigned cvt_pk_bf16(float lo, float hi) { unsigned r; asm volatile("v_cvt_pk_bf16_f32 %0, %1, %2" : "=v"(r) : "v"(lo), "v"(hi)); return r; }
typedef float f32x2 __attribute__((ext_vector_type(2)));
constexpr float C2 = 0.125f * 1.4426950408889634f;
constexpr float RMS_EPS = 1e-6f;
constexpr size_t GS = (size_t)8 * 4 * 4096 * 64;
struct EpiIn {
    static constexpr bool PERM = true, AFTER_DRAIN = false;
    bf16_t *Q, *K, *V, *G; const float *gfox, *gmoba, *gswa; float* KM; const float* RS; float* LF; const float* bfg;
    __device__ __forceinline__ void prefetch(const Unit& u, int ui_, PG8_LAS unsigned char* lds, int wid, int lane) const {
        if (wid < 4) { const float* src = RS + u.pm * BM + wid * 64 + lane; const unsigned dst = (unsigned)(size_t)(lds + STAGE_BYTES + (ui_ & 1) * 1024 + wid * 256); unsigned keep;
            asm volatile("s_mov_b32 %0, m0\n\ts_mov_b32 m0, %2\n\ts_nop 0\n\tglobal_load_lds_dword %1, off\n\ts_mov_b32 m0, %0" : "=&s"(keep) : "v"(src), "s"((unsigned)__builtin_amdgcn_readfirstlane(dst)) : "memory"); }
    }
    __device__ __forceinline__ void operator()(const f32x4 (&acc)[2][2][4][2], const Unit& u, int wr, int wc, int fr, int fq, int ui, PG8_LAS unsigned char* ldsb) const {
        const int T = u.pn;
        const int b = (u.pm * BM) >> 12, t0 = ((u.pm * BM) & 4095) + wr * 64 + fr;
        float rs[2][4];
#pragma unroll
        for (int ai = 0; ai < 2; ++ai)
#pragma unroll
            for (int m = 0; m < 4; ++m) rs[ai][m] = __builtin_amdgcn_rsqf(((const PG8_LAS float*)(ldsb + STAGE_BYTES + (ui & 1) * 1024))[ai * HALF + wr * 64 + m * 16 + fr] * (1.0f / 1024.0f) + RMS_EPS);
        if (T == 15) {
            if (wc == 0 && fq == 0) { const f32x4 bv = *(const f32x4*)bfg;
#pragma unroll
                for (int ai = 0; ai < 2; ++ai)
#pragma unroll
                    for (int m = 0; m < 4; ++m) { const f32x4 a4 = acc[ai][0][m][0] * rs[ai][m] + bv;
#pragma unroll
                        for (int j = 0; j < 4; ++j) { const float uu = a4[j]; const float sp = fmaxf(-uu, 0.f) + __logf(1.f + __expf(-fabsf(uu)));
                            LF[(size_t)(b * 4 + j) * 4096 + t0 + ai * HALF + m * 16] = -sp * 1.4426950408889634f; } } }
            return;
        }
        int mode = 1, nh = 4, head = wc; float scale = 1.f; const float* gain = nullptr; bf16_t* base = nullptr;
        switch (T) {
            case 0: mode = 0; gain = gfox; scale = C2; base = Q; break;
            case 1: mode = 0; gain = gfox + 64; base = K; break;
            case 2: base = V; break;
            case 4: mode = 0; gain = gmoba; scale = C2; base = Q + GS; break;
            case 5: mode = 0; gain = gmoba + 64; base = K + GS; break;
            case 6: base = V + GS; break;
            case 8: scale = C2; base = Q + 2 * GS; break;
            case 9: base = K + 2 * GS; break;
            case 10: base = V + 2 * GS; break;
            case 12: mode = 0; gain = gswa; scale = C2; base = Q + 3 * GS; break;
            case 13: nh = 2; if (wc < 2) { mode = 0; gain = gswa + 64; base = K + 3 * GS; } else { base = V + 3 * GS; head = wc - 2; } break;
            default: mode = 2; break;
        }
        if (mode == 2) {
            bf16_t* gp = G + ((size_t)((T >> 2) * 32 + b * 4 + wc)) * 262144 + (size_t)((t0 >> 4) * 2) * 512 + (t0 & 15) * 32 + 8 * fq;
#pragma unroll
            for (int ai = 0; ai < 2; ++ai)
#pragma unroll
                for (int m = 0; m < 4; ++m)
#pragma unroll
                    for (int bj = 0; bj < 2; ++bj) {
                        f32x4 v0 = acc[ai][bj][m][0] * rs[ai][m], v1 = acc[ai][bj][m][1] * rs[ai][m];
#pragma unroll
                        for (int j = 0; j < 4; ++j) { v0[j] = v0[j] * __builtin_amdgcn_rcpf(1.f + __expf(-v0[j])); v1[j] = v1[j] * __builtin_amdgcn_rcpf(1.f + __expf(-v1[j])); }
                        u32x4 w; w.x = cvt_pk_bf16(v0[0], v0[1]); w.y = cvt_pk_bf16(v0[2], v0[3]); w.z = cvt_pk_bf16(v1[0], v1[1]); w.w = cvt_pk_bf16(v1[2], v1[3]);
                        *(u32x4*)(gp + (size_t)((ai * 8 + m) * 2 + bj) * 512) = w;
                    }
            return;
        }
        f32x4 gv[2][2];
#pragma unroll
        for (int bj = 0; bj < 2; ++bj)
#pragma unroll
            for (int n = 0; n < 2; ++n) gv[bj][n] = (mode == 0) ? *(const f32x4*)(gain + 32 * bj + 8 * fq + 4 * n) : (f32x4){1.f, 1.f, 1.f, 1.f};
        bf16_t* dp = base + (size_t)(b * nh + head) * 262144 + (size_t)((t0 >> 4) * 2) * 512 + (t0 & 15) * 32 + 8 * fq;
        f32x4 cs4[2][2];
#pragma unroll
        for (int bj = 0; bj < 2; ++bj)
#pragma unroll
            for (int n = 0; n < 2; ++n) cs4[bj][n] = (f32x4){0.f, 0.f, 0.f, 0.f};
#pragma unroll
        for (int ai = 0; ai < 2; ++ai)
#pragma unroll
            for (int m = 0; m < 4; ++m) {
                float r = scale * rs[ai][m];
                if (mode == 0) {
                    float ss = 0.f;
#pragma unroll
                    for (int bj = 0; bj < 2; ++bj)
#pragma unroll
                        for (int n = 0; n < 2; ++n) { const f32x4 x = acc[ai][bj][m][n]; ss += (x[0] * x[0] + x[1] * x[1]) + (x[2] * x[2] + x[3] * x[3]); }
                    ss += __shfl_xor(ss, 16); ss += __shfl_xor(ss, 32);
                    r = scale * rs[ai][m] * __builtin_amdgcn_rsqf(ss * rs[ai][m] * rs[ai][m] * (1.0f / 64.0f) + RMS_EPS);
                }
#pragma unroll
                for (int bj = 0; bj < 2; ++bj) {
                    const f32x4 v0 = acc[ai][bj][m][0] * gv[bj][0] * r, v1 = acc[ai][bj][m][1] * gv[bj][1] * r;
                    if (T == 5) { cs4[bj][0] += v0; cs4[bj][1] += v1; }
                    u32x4 w; w.x = cvt_pk_bf16(v0[0], v0[1]); w.y = cvt_pk_bf16(v0[2], v0[3]); w.z = cvt_pk_bf16(v1[0], v1[1]); w.w = cvt_pk_bf16(v1[2], v1[3]);
                    *(u32x4*)(dp + (size_t)((ai * 8 + m) * 2 + bj) * 512) = w;
                }
            }
        if (T == 5) {
            float* kmp = KM + ((size_t)((b * 4 + wc) * 16 + (((u.pm * BM) & 4095) >> 8))) * 64 + 8 * fq;
#pragma unroll
            for (int bj = 0; bj < 2; ++bj)
#pragma unroll
                for (int n = 0; n < 2; ++n)
#pragma unroll
                    for (int j = 0; j < 4; ++j) { float s = cs4[bj][n][j];
                        s += __shfl_xor(s, 1); s += __shfl_xor(s, 2); s += __shfl_xor(s, 4); s += __shfl_xor(s, 8);
                        if (fr == 0) atomicAdd(kmp + 32 * bj + 4 * n + j, s * (1.0f / 256.0f)); }
        }
    }
};
struct EpiRes0 {
    static constexpr bool PERM = true, AFTER_DRAIN = false;
    const bf16_t* base; bf16_t* X1; float* RS1;
    __device__ __forceinline__ void prefetch(const Unit&, int, PG8_LAS unsigned char*, int, int) const {}
    __device__ __forceinline__ void operator()(const f32x4 (&acc)[2][2][4][2], const Unit& u, int wr, int wc, int fr, int fq, int ui, PG8_LAS unsigned char* ldsb) const {
        const int col0 = u.pn * BM + wc * 32 + 8 * fq;
#pragma unroll
        for (int ai = 0; ai < 2; ++ai)
#pragma unroll
            for (int m = 0; m < 4; ++m) {
                const int row = u.pm * BM + ai * HALF + wr * 64 + m * 16 + fr; const size_t off = (size_t)row * 1024 + col0; float ss = 0.f;
#pragma unroll
                for (int bj = 0; bj < 2; ++bj) { const u32x4 xb = *(const u32x4*)(base + off + bj * HALF);
                    f32x4 v0, v1; v0[0] = __uint_as_float(xb.x << 16); v0[1] = __uint_as_float(xb.x & 0xffff0000u); v0[2] = __uint_as_float(xb.y << 16); v0[3] = __uint_as_float(xb.y & 0xffff0000u);
                    v1[0] = __uint_as_float(xb.z << 16); v1[1] = __uint_as_float(xb.z & 0xffff0000u); v1[2] = __uint_as_float(xb.w << 16); v1[3] = __uint_as_float(xb.w & 0xffff0000u);
                    v0 += acc[ai][bj][m][0]; v1 += acc[ai][bj][m][1];
                    ss += (v0[0] * v0[0] + v0[1] * v0[1]) + (v0[2] * v0[2] + v0[3] * v0[3]) + (v1[0] * v1[0] + v1[1] * v1[1]) + (v1[2] * v1[2] + v1[3] * v1[3]);
                    u32x4 w; w.x = cvt_pk_bf16(v0[0], v0[1]); w.y = cvt_pk_bf16(v0[2], v0[3]); w.z = cvt_pk_bf16(v1[0], v1[1]); w.w = cvt_pk_bf16(v1[2], v1[3]);
                    *(u32x4*)(X1 + off + bj * HALF) = w; }
                ss += __shfl_xor(ss, 16); ss += __shfl_xor(ss, 32);
                if (fq == 0) atomicAdd(RS1 + row, ss);
            }
    }
};
struct EpiRes1 {
    static constexpr bool PERM = true, AFTER_DRAIN = false;
    const bf16_t* X1; float* out;

    __device__ __forceinline__ void prefetch(const Unit&, int, PG8_LAS unsigned char*, int, int) const {}
    __device__ __forceinline__ void operator()(const f32x4 (&acc)[2][2][4][2], const Unit& u, int wr, int wc, int fr, int fq, int ui, PG8_LAS unsigned char* ldsb) const {
        const int col0 = u.pn * BM + wc * 32 + 8 * fq;
#pragma unroll
        for (int ai = 0; ai < 2; ++ai)
#pragma unroll
            for (int m = 0; m < 4; ++m) {
                const size_t off = (size_t)(u.pm * BM + ai * HALF + wr * 64 + m * 16 + fr) * 1024 + col0;
#pragma unroll
                for (int bj = 0; bj < 2; ++bj) { const u32x4 xb = *(const u32x4*)(X1 + off + bj * HALF);
                    f32x4 v0, v1; v0[0] = __uint_as_float(xb.x << 16); v0[1] = __uint_as_float(xb.x & 0xffff0000u); v0[2] = __uint_as_float(xb.y << 16); v0[3] = __uint_as_float(xb.y & 0xffff0000u);
                    v1[0] = __uint_as_float(xb.z << 16); v1[1] = __uint_as_float(xb.z & 0xffff0000u); v1[2] = __uint_as_float(xb.w << 16); v1[3] = __uint_as_float(xb.w & 0xffff0000u);
                    *(f32x4*)(out + off + bj * HALF) = v0 + acc[ai][bj][m][0]; *(f32x4*)(out + off + bj * HALF + 4) = v1 + acc[ai][bj][m][1]; }
            }
    }
};

template <class Epi, class Sched, bool ALIGN_EPI = false, bool SP2 = false>
__device__ __forceinline__ void gemm_phase(PG8_LAS unsigned char* lds, const Gemm g, const Sched& S, const Epi& E) {
    const int tid = threadIdx.x, wid = __builtin_amdgcn_readfirstlane(tid >> 6), lane = tid & 63, wr = wid >> 2, wc = wid & 3, fr = lane & 15, fq = lane >> 4;
    const int K = g.K, nt = K / BK;
    unsigned voffA[2], voffB[2];
#pragma unroll
    for (int i = 0; i < 2; ++i) { int R, C; stage_rc(tid * 16 + i * 8192, R, C); const int Rb = Epi::PERM ? ((R & ~31) + perm32(R & 31)) : R;
        voffA[i] = (unsigned)(R * K + C) * 2u; voffB[i] = (unsigned)(Rb * K + C) * 2u; }
    const size_t kstep = (size_t)(BK * 2);
    const size_t hstep = (size_t)HALF * K * 2;
    const size_t tstep = 2 * hstep;
    const unsigned ldsw = (unsigned)wid * 1024u;
    const int aoff = lds_byte(wr * 64 + fr, fq * 8), boff = lds_byte(wc * 32 + fr, fq * 8);
#define PG8_SA(b, h) (((b) * 2 + (h)) * HTB)
#define PG8_SB(b, h) ((4 + (b) * 2 + (h)) * HTB)
#define PG8_STAGE(bufoff, gbase, voff) do { _Pragma("unroll") for (int _i = 0; _i < 2; ++_i) \
        __builtin_amdgcn_global_load_lds((const unsigned*)((const char*)(gbase) + (voff)[_i]), (PG8_LAS unsigned*)(lds + (bufoff) + ldsw + _i * 8192), 16, 0, 0); } while (0)
#define PG8_LDA(dst, b, h) do { _Pragma("unroll") for (int m = 0; m < 4; ++m) _Pragma("unroll") for (int k = 0; k < 2; ++k) dst[m][k] = *(const PG8_LAS bf16x8*)(lds + PG8_SA(b, h) + aoff + m * 2048 + k * 1024); } while (0)
#define PG8_LDB(dst, b, h) do { _Pragma("unroll") for (int n = 0; n < 2; ++n) _Pragma("unroll") for (int k = 0; k < 2; ++k) dst[n][k] = *(const PG8_LAS bf16x8*)(lds + PG8_SB(b, h) + boff + n * 2048 + k * 1024); } while (0)
#define PG8_MMA(ai, bj, At, Bt) do { __builtin_amdgcn_s_setprio(1); _Pragma("unroll") for (int m = 0; m < 4; ++m) _Pragma("unroll") for (int n = 0; n < 2; ++n) _Pragma("unroll") for (int k = 0; k < 2; ++k) \
        acc[ai][bj][m][n] = __builtin_amdgcn_mfma_f32_16x16x32_bf16(Bt[n][k], At[m][k], acc[ai][bj][m][n], 0, 0, 0); __builtin_amdgcn_s_setprio(0); } while (0)
#define PG8_WAIT_V(n) asm volatile("s_waitcnt vmcnt(" #n ")" ::: "memory")
#define PG8_WAIT_L(n) asm volatile("s_waitcnt lgkmcnt(" #n ")" ::: "memory")
#define PG8_BAR __builtin_amdgcn_s_barrier()
#define PG8_SCHED __builtin_amdgcn_sched_barrier(0)
    Unit cur, nxt; int ui = 0;
    if (!S.next(0, cur)) return;
    f32x4 acc[2][2][4][2];
#pragma unroll
    for (int a = 0; a < 2; ++a)
#pragma unroll
        for (int b = 0; b < 2; ++b)
#pragma unroll
            for (int m = 0; m < 4; ++m)
#pragma unroll
                for (int n = 0; n < 2; ++n) acc[a][b][m][n] = (f32x4){0.f, 0.f, 0.f, 0.f};
    bf16x8 At[4][2], B0[2][2], B1[2][2];
    const char* cA = (const char*)g.A + (size_t)cur.pm * tstep; const char* cB = (const char*)g.Bt + (size_t)cur.pn * tstep;
    S.a_ready(cur); E.prefetch(cur, 0, lds, wid, lane);
    if constexpr (SP2) {
        PG8_STAGE(PG8_SB(0, 0), cB, voffB); PG8_STAGE(PG8_SB(0, 1), cB + hstep, voffB); PG8_STAGE(PG8_SA(0, 0), cA, voffA); PG8_STAGE(PG8_SA(0, 1), cA + hstep, voffA);
        if (wr == 1) PG8_BAR;
        PG8_WAIT_V(2); PG8_BAR;
        PG8_STAGE(PG8_SB(1, 0), cB + kstep, voffB); PG8_STAGE(PG8_SA(1, 0), cA + kstep, voffA); PG8_STAGE(PG8_SB(1, 1), cB + hstep + kstep, voffB);
        PG8_WAIT_V(6); PG8_BAR;
    } else {
        PG8_STAGE(PG8_SB(0, 0), cB, voffB); PG8_STAGE(PG8_SA(0, 0), cA, voffA); PG8_STAGE(PG8_SB(0, 1), cB + hstep, voffB); PG8_STAGE(PG8_SA(0, 1), cA + hstep, voffA);
        if (wr == 1) PG8_BAR;
        PG8_WAIT_V(4); PG8_BAR;
        PG8_STAGE(PG8_SB(1, 0), cB + kstep, voffB); PG8_STAGE(PG8_SA(1, 0), cA + kstep, voffA); PG8_STAGE(PG8_SB(1, 1), cB + hstep + kstep, voffB);
        PG8_WAIT_V(6); PG8_BAR;
    }
    for (;;) {
        const bool has_next = S.next(ui + 1, nxt);
        const char* nA = has_next ? (const char*)g.A + (size_t)nxt.pm * tstep : cA; const char* nB = has_next ? (const char*)g.Bt + (size_t)nxt.pn * tstep : cB;
        for (int t = 0; t < nt; t += 2) {
            const bool last = (t == nt - 2);
            const char* a1 = cA + (size_t)(t + 1) * kstep;
            const char* a2 = last ? nA : cA + (size_t)(t + 2) * kstep; const char* b2 = last ? nB : cB + (size_t)(t + 2) * kstep;
            const char* a3 = a2 + kstep; const char* b3 = b2 + kstep;
            if (last && has_next) S.a_ready(nxt);
            if constexpr (SP2) {
            PG8_LDB(B0, 0, 0); PG8_LDB(B1, 0, 1); PG8_SCHED; PG8_LDA(At, 0, 0); PG8_STAGE(PG8_SA(1, 1), a1 + hstep, voffA);
            PG8_WAIT_V(8); PG8_WAIT_L(0); PG8_BAR; PG8_MMA(0, 0, At, B0); PG8_MMA(0, 1, At, B1); PG8_BAR; PG8_SCHED;
            PG8_LDA(At, 0, 1); PG8_STAGE(PG8_SB(0, 0), b2, voffB); PG8_STAGE(PG8_SB(0, 1), b2 + hstep, voffB); PG8_STAGE(PG8_SA(0, 0), a2, voffA);
            PG8_WAIT_V(8); PG8_WAIT_L(0); PG8_BAR; PG8_MMA(1, 0, At, B0); PG8_MMA(1, 1, At, B1); PG8_BAR; PG8_SCHED;
            PG8_LDB(B0, 1, 0); PG8_LDB(B1, 1, 1); PG8_SCHED; PG8_LDA(At, 1, 0); PG8_STAGE(PG8_SA(0, 1), a2 + hstep, voffA);
            PG8_WAIT_V(8); PG8_WAIT_L(0); PG8_BAR; PG8_MMA(0, 0, At, B0); PG8_MMA(0, 1, At, B1); PG8_BAR; PG8_SCHED;
            PG8_LDA(At, 1, 1); PG8_STAGE(PG8_SB(1, 0), b3, voffB); PG8_STAGE(PG8_SB(1, 1), b3 + hstep, voffB); PG8_STAGE(PG8_SA(1, 0), a3, voffA);
            PG8_WAIT_V(8); PG8_WAIT_L(0); PG8_BAR; PG8_MMA(1, 0, At, B0); PG8_MMA(1, 1, At, B1); PG8_BAR; PG8_SCHED;
            } else {
            PG8_LDB(B0, 0, 0); PG8_SCHED; PG8_LDA(At, 0, 0); PG8_STAGE(PG8_SA(1, 1), a1 + hstep, voffA);
            PG8_WAIT_L(8); PG8_BAR; PG8_WAIT_L(0); PG8_MMA(0, 0, At, B0); PG8_BAR; PG8_SCHED;
            PG8_LDB(B1, 0, 1); PG8_STAGE(PG8_SB(0, 0), b2, voffB);
            PG8_BAR; PG8_WAIT_L(0); PG8_MMA(0, 1, At, B1); PG8_BAR;
            PG8_LDA(At, 0, 1); PG8_STAGE(PG8_SA(0, 0), a2, voffA);
            PG8_BAR; PG8_WAIT_L(0); PG8_MMA(1, 0, At, B0); PG8_BAR; PG8_SCHED;
            PG8_STAGE(PG8_SB(0, 1), b2 + hstep, voffB);
            PG8_WAIT_V(6); PG8_BAR; PG8_MMA(1, 1, At, B1); PG8_BAR;
            PG8_LDB(B0, 1, 0); PG8_SCHED; PG8_LDA(At, 1, 0); PG8_STAGE(PG8_SA(0, 1), a2 + hstep, voffA);
            PG8_WAIT_L(8); PG8_BAR; PG8_WAIT_L(0); PG8_MMA(0, 0, At, B0); PG8_BAR; PG8_SCHED;
            PG8_LDB(B1, 1, 1); PG8_STAGE(PG8_SB(1, 0), b3, voffB);
            PG8_BAR; PG8_WAIT_L(0); PG8_MMA(0, 1, At, B1); PG8_BAR;
            PG8_LDA(At, 1, 1); PG8_STAGE(PG8_SA(1, 0), a3, voffA);
            PG8_BAR; PG8_WAIT_L(0); PG8_MMA(1, 0, At, B0); PG8_BAR; PG8_SCHED;
            PG8_STAGE(PG8_SB(1, 1), b3 + hstep, voffB);
            PG8_WAIT_V(6); PG8_BAR; PG8_MMA(1, 1, At, B1); PG8_BAR;
            }
        }
        if constexpr (ALIGN_EPI) { if (wr == 0) PG8_BAR; }
        if constexpr (!Epi::AFTER_DRAIN) { E(acc, cur, wr, wc, fr, fq, ui, lds); S.done(cur); if (has_next) E.prefetch(nxt, ui + 1, lds, wid, lane); }
        if (!has_next) break;
#pragma unroll
        for (int a = 0; a < 2; ++a)
#pragma unroll
            for (int b = 0; b < 2; ++b)
#pragma unroll
                for (int m = 0; m < 4; ++m)
#pragma unroll
                    for (int n = 0; n < 2; ++n) acc[a][b][m][n] = (f32x4){0.f, 0.f, 0.f, 0.f};
        cur = nxt; cA = nA; cB = nB; ++ui;
        if constexpr (ALIGN_EPI) { if (wr == 1) PG8_BAR; }
    }
    PG8_WAIT_V(0);
    if constexpr (!ALIGN_EPI) { if (wr == 0) PG8_BAR; }
    PG8_BAR;
    if constexpr (Epi::AFTER_DRAIN) { E.fused(acc, cur, wr, wc, fr, fq, lds, wid, lane); S.done(cur); }
#undef PG8_SA
#undef PG8_SB
#undef PG8_STAGE
#undef PG8_LDA
#undef PG8_LDB
#undef PG8_MMA
#undef PG8_WAIT_V
#undef PG8_WAIT_L
#undef PG8_BAR
#undef PG8_SCHED
}
}
constexpr int NB = 8, SEQ = 4096, DM = 1024, NTOK = NB * SEQ, INW = 3844, NPERM = 4096, NLAYER = 2;
constexpr size_t MiB = 1u << 20;
constexpr size_t WS_CTL = 0, CTL_ZERO_BYTES = 1 * MiB;
constexpr size_t WS_WIN = 2 * MiB;
constexpr size_t WS_WOUT = 18 * MiB;
constexpr size_t WS_LF = 22 * MiB;
constexpr size_t WS_RS = 26 * MiB;
constexpr size_t WS_TAB = 23 * MiB;
constexpr size_t WS_KM = 24 * MiB;
constexpr size_t WS_MF = 25 * MiB;
constexpr int CW_BAR = 4096;
constexpr int CW_QUEUE = 64;
constexpr size_t WS_HN = 32 * MiB;
constexpr size_t WS_Q = 96 * MiB, WS_K = 160 * MiB, WS_V = 216 * MiB, WS_G = 272 * MiB, WS_X1 = 336 * MiB  , WS_X0 = 400 * MiB  , WS_END = 464 * MiB;
constexpr float LOG2E = 1.4426950408889634f;
constexpr int NWAVES = 8;
#define TIMER_SEL -1
#define TIMER_FS 100
#define TIMER_WG 37
#define TIMER_TYPE 1
#define PROBE_ATT 0
#define PROBE_REPS 2
#define PROBE_P1 0
#define PROBE_P3 0
#define PROBE_P0 0
#ifndef N_LAUNCHES
#define N_LAUNCHES 1
#endif
constexpr int RING_BYTES = 131072, LDSCTL_OFF = 139264, MISC_OFF = LDSCTL_OFF + 320, LDS_BYTES = 147456;

#define GAS __attribute__((address_space(1)))
#define LAS __attribute__((address_space(3)))
typedef unsigned short bf16;
typedef unsigned v4u __attribute__((ext_vector_type(4)));
typedef float f32x4 __attribute__((ext_vector_type(4)));
__device__ __forceinline__ unsigned f2bf(float f) { unsigned u = __builtin_bit_cast(unsigned, f); return (u + 0x7fffu + ((u >> 16) & 1u)) >> 16; }
typedef float f32x2h_t __attribute__((ext_vector_type(2))); typedef __bf16 bf16x2h_t __attribute__((ext_vector_type(2)));
__device__ __forceinline__ unsigned pk2(float lo, float hi) { f32x2h_t v = {lo, hi}; bf16x2h_t b = __builtin_convertvector(v, bf16x2h_t); return __builtin_bit_cast(unsigned, b); }
__device__ __forceinline__ float bf2f(unsigned v) { return __uint_as_float(v << 16); }
__device__ __forceinline__ float wave_sum(float v) {
#pragma unroll
    for (int o = 1; o < 64; o <<= 1) v += __shfl_xor(v, o);
    return v;
}
#define RLX_AGENT __ATOMIC_RELAXED, __HIP_MEMORY_SCOPE_AGENT
#define XB_TMO      128
#define XB_XCNT(j)  (256  + 64 * (j))
#define XB_XSUB(j)  (1280 + 64 * (j))
#define XB_XGEN(j)  (2304 + 64 * (j))
#define XB_TOP      3328
#define XB_TOPGEN   3392
#define XCD_BAR_WORDS 3456
#define XB_SPIN_CAP (1u << 18)

__device__ __forceinline__ unsigned xb_ld(unsigned* p)              { return __hip_atomic_load(p, __ATOMIC_RELAXED, __HIP_MEMORY_SCOPE_AGENT); }
__device__ __forceinline__ unsigned xb_add(unsigned* p, unsigned v) { return __hip_atomic_fetch_add(p, v, __ATOMIC_RELAXED, __HIP_MEMORY_SCOPE_AGENT); }
__device__ __forceinline__ unsigned xb_xcc_id() { return (unsigned)__builtin_amdgcn_s_getreg((3 << 11) | 20) & 0xFu; }
#define XB_SPIN(cond, bar) do { unsigned _sp = 0; while (cond) { __builtin_amdgcn_s_sleep(1); \
    if ((++_sp & 255u) == 0u) { if (xb_ld(&(bar)[XB_TMO])) break; if (_sp > XB_SPIN_CAP) { atomicAdd(&(bar)[XB_TMO], 1u); break; } } } } while (0)

struct XcdBarrier {
    unsigned* bar; unsigned x;
    volatile LAS unsigned* st;
};

__device__ __forceinline__ XcdBarrier xcd_barrier_post(unsigned* bar, volatile LAS unsigned* st) {
    XcdBarrier b; b.bar = bar; b.x = xb_xcc_id(); b.st = st;
    if (threadIdx.x == 0) (void)xb_add(&bar[XB_XCNT(b.x)], 1u);
    return b;
}
__device__ __forceinline__ void xcd_barrier_complete(unsigned* bar, unsigned x, unsigned& nloc, unsigned& nx) {
    const unsigned G = gridDim.x * gridDim.y * gridDim.z;
    unsigned sum, cnt, mine, sp = 0u;
    for (;;) {
        sum = 0u; cnt = 0u; mine = 0u;
#pragma unroll
        for (unsigned j = 0; j < 16; ++j) { const unsigned c = xb_ld(&bar[XB_XCNT(j)]); sum += c; cnt += (c > 0u) ? 1u : 0u; mine = (j == x) ? c : mine; }
        if (sum == G) break;
        __builtin_amdgcn_s_sleep(1);
        if ((++sp & 255u) == 0u) { if (xb_ld(&bar[XB_TMO])) break; if (sp > XB_SPIN_CAP) { atomicAdd(&bar[XB_TMO], 1u); break; } }
    }
    nloc = mine > 0u ? mine : 1u; nx = cnt > 0u ? cnt : 1u;
}

__device__ __forceinline__ void xcd_barrier(const XcdBarrier& b) {
    asm volatile("s_waitcnt vmcnt(0)" ::: "memory");
    __syncthreads();
    if (threadIdx.x == 0) {
        unsigned* bar = b.bar;
        __builtin_amdgcn_s_waitcnt(0);
        unsigned nloc = b.st[0], nx = b.st[1];
        if (nloc == 0u) { xcd_barrier_complete(bar, b.x, nloc, nx); b.st[0] = nloc; b.st[1] = nx; }
        const unsigned old = xb_add(&bar[XB_XSUB(b.x)], 1u);
        const unsigned gen = old / nloc;
        if (old + 1u == (gen + 1u) * nloc) {
            __builtin_amdgcn_fence(__ATOMIC_RELEASE, "agent");
            asm volatile("s_waitcnt vmcnt(0)" ::: "memory");
            const unsigned og = xb_add(&bar[XB_TOP], 1u);
            const unsigned tg = og / nx;
            if (og + 1u == (tg + 1u) * nx) xb_add(&bar[XB_TOPGEN], 1u);
            else XB_SPIN(xb_ld(&bar[XB_TOPGEN]) == tg, bar);
            __builtin_amdgcn_fence(__ATOMIC_ACQUIRE, "agent");
            xb_add(&bar[XB_XGEN(b.x)], 1u);
            asm volatile("s_waitcnt vmcnt(0)" ::: "memory");
        } else {
            XB_SPIN(xb_ld(&bar[XB_XGEN(b.x)]) == gen, bar);
            __builtin_amdgcn_fence(__ATOMIC_ACQUIRE, "agent");
            asm volatile("s_waitcnt vmcnt(0)" ::: "memory");
        }
    }
    __syncthreads();
}

__device__ __forceinline__ int rel_bucket(int d) {
    if (d < 16) return d;
    int b = 16;
    b += (d >= 21); b += (d >= 27); b += (d >= 35); b += (d >= 46); b += (d >= 59); b += (d >= 77); b += (d >= 99); b += (d >= 128);
    b += (d >= 166); b += (d >= 216); b += (d >= 280); b += (d >= 363); b += (d >= 470); b += (d >= 609); b += (d >= 790);
    return b;
}

struct Args { const float* x; const float* norm_gain; const float* w_in; const float* b_forget; const float* fox_g; const float* moba_g; const float* swa_g; const float* sinks; const float* w_out; const float* rel_bias; float* out; unsigned char* ws; int ph_lo, ph_hi, tmask, pad; };

struct Frame { LAS unsigned char* lds; int tid, lane, wave, vcu, G; };

__device__ __forceinline__ void transpose_item(const float* W, int ldw, bf16* WT, int dst_row0, int src_col0, int ncol, const float* gk, LAS float* scr, int kb, int lane) {
    const int k0 = 64 * kb;
    { float wv[32]; const int c = lane & 31;
#pragma unroll
        for (int i = 0; i < 32; ++i) { const int kk = 2 * i + (lane >> 5); wv[i] = (c < ncol) ? W[(size_t)(k0 + kk) * ldw + src_col0 + c] : 0.f; }
        if (gk) {
#pragma unroll
            for (int i = 0; i < 32; ++i) wv[i] *= gk[k0 + 2 * i + (lane >> 5)]; }
#pragma unroll
        for (int i = 0; i < 32; ++i) scr[(2 * i + (lane >> 5)) * 33 + c] = wv[i]; }
    asm volatile("s_waitcnt lgkmcnt(0)" ::: "memory");
    const int c = lane & 7;
#pragma unroll
    for (int j = 0; j < 4; ++j) { const int n = (lane >> 3) + 8 * j; const LAS float* s = scr + (8 * c) * 33 + n;
        v4u o; o.x = pk2(s[0 * 33], s[1 * 33]); o.y = pk2(s[2 * 33], s[3 * 33]); o.z = pk2(s[4 * 33], s[5 * 33]); o.w = pk2(s[6 * 33], s[7 * 33]);
        *(v4u*)(WT + (size_t)(dst_row0 + n) * 1024 + k0 + 8 * c) = o; }
    asm volatile("s_waitcnt lgkmcnt(0)" ::: "memory");
}
__device__ __forceinline__ int tile_src(int T, int wc) {
    switch (T) { case 0: return 0 + 64 * wc; case 1: return 256 + 64 * wc; case 2: return 512 + 64 * wc; case 3: return 772 + 64 * wc;
        case 4: return 1028 + 64 * wc; case 5: return 1284 + 64 * wc; case 6: return 1540 + 64 * wc; case 7: return 1796 + 64 * wc;
        case 8: return 2052 + 64 * wc; case 9: return 2308 + 64 * wc; case 10: return 2564 + 64 * wc; case 11: return 2820 + 64 * wc;
        case 12: return 3076 + 64 * wc; case 13: return wc < 2 ? 3332 + 64 * wc : 3460 + 64 * (wc - 2); default: return 3588 + 64 * wc; }
}
__device__ __forceinline__ void p_weights(Frame& F, const Args& a) {
    LAS float* scr = (LAS float*)(F.lds + F.wave * 16384);
    const int gw = F.vcu * 2 + (F.wave - 6), NGW = F.G * 2;
    bf16* win = (bf16*)(a.ws + WS_WIN); bf16* wout = (bf16*)(a.ws + WS_WOUT);
    constexpr int I_IN = 128 * 16, I_OUT = 32 * 16;
    for (int it = gw; it < 2 * (I_IN + I_OUT); it += NGW) {
        const int layer = it / (I_IN + I_OUT); int r = it % (I_IN + I_OUT);
        if (r < I_IN) { const int kb = r >> 7, g = r & 127, T = g >> 3, gg = g & 7, bj = gg >> 2, wc = gg & 3;
            const int src = (T < 15) ? tile_src(T, wc) + 32 * bj : 768, ncol = (T < 15) ? 32 : (gg == 0 ? 4 : 0);
            transpose_item(a.w_in + (size_t)layer * DM * INW, INW, win + (size_t)layer * NPERM * DM, 32 * g, src, ncol, a.norm_gain + layer * DM, scr, kb, F.lane); }
        else { r -= I_IN; const int kb = r / 32, g = r % 32;
            transpose_item(a.w_out + (size_t)layer * DM * DM, DM, wout + (size_t)layer * DM * DM, 32 * g, 32 * g, 32, nullptr, scr, kb, F.lane); }
    }
}
__device__ __forceinline__ void p_tables(Frame& F, const Args& a) {
    if (F.vcu == 0) { float* tab = (float*)(a.ws + WS_TAB);
        for (int i = F.tid; i < 8 * 1024; i += NWAVES * 64) { const int hc = i >> 10, d = i & 1023; tab[i] = a.rel_bias[rel_bucket(d) * 8 + hc] * LOG2E; } }
}
__device__ __forceinline__ void p_consts(Frame& F, const Args& a) {
    if (F.vcu == 0 && F.wave == 0) for (int layer = 0; layer < NLAYER; ++layer) {
        const int lane = F.lane; float* MF = (float*)(a.ws + WS_MF) + layer * 4;
        float bm = 0.f;
#pragma unroll
        for (int j = 0; j < 4; ++j) bm = fmaxf(bm, fabsf(a.rel_bias[64 * j + lane]));
#pragma unroll
        for (int o = 1; o < 64; o <<= 1) bm = fmaxf(bm, __shfl_xor(bm, o));
        const float* gp[3] = {a.fox_g + layer * 128, a.moba_g + layer * 128, a.swa_g + layer * 128};
#pragma unroll
        for (int k = 0; k < 3; ++k) { float mq = fabsf(gp[k][lane]), mk = fabsf(gp[k][64 + lane]);
#pragma unroll
            for (int o = 1; o < 64; o <<= 1) { mq = fmaxf(mq, __shfl_xor(mq, o)); mk = fmaxf(mk, __shfl_xor(mk, o)); }
            const float m = 8.f * LOG2E * mq * mk * 1.02f + 0.1f + (k == 0 ? 0.f : bm * LOG2E);
            if (lane == 0) MF[k == 0 ? 0 : (k == 1 ? 1 : 3)] = m; }
        if (lane == 0) MF[2] = 0.f;
    }
}
__device__ __forceinline__ void p_convert(Frame& F, const Args& a) {
    const int lane = F.lane, gt = F.vcu * 384 + F.tid, NT_ = F.G * 384;
    { float* KM = (float*)(a.ws + WS_KM); for (int i = gt; i < 32 * 16 * 64; i += NT_) KM[i] = 0.f;
      float* RS1 = (float*)(a.ws + WS_RS) + NTOK; for (int i = gt; i < NTOK; i += NT_) RS1[i] = 0.f; }
    bf16* XB = (bf16*)(a.ws + WS_X0); float* RS0 = (float*)(a.ws + WS_RS);
    const int gwv = F.vcu * 6 + F.wave, NGW = F.G * 6;
    for (int r0 = 4 * gwv; r0 < NTOK; r0 += 4 * NGW) {
        f32x4 v[4][4];
#pragma unroll
        for (int rr = 0; rr < 4; ++rr) { const f32x4* xr = (const f32x4*)(a.x + (size_t)(r0 + rr) * DM) + lane;
#pragma unroll
            for (int j = 0; j < 4; ++j) v[rr][j] = xr[64 * j]; }
        float ss[4];
#pragma unroll
        for (int rr = 0; rr < 4; ++rr) { ss[rr] = 0.f; unsigned long long* o8 = (unsigned long long*)(XB + (size_t)(r0 + rr) * DM) + lane;
#pragma unroll
            for (int j = 0; j < 4; ++j) { const f32x4 y = v[rr][j]; ss[rr] += (y[0] * y[0] + y[1] * y[1]) + (y[2] * y[2] + y[3] * y[3]);
                o8[64 * j] = (unsigned long long)pk2(y[0], y[1]) | ((unsigned long long)pk2(y[2], y[3]) << 32); } }
#pragma unroll
        for (int o = 1; o < 64; o <<= 1)
#pragma unroll
            for (int rr = 0; rr < 4; ++rr) ss[rr] += __shfl_xor(ss[rr], o);
        if (lane < 4) RS0[r0 + lane] = lane == 0 ? ss[0] : (lane == 1 ? ss[1] : (lane == 2 ? ss[2] : ss[3]));
    }
}
namespace att {
using bf16x8 = __attribute__((ext_vector_type(8))) short;
using s16x4 = __attribute__((ext_vector_type(4))) short;
using f32x16 = __attribute__((ext_vector_type(16))) float;
using u32x4 = __attribute__((ext_vector_type(4))) unsigned;
typedef __attribute__((address_space(3))) const char* lds_cptr;
typedef __attribute__((address_space(3))) char* lds_ptr;
typedef short v4i16_t __attribute__((ext_vector_type(4)));
typedef float f32x2_t __attribute__((ext_vector_type(2))); typedef __bf16 bf16x2_t __attribute__((ext_vector_type(2)));
constexpr int NSLOT = 5, PFD = 2, SLOTB = 8192;
constexpr int L_K = 0, L_V = NSLOT * SLOTB, L_OST = 0  , L_WS = 2 * NSLOT * SLOTB, L_CS = L_WS + 8 * 256, L_TAB = L_CS + 16384, L_G = L_TAB + 4608, L_MISC = L_G + 8 * 4096, L_END = L_MISC + 1024;
static_assert(L_END <= 139264 && 8 * 4096 <= NSLOT * SLOTB, "attention LDS map (the kernel's control words start at 136 KiB)");
constexpr float THR2 = 44.f;
#define SBAR() __builtin_amdgcn_sched_barrier(0)
__device__ __forceinline__ int crow(int r, int hi) { return (r & 3) + 8 * (r >> 2) + 4 * hi; }
__device__ __forceinline__ void glds16(const void* gsrc, unsigned lds_dst) { unsigned keep;
    asm volatile("s_mov_b32 %0, m0\n\ts_mov_b32 m0, %2\n\ts_nop 0\n\tglobal_load_lds_dwordx4 %1, off\n\ts_mov_b32 m0, %0" : "=&s"(keep) : "v"(gsrc), "s"(lds_dst) : "memory"); }
__device__ __forceinline__ unsigned cvtpk_s(float lo, float hi) { f32x2_t v = {lo, hi}; bf16x2_t b = __builtin_convertvector(v, bf16x2_t); return __builtin_bit_cast(unsigned, b); }
__device__ __forceinline__ s16x4 vtr(lds_cptr p) { return __builtin_bit_cast(s16x4, __builtin_amdgcn_ds_read_tr16_b64_v4i16((__attribute__((address_space(3))) v4i16_t*)p)); }
#define MFMA32(a, b, c) __builtin_amdgcn_mfma_f32_32x32x16_bf16(a, b, c, 0, 0, 0)
__device__ __forceinline__ void qkt(f32x16& p0, f32x16& p1, lds_cptr kp, const bf16x8* qr, float cinit) {
    f32x16 c;
#pragma unroll
    for (int r = 0; r < 16; ++r) c[r] = cinit;
    p0 = c; p1 = c;
#pragma unroll
    for (int d0 = 0; d0 < 4; ++d0) {
        const bf16x8 b0 = *(const __attribute__((address_space(3))) bf16x8*)(kp + d0 * 2048);
        const bf16x8 b1 = *(const __attribute__((address_space(3))) bf16x8*)(kp + d0 * 2048 + 512);
        p0 = MFMA32(b0, qr[d0], p0); p1 = MFMA32(b1, qr[d0], p1);
    }
}
__device__ __forceinline__ void pv(f32x16* o, lds_cptr vp, bf16x8 pa0, bf16x8 pa1, bf16x8 pa2, bf16x8 pa3) {
#pragma unroll
    for (int d0 = 0; d0 < 2; ++d0) { s16x4 lo[4], hi[4];
#pragma unroll
        for (int ks = 0; ks < 4; ++ks) { lo[ks] = vtr(vp + d0 * 4096 + ks * 1024); hi[ks] = vtr(vp + d0 * 4096 + ks * 1024 + 512); }
#define PK(k) (bf16x8){lo[k][0], lo[k][1], lo[k][2], lo[k][3], hi[k][0], hi[k][1], hi[k][2], hi[k][3]}
        o[d0] = MFMA32(pa0, PK(0), o[d0]); o[d0] = MFMA32(pa1, PK(1), o[d0]); o[d0] = MFMA32(pa2, PK(2), o[d0]); o[d0] = MFMA32(pa3, PK(3), o[d0]);
#undef PK
    }
}
__device__ __forceinline__ void kload(bf16x8* kf, lds_cptr kp) {
#pragma unroll
    for (int d0 = 0; d0 < 4; ++d0) { kf[2 * d0] = *(const __attribute__((address_space(3))) bf16x8*)(kp + d0 * 2048); kf[2 * d0 + 1] = *(const __attribute__((address_space(3))) bf16x8*)(kp + d0 * 2048 + 512); }
}
__device__ __forceinline__ void vload(s16x4* vlo, s16x4* vhi, lds_cptr vp) {
#pragma unroll
    for (int i = 0; i < 8; ++i) { vlo[i] = vtr(vp + (i >> 2) * 4096 + (i & 3) * 1024); vhi[i] = vtr(vp + (i >> 2) * 4096 + (i & 3) * 1024 + 512); }
}
__device__ __forceinline__ void qkt_r(f32x16& p0, f32x16& p1, const bf16x8* kf, const bf16x8* qr, float cinit) {
    f32x16 c;
#pragma unroll
    for (int r = 0; r < 16; ++r) c[r] = cinit;
    p0 = c; p1 = c;
#pragma unroll
    for (int d0 = 0; d0 < 4; ++d0) { p0 = MFMA32(kf[2 * d0], qr[d0], p0); p1 = MFMA32(kf[2 * d0 + 1], qr[d0], p1); }
}
__device__ __forceinline__ void pv_r(f32x16* o, const s16x4* vlo, const s16x4* vhi, bf16x8 pa0, bf16x8 pa1, bf16x8 pa2, bf16x8 pa3) {
#define VFR(i) (bf16x8){vlo[i][0], vlo[i][1], vlo[i][2], vlo[i][3], vhi[i][0], vhi[i][1], vhi[i][2], vhi[i][3]}
    o[0] = MFMA32(pa0, VFR(0), o[0]); o[1] = MFMA32(pa0, VFR(4), o[1]); o[0] = MFMA32(pa1, VFR(1), o[0]); o[1] = MFMA32(pa1, VFR(5), o[1]);
    o[0] = MFMA32(pa2, VFR(2), o[0]); o[1] = MFMA32(pa2, VFR(6), o[1]); o[0] = MFMA32(pa3, VFR(3), o[0]); o[1] = MFMA32(pa3, VFR(7), o[1]);
#undef VFR
}
struct ACtx { const bf16 *Q, *K, *V, *G; bf16* Y; const float *LF, *TAB, *KM, *MF; const float* sinks; int tflag; };
#define WAITBAR(N) asm volatile("s_waitcnt vmcnt(" #N ") lgkmcnt(0)\n\ts_barrier" ::: "memory")

#define USTAMP(k) do { if (TIMER_SEL >= 0 && TYPE == TIMER_TYPE && C.tflag && tid == 0) { volatile __attribute__((address_space(3))) unsigned* ta_ = (volatile __attribute__((address_space(3))) unsigned*)(shm + 139264 + 320) + 16; const unsigned now_ = (unsigned)__builtin_amdgcn_s_memrealtime(); ta_[k] += now_ - ta_[31]; ta_[31] = now_; } } while (0)
__device__ __forceinline__ int ticket_type(int u) { const int ty = u >> 9; return ty == 0 ? 1 : (ty == 1 ? 0 : ty); }
__device__ __forceinline__ void prefetch_unit(const ACtx& C, int u, lds_ptr shm, bf16x8* qn) {
    int tid = threadIdx.x; asm volatile("" : "+v"(tid));
    const int lane = tid & 63, r32 = lane & 31, hi = lane >> 5; const int wid = __builtin_amdgcn_readfirstlane(tid >> 6);
    const int T = ticket_type(u), r = u & 511, qb = 15 - (r >> 5), bh = r & 31, b = bh >> 2, h = bh & 3;
    const int kvh = (T == 3) ? (b * 2 + (h >> 1)) : bh;
    const bf16* Kh = C.K + T * pg8::GS + (size_t)kvh * SEQ * 64; const bf16* Vh = C.V + T * pg8::GS + (size_t)kvh * SEQ * 64;
    const bf16* ksrc = Kh + ((lane >> 4) * 2 + (wid >> 2)) * 512 + (lane & 15) * 32 + 8 * (wid & 3);
    const bf16* vsrc = Vh + ((wid & 3) * 2 + (wid >> 2)) * 512 + (lane >> 2) * 32 + 8 * (lane & 3);
    const unsigned lds0 = (unsigned)(size_t)shm, kdst = lds0 + L_K + wid * 1024, vdst = lds0 + L_V + wid * 1024;
    const int t_hi = 4 * qb + 3;
    glds16(ksrc + (size_t)t_hi * 4096, (unsigned)__builtin_amdgcn_readfirstlane(kdst)); glds16(vsrc + (size_t)t_hi * 4096, (unsigned)__builtin_amdgcn_readfirstlane(vdst));
    glds16(ksrc + (size_t)(t_hi - 1) * 4096, (unsigned)__builtin_amdgcn_readfirstlane(kdst + SLOTB)); glds16(vsrc + (size_t)(t_hi - 1) * 4096, (unsigned)__builtin_amdgcn_readfirstlane(vdst + SLOTB));
    const bf16* Qw = C.Q + T * pg8::GS + ((size_t)bh * SEQ + qb * 256 + wid * 32) * 64;
#pragma unroll
    for (int d0 = 0; d0 < 4; ++d0) qn[d0] = *reinterpret_cast<const bf16x8*>(&Qw[((r32 >> 4) * 2 + (d0 >> 1)) * 512 + (r32 & 15) * 32 + 16 * (d0 & 1) + 8 * hi]);
}
template <int TYPE> __device__ __forceinline__ int attn_unit(const ACtx& C, int bh, int qb, lds_ptr shm, bf16x8 (&qr)[4], int tick, __attribute__((address_space(3))) int* tslot) {
    int tid = threadIdx.x; asm volatile("" : "+v"(tid));
    const int lane = tid & 63, r32 = lane & 31, hi = lane >> 5; const int wid = __builtin_amdgcn_readfirstlane(tid >> 6);
    const int b = bh >> 2, h = bh & 3, q0 = qb * 256, qrel = wid * 32 + r32, t = q0 + qrel;
    const int kvh = (TYPE == 3) ? (b * 2 + (h >> 1)) : bh;
    const bf16* Qw = C.Q + TYPE * pg8::GS + ((size_t)bh * SEQ + q0 + wid * 32) * 64;
    const bf16* Kh = C.K + TYPE * pg8::GS + (size_t)kvh * SEQ * 64; const bf16* Vh = C.V + TYPE * pg8::GS + (size_t)kvh * SEQ * 64;
    const unsigned lds0 = (unsigned)(size_t)shm;
    __attribute__((address_space(3))) float* wsf = (__attribute__((address_space(3))) float*)(shm + L_WS) + wid * 64;
    __attribute__((address_space(3))) float* tabL = (__attribute__((address_space(3))) float*)(shm + L_TAB);
    __attribute__((address_space(3))) float* cs = (__attribute__((address_space(3))) float*)(shm + L_CS);
    __attribute__((address_space(3))) float* misc = (__attribute__((address_space(3))) float*)(shm + L_MISC);
    __attribute__((address_space(3))) int* misci = (__attribute__((address_space(3))) int*)(shm + L_MISC);
    const bf16* ksrc = Kh + ((lane >> 4) * 2 + (wid >> 2)) * 512 + (lane & 15) * 32 + 8 * (wid & 3);
    const bf16* vsrc = Vh + ((wid & 3) * 2 + (wid >> 2)) * 512 + (lane >> 2) * 32 + 8 * (lane & 3);
    const unsigned kdst = lds0 + L_K + wid * 1024, vdst = lds0 + L_V + wid * 1024;
#define DMA_KV(tile, slot) do { glds16(ksrc + (size_t)(tile) * 4096, (unsigned)__builtin_amdgcn_readfirstlane(kdst + (slot) * SLOTB)); glds16(vsrc + (size_t)(tile) * 4096, (unsigned)__builtin_amdgcn_readfirstlane(vdst + (slot) * SLOTB)); } while (0)
    const lds_cptr kp0 = (lds_cptr)shm + L_K + hi * 1024 + r32 * 16;
    const lds_cptr vp0 = (lds_cptr)shm + L_V + ((lane >> 4) & 1) * 32 + (lane & 3) * 8 + (4 * hi + ((lane & 15) >> 2)) * 64;
    const float Mf = (TYPE == 2) ? 0.f : C.MF[TYPE];
    const int t_hi = 4 * qb + 3; int t_lo = 0;
    if (TYPE == 3) { t_lo = 4 * qb - 2; if (t_lo < 0) t_lo = 0; }
    USTAMP(24);
    const size_t yrow0 = (size_t)(b * SEQ + q0 + wid * 32);
    { const bf16* gslab = C.G + (size_t)(TYPE * 32 + bh) * 262144 + (size_t)(q0 + wid * 32) * 64;
#pragma unroll
        for (int i = 0; i < 4; ++i) { const int row = 8 * i + (lane >> 3);
            glds16(gslab + ((row >> 4) * 2 + ((lane & 7) >> 2)) * 512 + (row & 15) * 32 + 8 * (lane & 3), (unsigned)__builtin_amdgcn_readfirstlane(lds0 + L_G + wid * 4096 + i * 1024)); } }
    unsigned sel = 0u; float ct = 0.f;
    if (TYPE == 0) {
        const float* lfp = C.LF + (size_t)bh * SEQ; const bool on = 8 * tid < q0 + 256;
        f32x4 a4 = {0.f, 0.f, 0.f, 0.f}, b4 = {0.f, 0.f, 0.f, 0.f};
        if (on) { a4 = *(const f32x4*)(lfp + 8 * tid); b4 = *(const f32x4*)(lfp + 8 * tid + 4); }
        a4[1] += a4[0]; a4[2] += a4[1]; a4[3] += a4[2]; b4[0] += a4[3]; b4[1] += b4[0]; b4[2] += b4[1]; b4[3] += b4[2];
        float sc = b4[3];
#pragma unroll
        for (int o = 1; o < 64; o <<= 1) { const float u = __shfl_up(sc, o); if (lane >= o) sc += u; }
        if (lane == 63) misc[wid] = sc;
        __syncthreads();
        float base = sc - b4[3];
#pragma unroll
        for (int w = 0; w < 7; ++w) if (w < wid) base += misc[w];
        if (on) { *(__attribute__((address_space(3))) f32x4*)(cs + 8 * tid) = a4 + base; *(__attribute__((address_space(3))) f32x4*)(cs + 8 * tid + 4) = b4 + base; }
        __syncthreads();
        const float cref = cs[q0];
        if (wid == 0) { const bool skip = (lane < 4 * qb) && (cs[64 * lane + 63] - cref > 2.f * Mf + THR2);
            const int cnt = __popcll(__ballot(skip)); if (lane == 0) misci[40] = cnt; }
        __syncthreads();
        t_lo = misci[40]; ct = cs[t];
    }
    if (TYPE == 1 || TYPE == 3) {
        const float* tg = C.TAB + ((TYPE == 3 ? 4 : 0) + h) * 1024;
        { float tv[3]; const float b31 = (TYPE == 1) ? tg[1023] : 0.f; float k0 = 0.f, k1 = 0.f;
#pragma unroll
            for (int k = 0; k < 3; ++k) { const int j = tid + 512 * k, d = 1023 - j; tv[k] = (j < 1088 && d >= 0 && (TYPE == 1 || d < 128)) ? tg[d] - b31 : -INFINITY; }
            if (TYPE == 1) { const float* kg = C.KM + (size_t)bh * 16 * 64; if (tid < qb * 64) k0 = kg[tid]; if (tid + 512 < qb * 64) k1 = kg[tid + 512]; }
#pragma unroll
            for (int k = 0; k < 3; ++k) { const int j = tid + 512 * k; if (j < 1088) tabL[j] = tv[k]; }
            if (TYPE == 1) { cs[tid] = k0; cs[tid + 512] = k1; } }
        __syncthreads();
        if (TYPE == 1) {
            if (qb <= 3) sel = (1u << qb) - 1u;
            else {
                float qf[32];
#pragma unroll
                for (int d0 = 0; d0 < 4; ++d0) { const u32x4 w = __builtin_bit_cast(u32x4, qr[d0]);
#pragma unroll
                    for (int j = 0; j < 4; ++j) { qf[d0 * 8 + 2 * j] = __uint_as_float(w[j] << 16); qf[d0 * 8 + 2 * j + 1] = __uint_as_float(w[j] & 0xffff0000u); } }
                float v1 = -INFINITY, v2 = -INFINITY, v3 = -INFINITY; int i1 = 0, i2 = 0, i3 = 0;
                for (int n = 0; n < qb; ++n) { float s = 0.f;
#pragma unroll
                    for (int d0 = 0; d0 < 4; ++d0) { const f32x4 ka = *(const __attribute__((address_space(3))) f32x4*)(cs + n * 64 + d0 * 16 + hi * 8), kb4 = *(const __attribute__((address_space(3))) f32x4*)(cs + n * 64 + d0 * 16 + hi * 8 + 4);
#pragma unroll
                        for (int j = 0; j < 4; ++j) { s += qf[d0 * 8 + j] * ka[j]; s += qf[d0 * 8 + 4 + j] * kb4[j]; } }
                    { auto rr = __builtin_amdgcn_permlane32_swap(__float_as_uint(s), __float_as_uint(s), false, false); s = __uint_as_float(rr[0]) + __uint_as_float(rr[1]); }
                    if (s > v1) { v3 = v2; i3 = i2; v2 = v1; i2 = i1; v1 = s; i1 = n; } else if (s > v2) { v3 = v2; i3 = i2; v2 = s; i2 = n; } else if (s > v3) { v3 = s; i3 = n; } }
                sel = (1u << i1) | (1u << i2) | (1u << i3); }
        }
    }
    const int n_tiles = t_hi - t_lo + 1;
    asm volatile("" : "+v"(qr[0]), "+v"(qr[1]), "+v"(qr[2]), "+v"(qr[3]));
    f32x16 o[2]; o[0] = f32x16{}; o[1] = f32x16{}; f32x16 lacc = f32x16{};
    float carry = (TYPE == 2) ? 1.f : 0.f; bool done_w = false;
    f32x16 cvec;
    { const float c0_ = (TYPE == 2) ? 0.f : ((TYPE == 0) ? ct - Mf : -Mf);
#pragma unroll
        for (int r = 0; r < 16; ++r) cvec[r] = c0_; }
    asm volatile("" : "+v"(cvec));
    const bf16x8 ones = {0x3f80, 0x3f80, 0x3f80, 0x3f80, 0x3f80, 0x3f80, 0x3f80, 0x3f80};
    const int jdiag = wid >> 1;
    const int jlo_w = (TYPE == 3) ? ((32 * wid - 127) >> 6) : -100000;
    if (TYPE == 2) { if (tid < 16) misci[64 + tid] = 0; }
    USTAMP(21);
    if (TIMER_SEL == 98 && TYPE == TIMER_TYPE && C.tflag && tid == 0) { volatile __attribute__((address_space(3))) unsigned* ta_ = (volatile __attribute__((address_space(3))) unsigned*)(shm + 139264 + 320) + 16; ta_[26] = (unsigned)__builtin_amdgcn_s_memtime(); }
    bf16x8 kf[8]; s16x4 vlo[8], vhi[8]; f32x16 p0, p1;
    const bool late = false;
#define FINISH(tile_, jr_, slot_) do { \
            vload(vlo, vhi, vp0 + (slot_) * SLOTB); SBAR(); \
            const int kb = 64 * (jr_) + 4 * hi; \
            unsigned keepm = 0xffffffffu; \
            if (TYPE == 0) { \
            _Pragma("unroll") \
                for (int g4 = 0; g4 < 4; ++g4) { const f32x4 c0 = *(const __attribute__((address_space(3))) f32x4*)(cs + 64 * (tile_) + 8 * g4 + 4 * hi), c1 = *(const __attribute__((address_space(3))) f32x4*)(cs + 64 * (tile_) + 32 + 8 * g4 + 4 * hi); \
            _Pragma("unroll") \
                    for (int j = 0; j < 4; ++j) { p0[4 * g4 + j] -= c0[j]; p1[4 * g4 + j] -= c1[j]; } } \
                if ((jr_) == jdiag) { \
            _Pragma("unroll") \
                    for (int r = 0; r < 16; ++r) { const int kv = kb + (r & 3) + 8 * (r >> 2); if (kv > qrel) p0[r] = -INFINITY; if (kv + 32 > qrel) p1[r] = -INFINITY; } } \
            _Pragma("unroll") \
                for (int r = 0; r < 16; ++r) { p0[r] = __builtin_amdgcn_exp2f(p0[r]); p1[r] = __builtin_amdgcn_exp2f(p1[r]); } \
            } \
            if (TYPE == 1 || TYPE == 3) { \
                const bool far = (TYPE == 1) && ((q0 + 32 * wid - 64 * (tile_) - 63) >= 790); \
                if (!far) { const __attribute__((address_space(3))) float* tp_ = tabL + (1023 - (qrel - kb)); \
            _Pragma("unroll") \
                    for (int r = 0; r < 16; ++r) { p0[r] += tp_[(r & 3) + 8 * (r >> 2)]; p1[r] += tp_[(r & 3) + 8 * (r >> 2) + 32]; } } \
                if (TYPE == 1 && (jr_) < 0) keepm = ((sel >> ((tile_) >> 2)) & 1u) ? 0xffffffffu : 0u; \
            _Pragma("unroll") \
                for (int r = 0; r < 16; ++r) { p0[r] = __builtin_amdgcn_exp2f(p0[r]); p1[r] = __builtin_amdgcn_exp2f(p1[r]); } \
            } \
            if (TYPE == 2) { \
                f32x16 w0, w1; \
            _Pragma("unroll") \
                for (int r = 0; r < 16; ++r) { float c0_, c1_; asm("v_min_f32_e32 %0, 0x42a00000, %1" : "=v"(c0_) : "v"(p0[r])); asm("v_min_f32_e32 %0, 0x42a00000, %1" : "=v"(c1_) : "v"(p1[r])); p0[r] = __builtin_amdgcn_exp2f(c0_); p1[r] = __builtin_amdgcn_exp2f(c1_); } \
                if ((jr_) == jdiag) { \
            _Pragma("unroll") \
                    for (int r = 0; r < 16; ++r) { const int kv = kb + (r & 3) + 8 * (r >> 2); if (kv >= qrel) p0[r] = 0.f; if (kv + 32 >= qrel) p1[r] = 0.f; } } \
            _Pragma("unroll") \
                for (int r = 0; r < 16; ++r) { w0[r] = 1.f + p0[r]; w1[r] = 1.f + p1[r]; } \
                float own[8], part[8]; \
            _Pragma("unroll") \
                for (int rb = 0; rb < 4; ++rb) { own[rb] = (w0[4 * rb] * w0[4 * rb + 1]) * (w0[4 * rb + 2] * w0[4 * rb + 3]); own[4 + rb] = (w1[4 * rb] * w1[4 * rb + 1]) * (w1[4 * rb + 2] * w1[4 * rb + 3]); } \
            _Pragma("unroll") \
                for (int rb = 0; rb < 8; ++rb) { auto rr = __builtin_amdgcn_permlane32_swap(__float_as_uint(own[rb]), __float_as_uint(own[rb]), false, false); part[rb] = __uint_as_float(hi ? rr[0] : rr[1]); } \
                float run = carry; \
            _Pragma("unroll") \
                for (int rb = 7; rb >= 0; --rb) { \
                    float E = hi == 0 ? run * part[rb] : run; run *= own[rb] * part[rb]; \
            _Pragma("unroll") \
                    for (int j = 3; j >= 0; --j) { const int r = 4 * (rb & 3) + j; \
                        if (rb >= 4) { E *= w1[r]; p1[r] *= __builtin_amdgcn_rcpf(E); } else { E *= w0[r]; p0[r] *= __builtin_amdgcn_rcpf(E); } } } \
                carry = run; \
                done_w = __all(carry > 1.7592186e13f) != 0;     \
            } \
            u32x4 pw0, pw1, pw2, pw3; \
            _Pragma("unroll") \
            for (int j = 0; j < 4; ++j) { pw0[j] = cvtpk_s(p0[2 * j], p0[2 * j + 1]); pw1[j] = cvtpk_s(p0[8 + 2 * j], p0[9 + 2 * j]); pw2[j] = cvtpk_s(p1[2 * j], p1[2 * j + 1]); pw3[j] = cvtpk_s(p1[8 + 2 * j], p1[9 + 2 * j]); } \
            if (TYPE == 1) { pw0 &= keepm; pw1 &= keepm; pw2 &= keepm; pw3 &= keepm; } \
            const bf16x8 pa0 = __builtin_bit_cast(bf16x8, pw0), pa1 = __builtin_bit_cast(bf16x8, pw1), pa2 = __builtin_bit_cast(bf16x8, pw2), pa3 = __builtin_bit_cast(bf16x8, pw3); \
            pv_r(o, vlo, vhi, pa0, pa1, pa2, pa3); \
            if (TYPE != 2) { lacc = MFMA32(pa0, ones, lacc); lacc = MFMA32(pa1, ones, lacc); lacc = MFMA32(pa2, ones, lacc); lacc = MFMA32(pa3, ones, lacc); } \
        } while (0)
#define SCORE(slot_) do { kload(kf, kp0 + (slot_) * SLOTB); SBAR(); \
        if (TYPE == 2) { p0 = MFMA32(kf[0], qr[0], (f32x16{})); p1 = MFMA32(kf[1], qr[0], (f32x16{})); } else { p0 = MFMA32(kf[0], qr[0], cvec); p1 = MFMA32(kf[1], qr[0], cvec); } \
        _Pragma("unroll") for (int d0 = 1; d0 < 4; ++d0) { p0 = MFMA32(kf[2 * d0], qr[d0], p0); p1 = MFMA32(kf[2 * d0 + 1], qr[d0], p1); } SBAR(); } while (0)
    int slot = 0, dslot = PFD, ptile = 0, pslot = 0; bool pend = false, stop = false;
    for (int i = 0; ; ++i) {
        const int tile = t_hi - i, jr = tile - 4 * qb;
        if (i < n_tiles && !stop) {
            { const int tp = tile - PFD; DMA_KV(tp < 0 ? 0 : tp, dslot); }
            dslot = (dslot == NSLOT - 1) ? 0 : dslot + 1;
            WAITBAR(4);
            if (TYPE == 2 && i > 0) { const u32x4 fa = *(const __attribute__((address_space(3))) u32x4*)(misci + 64 + ((i - 1) & 1) * 8), fb = *(const __attribute__((address_space(3))) u32x4*)(misci + 68 + ((i - 1) & 1) * 8);
                if ((fa[0] & fa[1] & fa[2] & fa[3] & fb[0] & fb[1] & fb[2] & fb[3]) != 0u) stop = true; }
        }
        if (late && pend) { FINISH(ptile, ptile - 4 * qb, pslot); pend = false; }
        if (i >= n_tiles || stop) break;
        const bool active = (jr <= jdiag) && (jr >= jlo_w) && !(TYPE == 2 && done_w);
        if (active) { SCORE(slot); }
        if (!late) { if (active) { FINISH(tile, jr, slot); } } else { pend = active; ptile = tile; pslot = slot; }
        if (TYPE == 2) { if (lane == 0) misci[64 + (i & 1) * 8 + wid] = done_w ? 1 : 0; }
        slot = (slot == NSLOT - 1) ? 0 : slot + 1;
    }
#undef FINISH
#undef SCORE
    if (TIMER_SEL == 98 && TYPE == TIMER_TYPE && C.tflag && tid == 0) { volatile __attribute__((address_space(3))) unsigned* ta_ = (volatile __attribute__((address_space(3))) unsigned*)(shm + 139264 + 320) + 16; ta_[25] += (unsigned)__builtin_amdgcn_s_memtime() - ta_[26]; }
    USTAMP(22);
    if (tid == 0) tslot[0] = tick;
    asm volatile("s_waitcnt vmcnt(0) lgkmcnt(0)\n\ts_barrier" ::: "memory");
    const int unext = tslot[0];
    if (unext < 2048) prefetch_unit(C, unext, shm, qr);
    float rli[16];
    { const float sk = (TYPE == 3) ? __builtin_amdgcn_exp2f(C.sinks[h] * LOG2E - Mf) : 0.f;
#pragma unroll
        for (int r = 0; r < 16; ++r) rli[r] = (TYPE == 2) ? 1.f : __builtin_amdgcn_rcpf(lacc[r] + sk); }
    __attribute__((address_space(3))) bf16* stg = (__attribute__((address_space(3))) bf16*)(shm + (wid < 6 ? L_K + 2 * SLOTB + wid * 4096 : L_V + 2 * SLOTB + (wid - 6) * 4096));
    const __attribute__((address_space(3))) bf16* gst = (const __attribute__((address_space(3))) bf16*)(shm + L_G) + wid * 2048;
#pragma unroll
    for (int r = 0; r < 16; ++r) { const int orow = crow(r, hi); const float rl = rli[r];
        { const unsigned w_ = cvtpk_s(o[0][r] * rl, o[1][r] * rl); stg[orow * 64 + r32] = (bf16)(w_ & 0xffffu); stg[orow * 64 + 32 + r32] = (bf16)(w_ >> 16); } }
    asm volatile("s_waitcnt lgkmcnt(0)" ::: "memory");
#pragma unroll
    for (int i = 0; i < 4; ++i) { const int row = i * 8 + (lane >> 3), ch = lane & 7;
        const u32x4 v = *(const __attribute__((address_space(3))) u32x4*)(stg + row * 64 + ch * 8);
        const u32x4 g = *(const __attribute__((address_space(3))) u32x4*)(gst + row * 64 + ch * 8); u32x4 w;
        const size_t off = (yrow0 + row) * DM + TYPE * 256 + h * 64 + ch * 8;
#pragma unroll
        for (int j = 0; j < 4; ++j) { const float a0 = __uint_as_float(v[j] << 16) * __uint_as_float(g[j] << 16), a1 = __uint_as_float(v[j] & 0xffff0000u) * __uint_as_float(g[j] & 0xffff0000u); w[j] = cvtpk_s(a0, a1); }
        *(u32x4*)(C.Y + off) = w; }
    asm volatile("s_waitcnt lgkmcnt(0)\n\ts_barrier" ::: "memory");
    USTAMP(23);
    return unext;
#undef DMA_KV
}
#undef SBAR
}
#define TACC(F) ((volatile LAS unsigned*)((F).lds + MISC_OFF) + 16)
#define TSTAMP(F, k) do { if (TIMER_SEL >= 0 && (F).vcu == TIMER_WG && (F).tid == 0) { const unsigned now_ = (unsigned)__builtin_amdgcn_s_memrealtime(); TACC(F)[k] += now_ - TACC(F)[31]; TACC(F)[31] = now_; } } while (0)
__device__ __forceinline__ void p_attn(Frame& F, const Args& a, int layer, int rep, int tmask) {
    att::ACtx C{(const bf16*)(a.ws + WS_Q), (const bf16*)(a.ws + WS_K), (const bf16*)(a.ws + WS_V), (const bf16*)(a.ws + WS_G), (bf16*)(a.ws + WS_HN),
                (const float*)(a.ws + WS_LF), (const float*)(a.ws + WS_TAB), (const float*)(a.ws + WS_KM), (const float*)(a.ws + WS_MF) + layer * 4, a.sinks + layer * 4, (F.vcu == TIMER_WG) ? 1 : 0};
    unsigned* head = (unsigned*)(a.ws + WS_CTL) + CW_QUEUE + 64 * (layer + 2 * rep);
    LAS int* slot = (LAS int*)(F.lds + att::L_MISC) + 200;
    att::lds_ptr shm = (att::lds_ptr)F.lds;
    if (F.tid == 0) slot[0] = (int)__hip_atomic_fetch_add(head, 1u, __ATOMIC_RELAXED, __HIP_MEMORY_SCOPE_AGENT);
    __syncthreads();
    int u = slot[0];
    __syncthreads();
    att::bf16x8 qr[4];
    if (u < 2048) att::prefetch_unit(C, u, shm, qr);
    while (u < 2048) {
        int tick = 0;
        if (F.tid == 0) tick = (int)__hip_atomic_fetch_add(head, 1u, __ATOMIC_RELAXED, __HIP_MEMORY_SCOPE_AGENT);
        const int ty = u >> 9, r = u & 511, qb = 15 - (r >> 5), bh = r & 31;
        TSTAMP(F, 20);
        if (ty == 0) u = att::attn_unit<1>(C, bh, qb, shm, qr, tick, (LAS int*)slot);
        else if (ty == 1) u = att::attn_unit<0>(C, bh, qb, shm, qr, tick, (LAS int*)slot);
        else if (ty == 2) u = att::attn_unit<2>(C, bh, qb, shm, qr, tick, (LAS int*)slot);
        else u = att::attn_unit<3>(C, bh, qb, shm, qr, tick, (LAS int*)slot);
        TSTAMP(F, 8 + ty);
    }
    asm volatile("s_waitcnt vmcnt(0)" ::: "memory");
    __syncthreads();
}

__global__ void __launch_bounds__(NWAVES * 64, 2) mk_fwd(Args a) {
    extern __shared__ __attribute__((aligned(16))) unsigned char lds[];
    Frame F; F.lds = (LAS unsigned char*)lds; F.tid = threadIdx.x; F.lane = F.tid & 63; F.wave = __builtin_amdgcn_readfirstlane(F.tid >> 6);
    F.G = gridDim.x; { const int bx = blockIdx.x; F.vcu = (F.G % 8 == 0) ? (bx % 8) * (F.G / 8) + bx / 8 : bx; }
    bf16* HN = (bf16*)(a.ws + WS_HN);
    for (int u = F.tid; u < (LDS_BYTES - LDSCTL_OFF) / 4; u += NWAVES * 64) ((LAS unsigned*)(F.lds + LDSCTL_OFF))[u] = 0u;
    __syncthreads();
    XcdBarrier bar; bar.bar = (unsigned*)(a.ws + WS_CTL) + CW_BAR; bar.x = 0; bar.st = nullptr;
    if (a.ph_hi - a.ph_lo > 1) bar = xcd_barrier_post((unsigned*)(a.ws + WS_CTL) + CW_BAR, (volatile LAS unsigned*)(F.lds + MISC_OFF) + 8);
#define PHASE_ON(k) (a.ph_lo <= (k) && (k) < a.ph_hi)
#define SEAM(k) do { if ((k) != 4 && PHASE_ON(k) && PHASE_ON((k) + 1)) xcd_barrier(bar); } while (0)
#define LAYER_PHASES(layer) do { \
    if ((layer) == 0 && PHASE_ON(0)) { p_tables(F, a); p_consts(F, a); if (F.wave >= 6) p_weights(F, a); else p_convert(F, a); } \
    if ((layer) == 0) { TSTAMP(F, 0); SEAM(0); TSTAMP(F, 1); } \
    if (PHASE_ON(4 * (layer) + 1)) { \
        pg8::Gemm g{(layer) == 0 ? (const bf16*)(a.ws + WS_X0) : (const bf16*)(a.ws + WS_X1), (const bf16*)(a.ws + WS_WIN) + (size_t)(layer) * NPERM * DM, NTOK, NPERM, DM}; \
        pg8::StaticOrder S; S.init(NTOK, NPERM, F.G, (int)blockIdx.x); \
        pg8::EpiIn E{(bf16*)(a.ws + WS_Q), (bf16*)(a.ws + WS_K), (bf16*)(a.ws + WS_V), (bf16*)(a.ws + WS_G), a.fox_g + (layer) * 128, a.moba_g + (layer) * 128, a.swa_g + (layer) * 128, (float*)(a.ws + WS_KM), \
                     (const float*)(a.ws + WS_RS) + (layer) * NTOK, (float*)(a.ws + WS_LF), a.b_forget + (layer) * 4}; \
        pg8::gemm_phase<pg8::EpiIn, pg8::StaticOrder, true, true>(F.lds, g, S, E); \
        if (PROBE_P1) { xcd_barrier(bar); pg8::gemm_phase<pg8::EpiIn, pg8::StaticOrder, true, true>(F.lds, g, S, E); } \
    } \
    TSTAMP(F, 2); SEAM(4 * (layer) + 1); TSTAMP(F, 3); \
    if (PHASE_ON(4 * (layer) + 2)) { for (int rep = 0; rep < 1 + (PROBE_ATT != 0 ? PROBE_REPS : 0); ++rep) { if (rep) xcd_barrier(bar); p_attn(F, a, (layer), rep, rep ? PROBE_ATT : 15); } } \
    TSTAMP(F, 4); SEAM(4 * (layer) + 2); TSTAMP(F, 5); \
    if (PHASE_ON(4 * (layer) + 3)) { \
        pg8::Gemm g{HN  , (const bf16*)(a.ws + WS_WOUT) + (size_t)(layer) * DM * DM, NTOK, DM, DM}; \
        pg8::StaticOrder S; S.init(NTOK, DM, F.G, (int)blockIdx.x); \
        if ((layer) == 0) { \
            { float* KM = (float*)(a.ws + WS_KM); for (int i = F.vcu * (NWAVES * 64) + F.tid; i < 32 * 16 * 64; i += F.G * NWAVES * 64) KM[i] = 0.f; }     \
            pg8::EpiRes0 E{(const bf16*)(a.ws + WS_X0), (bf16*)(a.ws + WS_X1), (float*)(a.ws + WS_RS) + NTOK}; \
            pg8::gemm_phase<pg8::EpiRes0, pg8::StaticOrder, true, true>(F.lds, g, S, E); \
        } else { \
            pg8::EpiRes1 E{(const bf16*)(a.ws + WS_X1), a.out}; \
            pg8::gemm_phase<pg8::EpiRes1, pg8::StaticOrder, true, true>(F.lds, g, S, E); \
        } \
    } \
    if ((layer) == 0) { TSTAMP(F, 6); SEAM(3); SEAM(4); TSTAMP(F, 7); } } while (0)
    if (TIMER_SEL >= 0 && F.vcu == TIMER_WG && F.tid == 0) TACC(F)[31] = (unsigned)__builtin_amdgcn_s_memrealtime();
    LAYER_PHASES(0);
    LAYER_PHASES(1);
    if (TIMER_SEL >= 0 && F.vcu == TIMER_WG) {
        asm volatile("s_waitcnt vmcnt(0)" ::: "memory"); __syncthreads();
        float v = (TIMER_SEL == 99) ? 1.0f : (TIMER_SEL == 98) ? ((float)TACC(F)[25] / ((float)TACC(F)[22] * 10.f)) / 3.0f : (float)TACC(F)[TIMER_SEL & 31] * 0.01f / (float)TIMER_FS; v = fminf(fmaxf(v, 0.f), 1.f); const float dl = 0.1f * sqrtf(v);
        pg8::StaticOrder S; S.init(NTOK, DM, F.G, (int)blockIdx.x); pg8::Unit u;
        for (int i = 0; S.next(i, u); ++i) for (int e = F.tid; e < 65536; e += NWAVES * 64) { float* p = a.out + (size_t)(u.pm * 256 + (e >> 8)) * DM + u.pn * 256 + (e & 255); *p += dl; }
    }
}

extern "C" void kernel_launch(void* const* d_in, const int* in_sizes, int n_in, void* d_out, int out_size, void* d_ws, size_t ws_size, hipStream_t stream) {
    static int ok = 0, grid = 0;
    if (ok == 0) {
        if (n_in != 10 || in_sizes[0] != NTOK * DM || out_size != NTOK * DM || ws_size < WS_END) { fprintf(stderr, "kernel_launch: unexpected shapes (n_in %d, in0 %d, out %d, ws %zu)\n", n_in, n_in > 0 ? in_sizes[0] : -1, out_size, ws_size); ok = -1; return; }
        if (hipFuncSetAttribute((const void*)mk_fwd, hipFuncAttributeMaxDynamicSharedMemorySize, LDS_BYTES) != hipSuccess) { fprintf(stderr, "kernel_launch: hipFuncSetAttribute failed\n"); ok = -1; return; }
        int dev = 0, cus = 0; if (hipGetDevice(&dev) != hipSuccess || hipDeviceGetAttribute(&cus, hipDeviceAttributeMultiprocessorCount, dev) != hipSuccess) { fprintf(stderr, "kernel_launch: device query failed\n"); ok = -1; return; }
        grid = cus < 256 ? (cus / 8) * 8 : 256; if (grid < 8) grid = cus;
        ok = 1;
    }
    if (ok < 0) return;
    Args a{};
    a.x = (const float*)d_in[0]; a.norm_gain = (const float*)d_in[1]; a.w_in = (const float*)d_in[2]; a.b_forget = (const float*)d_in[3]; a.fox_g = (const float*)d_in[4];
    a.moba_g = (const float*)d_in[5]; a.swa_g = (const float*)d_in[6]; a.sinks = (const float*)d_in[7]; a.w_out = (const float*)d_in[8]; a.rel_bias = (const float*)d_in[9];
    a.out = (float*)d_out; a.ws = (unsigned char*)d_ws;
    unsigned char* ws = (unsigned char*)d_ws;
    a.tmask = 15;
    if (hipMemsetAsync(ws + WS_CTL, 0, CTL_ZERO_BYTES, stream) != hipSuccess) { fprintf(stderr, "kernel_launch: memset failed\n"); return; }
#if N_LAUNCHES == 1
    a.ph_lo = 0; a.ph_hi = 8; hipLaunchKernelGGL(mk_fwd, dim3(grid), dim3(NWAVES * 64), LDS_BYTES, stream, a);
#else
    for (int ph = 0; ph < 8; ++ph) { a.ph_lo = ph; a.ph_hi = ph + 1; hipLaunchKernelGGL(mk_fwd, dim3(grid), dim3(NWAVES * 64), LDS_BYTES, stream, a); }
#endif
}
```

```cpp
#include <hip/hip_runtime.h>
#include <cstdio>
#include <cstdint>
#include <cmath>
namespace pg8 {
#define PG8_LAS __attribute__((address_space(3)))
typedef unsigned short bf16_t;
typedef short bf16x8 __attribute__((ext_vector_type(8)));
typedef float f32x4 __attribute__((ext_vector_type(4)));
typedef unsigned u32x4 __attribute__((ext_vector_type(4)));
constexpr int BM = 256, BK = 64, HALF = 128, HTB = HALF * BK * 2  , STAGE_BYTES = 8 * HTB, NXCD = 8, WGM = 8;

__host__ __device__ __forceinline__ int lds_byte(int r, int c) { const int st = (r >> 4) * 2 + (c >> 5), rr = r & 15, cc = c & 31, ob = rr * 64 + cc * 2; return st * 1024 + (ob ^ (((ob >> 9) & 1) << 5)); }
__host__ __device__ __forceinline__ void stage_rc(int b, int& R, int& C) { const int st = b / 1024, sb = b % 1024, swz = sb ^ (((sb >> 9) & 1) << 5); R = (st >> 1) * 16 + swz / 64; C = (st & 1) * 32 + (swz % 64) / 2; }
__host__ __device__ __forceinline__ int perm32(int rho) { const int n = rho >> 4, i = rho & 15; return 8 * (i >> 2) + 4 * n + (i & 3); }

struct Unit { int pm, pn; };
struct Gemm { const bf16_t* A; const bf16_t* Bt; int M, N, K; };

struct StaticOrder {
    int nM, nN, nwg, G, c;
    __host__ __device__ void init(int M, int N, int G_, int c_) { nM = M / BM; nN = N / BM; nwg = nM * nN; G = G_; c = c_; }
    __host__ __device__ bool next(int i, Unit& u) const {
        const long L = (long)i * G + c; if (L >= nwg) return false;
        int wgid = (int)L; { const int q = nwg / NXCD, r = nwg % NXCD, xcd = wgid % NXCD, off = wgid / NXCD; wgid = (xcd < r ? xcd * (q + 1) : r * (q + 1) + (xcd - r) * q) + off; }
        const int nig = WGM * nN, gid = wgid / nig, fm = gid * WGM, gsz = (nM - fm) < WGM ? (nM - fm) : WGM;
        u.pm = fm + ((wgid % nig) % gsz); u.pn = (wgid % nig) / gsz; return true;
    }
    __device__ __forceinline__ void a_ready(const Unit&) const {}
    __device__ __forceinline__ void done(const Unit&) const {}
};
struct FlagOrder : StaticOrder {
    unsigned* rdy; unsigned need;
    __host__ __device__ bool next(int i, Unit& u) const { if (!StaticOrder::next(i, u)) return false; u.pm = (u.pm & ~15) | (15 - (u.pm & 15)); return true; }
    __device__ __forceinline__ void a_ready(const Unit& u) const {
        unsigned* p = rdy + u.pm; unsigned sp = 0;
        while ((unsigned)__builtin_amdgcn_readfirstlane(__hip_atomic_load(p, __ATOMIC_RELAXED, __HIP_MEMORY_SCOPE_AGENT)) < need) { __builtin_amdgcn_s_sleep(2); if (++sp > (1u << 21)) break; }
    }
};


__device__ __forceinline__ unsigned cvt_pk_bf16(float lo, float hi) { unsigned r; asm volatile("v_cvt_pk_bf16_f32 %0, %1, %2" : "=v"(r) : "v"(lo), "v"(hi)); return r; }
typedef float f32x2 __attribute__((ext_vector_type(2)));
constexpr float C2 = 0.125f * 1.4426950408889634f;
constexpr float RMS_EPS = 1e-6f;
constexpr size_t GS = (size_t)8 * 4 * 4096 * 64;
struct EpiIn {
    static constexpr bool PERM = true, AFTER_DRAIN = false;
    bf16_t *Q, *K, *V, *G; const float *gfox, *gmoba, *gswa; float* KM; const float* RS; float* LF; const float* bfg;
    __device__ __forceinline__ void prefetch(const Unit& u, int ui_, PG8_LAS unsigned char* lds, int wid, int lane) const {
        if (wid < 4) { const float* src = RS + u.pm * BM + wid * 64 + lane; const unsigned dst = (unsigned)(size_t)(lds + STAGE_BYTES + (ui_ & 1) * 1024 + wid * 256); unsigned keep;
            asm volatile("s_mov_b32 %0, m0\n\ts_mov_b32 m0, %2\n\ts_nop 0\n\tglobal_load_lds_dword %1, off\n\ts_mov_b32 m0, %0" : "=&s"(keep) : "v"(src), "s"((unsigned)__builtin_amdgcn_readfirstlane(dst)) : "memory"); }
    }
    __device__ __forceinline__ void operator()(const f32x4 (&acc)[2][2][4][2], const Unit& u, int wr, int wc, int fr, int fq, int ui, PG8_LAS unsigned char* ldsb) const {
        const int T = u.pn;
        const int b = (u.pm * BM) >> 12, t0 = ((u.pm * BM) & 4095) + wr * 64 + fr;
        float rs[2][4];
#pragma unroll
        for (int ai = 0; ai < 2; ++ai)
#pragma unroll
            for (int m = 0; m < 4; ++m) rs[ai][m] = __builtin_amdgcn_rsqf(((const PG8_LAS float*)(ldsb + STAGE_BYTES + (ui & 1) * 1024))[ai * HALF + wr * 64 + m * 16 + fr] * (1.0f / 1024.0f) + RMS_EPS);
        if (T == 15) {
            if (wc == 0 && fq == 0) { const f32x4 bv = *(const f32x4*)bfg;
#pragma unroll
                for (int ai = 0; ai < 2; ++ai)
#pragma unroll
                    for (int m = 0; m < 4; ++m) { const f32x4 a4 = acc[ai][0][m][0] * rs[ai][m] + bv;
#pragma unroll
                        for (int j = 0; j < 4; ++j) { const float uu = a4[j]; const float sp = fmaxf(-uu, 0.f) + __logf(1.f + __expf(-fabsf(uu)));
                            LF[(size_t)(b * 4 + j) * 4096 + t0 + ai * HALF + m * 16] = -sp * 1.4426950408889634f; } } }
            return;
        }
        int mode = 1, nh = 4, head = wc; float scale = 1.f; const float* gain = nullptr; bf16_t* base = nullptr;
        switch (T) {
            case 0: mode = 0; gain = gfox; scale = C2; base = Q; break;
            case 1: mode = 0; gain = gfox + 64; base = K; break;
            case 2: base = V; break;
            case 4: mode = 0; gain = gmoba; scale = C2; base = Q + GS; break;
            case 5: mode = 0; gain = gmoba + 64; base = K + GS; break;
            case 6: base = V + GS; break;
            case 8: scale = C2; base = Q + 2 * GS; break;
            case 9: base = K + 2 * GS; break;
            case 10: base = V + 2 * GS; break;
            case 12: mode = 0; gain = gswa; scale = C2; base = Q + 3 * GS; break;
            case 13: nh = 2; if (wc < 2) { mode = 0; gain = gswa + 64; base = K + 3 * GS; } else { base = V + 3 * GS; head = wc - 2; } break;
            default: mode = 2; break;
        }
        if (mode == 2) {
            bf16_t* gp = G + ((size_t)((T >> 2) * 32 + b * 4 + wc)) * 262144 + (size_t)((t0 >> 4) * 2) * 512 + (t0 & 15) * 32 + 8 * fq;
#pragma unroll
            for (int ai = 0; ai < 2; ++ai)
#pragma unroll
                for (int m = 0; m < 4; ++m)
#pragma unroll
                    for (int bj = 0; bj < 2; ++bj) {
                        f32x4 v0 = acc[ai][bj][m][0] * rs[ai][m], v1 = acc[ai][bj][m][1] * rs[ai][m];
#pragma unroll
                        for (int j = 0; j < 4; ++j) { v0[j] = v0[j] * __builtin_amdgcn_rcpf(1.f + __expf(-v0[j])); v1[j] = v1[j] * __builtin_amdgcn_rcpf(1.f + __expf(-v1[j])); }
                        u32x4 w; w.x = cvt_pk_bf16(v0[0], v0[1]); w.y = cvt_pk_bf16(v0[2], v0[3]); w.z = cvt_pk_bf16(v1[0], v1[1]); w.w = cvt_pk_bf16(v1[2], v1[3]);
                        *(u32x4*)(gp + (size_t)((ai * 8 + m) * 2 + bj) * 512) = w;
                    }
            return;
        }
        f32x4 gv[2][2];
#pragma unroll
        for (int bj = 0; bj < 2; ++bj)
#pragma unroll
            for (int n = 0; n < 2; ++n) gv[bj][n] = (mode == 0) ? *(const f32x4*)(gain + 32 * bj + 8 * fq + 4 * n) : (f32x4){1.f, 1.f, 1.f, 1.f};
        bf16_t* dp = base + (size_t)(b * nh + head) * 262144 + (size_t)((t0 >> 4) * 2) * 512 + (t0 & 15) * 32 + 8 * fq;
        f32x4 cs4[2][2];
#pragma unroll
        for (int bj = 0; bj < 2; ++bj)
#pragma unroll
            for (int n = 0; n < 2; ++n) cs4[bj][n] = (f32x4){0.f, 0.f, 0.f, 0.f};
#pragma unroll
        for (int ai = 0; ai < 2; ++ai)
#pragma unroll
            for (int m = 0; m < 4; ++m) {
                float r = scale * rs[ai][m];
                if (mode == 0) {
                    float ss = 0.f;
#pragma unroll
                    for (int bj = 0; bj < 2; ++bj)
#pragma unroll
                        for (int n = 0; n < 2; ++n) { const f32x4 x = acc[ai][bj][m][n]; ss += (x[0] * x[0] + x[1] * x[1]) + (x[2] * x[2] + x[3] * x[3]); }
                    ss += __shfl_xor(ss, 16); ss += __shfl_xor(ss, 32);
                    r = scale * rs[ai][m] * __builtin_amdgcn_rsqf(ss * rs[ai][m] * rs[ai][m] * (1.0f / 64.0f) + RMS_EPS);
                }
#pragma unroll
                for (int bj = 0; bj < 2; ++bj) {
                    const f32x4 v0 = acc[ai][bj][m][0] * gv[bj][0] * r, v1 = acc[ai][bj][m][1] * gv[bj][1] * r;
                    if (T == 5) { cs4[bj][0] += v0; cs4[bj][1] += v1; }
                    u32x4 w; w.x = cvt_pk_bf16(v0[0], v0[1]); w.y = cvt_pk_bf16(v0[2], v0[3]); w.z = cvt_pk_bf16(v1[0], v1[1]); w.w = cvt_pk_bf16(v1[2], v1[3]);
                    *(u32x4*)(dp + (size_t)((ai * 8 + m) * 2 + bj) * 512) = w;
                }
            }
        if (T == 5) {
            float* kmp = KM + ((size_t)((b * 4 + wc) * 16 + (((u.pm * BM) & 4095) >> 8))) * 64 + 8 * fq;
#pragma unroll
            for (int bj = 0; bj < 2; ++bj)
#pragma unroll
                for (int n = 0; n < 2; ++n)
#pragma unroll
                    for (int j = 0; j < 4; ++j) { float s = cs4[bj][n][j];
                        s += __shfl_xor(s, 1); s += __shfl_xor(s, 2); s += __shfl_xor(s, 4); s += __shfl_xor(s, 8);
                        if (fr == 0) atomicAdd(kmp + 32 * bj + 4 * n + j, s * (1.0f / 256.0f)); }
        }
    }
};
struct EpiRes0 {
    static constexpr bool PERM = true, AFTER_DRAIN = false;
    const bf16_t* base; bf16_t* X1; float* RS1;
    __device__ __forceinline__ void prefetch(const Unit&, int, PG8_LAS unsigned char*, int, int) const {}
    __device__ __forceinline__ void operator()(const f32x4 (&acc)[2][2][4][2], const Unit& u, int wr, int wc, int fr, int fq, int ui, PG8_LAS unsigned char* ldsb) const {
        const int col0 = u.pn * BM + wc * 32 + 8 * fq;
        u32x4 xr[2][4][2];
#pragma unroll
        for (int ai = 0; ai < 2; ++ai)
#pragma unroll
            for (int m = 0; m < 4; ++m)
#pragma unroll
                for (int bj = 0; bj < 2; ++bj) xr[ai][m][bj] = *(const u32x4*)(base + (size_t)(u.pm * BM + ai * HALF + wr * 64 + m * 16 + fr) * 1024 + col0 + bj * HALF);
#pragma unroll
        for (int ai = 0; ai < 2; ++ai)
#pragma unroll
            for (int m = 0; m < 4; ++m) {
                const int row = u.pm * BM + ai * HALF + wr * 64 + m * 16 + fr; const size_t off = (size_t)row * 1024 + col0; float ss = 0.f;
#pragma unroll
                for (int bj = 0; bj < 2; ++bj) { const u32x4 xb = xr[ai][m][bj];
                    f32x4 v0, v1; v0[0] = __uint_as_float(xb.x << 16); v0[1] = __uint_as_float(xb.x & 0xffff0000u); v0[2] = __uint_as_float(xb.y << 16); v0[3] = __uint_as_float(xb.y & 0xffff0000u);
                    v1[0] = __uint_as_float(xb.z << 16); v1[1] = __uint_as_float(xb.z & 0xffff0000u); v1[2] = __uint_as_float(xb.w << 16); v1[3] = __uint_as_float(xb.w & 0xffff0000u);
                    v0 += acc[ai][bj][m][0]; v1 += acc[ai][bj][m][1];
                    ss += (v0[0] * v0[0] + v0[1] * v0[1]) + (v0[2] * v0[2] + v0[3] * v0[3]) + (v1[0] * v1[0] + v1[1] * v1[1]) + (v1[2] * v1[2] + v1[3] * v1[3]);
                    u32x4 w; w.x = cvt_pk_bf16(v0[0], v0[1]); w.y = cvt_pk_bf16(v0[2], v0[3]); w.z = cvt_pk_bf16(v1[0], v1[1]); w.w = cvt_pk_bf16(v1[2], v1[3]);
                    *(u32x4*)(X1 + off + bj * HALF) = w; }
                ss += __shfl_xor(ss, 16); ss += __shfl_xor(ss, 32);
                if (fq == 0) atomicAdd(RS1 + row, ss);
            }
    }
};
struct EpiRes1 {
    static constexpr bool PERM = true, AFTER_DRAIN = false;
    const bf16_t* X1; float* out;

    __device__ __forceinline__ void prefetch(const Unit&, int, PG8_LAS unsigned char*, int, int) const {}
    __device__ __forceinline__ void operator()(const f32x4 (&acc)[2][2][4][2], const Unit& u, int wr, int wc, int fr, int fq, int ui, PG8_LAS unsigned char* ldsb) const {
        const int col0 = u.pn * BM + wc * 32 + 8 * fq;
        u32x4 xr[2][4][2];
#pragma unroll
        for (int ai = 0; ai < 2; ++ai)
#pragma unroll
            for (int m = 0; m < 4; ++m)
#pragma unroll
                for (int bj = 0; bj < 2; ++bj) xr[ai][m][bj] = *(const u32x4*)(X1 + (size_t)(u.pm * BM + ai * HALF + wr * 64 + m * 16 + fr) * 1024 + col0 + bj * HALF);
#pragma unroll
        for (int ai = 0; ai < 2; ++ai)
#pragma unroll
            for (int m = 0; m < 4; ++m) {
                const size_t off = (size_t)(u.pm * BM + ai * HALF + wr * 64 + m * 16 + fr) * 1024 + col0;
#pragma unroll
                for (int bj = 0; bj < 2; ++bj) { const u32x4 xb = xr[ai][m][bj];
                    f32x4 v0, v1; v0[0] = __uint_as_float(xb.x << 16); v0[1] = __uint_as_float(xb.x & 0xffff0000u); v0[2] = __uint_as_float(xb.y << 16); v0[3] = __uint_as_float(xb.y & 0xffff0000u);
                    v1[0] = __uint_as_float(xb.z << 16); v1[1] = __uint_as_float(xb.z & 0xffff0000u); v1[2] = __uint_as_float(xb.w << 16); v1[3] = __uint_as_float(xb.w & 0xffff0000u);
                    *(f32x4*)(out + off + bj * HALF) = v0 + acc[ai][bj][m][0]; *(f32x4*)(out + off + bj * HALF + 4) = v1 + acc[ai][bj][m][1]; }
            }
    }
};

template <class Epi, class Sched, bool ALIGN_EPI = false, bool SP2 = false>
__device__ __forceinline__ void gemm_phase(PG8_LAS unsigned char* lds, const Gemm g, const Sched& S, const Epi& E) {
    const int tid = threadIdx.x, wid = __builtin_amdgcn_readfirstlane(tid >> 6), lane = tid & 63, wr = wid >> 2, wc = wid & 3, fr = lane & 15, fq = lane >> 4;
    const int K = g.K, nt = K / BK;
    unsigned voffA[2], voffB[2];
#pragma unroll
    for (int i = 0; i < 2; ++i) { int R, C; stage_rc(tid * 16 + i * 8192, R, C); const int Rb = Epi::PERM ? ((R & ~31) + perm32(R & 31)) : R;
        voffA[i] = (unsigned)(R * K + C) * 2u; voffB[i] = (unsigned)(Rb * K + C) * 2u; }
    const size_t kstep = (size_t)(BK * 2);
    const size_t hstep = (size_t)HALF * K * 2;
    const size_t tstep = 2 * hstep;
    const unsigned ldsw = (unsigned)wid * 1024u;
    const int aoff = lds_byte(wr * 64 + fr, fq * 8), boff = lds_byte(wc * 32 + fr, fq * 8);
#define PG8_SA(b, h) (((b) * 2 + (h)) * HTB)
#define PG8_SB(b, h) ((4 + (b) * 2 + (h)) * HTB)
#define PG8_STAGE(bufoff, gbase, voff) do { _Pragma("unroll") for (int _i = 0; _i < 2; ++_i) \
        __builtin_amdgcn_global_load_lds((const unsigned*)((const char*)(gbase) + (voff)[_i]), (PG8_LAS unsigned*)(lds + (bufoff) + ldsw + _i * 8192), 16, 0, 0); } while (0)
#define PG8_LDA(dst, b, h) do { _Pragma("unroll") for (int m = 0; m < 4; ++m) _Pragma("unroll") for (int k = 0; k < 2; ++k) dst[m][k] = *(const PG8_LAS bf16x8*)(lds + PG8_SA(b, h) + aoff + m * 2048 + k * 1024); } while (0)
#define PG8_LDB(dst, b, h) do { _Pragma("unroll") for (int n = 0; n < 2; ++n) _Pragma("unroll") for (int k = 0; k < 2; ++k) dst[n][k] = *(const PG8_LAS bf16x8*)(lds + PG8_SB(b, h) + boff + n * 2048 + k * 1024); } while (0)
#define PG8_MMA(ai, bj, At, Bt) do { __builtin_amdgcn_s_setprio(1); _Pragma("unroll") for (int m = 0; m < 4; ++m) _Pragma("unroll") for (int n = 0; n < 2; ++n) _Pragma("unroll") for (int k = 0; k < 2; ++k) \
        acc[ai][bj][m][n] = __builtin_amdgcn_mfma_f32_16x16x32_bf16(Bt[n][k], At[m][k], acc[ai][bj][m][n], 0, 0, 0); __builtin_amdgcn_s_setprio(0); } while (0)
#define PG8_WAIT_V(n) asm volatile("s_waitcnt vmcnt(" #n ")" ::: "memory")
#define PG8_WAIT_L(n) asm volatile("s_waitcnt lgkmcnt(" #n ")" ::: "memory")
#define PG8_BAR __builtin_amdgcn_s_barrier()
#define PG8_SCHED __builtin_amdgcn_sched_barrier(0)
    Unit cur, nxt; int ui = 0;
    if (!S.next(0, cur)) return;
    f32x4 acc[2][2][4][2];
#pragma unroll
    for (int a = 0; a < 2; ++a)
#pragma unroll
        for (int b = 0; b < 2; ++b)
#pragma unroll
            for (int m = 0; m < 4; ++m)
#pragma unroll
                for (int n = 0; n < 2; ++n) acc[a][b][m][n] = (f32x4){0.f, 0.f, 0.f, 0.f};
    bf16x8 At[4][2], B0[2][2], B1[2][2];
    const char* cA = (const char*)g.A + (size_t)cur.pm * tstep; const char* cB = (const char*)g.Bt + (size_t)cur.pn * tstep;
    S.a_ready(cur); E.prefetch(cur, 0, lds, wid, lane);
    if constexpr (SP2) {
        PG8_STAGE(PG8_SB(0, 0), cB, voffB); PG8_STAGE(PG8_SB(0, 1), cB + hstep, voffB); PG8_STAGE(PG8_SA(0, 0), cA, voffA); PG8_STAGE(PG8_SA(0, 1), cA + hstep, voffA);
        if (wr == 1) PG8_BAR;
        PG8_WAIT_V(2); PG8_BAR;
        PG8_STAGE(PG8_SB(1, 0), cB + kstep, voffB); PG8_STAGE(PG8_SA(1, 0), cA + kstep, voffA); PG8_STAGE(PG8_SB(1, 1), cB + hstep + kstep, voffB);
        PG8_WAIT_V(6); PG8_BAR;
    } else {
        PG8_STAGE(PG8_SB(0, 0), cB, voffB); PG8_STAGE(PG8_SA(0, 0), cA, voffA); PG8_STAGE(PG8_SB(0, 1), cB + hstep, voffB); PG8_STAGE(PG8_SA(0, 1), cA + hstep, voffA);
        if (wr == 1) PG8_BAR;
        PG8_WAIT_V(4); PG8_BAR;
        PG8_STAGE(PG8_SB(1, 0), cB + kstep, voffB); PG8_STAGE(PG8_SA(1, 0), cA + kstep, voffA); PG8_STAGE(PG8_SB(1, 1), cB + hstep + kstep, voffB);
        PG8_WAIT_V(6); PG8_BAR;
    }
    for (;;) {
        const bool has_next = S.next(ui + 1, nxt);
        const char* nA = has_next ? (const char*)g.A + (size_t)nxt.pm * tstep : cA; const char* nB = has_next ? (const char*)g.Bt + (size_t)nxt.pn * tstep : cB;
        for (int t = 0; t < nt; t += 2) {
            const bool last = (t == nt - 2);
            const char* a1 = cA + (size_t)(t + 1) * kstep;
            const char* a2 = last ? nA : cA + (size_t)(t + 2) * kstep; const char* b2 = last ? nB : cB + (size_t)(t + 2) * kstep;
            const char* a3 = a2 + kstep; const char* b3 = b2 + kstep;
            if (last && has_next) S.a_ready(nxt);
            if constexpr (SP2) {
            PG8_LDB(B0, 0, 0); PG8_LDB(B1, 0, 1); PG8_SCHED; PG8_LDA(At, 0, 0); PG8_STAGE(PG8_SA(1, 1), a1 + hstep, voffA);
            PG8_WAIT_V(8); PG8_WAIT_L(0); PG8_BAR; PG8_MMA(0, 0, At, B0); PG8_MMA(0, 1, At, B1); PG8_BAR; PG8_SCHED;
            PG8_LDA(At, 0, 1); PG8_STAGE(PG8_SB(0, 0), b2, voffB); PG8_STAGE(PG8_SB(0, 1), b2 + hstep, voffB); PG8_STAGE(PG8_SA(0, 0), a2, voffA);
            PG8_WAIT_V(8); PG8_WAIT_L(0); PG8_BAR; PG8_MMA(1, 0, At, B0); PG8_MMA(1, 1, At, B1); PG8_BAR; PG8_SCHED;
            PG8_LDB(B0, 1, 0); PG8_LDB(B1, 1, 1); PG8_SCHED; PG8_LDA(At, 1, 0); PG8_STAGE(PG8_SA(0, 1), a2 + hstep, voffA);
            PG8_WAIT_V(8); PG8_WAIT_L(0); PG8_BAR; PG8_MMA(0, 0, At, B0); PG8_MMA(0, 1, At, B1); PG8_BAR; PG8_SCHED;
            PG8_LDA(At, 1, 1); PG8_STAGE(PG8_SB(1, 0), b3, voffB); PG8_STAGE(PG8_SB(1, 1), b3 + hstep, voffB); PG8_STAGE(PG8_SA(1, 0), a3, voffA);
            PG8_WAIT_V(8); PG8_WAIT_L(0); PG8_BAR; PG8_MMA(1, 0, At, B0); PG8_MMA(1, 1, At, B1); PG8_BAR; PG8_SCHED;
            } else {
            PG8_LDB(B0, 0, 0); PG8_SCHED; PG8_LDA(At, 0, 0); PG8_STAGE(PG8_SA(1, 1), a1 + hstep, voffA);
            PG8_WAIT_L(8); PG8_BAR; PG8_WAIT_L(0); PG8_MMA(0, 0, At, B0); PG8_BAR; PG8_SCHED;
            PG8_LDB(B1, 0, 1); PG8_STAGE(PG8_SB(0, 0), b2, voffB);
            PG8_BAR; PG8_WAIT_L(0); PG8_MMA(0, 1, At, B1); PG8_BAR;
            PG8_LDA(At, 0, 1); PG8_STAGE(PG8_SA(0, 0), a2, voffA);
            PG8_BAR; PG8_WAIT_L(0); PG8_MMA(1, 0, At, B0); PG8_BAR; PG8_SCHED;
            PG8_STAGE(PG8_SB(0, 1), b2 + hstep, voffB);
            PG8_WAIT_V(6); PG8_BAR; PG8_MMA(1, 1, At, B1); PG8_BAR;
            PG8_LDB(B0, 1, 0); PG8_SCHED; PG8_LDA(At, 1, 0); PG8_STAGE(PG8_SA(0, 1), a2 + hstep, voffA);
            PG8_WAIT_L(8); PG8_BAR; PG8_WAIT_L(0); PG8_MMA(0, 0, At, B0); PG8_BAR; PG8_SCHED;
            PG8_LDB(B1, 1, 1); PG8_STAGE(PG8_SB(1, 0), b3, voffB);
            PG8_BAR; PG8_WAIT_L(0); PG8_MMA(0, 1, At, B1); PG8_BAR;
            PG8_LDA(At, 1, 1); PG8_STAGE(PG8_SA(1, 0), a3, voffA);
            PG8_BAR; PG8_WAIT_L(0); PG8_MMA(1, 0, At, B0); PG8_BAR; PG8_SCHED;
            PG8_STAGE(PG8_SB(1, 1), b3 + hstep, voffB);
            PG8_WAIT_V(6); PG8_BAR; PG8_MMA(1, 1, At, B1); PG8_BAR;
            }
        }
        if constexpr (ALIGN_EPI) { if (wr == 0) PG8_BAR; }
        if constexpr (!Epi::AFTER_DRAIN) { E(acc, cur, wr, wc, fr, fq, ui, lds); S.done(cur); if (has_next) E.prefetch(nxt, ui + 1, lds, wid, lane); }
        if (!has_next) break;
#pragma unroll
        for (int a = 0; a < 2; ++a)
#pragma unroll
            for (int b = 0; b < 2; ++b)
#pragma unroll
                for (int m = 0; m < 4; ++m)
#pragma unroll
                    for (int n = 0; n < 2; ++n) acc[a][b][m][n] = (f32x4){0.f, 0.f, 0.f, 0.f};
        cur = nxt; cA = nA; cB = nB; ++ui;
        if constexpr (ALIGN_EPI) { if (wr == 1) PG8_BAR; }
    }
    PG8_WAIT_V(0);
    if constexpr (!ALIGN_EPI) { if (wr == 0) PG8_BAR; }
    PG8_BAR;
    if constexpr (Epi::AFTER_DRAIN) { E.fused(acc, cur, wr, wc, fr, fq, lds, wid, lane); S.done(cur); }
#undef PG8_SA
#undef PG8_SB
#undef PG8_STAGE
#undef PG8_LDA
#undef PG8_LDB
#undef PG8_MMA
#undef PG8_WAIT_V
#undef PG8_WAIT_L
#undef PG8_BAR
#undef PG8_SCHED
}
}
constexpr int NB = 8, SEQ = 4096, DM = 1024, NTOK = NB * SEQ, INW = 3844, NPERM = 4096, NLAYER = 2;
constexpr size_t MiB = 1u << 20;
constexpr size_t WS_CTL = 0, CTL_ZERO_BYTES = 1 * MiB;
constexpr size_t WS_WIN = 2 * MiB;
constexpr size_t WS_WOUT = 18 * MiB;
constexpr size_t WS_LF = 22 * MiB;
constexpr size_t WS_RS = 26 * MiB;
constexpr size_t WS_TAB = 23 * MiB;
constexpr size_t WS_KM = 24 * MiB;
constexpr size_t WS_MF = 25 * MiB;
constexpr int CW_BAR = 4096;
constexpr int CW_RDY = 1024;
constexpr int CW_QUEUE = 64;
constexpr size_t WS_HN = 32 * MiB;
constexpr size_t WS_Q = 96 * MiB, WS_K = 160 * MiB, WS_V = 216 * MiB, WS_G = 272 * MiB, WS_X1 = 336 * MiB  , WS_X0 = 400 * MiB  , WS_END = 464 * MiB;
constexpr float LOG2E = 1.4426950408889634f;
constexpr int NWAVES = 8;
#define TIMER_SEL -1
#define TIMER_FS 100
#define TIMER_WG 37
#define TIMER_TYPE 1
#define PROBE_ATT 0
#define PROBE_REPS 2
#define PROBE_P1 0
#define PROBE_P3 0
#define PROBE_P0 0
#ifndef N_LAUNCHES
#define N_LAUNCHES 1
#endif
constexpr int RING_BYTES = 131072, LDSCTL_OFF = 139264, MISC_OFF = LDSCTL_OFF + 320, LDS_BYTES = 147456;

#define GAS __attribute__((address_space(1)))
#define LAS __attribute__((address_space(3)))
typedef unsigned short bf16;
typedef unsigned v4u __attribute__((ext_vector_type(4)));
typedef float f32x4 __attribute__((ext_vector_type(4)));
__device__ __forceinline__ unsigned f2bf(float f) { unsigned u = __builtin_bit_cast(unsigned, f); return (u + 0x7fffu + ((u >> 16) & 1u)) >> 16; }
typedef float f32x2h_t __attribute__((ext_vector_type(2))); typedef __bf16 bf16x2h_t __attribute__((ext_vector_type(2)));
__device__ __forceinline__ unsigned pk2(float lo, float hi) { f32x2h_t v = {lo, hi}; bf16x2h_t b = __builtin_convertvector(v, bf16x2h_t); return __builtin_bit_cast(unsigned, b); }
__device__ __forceinline__ float bf2f(unsigned v) { return __uint_as_float(v << 16); }
__device__ __forceinline__ float wave_sum(float v) {
#pragma unroll
    for (int o = 1; o < 64; o <<= 1) v += __shfl_xor(v, o);
    return v;
}
#define RLX_AGENT __ATOMIC_RELAXED, __HIP_MEMORY_SCOPE_AGENT
#define XB_TMO      128
#define XB_XCNT(j)  (256  + 64 * (j))
#define XB_XSUB(j)  (1280 + 64 * (j))
#define XB_XGEN(j)  (2304 + 64 * (j))
#define XB_TOP      3328
#define XB_TOPGEN   3392
#define XCD_BAR_WORDS 3456
#define XB_SPIN_CAP (1u << 18)

__device__ __forceinline__ unsigned xb_ld(unsigned* p)              { return __hip_atomic_load(p, __ATOMIC_RELAXED, __HIP_MEMORY_SCOPE_AGENT); }
__device__ __forceinline__ unsigned xb_add(unsigned* p, unsigned v) { return __hip_atomic_fetch_add(p, v, __ATOMIC_RELAXED, __HIP_MEMORY_SCOPE_AGENT); }
__device__ __forceinline__ unsigned xb_xcc_id() { return (unsigned)__builtin_amdgcn_s_getreg((3 << 11) | 20) & 0xFu; }
#define XB_SPIN(cond, bar) do { unsigned _sp = 0; while (cond) { __builtin_amdgcn_s_sleep(1); \
    if ((++_sp & 255u) == 0u) { if (xb_ld(&(bar)[XB_TMO])) break; if (_sp > XB_SPIN_CAP) { atomicAdd(&(bar)[XB_TMO], 1u); break; } } } } while (0)

struct XcdBarrier {
    unsigned* bar; unsigned x;
    volatile LAS unsigned* st;
};

__device__ __forceinline__ XcdBarrier xcd_barrier_post(unsigned* bar, volatile LAS unsigned* st) {
    XcdBarrier b; b.bar = bar; b.x = xb_xcc_id(); b.st = st;
    if (threadIdx.x == 0) (void)xb_add(&bar[XB_XCNT(b.x)], 1u);
    return b;
}
__device__ __forceinline__ void xcd_barrier_complete(unsigned* bar, unsigned x, unsigned& nloc, unsigned& nx) {
    const unsigned G = gridDim.x * gridDim.y * gridDim.z;
    unsigned sum, cnt, mine, sp = 0u;
    for (;;) {
        sum = 0u; cnt = 0u; mine = 0u;
#pragma unroll
        for (unsigned j = 0; j < 16; ++j) { const unsigned c = xb_ld(&bar[XB_XCNT(j)]); sum += c; cnt += (c > 0u) ? 1u : 0u; mine = (j == x) ? c : mine; }
        if (sum == G) break;
        __builtin_amdgcn_s_sleep(1);
        if ((++sp & 255u) == 0u) { if (xb_ld(&bar[XB_TMO])) break; if (sp > XB_SPIN_CAP) { atomicAdd(&bar[XB_TMO], 1u); break; } }
    }
    nloc = mine > 0u ? mine : 1u; nx = cnt > 0u ? cnt : 1u;
}

__device__ __forceinline__ void xcd_barrier(const XcdBarrier& b) {
    asm volatile("s_waitcnt vmcnt(0)" ::: "memory");
    __syncthreads();
    if (threadIdx.x == 0) {
        unsigned* bar = b.bar;
        __builtin_amdgcn_s_waitcnt(0);
        unsigned nloc = b.st[0], nx = b.st[1];
        if (nloc == 0u) { xcd_barrier_complete(bar, b.x, nloc, nx); b.st[0] = nloc; b.st[1] = nx; }
        const unsigned old = xb_add(&bar[XB_XSUB(b.x)], 1u);
        const unsigned gen = old / nloc;
        if (old + 1u == (gen + 1u) * nloc) {
            __builtin_amdgcn_fence(__ATOMIC_RELEASE, "agent");
            asm volatile("s_waitcnt vmcnt(0)" ::: "memory");
            const unsigned og = xb_add(&bar[XB_TOP], 1u);
            const unsigned tg = og / nx;
            if (og + 1u == (tg + 1u) * nx) xb_add(&bar[XB_TOPGEN], 1u);
            else XB_SPIN(xb_ld(&bar[XB_TOPGEN]) == tg, bar);
            __builtin_amdgcn_fence(__ATOMIC_ACQUIRE, "agent");
            xb_add(&bar[XB_XGEN(b.x)], 1u);
            asm volatile("s_waitcnt vmcnt(0)" ::: "memory");
        } else {
            XB_SPIN(xb_ld(&bar[XB_XGEN(b.x)]) == gen, bar);
            __builtin_amdgcn_fence(__ATOMIC_ACQUIRE, "agent");
            asm volatile("s_waitcnt vmcnt(0)" ::: "memory");
        }
    }
    __syncthreads();
}

__device__ __forceinline__ int rel_bucket(int d) {
    if (d < 16) return d;
    int b = 16;
    b += (d >= 21); b += (d >= 27); b += (d >= 35); b += (d >= 46); b += (d >= 59); b += (d >= 77); b += (d >= 99); b += (d >= 128);
    b += (d >= 166); b += (d >= 216); b += (d >= 280); b += (d >= 363); b += (d >= 470); b += (d >= 609); b += (d >= 790);
    return b;
}

struct Args { const float* x; const float* norm_gain; const float* w_in; const float* b_forget; const float* fox_g; const float* moba_g; const float* swa_g; const float* sinks; const float* w_out; const float* rel_bias; float* out; unsigned char* ws; int ph_lo, ph_hi, tmask, pad; };

struct Frame { LAS unsigned char* lds; int tid, lane, wave, vcu, G; };

__device__ __forceinline__ void transpose_item(const float* W, int ldw, bf16* WT, int dst_row0, int src_col0, int ncol, const float* gk, LAS float* scr, int kb, int lane) {
    const int k0 = 64 * kb;
    { float wv[32]; const int c = lane & 31;
#pragma unroll
        for (int i = 0; i < 32; ++i) { const int kk = 2 * i + (lane >> 5); wv[i] = (c < ncol) ? W[(size_t)(k0 + kk) * ldw + src_col0 + c] : 0.f; }
        if (gk) {
#pragma unroll
            for (int i = 0; i < 32; ++i) wv[i] *= gk[k0 + 2 * i + (lane >> 5)]; }
#pragma unroll
        for (int i = 0; i < 32; ++i) scr[(2 * i + (lane >> 5)) * 33 + c] = wv[i]; }
    asm volatile("s_waitcnt lgkmcnt(0)" ::: "memory");
    const int c = lane & 7;
#pragma unroll
    for (int j = 0; j < 4; ++j) { const int n = (lane >> 3) + 8 * j; const LAS float* s = scr + (8 * c) * 33 + n;
        v4u o; o.x = pk2(s[0 * 33], s[1 * 33]); o.y = pk2(s[2 * 33], s[3 * 33]); o.z = pk2(s[4 * 33], s[5 * 33]); o.w = pk2(s[6 * 33], s[7 * 33]);
        *(v4u*)(WT + (size_t)(dst_row0 + n) * 1024 + k0 + 8 * c) = o; }
    asm volatile("s_waitcnt lgkmcnt(0)" ::: "memory");
}
__device__ __forceinline__ int tile_src(int T, int wc) {
    switch (T) { case 0: return 0 + 64 * wc; case 1: return 256 + 64 * wc; case 2: return 512 + 64 * wc; case 3: return 772 + 64 * wc;
        case 4: return 1028 + 64 * wc; case 5: return 1284 + 64 * wc; case 6: return 1540 + 64 * wc; case 7: return 1796 + 64 * wc;
        case 8: return 2052 + 64 * wc; case 9: return 2308 + 64 * wc; case 10: return 2564 + 64 * wc; case 11: return 2820 + 64 * wc;
        case 12: return 3076 + 64 * wc; case 13: return wc < 2 ? 3332 + 64 * wc : 3460 + 64 * (wc - 2); default: return 3588 + 64 * wc; }
}
__device__ __forceinline__ void p_weights(Frame& F, const Args& a) {
    LAS float* scr = (LAS float*)(F.lds + F.wave * 16384);
    const int gw = F.vcu * 2 + (F.wave - 6), NGW = F.G * 2;
    bf16* win = (bf16*)(a.ws + WS_WIN); bf16* wout = (bf16*)(a.ws + WS_WOUT);
    constexpr int I_IN = 128 * 16, I_OUT = 32 * 16;
    for (int it = gw; it < 2 * (I_IN + I_OUT); it += NGW) {
        const int layer = it / (I_IN + I_OUT); int r = it % (I_IN + I_OUT);
        if (r < I_IN) { const int kb = r >> 7, g = r & 127, T = g >> 3, gg = g & 7, bj = gg >> 2, wc = gg & 3;
            const int src = (T < 15) ? tile_src(T, wc) + 32 * bj : 768, ncol = (T < 15) ? 32 : (gg == 0 ? 4 : 0);
            transpose_item(a.w_in + (size_t)layer * DM * INW, INW, win + (size_t)layer * NPERM * DM, 32 * g, src, ncol, a.norm_gain + layer * DM, scr, kb, F.lane); }
        else { r -= I_IN; const int kb = r / 32, g = r % 32;
            transpose_item(a.w_out + (size_t)layer * DM * DM, DM, wout + (size_t)layer * DM * DM, 32 * g, 32 * g, 32, nullptr, scr, kb, F.lane); }
    }
}
__device__ __forceinline__ void p_tables(Frame& F, const Args& a) {
    if (F.vcu == 0) { float* tab = (float*)(a.ws + WS_TAB);
        for (int i = F.tid; i < 8 * 1024; i += NWAVES * 64) { const int hc = i >> 10, d = i & 1023; tab[i] = a.rel_bias[rel_bucket(d) * 8 + hc] * LOG2E; } }
}
__device__ __forceinline__ void p_consts(Frame& F, const Args& a) {
    if (F.vcu == 0 && F.wave == 0) for (int layer = 0; layer < NLAYER; ++layer) {
        const int lane = F.lane; float* MF = (float*)(a.ws + WS_MF) + layer * 4;
        float bm = 0.f;
#pragma unroll
        for (int j = 0; j < 4; ++j) bm = fmaxf(bm, fabsf(a.rel_bias[64 * j + lane]));
#pragma unroll
        for (int o = 1; o < 64; o <<= 1) bm = fmaxf(bm, __shfl_xor(bm, o));
        const float* gp[3] = {a.fox_g + layer * 128, a.moba_g + layer * 128, a.swa_g + layer * 128};
#pragma unroll
        for (int k = 0; k < 3; ++k) { float mq = fabsf(gp[k][lane]), mk = fabsf(gp[k][64 + lane]);
#pragma unroll
            for (int o = 1; o < 64; o <<= 1) { mq = fmaxf(mq, __shfl_xor(mq, o)); mk = fmaxf(mk, __shfl_xor(mk, o)); }
            const float m = 8.f * LOG2E * mq * mk * 1.02f + 0.1f + (k == 0 ? 0.f : bm * LOG2E);
            if (lane == 0) MF[k == 0 ? 0 : (k == 1 ? 1 : 3)] = m; }
        if (lane == 0) MF[2] = 0.f;
    }
}
__device__ __forceinline__ void p_convert(Frame& F, const Args& a) {
    const int lane = F.lane, gt = F.vcu * 384 + F.tid, NT_ = F.G * 384;
    { float* KM = (float*)(a.ws + WS_KM); for (int i = gt; i < 2 * 32 * 16 * 64; i += NT_) KM[i] = 0.f;
      float* RS1 = (float*)(a.ws + WS_RS) + NTOK; for (int i = gt; i < NTOK; i += NT_) RS1[i] = 0.f; }
    bf16* XB = (bf16*)(a.ws + WS_X0); float* RS0 = (float*)(a.ws + WS_RS);
    const int gwv = F.vcu * 6 + F.wave, NGW = F.G * 6;
    for (int r0 = 4 * gwv; r0 < NTOK; r0 += 4 * NGW) {
        f32x4 v[4][4];
#pragma unroll
        for (int rr = 0; rr < 4; ++rr) { const f32x4* xr = (const f32x4*)(a.x + (size_t)(r0 + rr) * DM) + lane;
#pragma unroll
            for (int j = 0; j < 4; ++j) v[rr][j] = xr[64 * j]; }
        float ss[4];
#pragma unroll
        for (int rr = 0; rr < 4; ++rr) { ss[rr] = 0.f; unsigned long long* o8 = (unsigned long long*)(XB + (size_t)(r0 + rr) * DM) + lane;
#pragma unroll
            for (int j = 0; j < 4; ++j) { const f32x4 y = v[rr][j]; ss[rr] += (y[0] * y[0] + y[1] * y[1]) + (y[2] * y[2] + y[3] * y[3]);
                o8[64 * j] = (unsigned long long)pk2(y[0], y[1]) | ((unsigned long long)pk2(y[2], y[3]) << 32); } }
#pragma unroll
        for (int o = 1; o < 64; o <<= 1)
#pragma unroll
            for (int rr = 0; rr < 4; ++rr) ss[rr] += __shfl_xor(ss[rr], o);
        if (lane < 4) RS0[r0 + lane] = lane == 0 ? ss[0] : (lane == 1 ? ss[1] : (lane == 2 ? ss[2] : ss[3]));
    }
}
namespace att {
using bf16x8 = __attribute__((ext_vector_type(8))) short;
using s16x4 = __attribute__((ext_vector_type(4))) short;
using f32x16 = __attribute__((ext_vector_type(16))) float;
using u32x4 = __attribute__((ext_vector_type(4))) unsigned;
typedef __attribute__((address_space(3))) const char* lds_cptr;
typedef __attribute__((address_space(3))) char* lds_ptr;
typedef short v4i16_t __attribute__((ext_vector_type(4)));
typedef float f32x2_t __attribute__((ext_vector_type(2))); typedef __bf16 bf16x2_t __attribute__((ext_vector_type(2)));
constexpr int NSLOT = 5, PFD = 2, SLOTB = 8192;
constexpr int L_K = 0, L_V = NSLOT * SLOTB, L_OST = 0  , L_WS = 2 * NSLOT * SLOTB, L_CS = L_WS + 8 * 256, L_TAB = L_CS + 16384, L_G = L_TAB + 4608, L_MISC = L_G + 8 * 4096, L_END = L_MISC + 1024;
static_assert(L_END <= 139264 && 8 * 4096 <= NSLOT * SLOTB, "attention LDS map (the kernel's control words start at 136 KiB)");
constexpr float THR2 = 44.f;
#define SBAR() __builtin_amdgcn_sched_barrier(0)
__device__ __forceinline__ int crow(int r, int hi) { return (r & 3) + 8 * (r >> 2) + 4 * hi; }
__device__ __forceinline__ void glds16(const void* gsrc, unsigned lds_dst) { unsigned keep;
    asm volatile("s_mov_b32 %0, m0\n\ts_mov_b32 m0, %2\n\ts_nop 0\n\tglobal_load_lds_dwordx4 %1, off\n\ts_mov_b32 m0, %0" : "=&s"(keep) : "v"(gsrc), "s"(lds_dst) : "memory"); }
__device__ __forceinline__ unsigned cvtpk_s(float lo, float hi) { f32x2_t v = {lo, hi}; bf16x2_t b = __builtin_convertvector(v, bf16x2_t); return __builtin_bit_cast(unsigned, b); }
__device__ __forceinline__ s16x4 vtr(lds_cptr p) { return __builtin_bit_cast(s16x4, __builtin_amdgcn_ds_read_tr16_b64_v4i16((__attribute__((address_space(3))) v4i16_t*)p)); }
#define MFMA32(a, b, c) __builtin_amdgcn_mfma_f32_32x32x16_bf16(a, b, c, 0, 0, 0)
__device__ __forceinline__ void qkt(f32x16& p0, f32x16& p1, lds_cptr kp, const bf16x8* qr, float cinit) {
    f32x16 c;
#pragma unroll
    for (int r = 0; r < 16; ++r) c[r] = cinit;
    p0 = c; p1 = c;
#pragma unroll
    for (int d0 = 0; d0 < 4; ++d0) {
        const bf16x8 b0 = *(const __attribute__((address_space(3))) bf16x8*)(kp + d0 * 2048);
        const bf16x8 b1 = *(const __attribute__((address_space(3))) bf16x8*)(kp + d0 * 2048 + 512);
        p0 = MFMA32(b0, qr[d0], p0); p1 = MFMA32(b1, qr[d0], p1);
    }
}
__device__ __forceinline__ void pv(f32x16* o, lds_cptr vp, bf16x8 pa0, bf16x8 pa1, bf16x8 pa2, bf16x8 pa3) {
#pragma unroll
    for (int d0 = 0; d0 < 2; ++d0) { s16x4 lo[4], hi[4];
#pragma unroll
        for (int ks = 0; ks < 4; ++ks) { lo[ks] = vtr(vp + d0 * 4096 + ks * 1024); hi[ks] = vtr(vp + d0 * 4096 + ks * 1024 + 512); }
#define PK(k) (bf16x8){lo[k][0], lo[k][1], lo[k][2], lo[k][3], hi[k][0], hi[k][1], hi[k][2], hi[k][3]}
        o[d0] = MFMA32(pa0, PK(0), o[d0]); o[d0] = MFMA32(pa1, PK(1), o[d0]); o[d0] = MFMA32(pa2, PK(2), o[d0]); o[d0] = MFMA32(pa3, PK(3), o[d0]);
#undef PK
    }
}
__device__ __forceinline__ void kload(bf16x8* kf, lds_cptr kp) {
#pragma unroll
    for (int d0 = 0; d0 < 4; ++d0) { kf[2 * d0] = *(const __attribute__((address_space(3))) bf16x8*)(kp + d0 * 2048); kf[2 * d0 + 1] = *(const __attribute__((address_space(3))) bf16x8*)(kp + d0 * 2048 + 512); }
}
__device__ __forceinline__ void kload2(bf16x8* kf, lds_cptr kpe, lds_cptr kpo) {
#pragma unroll
    for (int d0 = 0; d0 < 4; ++d0) { const lds_cptr p = ((d0 & 1) ? kpo : kpe) + (d0 >> 1) * 1024;
        kf[2 * d0] = *(const __attribute__((address_space(3))) bf16x8*)(p); kf[2 * d0 + 1] = *(const __attribute__((address_space(3))) bf16x8*)(p + 4096); }
}
__device__ __forceinline__ void vload(s16x4* vlo, s16x4* vhi, lds_cptr vp) {
#pragma unroll
    for (int i = 0; i < 8; ++i) { vlo[i] = vtr(vp + (i >> 2) * 4096 + (i & 3) * 1024); vhi[i] = vtr(vp + (i >> 2) * 4096 + (i & 3) * 1024 + 512); }
}
__device__ __forceinline__ void qkt_r(f32x16& p0, f32x16& p1, const bf16x8* kf, const bf16x8* qr, float cinit) {
    f32x16 c;
#pragma unroll
    for (int r = 0; r < 16; ++r) c[r] = cinit;
    p0 = c; p1 = c;
#pragma unroll
    for (int d0 = 0; d0 < 4; ++d0) { p0 = MFMA32(kf[2 * d0], qr[d0], p0); p1 = MFMA32(kf[2 * d0 + 1], qr[d0], p1); }
}
__device__ __forceinline__ void pv_r(f32x16* o, const s16x4* vlo, const s16x4* vhi, bf16x8 pa0, bf16x8 pa1, bf16x8 pa2, bf16x8 pa3) {
#define VFR(i) (bf16x8){vlo[i][0], vlo[i][1], vlo[i][2], vlo[i][3], vhi[i][0], vhi[i][1], vhi[i][2], vhi[i][3]}
    o[0] = MFMA32(pa0, VFR(0), o[0]); o[1] = MFMA32(pa0, VFR(4), o[1]); o[0] = MFMA32(pa1, VFR(1), o[0]); o[1] = MFMA32(pa1, VFR(5), o[1]);
    o[0] = MFMA32(pa2, VFR(2), o[0]); o[1] = MFMA32(pa2, VFR(6), o[1]); o[0] = MFMA32(pa3, VFR(3), o[0]); o[1] = MFMA32(pa3, VFR(7), o[1]);
#undef VFR
}
struct ACtx { const bf16 *Q, *K, *V, *G; bf16* Y; const float *LF, *TAB, *KM, *MF; const float* sinks; int tflag; };
#define WAITBAR(N) asm volatile("s_waitcnt vmcnt(" #N ") lgkmcnt(0)\n\ts_barrier" ::: "memory")

#define USTAMP(k) do { if (TIMER_SEL >= 0 && TYPE == TIMER_TYPE && C.tflag && tid == 0) { volatile __attribute__((address_space(3))) unsigned* ta_ = (volatile __attribute__((address_space(3))) unsigned*)(shm + 139264 + 320) + 16; const unsigned now_ = (unsigned)__builtin_amdgcn_s_memrealtime(); ta_[k] += now_ - ta_[31]; ta_[31] = now_; } } while (0)
__device__ __forceinline__ int ticket_type(int u) { const int ty = u >> 9; return ty == 0 ? 1 : (ty == 1 ? 0 : ty); }
__device__ __forceinline__ void prefetch_unit(const ACtx& C, int u, lds_ptr shm, bf16x8* qn) {
    int tid = threadIdx.x; asm volatile("" : "+v"(tid));
    const int lane = tid & 63, r32 = lane & 31, hi = lane >> 5; const int wid = __builtin_amdgcn_readfirstlane(tid >> 6);
    const int T = ticket_type(u), r = u & 511, qb = 15 - (r >> 5), bh = r & 31, b = bh >> 2, h = bh & 3;
    const int kvh = (T == 3) ? (b * 2 + (h >> 1)) : bh;
    const bf16* Kh = C.K + T * pg8::GS + (size_t)kvh * SEQ * 64; const bf16* Vh = C.V + T * pg8::GS + (size_t)kvh * SEQ * 64;
    const bf16* ksrc = Kh + wid * 512 + (lane >> 2) * 32 + (((lane & 3) ^ ((lane >> 4) & 3)) * 8);
    const bf16* vsrc = Vh + ((wid & 3) * 2 + (wid >> 2)) * 512 + (lane >> 2) * 32 + 8 * (lane & 3);
    const unsigned lds0 = (unsigned)(size_t)shm, kdst = lds0 + L_K + wid * 1024, vdst = lds0 + L_V + wid * 1024;
    const int t_hi = 4 * qb + 3;
    glds16(ksrc + (size_t)t_hi * 4096, (unsigned)__builtin_amdgcn_readfirstlane(kdst)); glds16(vsrc + (size_t)t_hi * 4096, (unsigned)__builtin_amdgcn_readfirstlane(vdst));
    glds16(ksrc + (size_t)(t_hi - 1) * 4096, (unsigned)__builtin_amdgcn_readfirstlane(kdst + SLOTB)); glds16(vsrc + (size_t)(t_hi - 1) * 4096, (unsigned)__builtin_amdgcn_readfirstlane(vdst + SLOTB));
    const bf16* Qw = C.Q + T * pg8::GS + ((size_t)bh * SEQ + qb * 256 + wid * 32) * 64;
#pragma unroll
    for (int d0 = 0; d0 < 4; ++d0) qn[d0] = *reinterpret_cast<const bf16x8*>(&Qw[((r32 >> 4) * 2 + (d0 >> 1)) * 512 + (r32 & 15) * 32 + 16 * (d0 & 1) + 8 * hi]);
}
template <int TYPE> __device__ __forceinline__ int attn_unit(const ACtx& C, int bh, int qb, lds_ptr shm, bf16x8 (&qr)[4], int tick, __attribute__((address_space(3))) int* tslot, unsigned* rdy_prev) {
    int tid = threadIdx.x; asm volatile("" : "+v"(tid));
    const int lane = tid & 63, r32 = lane & 31, hi = lane >> 5; const int wid = __builtin_amdgcn_readfirstlane(tid >> 6);
    const int b = bh >> 2, h = bh & 3, q0 = qb * 256, qrel = wid * 32 + r32, t = q0 + qrel;
    const int kvh = (TYPE == 3) ? (b * 2 + (h >> 1)) : bh;
    const bf16* Qw = C.Q + TYPE * pg8::GS + ((size_t)bh * SEQ + q0 + wid * 32) * 64;
    const bf16* Kh = C.K + TYPE * pg8::GS + (size_t)kvh * SEQ * 64; const bf16* Vh = C.V + TYPE * pg8::GS + (size_t)kvh * SEQ * 64;
    const unsigned lds0 = (unsigned)(size_t)shm;
    __attribute__((address_space(3))) float* wsf = (__attribute__((address_space(3))) float*)(shm + L_WS) + wid * 64;
    __attribute__((address_space(3))) float* tabL = (__attribute__((address_space(3))) float*)(shm + L_TAB);
    __attribute__((address_space(3))) float* cs = (__attribute__((address_space(3))) float*)(shm + L_CS);
    __attribute__((address_space(3))) float* misc = (__attribute__((address_space(3))) float*)(shm + L_MISC);
    __attribute__((address_space(3))) int* misci = (__attribute__((address_space(3))) int*)(shm + L_MISC);
    const bf16* ksrc = Kh + wid * 512 + (lane >> 2) * 32 + (((lane & 3) ^ ((lane >> 4) & 3)) * 8);
    const bf16* vsrc = Vh + ((wid & 3) * 2 + (wid >> 2)) * 512 + (lane >> 2) * 32 + 8 * (lane & 3);
    const unsigned kdst = lds0 + L_K + wid * 1024, vdst = lds0 + L_V + wid * 1024;
#define DMA_KV(tile, slot) do { glds16(ksrc + (size_t)(tile) * 4096, (unsigned)__builtin_amdgcn_readfirstlane(kdst + (slot) * SLOTB)); glds16(vsrc + (size_t)(tile) * 4096, (unsigned)__builtin_amdgcn_readfirstlane(vdst + (slot) * SLOTB)); } while (0)
    const unsigned koff_e = L_K + ((r32 >> 4) * 2) * 1024 + (r32 & 15) * 64 + ((hi ^ ((r32 >> 2) & 3)) * 16);
    const lds_cptr kpe = (lds_cptr)shm + koff_e, kpo = (lds_cptr)shm + (koff_e ^ 32u);
    const lds_cptr vp0 = (lds_cptr)shm + L_V + ((lane >> 4) & 1) * 32 + (lane & 3) * 8 + (4 * hi + ((lane & 15) >> 2)) * 64;
    const float Mf = (TYPE == 2) ? 0.f : C.MF[TYPE];
    const int t_hi = 4 * qb + 3; int t_lo = 0;
    if (TYPE == 3) { t_lo = 4 * qb - 2; if (t_lo < 0) t_lo = 0; }
    USTAMP(24);
    const size_t yrow0 = (size_t)(b * SEQ + q0 + wid * 32);
    { const bf16* gslab = C.G + (size_t)(TYPE * 32 + bh) * 262144 + (size_t)(q0 + wid * 32) * 64;
#pragma unroll
        for (int i = 0; i < 4; ++i) { const int row = 8 * i + (lane >> 3);
            glds16(gslab + ((row >> 4) * 2 + ((lane & 7) >> 2)) * 512 + (row & 15) * 32 + 8 * (lane & 3), (unsigned)__builtin_amdgcn_readfirstlane(lds0 + L_G + wid * 4096 + i * 1024)); } }
    unsigned sel = 0u; float ct = 0.f;
    if (TYPE == 0) {
        const float* lfp = C.LF + (size_t)bh * SEQ; const bool on = 8 * tid < q0 + 256;
        f32x4 a4 = {0.f, 0.f, 0.f, 0.f}, b4 = {0.f, 0.f, 0.f, 0.f};
        if (on) { a4 = *(const f32x4*)(lfp + 8 * tid); b4 = *(const f32x4*)(lfp + 8 * tid + 4); }
        a4[1] += a4[0]; a4[2] += a4[1]; a4[3] += a4[2]; b4[0] += a4[3]; b4[1] += b4[0]; b4[2] += b4[1]; b4[3] += b4[2];
        float sc = b4[3];
#pragma unroll
        for (int o = 1; o < 64; o <<= 1) { const float u = __shfl_up(sc, o); if (lane >= o) sc += u; }
        if (lane == 63) misc[wid] = sc;
        __syncthreads();
        float base = sc - b4[3];
#pragma unroll
        for (int w = 0; w < 7; ++w) if (w < wid) base += misc[w];
        if (on) { *(__attribute__((address_space(3))) f32x4*)(cs + 8 * tid) = a4 + base; *(__attribute__((address_space(3))) f32x4*)(cs + 8 * tid + 4) = b4 + base; }
        __syncthreads();
        const float cref = cs[q0];
        if (wid == 0) { const bool skip = (lane < 4 * qb) && (cs[64 * lane + 63] - cref > 2.f * Mf + THR2);
            const int cnt = __popcll(__ballot(skip)); if (lane == 0) misci[40] = cnt; }
        __syncthreads();
        t_lo = misci[40]; ct = cs[t];
    }
    if (TYPE == 1 || TYPE == 3) {
        const float* tg = C.TAB + ((TYPE == 3 ? 4 : 0) + h) * 1024;
        { float tv[3]; const float b31 = (TYPE == 1) ? tg[1023] : 0.f; float k0 = 0.f, k1 = 0.f;
#pragma unroll
            for (int k = 0; k < 3; ++k) { const int j = tid + 512 * k, d = 1023 - j; tv[k] = (j < 1088 && d >= 0 && (TYPE == 1 || d < 128)) ? tg[d] - b31 : -INFINITY; }
            if (TYPE == 1) { const float* kg = C.KM + (size_t)bh * 16 * 64; if (tid < qb * 64) k0 = kg[tid]; if (tid + 512 < qb * 64) k1 = kg[tid + 512]; }
#pragma unroll
            for (int k = 0; k < 3; ++k) { const int j = tid + 512 * k; if (j < 1088) tabL[j] = tv[k]; }
            if (TYPE == 1) { cs[tid] = k0; cs[tid + 512] = k1; } }
        __syncthreads();
        if (TYPE == 1) {
            if (qb <= 3) sel = (1u << qb) - 1u;
            else {
                float qf[32];
#pragma unroll
                for (int d0 = 0; d0 < 4; ++d0) { const u32x4 w = __builtin_bit_cast(u32x4, qr[d0]);
#pragma unroll
                    for (int j = 0; j < 4; ++j) { qf[d0 * 8 + 2 * j] = __uint_as_float(w[j] << 16); qf[d0 * 8 + 2 * j + 1] = __uint_as_float(w[j] & 0xffff0000u); } }
                float v1 = -INFINITY, v2 = -INFINITY, v3 = -INFINITY; int i1 = 0, i2 = 0, i3 = 0;
                for (int n = 0; n < qb; ++n) { float s = 0.f;
#pragma unroll
                    for (int d0 = 0; d0 < 4; ++d0) { const f32x4 ka = *(const __attribute__((address_space(3))) f32x4*)(cs + n * 64 + d0 * 16 + hi * 8), kb4 = *(const __attribute__((address_space(3))) f32x4*)(cs + n * 64 + d0 * 16 + hi * 8 + 4);
#pragma unroll
                        for (int j = 0; j < 4; ++j) { s += qf[d0 * 8 + j] * ka[j]; s += qf[d0 * 8 + 4 + j] * kb4[j]; } }
                    { auto rr = __builtin_amdgcn_permlane32_swap(__float_as_uint(s), __float_as_uint(s), false, false); s = __uint_as_float(rr[0]) + __uint_as_float(rr[1]); }
                    if (s > v1) { v3 = v2; i3 = i2; v2 = v1; i2 = i1; v1 = s; i1 = n; } else if (s > v2) { v3 = v2; i3 = i2; v2 = s; i2 = n; } else if (s > v3) { v3 = s; i3 = n; } }
                sel = (1u << i1) | (1u << i2) | (1u << i3); }
        }
    }
    const int n_tiles = t_hi - t_lo + 1;
    asm volatile("" : "+v"(qr[0]), "+v"(qr[1]), "+v"(qr[2]), "+v"(qr[3]));
    f32x16 o[2]; o[0] = f32x16{}; o[1] = f32x16{}; f32x16 lacc = f32x16{};
    float carry = (TYPE == 2) ? 1.f : 0.f; bool done_w = false;
    f32x16 cvec;
    { const float c0_ = (TYPE == 2) ? 0.f : ((TYPE == 0) ? ct - Mf : -Mf);
#pragma unroll
        for (int r = 0; r < 16; ++r) cvec[r] = c0_; }
    asm volatile("" : "+v"(cvec));
    const bf16x8 ones = {0x3f80, 0x3f80, 0x3f80, 0x3f80, 0x3f80, 0x3f80, 0x3f80, 0x3f80};
    const int jdiag = wid >> 1;
    const int jlo_w = (TYPE == 3) ? ((32 * wid - 127) >> 6) : -100000;
    if (TYPE == 2) { if (tid < 16) misci[64 + tid] = 0; }
    USTAMP(21);
    if (TIMER_SEL == 98 && TYPE == TIMER_TYPE && C.tflag && tid == 0) { volatile __attribute__((address_space(3))) unsigned* ta_ = (volatile __attribute__((address_space(3))) unsigned*)(shm + 139264 + 320) + 16; ta_[26] = (unsigned)__builtin_amdgcn_s_memtime(); }
    bf16x8 kf[8]; s16x4 vlo[8], vhi[8]; f32x16 p0, p1;
    const bool late = false;
#define FINISH(tile_, jr_, slot_) do { \
            vload(vlo, vhi, vp0 + (slot_) * SLOTB); SBAR(); \
            const int kb = 64 * (jr_) + 4 * hi; \
            unsigned keepm = 0xffffffffu; \
            if (TYPE == 0) { \
            _Pragma("unroll") \
                for (int g4 = 0; g4 < 4; ++g4) { const f32x4 c0 = *(const __attribute__((address_space(3))) f32x4*)(cs + 64 * (tile_) + 8 * g4 + 4 * hi), c1 = *(const __attribute__((address_space(3))) f32x4*)(cs + 64 * (tile_) + 32 + 8 * g4 + 4 * hi); \
            _Pragma("unroll") \
                    for (int j = 0; j < 4; ++j) { p0[4 * g4 + j] -= c0[j]; p1[4 * g4 + j] -= c1[j]; } } \
                if ((jr_) == jdiag) { \
            _Pragma("unroll") \
                    for (int r = 0; r < 16; ++r) { const int kv = kb + (r & 3) + 8 * (r >> 2); if (kv > qrel) p0[r] = -INFINITY; if (kv + 32 > qrel) p1[r] = -INFINITY; } } \
            _Pragma("unroll") \
                for (int r = 0; r < 16; ++r) { p0[r] = __builtin_amdgcn_exp2f(p0[r]); p1[r] = __builtin_amdgcn_exp2f(p1[r]); } \
            } \
            if (TYPE == 1 || TYPE == 3) { \
                const bool far = (TYPE == 1) && ((q0 + 32 * wid - 64 * (tile_) - 63) >= 790); \
                if (!far) { const __attribute__((address_space(3))) float* tp_ = tabL + (1023 - (qrel - kb)); \
            _Pragma("unroll") \
                    for (int r = 0; r < 16; ++r) { p0[r] += tp_[(r & 3) + 8 * (r >> 2)]; p1[r] += tp_[(r & 3) + 8 * (r >> 2) + 32]; } } \
                if (TYPE == 1 && (jr_) < 0) keepm = ((sel >> ((tile_) >> 2)) & 1u) ? 0xffffffffu : 0u; \
            _Pragma("unroll") \
                for (int r = 0; r < 16; ++r) { p0[r] = __builtin_amdgcn_exp2f(p0[r]); p1[r] = __builtin_amdgcn_exp2f(p1[r]); } \
            } \
            if (TYPE == 2) { \
                f32x16 w0, w1; \
            _Pragma("unroll") \
                for (int r = 0; r < 16; ++r) { float c0_, c1_; asm("v_min_f32_e32 %0, 0x42a00000, %1" : "=v"(c0_) : "v"(p0[r])); asm("v_min_f32_e32 %0, 0x42a00000, %1" : "=v"(c1_) : "v"(p1[r])); p0[r] = __builtin_amdgcn_exp2f(c0_); p1[r] = __builtin_amdgcn_exp2f(c1_); } \
                if ((jr_) == jdiag) { \
            _Pragma("unroll") \
                    for (int r = 0; r < 16; ++r) { const int kv = kb + (r & 3) + 8 * (r >> 2); if (kv >= qrel) p0[r] = 0.f; if (kv + 32 >= qrel) p1[r] = 0.f; } } \
            _Pragma("unroll") \
                for (int r = 0; r < 16; ++r) { w0[r] = 1.f + p0[r]; w1[r] = 1.f + p1[r]; } \
                float own[8], part[8]; \
            _Pragma("unroll") \
                for (int rb = 0; rb < 4; ++rb) { own[rb] = (w0[4 * rb] * w0[4 * rb + 1]) * (w0[4 * rb + 2] * w0[4 * rb + 3]); own[4 + rb] = (w1[4 * rb] * w1[4 * rb + 1]) * (w1[4 * rb + 2] * w1[4 * rb + 3]); } \
            _Pragma("unroll") \
                for (int rb = 0; rb < 8; ++rb) { auto rr = __builtin_amdgcn_permlane32_swap(__float_as_uint(own[rb]), __float_as_uint(own[rb]), false, false); part[rb] = __uint_as_float(hi ? rr[0] : rr[1]); } \
                float run = carry; \
            _Pragma("unroll") \
                for (int rb = 7; rb >= 0; --rb) { \
                    float E = hi == 0 ? run * part[rb] : run; run *= own[rb] * part[rb]; \
            _Pragma("unroll") \
                    for (int j = 3; j >= 0; --j) { const int r = 4 * (rb & 3) + j; \
                        if (rb >= 4) { E *= w1[r]; p1[r] *= __builtin_amdgcn_rcpf(E); } else { E *= w0[r]; p0[r] *= __builtin_amdgcn_rcpf(E); } } } \
                carry = run; \
                done_w = __all(carry > 1.7592186e13f) != 0;     \
            } \
            u32x4 pw0, pw1, pw2, pw3; \
            _Pragma("unroll") \
            for (int j = 0; j < 4; ++j) { pw0[j] = cvtpk_s(p0[2 * j], p0[2 * j + 1]); pw1[j] = cvtpk_s(p0[8 + 2 * j], p0[9 + 2 * j]); pw2[j] = cvtpk_s(p1[2 * j], p1[2 * j + 1]); pw3[j] = cvtpk_s(p1[8 + 2 * j], p1[9 + 2 * j]); } \
            if (TYPE == 1) { pw0 &= keepm; pw1 &= keepm; pw2 &= keepm; pw3 &= keepm; } \
            const bf16x8 pa0 = __builtin_bit_cast(bf16x8, pw0), pa1 = __builtin_bit_cast(bf16x8, pw1), pa2 = __builtin_bit_cast(bf16x8, pw2), pa3 = __builtin_bit_cast(bf16x8, pw3); \
            pv_r(o, vlo, vhi, pa0, pa1, pa2, pa3); \
            if (TYPE != 2) { lacc = MFMA32(pa0, ones, lacc); lacc = MFMA32(pa1, ones, lacc); lacc = MFMA32(pa2, ones, lacc); lacc = MFMA32(pa3, ones, lacc); } \
        } while (0)
#define SCORE(slot_) do { kload2(kf, kpe + (slot_) * SLOTB, kpo + (slot_) * SLOTB); SBAR(); \
        if (TYPE == 2) { p0 = MFMA32(kf[0], qr[0], (f32x16{})); p1 = MFMA32(kf[1], qr[0], (f32x16{})); } else { p0 = MFMA32(kf[0], qr[0], cvec); p1 = MFMA32(kf[1], qr[0], cvec); } \
        _Pragma("unroll") for (int d0 = 1; d0 < 4; ++d0) { p0 = MFMA32(kf[2 * d0], qr[d0], p0); p1 = MFMA32(kf[2 * d0 + 1], qr[d0], p1); } SBAR(); } while (0)
    int slot = 0, dslot = PFD, ptile = 0, pslot = 0; bool pend = false, stop = false;
    for (int i = 0; ; ++i) {
        const int tile = t_hi - i, jr = tile - 4 * qb;
        if (i < n_tiles && !stop) {
            { const int tp = tile - PFD; DMA_KV(tp < 0 ? 0 : tp, dslot); }
            dslot = (dslot == NSLOT - 1) ? 0 : dslot + 1;
            WAITBAR(4);
            if (TYPE == 2 && i > 0) { const u32x4 fa = *(const __attribute__((address_space(3))) u32x4*)(misci + 64 + ((i - 1) & 1) * 8), fb = *(const __attribute__((address_space(3))) u32x4*)(misci + 68 + ((i - 1) & 1) * 8);
                if ((fa[0] & fa[1] & fa[2] & fa[3] & fb[0] & fb[1] & fb[2] & fb[3]) != 0u) stop = true; }
        }
        if (late && pend) { FINISH(ptile, ptile - 4 * qb, pslot); pend = false; }
        if (i >= n_tiles || stop) break;
        const bool active = (jr <= jdiag) && (jr >= jlo_w) && !(TYPE == 2 && done_w);
        if (active) { SCORE(slot); }
        if (!late) { if (active) { FINISH(tile, jr, slot); } } else { pend = active; ptile = tile; pslot = slot; }
        if (TYPE == 2) { if (lane == 0) misci[64 + (i & 1) * 8 + wid] = done_w ? 1 : 0; }
        slot = (slot == NSLOT - 1) ? 0 : slot + 1;
    }
#undef FINISH
#undef SCORE
    if (TIMER_SEL == 98 && TYPE == TIMER_TYPE && C.tflag && tid == 0) { volatile __attribute__((address_space(3))) unsigned* ta_ = (volatile __attribute__((address_space(3))) unsigned*)(shm + 139264 + 320) + 16; ta_[25] += (unsigned)__builtin_amdgcn_s_memtime() - ta_[26]; }
    USTAMP(22);
    if (tid == 0) tslot[0] = tick;
    asm volatile("s_waitcnt vmcnt(0) lgkmcnt(0)\n\ts_barrier" ::: "memory");
    if (tid == 0 && rdy_prev != nullptr) (void)__hip_atomic_fetch_add(rdy_prev, 1u, __ATOMIC_RELAXED, __HIP_MEMORY_SCOPE_AGENT);
    const int unext = tslot[0];
    if (unext < 2048) prefetch_unit(C, unext, shm, qr);
    float rli[16];
    { const float sk = (TYPE == 3) ? __builtin_amdgcn_exp2f(C.sinks[h] * LOG2E - Mf) : 0.f;
#pragma unroll
        for (int r = 0; r < 16; ++r) rli[r] = (TYPE == 2) ? 1.f : __builtin_amdgcn_rcpf(lacc[r] + sk); }
    __attribute__((address_space(3))) bf16* stg = (__attribute__((address_space(3))) bf16*)(shm + (wid < 6 ? L_K + 2 * SLOTB + wid * 4096 : L_V + 2 * SLOTB + (wid - 6) * 4096));
    const __attribute__((address_space(3))) bf16* gst = (const __attribute__((address_space(3))) bf16*)(shm + L_G) + wid * 2048;
#pragma unroll
    for (int r = 0; r < 16; ++r) { const int orow = crow(r, hi); const float rl = rli[r];
        { const unsigned w_ = cvtpk_s(o[0][r] * rl, o[1][r] * rl); stg[orow * 64 + r32] = (bf16)(w_ & 0xffffu); stg[orow * 64 + 32 + r32] = (bf16)(w_ >> 16); } }
    asm volatile("s_waitcnt lgkmcnt(0)" ::: "memory");
#pragma unroll
    for (int i = 0; i < 4; ++i) { const int row = i * 8 + (lane >> 3), ch = lane & 7;
        const u32x4 v = *(const __attribute__((address_space(3))) u32x4*)(stg + row * 64 + ch * 8);
        const u32x4 g = *(const __attribute__((address_space(3))) u32x4*)(gst + row * 64 + ch * 8); u32x4 w;
        const size_t off = (yrow0 + row) * DM + TYPE * 256 + h * 64 + ch * 8;
#pragma unroll
        for (int j = 0; j < 4; ++j) { const float a0 = __uint_as_float(v[j] << 16) * __uint_as_float(g[j] << 16), a1 = __uint_as_float(v[j] & 0xffff0000u) * __uint_as_float(g[j] & 0xffff0000u); w[j] = cvtpk_s(a0, a1); }
        { const bf16* yp_ = C.Y + off; asm volatile("global_store_dwordx4 %0, %1, off sc1\n\ts_nop 1" :: "v"(yp_), "v"(w) : "memory"); } }
    asm volatile("s_waitcnt lgkmcnt(0)\n\ts_barrier" ::: "memory");
    USTAMP(23);
    return unext;
#undef DMA_KV
}
#undef SBAR
}
#define TACC(F) ((volatile LAS unsigned*)((F).lds + MISC_OFF) + 16)
#define TSTAMP(F, k) do { if (TIMER_SEL >= 0 && (F).vcu == TIMER_WG && (F).tid == 0) { const unsigned now_ = (unsigned)__builtin_amdgcn_s_memrealtime(); TACC(F)[k] += now_ - TACC(F)[31]; TACC(F)[31] = now_; } } while (0)
__device__ __forceinline__ void p_attn(Frame& F, const Args& a, int layer, int rep, int tmask) {
    att::ACtx C{(const bf16*)(a.ws + WS_Q), (const bf16*)(a.ws + WS_K), (const bf16*)(a.ws + WS_V), (const bf16*)(a.ws + WS_G), (bf16*)(a.ws + WS_HN),
                (const float*)(a.ws + WS_LF), (const float*)(a.ws + WS_TAB), (const float*)(a.ws + WS_KM) + layer * 32768, (const float*)(a.ws + WS_MF) + layer * 4, a.sinks + layer * 4, (F.vcu == TIMER_WG) ? 1 : 0};
    unsigned* head = (unsigned*)(a.ws + WS_CTL) + CW_QUEUE + 64 * (layer + 2 * rep);
    LAS int* slot = (LAS int*)(F.lds + att::L_MISC) + 200;
    att::lds_ptr shm = (att::lds_ptr)F.lds;
    if (F.tid == 0) slot[0] = (int)__hip_atomic_fetch_add(head, 1u, __ATOMIC_RELAXED, __HIP_MEMORY_SCOPE_AGENT);
    __syncthreads();
    int u = slot[0];
    __syncthreads();
    att::bf16x8 qr[4];
    if (u < 2048) att::prefetch_unit(C, u, shm, qr);
    unsigned* const rdy = (unsigned*)(a.ws + WS_CTL) + CW_RDY + 128 * layer; unsigned* pend = nullptr;
    while (u < 2048) {
        int tick = 0;
        if (F.tid == 0) tick = (int)__hip_atomic_fetch_add(head, 1u, __ATOMIC_RELAXED, __HIP_MEMORY_SCOPE_AGENT);
        const int ty = u >> 9, r = u & 511, qb = 15 - (r >> 5), bh = r & 31;
        TSTAMP(F, 20);
        unsigned* const mine = rdy + ((bh >> 2) * 16 + qb);
        if (ty == 0) u = att::attn_unit<1>(C, bh, qb, shm, qr, tick, (LAS int*)slot, pend);
        else if (ty == 1) u = att::attn_unit<0>(C, bh, qb, shm, qr, tick, (LAS int*)slot, pend);
        else if (ty == 2) u = att::attn_unit<2>(C, bh, qb, shm, qr, tick, (LAS int*)slot, pend);
        else u = att::attn_unit<3>(C, bh, qb, shm, qr, tick, (LAS int*)slot, pend);
        TSTAMP(F, 8 + ty);
        pend = mine;
    }
    asm volatile("s_waitcnt vmcnt(0)" ::: "memory");
    __syncthreads();
    if (F.tid == 0 && pend != nullptr) (void)__hip_atomic_fetch_add(pend, 1u, __ATOMIC_RELAXED, __HIP_MEMORY_SCOPE_AGENT);
}

__global__ void __launch_bounds__(NWAVES * 64, 2) mk_fwd(Args a) {
    extern __shared__ __attribute__((aligned(16))) unsigned char lds[];
    Frame F; F.lds = (LAS unsigned char*)lds; F.tid = threadIdx.x; F.lane = F.tid & 63; F.wave = __builtin_amdgcn_readfirstlane(F.tid >> 6);
    F.G = gridDim.x; { const int bx = blockIdx.x; F.vcu = (F.G % 8 == 0) ? (bx % 8) * (F.G / 8) + bx / 8 : bx; }
    bf16* HN = (bf16*)(a.ws + WS_HN);
    for (int u = F.tid; u < (LDS_BYTES - LDSCTL_OFF) / 4; u += NWAVES * 64) ((LAS unsigned*)(F.lds + LDSCTL_OFF))[u] = 0u;
    __syncthreads();
    XcdBarrier bar; bar.bar = (unsigned*)(a.ws + WS_CTL) + CW_BAR; bar.x = 0; bar.st = nullptr;
    if (a.ph_hi - a.ph_lo > 1) bar = xcd_barrier_post((unsigned*)(a.ws + WS_CTL) + CW_BAR, (volatile LAS unsigned*)(F.lds + MISC_OFF) + 8);
#define PHASE_ON(k) (a.ph_lo <= (k) && (k) < a.ph_hi)
#define SEAM(k) do { if ((k) != 4 && PHASE_ON(k) && PHASE_ON((k) + 1)) xcd_barrier(bar); } while (0)
#define LAYER_PHASES(layer) do { \
    if ((layer) == 0 && PHASE_ON(0)) { p_tables(F, a); p_consts(F, a); if (F.wave >= 6) p_weights(F, a); else p_convert(F, a); } \
    if ((layer) == 0) { TSTAMP(F, 0); SEAM(0); TSTAMP(F, 1); } \
    if (PHASE_ON(4 * (layer) + 1)) { \
        pg8::Gemm g{(layer) == 0 ? (const bf16*)(a.ws + WS_X0) : (const bf16*)(a.ws + WS_X1), (const bf16*)(a.ws + WS_WIN) + (size_t)(layer) * NPERM * DM, NTOK, NPERM, DM}; \
        pg8::StaticOrder S; S.init(NTOK, NPERM, F.G, (int)blockIdx.x); \
        pg8::EpiIn E{(bf16*)(a.ws + WS_Q), (bf16*)(a.ws + WS_K), (bf16*)(a.ws + WS_V), (bf16*)(a.ws + WS_G), a.fox_g + (layer) * 128, a.moba_g + (layer) * 128, a.swa_g + (layer) * 128, (float*)(a.ws + WS_KM) + (layer) * 32768, \
                     (const float*)(a.ws + WS_RS) + (layer) * NTOK, (float*)(a.ws + WS_LF), a.b_forget + (layer) * 4}; \
        pg8::gemm_phase<pg8::EpiIn, pg8::StaticOrder, true, true>(F.lds, g, S, E); \
        if (PROBE_P1) { xcd_barrier(bar); pg8::gemm_phase<pg8::EpiIn, pg8::StaticOrder, true, true>(F.lds, g, S, E); } \
    } \
    TSTAMP(F, 2); SEAM(4 * (layer) + 1); TSTAMP(F, 3); \
    if (PHASE_ON(4 * (layer) + 2)) { for (int rep = 0; rep < 1 + (PROBE_ATT != 0 ? PROBE_REPS : 0); ++rep) { if (rep) xcd_barrier(bar); p_attn(F, a, (layer), rep, rep ? PROBE_ATT : 15); } } \
    TSTAMP(F, 4);   TSTAMP(F, 5); \
    if (PHASE_ON(4 * (layer) + 3)) { \
        pg8::Gemm g{HN  , (const bf16*)(a.ws + WS_WOUT) + (size_t)(layer) * DM * DM, NTOK, DM, DM}; \
        pg8::FlagOrder S; S.init(NTOK, DM, F.G, (int)blockIdx.x); S.rdy = (unsigned*)(a.ws + WS_CTL) + CW_RDY + 128 * (layer); S.need = 16u; \
        if ((layer) == 0) { \
            pg8::EpiRes0 E{(const bf16*)(a.ws + WS_X0), (bf16*)(a.ws + WS_X1), (float*)(a.ws + WS_RS) + NTOK}; \
            pg8::gemm_phase<pg8::EpiRes0, pg8::FlagOrder, true, true>(F.lds, g, S, E); \
        } else { \
            pg8::EpiRes1 E{(const bf16*)(a.ws + WS_X1), a.out}; \
            pg8::gemm_phase<pg8::EpiRes1, pg8::FlagOrder, true, true>(F.lds, g, S, E); \
        } \
    } \
    if ((layer) == 0) { TSTAMP(F, 6); SEAM(3); SEAM(4); TSTAMP(F, 7); } } while (0)
    if (TIMER_SEL >= 0 && F.vcu == TIMER_WG && F.tid == 0) TACC(F)[31] = (unsigned)__builtin_amdgcn_s_memrealtime();
    LAYER_PHASES(0);
    LAYER_PHASES(1);
    if (TIMER_SEL >= 0 && F.vcu == TIMER_WG) {
        asm volatile("s_waitcnt vmcnt(0)" ::: "memory"); __syncthreads();
        float v = (TIMER_SEL == 99) ? 1.0f : (TIMER_SEL == 98) ? ((float)TACC(F)[25] / ((float)TACC(F)[22] * 10.f)) / 3.0f : (float)TACC(F)[TIMER_SEL & 31] * 0.01f / (float)TIMER_FS; v = fminf(fmaxf(v, 0.f), 1.f); const float dl = 0.1f * sqrtf(v);
        pg8::FlagOrder S; S.init(NTOK, DM, F.G, (int)blockIdx.x); pg8::Unit u;
        for (int i = 0; S.next(i, u); ++i) for (int e = F.tid; e < 65536; e += NWAVES * 64) { float* p = a.out + (size_t)(u.pm * 256 + (e >> 8)) * DM + u.pn * 256 + (e & 255); *p += dl; }
    }
}

extern "C" void kernel_launch(void* const* d_in, const int* in_sizes, int n_in, void* d_out, int out_size, void* d_ws, size_t ws_size, hipStream_t stream) {
    static int ok = 0, grid = 0;
    if (ok == 0) {
        if (n_in != 10 || in_sizes[0] != NTOK * DM || out_size != NTOK * DM || ws_size < WS_END) { fprintf(stderr, "kernel_launch: unexpected shapes (n_in %d, in0 %d, out %d, ws %zu)\n", n_in, n_in > 0 ? in_sizes[0] : -1, out_size, ws_size); ok = -1; return; }
        if (hipFuncSetAttribute((const void*)mk_fwd, hipFuncAttributeMaxDynamicSharedMemorySize, LDS_BYTES) != hipSuccess) { fprintf(stderr, "kernel_launch: hipFuncSetAttribute failed\n"); ok = -1; return; }
        int dev = 0, cus = 0; if (hipGetDevice(&dev) != hipSuccess || hipDeviceGetAttribute(&cus, hipDeviceAttributeMultiprocessorCount, dev) != hipSuccess) { fprintf(stderr, "kernel_launch: device query failed\n"); ok = -1; return; }
        grid = cus < 256 ? (cus / 8) * 8 : 256; if (grid < 8) grid = cus;
        ok = 1;
    }
    if (ok < 0) return;
    Args a{};
    a.x = (const float*)d_in[0]; a.norm_gain = (const float*)d_in[1]; a.w_in = (const float*)d_in[2]; a.b_forget = (const float*)d_in[3]; a.fox_g = (const float*)d_in[4];
    a.moba_g = (const float*)d_in[5]; a.swa_g = (const float*)d_in[6]; a.sinks = (const float*)d_in[7]; a.w_out = (const float*)d_in[8]; a.rel_bias = (const float*)d_in[9];
    a.out = (float*)d_out; a.ws = (unsigned char*)d_ws;
    unsigned char* ws = (unsigned char*)d_ws;
    a.tmask = 15;
    if (hipMemsetAsync(ws + WS_CTL, 0, CTL_ZERO_BYTES, stream) != hipSuccess) { fprintf(stderr, "kernel_launch: memset failed\n"); return; }
#if N_LAUNCHES == 1
    a.ph_lo = 0; a.ph_hi = 8; hipLaunchKernelGGL(mk_fwd, dim3(grid), dim3(NWAVES * 64), LDS_BYTES, stream, a);
#else
    for (int ph = 0; ph < 8; ++ph) { a.ph_lo = ph; a.ph_hi = ph + 1; hipLaunchKernelGGL(mk_fwd, dim3(grid), dim3(NWAVES * 64), LDS_BYTES, stream, a); }
#endif
}
```

```cpp
#include <hip/hip_runtime.h>
#include <cstdio>
#include <cstdint>
#include <cmath>
namespace pg8 {
#define PG8_LAS __attribute__((address_space(3)))
typedef unsigned short bf16_t;
typedef short bf16x8 __attribute__((ext_vector_type(8)));
typedef float f32x4 __attribute__((ext_vector_type(4)));
typedef unsigned u32x4 __attribute__((ext_vector_type(4)));
constexpr int BM = 256, BK = 64, HALF = 128, HTB = HALF * BK * 2  , STAGE_BYTES = 8 * HTB, NXCD = 8, WGM = 8;

__host__ __device__ __forceinline__ int lds_byte(int r, int c) { const int st = (r >> 4) * 2 + (c >> 5), rr = r & 15, cc = c & 31, ob = rr * 64 + cc * 2; return st * 1024 + (ob ^ (((ob >> 9) & 1) << 5)); }
__host__ __device__ __forceinline__ void stage_rc(int b, int& R, int& C) { const int st = b / 1024, sb = b % 1024, swz = sb ^ (((sb >> 9) & 1) << 5); R = (st >> 1) * 16 + swz / 64; C = (st & 1) * 32 + (swz % 64) / 2; }
__host__ __device__ __forceinline__ int perm32(int rho) { const int n = rho >> 4, i = rho & 15; return 8 * (i >> 2) + 4 * n + (i & 3); }

struct Unit { int pm, pn; };
struct Gemm { const bf16_t* A; const bf16_t* Bt; int M, N, K; };

struct StaticOrder {
    int nM, nN, nwg, G, c;
    __host__ __device__ void init(int M, int N, int G_, int c_) { nM = M / BM; nN = N / BM; nwg = nM * nN; G = G_; c = c_; }
    __host__ __device__ bool next(int i, Unit& u) const {
        const long L = (long)i * G + c; if (L >= nwg) return false;
        int wgid = (int)L; { const int q = nwg / NXCD, r = nwg % NXCD, xcd = wgid % NXCD, off = wgid / NXCD; wgid = (xcd < r ? xcd * (q + 1) : r * (q + 1) + (xcd - r) * q) + off; }
        const int nig = WGM * nN, gid = wgid / nig, fm = gid * WGM, gsz = (nM - fm) < WGM ? (nM - fm) : WGM;
        u.pm = fm + ((wgid % nig) % gsz); u.pn = (wgid % nig) / gsz; return true;
    }
    __device__ __forceinline__ void a_ready(const Unit&) const {}
    __device__ __forceinline__ void done(const Unit&) const {}
};
struct FlagOrder : StaticOrder {
    unsigned* rdy; unsigned need;
    __host__ __device__ bool next(int i, Unit& u) const { if (!StaticOrder::next(i, u)) return false; u.pm = (u.pm & ~15) | (15 - (u.pm & 15)); return true; }
    __device__ __forceinline__ void a_ready(const Unit& u) const {
        unsigned* p = rdy + u.pm; unsigned sp = 0;
        while ((unsigned)__builtin_amdgcn_readfirstlane(__hip_atomic_load(p, __ATOMIC_RELAXED, __HIP_MEMORY_SCOPE_AGENT)) < need) { __builtin_amdgcn_s_sleep(2); if (++sp > (1u << 21)) break; }
    }
};


__device__ __forceinline__ unsigned cvt_pk_bf16(float lo, float hi) { unsigned r; asm volatile("v_cvt_pk_bf16_f32 %0, %1, %2" : "=v"(r) : "v"(lo), "v"(hi)); return r; }
typedef float f32x2 __attribute__((ext_vector_type(2)));
constexpr float C2 = 0.125f * 1.4426950408889634f;
constexpr float RMS_EPS = 1e-6f;
constexpr size_t GS = (size_t)8 * 4 * 4096 * 64;
__device__ __forceinline__ void st_stream(void* p, u32x4 w) { __builtin_nontemporal_store(w, (u32x4*)p); }
struct EpiIn {
    static constexpr bool PERM = true, AFTER_DRAIN = false;
    bf16_t *Q, *K, *V, *G; const float *gfox, *gmoba, *gswa; float* KM; const float* RS; float* LF; const float* bfg;
    __device__ __forceinline__ void prefetch(const Unit& u, int ui_, PG8_LAS unsigned char* lds, int wid, int lane) const {
        if (wid < 4) { const float* src = RS + u.pm * BM + wid * 64 + lane; const unsigned dst = (unsigned)(size_t)(lds + STAGE_BYTES + (ui_ & 1) * 1024 + wid * 256); unsigned keep;
            asm volatile("s_mov_b32 %0, m0\n\ts_mov_b32 m0, %2\n\ts_nop 0\n\tglobal_load_lds_dword %1, off\n\ts_mov_b32 m0, %0" : "=&s"(keep) : "v"(src), "s"((unsigned)__builtin_amdgcn_readfirstlane(dst)) : "memory"); }
    }
    __device__ __forceinline__ void operator()(const f32x4 (&acc)[2][2][4][2], const Unit& u, int wr, int wc, int fr, int fq, int ui, PG8_LAS unsigned char* ldsb) const {
        const int T = u.pn;
        const int b = (u.pm * BM) >> 12, t0 = ((u.pm * BM) & 4095) + wr * 64 + fr;
        float rs[2][4];
#pragma unroll
        for (int ai = 0; ai < 2; ++ai)
#pragma unroll
            for (int m = 0; m < 4; ++m) rs[ai][m] = __builtin_amdgcn_rsqf(((const PG8_LAS float*)(ldsb + STAGE_BYTES + (ui & 1) * 1024))[ai * HALF + wr * 64 + m * 16 + fr] * (1.0f / 1024.0f) + RMS_EPS);
        if (T == 15) {
            if (wc == 0 && fq == 0) { const f32x4 bv = *(const f32x4*)bfg;
#pragma unroll
                for (int ai = 0; ai < 2; ++ai)
#pragma unroll
                    for (int m = 0; m < 4; ++m) { const f32x4 a4 = acc[ai][0][m][0] * rs[ai][m] + bv;
#pragma unroll
                        for (int j = 0; j < 4; ++j) { const float uu = a4[j]; const float sp = fmaxf(-uu, 0.f) + __logf(1.f + __expf(-fabsf(uu)));
                            LF[(size_t)(b * 4 + j) * 4096 + t0 + ai * HALF + m * 16] = -sp * 1.4426950408889634f; } } }
            return;
        }
        int mode = 1, nh = 4, head = wc; float scale = 1.f; const float* gain = nullptr; bf16_t* base = nullptr;
        switch (T) {
            case 0: mode = 0; gain = gfox; scale = C2; base = Q; break;
            case 1: mode = 0; gain = gfox + 64; base = K; break;
            case 2: base = V; break;
            case 4: mode = 0; gain = gmoba; scale = C2; base = Q + GS; break;
            case 5: mode = 0; gain = gmoba + 64; base = K + GS; break;
            case 6: base = V + GS; break;
            case 8: scale = C2; base = Q + 2 * GS; break;
            case 9: base = K + 2 * GS; break;
            case 10: base = V + 2 * GS; break;
            case 12: mode = 0; gain = gswa; scale = C2; base = Q + 3 * GS; break;
            case 13: nh = 2; if (wc < 2) { mode = 0; gain = gswa + 64; base = K + 3 * GS; } else { base = V + 3 * GS; head = wc - 2; } break;
            default: mode = 2; break;
        }
        if (mode == 2) {
            bf16_t* gp = G + ((size_t)((T >> 2) * 32 + b * 4 + wc)) * 262144 + (size_t)((t0 >> 4) * 2) * 512 + (t0 & 15) * 32 + 8 * fq;
#pragma unroll
            for (int ai = 0; ai < 2; ++ai)
#pragma unroll
                for (int m = 0; m < 4; ++m)
#pragma unroll
                    for (int bj = 0; bj < 2; ++bj) {
                        f32x4 v0 = acc[ai][bj][m][0] * rs[ai][m], v1 = acc[ai][bj][m][1] * rs[ai][m];
#pragma unroll
                        for (int j = 0; j < 4; ++j) { v0[j] = v0[j] * __builtin_amdgcn_rcpf(1.f + __expf(-v0[j])); v1[j] = v1[j] * __builtin_amdgcn_rcpf(1.f + __expf(-v1[j])); }
                        u32x4 w; w.x = cvt_pk_bf16(v0[0], v0[1]); w.y = cvt_pk_bf16(v0[2], v0[3]); w.z = cvt_pk_bf16(v1[0], v1[1]); w.w = cvt_pk_bf16(v1[2], v1[3]);
                        st_stream(gp + (size_t)((ai * 8 + m) * 2 + bj) * 512, w);
                    }
            return;
        }
        f32x4 gv[2][2];
#pragma unroll
        for (int bj = 0; bj < 2; ++bj)
#pragma unroll
            for (int n = 0; n < 2; ++n) gv[bj][n] = (mode == 0) ? *(const f32x4*)(gain + 32 * bj + 8 * fq + 4 * n) : (f32x4){1.f, 1.f, 1.f, 1.f};
        bf16_t* dp = base + (size_t)(b * nh + head) * 262144 + (size_t)((t0 >> 4) * 2) * 512 + (t0 & 15) * 32 + 8 * fq;
        f32x4 cs4[2][2];
#pragma unroll
        for (int bj = 0; bj < 2; ++bj)
#pragma unroll
            for (int n = 0; n < 2; ++n) cs4[bj][n] = (f32x4){0.f, 0.f, 0.f, 0.f};
#pragma unroll
        for (int ai = 0; ai < 2; ++ai)
#pragma unroll
            for (int m = 0; m < 4; ++m) {
                float r = scale * rs[ai][m];
                if (mode == 0) {
                    float ss = 0.f;
#pragma unroll
                    for (int bj = 0; bj < 2; ++bj)
#pragma unroll
                        for (int n = 0; n < 2; ++n) { const f32x4 x = acc[ai][bj][m][n]; ss += (x[0] * x[0] + x[1] * x[1]) + (x[2] * x[2] + x[3] * x[3]); }
                    ss += __shfl_xor(ss, 16); ss += __shfl_xor(ss, 32);
                    r = scale * rs[ai][m] * __builtin_amdgcn_rsqf(ss * rs[ai][m] * rs[ai][m] * (1.0f / 64.0f) + RMS_EPS);
                }
#pragma unroll
                for (int bj = 0; bj < 2; ++bj) {
                    const f32x4 v0 = acc[ai][bj][m][0] * gv[bj][0] * r, v1 = acc[ai][bj][m][1] * gv[bj][1] * r;
                    if (T == 5) { cs4[bj][0] += v0; cs4[bj][1] += v1; }
                    u32x4 w; w.x = cvt_pk_bf16(v0[0], v0[1]); w.y = cvt_pk_bf16(v0[2], v0[3]); w.z = cvt_pk_bf16(v1[0], v1[1]); w.w = cvt_pk_bf16(v1[2], v1[3]);
                    st_stream(dp + (size_t)((ai * 8 + m) * 2 + bj) * 512, w);
                }
            }
        if (T == 5) {
            float* kmp = KM + ((size_t)((b * 4 + wc) * 16 + (((u.pm * BM) & 4095) >> 8))) * 64 + 8 * fq;
#pragma unroll
            for (int bj = 0; bj < 2; ++bj)
#pragma unroll
                for (int n = 0; n < 2; ++n)
#pragma unroll
                    for (int j = 0; j < 4; ++j) { float s = cs4[bj][n][j];
                        s += __shfl_xor(s, 1); s += __shfl_xor(s, 2); s += __shfl_xor(s, 4); s += __shfl_xor(s, 8);
                        if (fr == 0) atomicAdd(kmp + 32 * bj + 4 * n + j, s * (1.0f / 256.0f)); }
        }
    }
};
struct EpiRes0 {
    static constexpr bool PERM = true, AFTER_DRAIN = false;
    const bf16_t* base; bf16_t* X1; float* RS1;
    __device__ __forceinline__ void prefetch(const Unit&, int, PG8_LAS unsigned char*, int, int) const {}
    __device__ __forceinline__ void operator()(const f32x4 (&acc)[2][2][4][2], const Unit& u, int wr, int wc, int fr, int fq, int ui, PG8_LAS unsigned char* ldsb) const {
        const int col0 = u.pn * BM + wc * 32 + 8 * fq;
        u32x4 xr[2][4][2];
#pragma unroll
        for (int ai = 0; ai < 2; ++ai)
#pragma unroll
            for (int m = 0; m < 4; ++m)
#pragma unroll
                for (int bj = 0; bj < 2; ++bj) xr[ai][m][bj] = *(const u32x4*)(base + (size_t)(u.pm * BM + ai * HALF + wr * 64 + m * 16 + fr) * 1024 + col0 + bj * HALF);
#pragma unroll
        for (int ai = 0; ai < 2; ++ai)
#pragma unroll
            for (int m = 0; m < 4; ++m) {
                const int row = u.pm * BM + ai * HALF + wr * 64 + m * 16 + fr; const size_t off = (size_t)row * 1024 + col0; float ss = 0.f;
#pragma unroll
                for (int bj = 0; bj < 2; ++bj) { const u32x4 xb = xr[ai][m][bj];
                    f32x4 v0, v1; v0[0] = __uint_as_float(xb.x << 16); v0[1] = __uint_as_float(xb.x & 0xffff0000u); v0[2] = __uint_as_float(xb.y << 16); v0[3] = __uint_as_float(xb.y & 0xffff0000u);
                    v1[0] = __uint_as_float(xb.z << 16); v1[1] = __uint_as_float(xb.z & 0xffff0000u); v1[2] = __uint_as_float(xb.w << 16); v1[3] = __uint_as_float(xb.w & 0xffff0000u);
                    v0 += acc[ai][bj][m][0]; v1 += acc[ai][bj][m][1];
                    ss += (v0[0] * v0[0] + v0[1] * v0[1]) + (v0[2] * v0[2] + v0[3] * v0[3]) + (v1[0] * v1[0] + v1[1] * v1[1]) + (v1[2] * v1[2] + v1[3] * v1[3]);
                    u32x4 w; w.x = cvt_pk_bf16(v0[0], v0[1]); w.y = cvt_pk_bf16(v0[2], v0[3]); w.z = cvt_pk_bf16(v1[0], v1[1]); w.w = cvt_pk_bf16(v1[2], v1[3]);
                    *(u32x4*)(X1 + off + bj * HALF) = w; }
                ss += __shfl_xor(ss, 16); ss += __shfl_xor(ss, 32);
                if (fq == 0) atomicAdd(RS1 + row, ss);
            }
    }
};
struct EpiRes1 {
    static constexpr bool PERM = true, AFTER_DRAIN = false;
    const bf16_t* X1; float* out;

    __device__ __forceinline__ void prefetch(const Unit&, int, PG8_LAS unsigned char*, int, int) const {}
    __device__ __forceinline__ void operator()(const f32x4 (&acc)[2][2][4][2], const Unit& u, int wr, int wc, int fr, int fq, int ui, PG8_LAS unsigned char* ldsb) const {
        const int col0 = u.pn * BM + wc * 32 + 8 * fq;
        u32x4 xr[2][4][2];
#pragma unroll
        for (int ai = 0; ai < 2; ++ai)
#pragma unroll
            for (int m = 0; m < 4; ++m)
#pragma unroll
                for (int bj = 0; bj < 2; ++bj) xr[ai][m][bj] = *(const u32x4*)(X1 + (size_t)(u.pm * BM + ai * HALF + wr * 64 + m * 16 + fr) * 1024 + col0 + bj * HALF);
#pragma unroll
        for (int ai = 0; ai < 2; ++ai)
#pragma unroll
            for (int m = 0; m < 4; ++m) {
                const size_t off = (size_t)(u.pm * BM + ai * HALF + wr * 64 + m * 16 + fr) * 1024 + col0;
#pragma unroll
                for (int bj = 0; bj < 2; ++bj) { const u32x4 xb = xr[ai][m][bj];
                    f32x4 v0, v1; v0[0] = __uint_as_float(xb.x << 16); v0[1] = __uint_as_float(xb.x & 0xffff0000u); v0[2] = __uint_as_float(xb.y << 16); v0[3] = __uint_as_float(xb.y & 0xffff0000u);
                    v1[0] = __uint_as_float(xb.z << 16); v1[1] = __uint_as_float(xb.z & 0xffff0000u); v1[2] = __uint_as_float(xb.w << 16); v1[3] = __uint_as_float(xb.w & 0xffff0000u);
                    *(f32x4*)(out + off + bj * HALF) = v0 + acc[ai][bj][m][0]; *(f32x4*)(out + off + bj * HALF + 4) = v1 + acc[ai][bj][m][1]; }
            }
    }
};

template <class Epi, class Sched, bool ALIGN_EPI = false, bool SP2 = false>
__device__ __forceinline__ void gemm_phase(PG8_LAS unsigned char* lds, const Gemm g, const Sched& S, const Epi& E) {
    const int tid = threadIdx.x, wid = __builtin_amdgcn_readfirstlane(tid >> 6), lane = tid & 63, wr = wid >> 2, wc = wid & 3, fr = lane & 15, fq = lane >> 4;
    const int K = g.K, nt = K / BK;
    unsigned voffA[2], voffB[2];
#pragma unroll
    for (int i = 0; i < 2; ++i) { int R, C; stage_rc(tid * 16 + i * 8192, R, C); const int Rb = Epi::PERM ? ((R & ~31) + perm32(R & 31)) : R;
        voffA[i] = (unsigned)(R * K + C) * 2u; voffB[i] = (unsigned)(Rb * K + C) * 2u; }
    const size_t kstep = (size_t)(BK * 2);
    const size_t hstep = (size_t)HALF * K * 2;
    const size_t tstep = 2 * hstep;
    const unsigned ldsw = (unsigned)wid * 1024u;
    const int aoff = lds_byte(wr * 64 + fr, fq * 8), boff = lds_byte(wc * 32 + fr, fq * 8);
#define PG8_SA(b, h) (((b) * 2 + (h)) * HTB)
#define PG8_SB(b, h) ((4 + (b) * 2 + (h)) * HTB)
#define PG8_STAGE(bufoff, gbase, voff) do { _Pragma("unroll") for (int _i = 0; _i < 2; ++_i) \
        __builtin_amdgcn_global_load_lds((const unsigned*)((const char*)(gbase) + (voff)[_i]), (PG8_LAS unsigned*)(lds + (bufoff) + ldsw + _i * 8192), 16, 0, 0); } while (0)
#define PG8_LDA(dst, b, h) do { _Pragma("unroll") for (int m = 0; m < 4; ++m) _Pragma("unroll") for (int k = 0; k < 2; ++k) dst[m][k] = *(const PG8_LAS bf16x8*)(lds + PG8_SA(b, h) + aoff + m * 2048 + k * 1024); } while (0)
#define PG8_LDB(dst, b, h) do { _Pragma("unroll") for (int n = 0; n < 2; ++n) _Pragma("unroll") for (int k = 0; k < 2; ++k) dst[n][k] = *(const PG8_LAS bf16x8*)(lds + PG8_SB(b, h) + boff + n * 2048 + k * 1024); } while (0)
#define PG8_MMA(ai, bj, At, Bt) do { __builtin_amdgcn_s_setprio(1); _Pragma("unroll") for (int m = 0; m < 4; ++m) _Pragma("unroll") for (int n = 0; n < 2; ++n) _Pragma("unroll") for (int k = 0; k < 2; ++k) \
        acc[ai][bj][m][n] = __builtin_amdgcn_mfma_f32_16x16x32_bf16(Bt[n][k], At[m][k], acc[ai][bj][m][n], 0, 0, 0); __builtin_amdgcn_s_setprio(0); } while (0)
#define PG8_WAIT_V(n) asm volatile("s_waitcnt vmcnt(" #n ")" ::: "memory")
#define PG8_WAIT_L(n) asm volatile("s_waitcnt lgkmcnt(" #n ")" ::: "memory")
#define PG8_BAR __builtin_amdgcn_s_barrier()
#define PG8_SCHED __builtin_amdgcn_sched_barrier(0)
    Unit cur, nxt; int ui = 0;
    if (!S.next(0, cur)) return;
    f32x4 acc[2][2][4][2];
#pragma unroll
    for (int a = 0; a < 2; ++a)
#pragma unroll
        for (int b = 0; b < 2; ++b)
#pragma unroll
            for (int m = 0; m < 4; ++m)
#pragma unroll
                for (int n = 0; n < 2; ++n) acc[a][b][m][n] = (f32x4){0.f, 0.f, 0.f, 0.f};
    bf16x8 At[4][2], B0[2][2], B1[2][2];
    const char* cA = (const char*)g.A + (size_t)cur.pm * tstep; const char* cB = (const char*)g.Bt + (size_t)cur.pn * tstep;
    S.a_ready(cur); E.prefetch(cur, 0, lds, wid, lane);
    if constexpr (SP2) {
        PG8_STAGE(PG8_SB(0, 0), cB, voffB); PG8_STAGE(PG8_SB(0, 1), cB + hstep, voffB); PG8_STAGE(PG8_SA(0, 0), cA, voffA); PG8_STAGE(PG8_SA(0, 1), cA + hstep, voffA);
        if (wr == 1) PG8_BAR;
        PG8_WAIT_V(2); PG8_BAR;
        PG8_STAGE(PG8_SB(1, 0), cB + kstep, voffB); PG8_STAGE(PG8_SA(1, 0), cA + kstep, voffA); PG8_STAGE(PG8_SB(1, 1), cB + hstep + kstep, voffB);
        PG8_WAIT_V(6); PG8_BAR;
    } else {
        PG8_STAGE(PG8_SB(0, 0), cB, voffB); PG8_STAGE(PG8_SA(0, 0), cA, voffA); PG8_STAGE(PG8_SB(0, 1), cB + hstep, voffB); PG8_STAGE(PG8_SA(0, 1), cA + hstep, voffA);
        if (wr == 1) PG8_BAR;
        PG8_WAIT_V(4); PG8_BAR;
        PG8_STAGE(PG8_SB(1, 0), cB + kstep, voffB); PG8_STAGE(PG8_SA(1, 0), cA + kstep, voffA); PG8_STAGE(PG8_SB(1, 1), cB + hstep + kstep, voffB);
        PG8_WAIT_V(6); PG8_BAR;
    }
    for (;;) {
        const bool has_next = S.next(ui + 1, nxt);
        const char* nA = has_next ? (const char*)g.A + (size_t)nxt.pm * tstep : cA; const char* nB = has_next ? (const char*)g.Bt + (size_t)nxt.pn * tstep : cB;
        for (int t = 0; t < nt; t += 2) {
            const bool last = (t == nt - 2);
            const char* a1 = cA + (size_t)(t + 1) * kstep;
            const char* a2 = last ? nA : cA + (size_t)(t + 2) * kstep; const char* b2 = last ? nB : cB + (size_t)(t + 2) * kstep;
            const char* a3 = a2 + kstep; const char* b3 = b2 + kstep;
            if (last && has_next) S.a_ready(nxt);
            if constexpr (SP2) {
            PG8_LDB(B0, 0, 0); PG8_LDB(B1, 0, 1); PG8_SCHED; PG8_LDA(At, 0, 0); PG8_STAGE(PG8_SA(1, 1), a1 + hstep, voffA);
            PG8_WAIT_V(8); PG8_WAIT_L(0); PG8_BAR; PG8_MMA(0, 0, At, B0); PG8_MMA(0, 1, At, B1); PG8_BAR; PG8_SCHED;
            PG8_LDA(At, 0, 1); PG8_STAGE(PG8_SB(0, 0), b2, voffB); PG8_STAGE(PG8_SB(0, 1), b2 + hstep, voffB); PG8_STAGE(PG8_SA(0, 0), a2, voffA);
            PG8_WAIT_V(8); PG8_WAIT_L(0); PG8_BAR; PG8_MMA(1, 0, At, B0); PG8_MMA(1, 1, At, B1); PG8_BAR; PG8_SCHED;
            PG8_LDB(B0, 1, 0); PG8_LDB(B1, 1, 1); PG8_SCHED; PG8_LDA(At, 1, 0); PG8_STAGE(PG8_SA(0, 1), a2 + hstep, voffA);
            PG8_WAIT_V(8); PG8_WAIT_L(0); PG8_BAR; PG8_MMA(0, 0, At, B0); PG8_MMA(0, 1, At, B1); PG8_BAR; PG8_SCHED;
            PG8_LDA(At, 1, 1); PG8_STAGE(PG8_SB(1, 0), b3, voffB); PG8_STAGE(PG8_SB(1, 1), b3 + hstep, voffB); PG8_STAGE(PG8_SA(1, 0), a3, voffA);
            PG8_WAIT_V(8); PG8_WAIT_L(0); PG8_BAR; PG8_MMA(1, 0, At, B0); PG8_MMA(1, 1, At, B1); PG8_BAR; PG8_SCHED;
            } else {
            PG8_LDB(B0, 0, 0); PG8_SCHED; PG8_LDA(At, 0, 0); PG8_STAGE(PG8_SA(1, 1), a1 + hstep, voffA);
            PG8_WAIT_L(8); PG8_BAR; PG8_WAIT_L(0); PG8_MMA(0, 0, At, B0); PG8_BAR; PG8_SCHED;
            PG8_LDB(B1, 0, 1); PG8_STAGE(PG8_SB(0, 0), b2, voffB);
            PG8_BAR; PG8_WAIT_L(0); PG8_MMA(0, 1, At, B1); PG8_BAR;
            PG8_LDA(At, 0, 1); PG8_STAGE(PG8_SA(0, 0), a2, voffA);
            PG8_BAR; PG8_WAIT_L(0); PG8_MMA(1, 0, At, B0); PG8_BAR; PG8_SCHED;
            PG8_STAGE(PG8_SB(0, 1), b2 + hstep, voffB);
            PG8_WAIT_V(6); PG8_BAR; PG8_MMA(1, 1, At, B1); PG8_BAR;
            PG8_LDB(B0, 1, 0); PG8_SCHED; PG8_LDA(At, 1, 0); PG8_STAGE(PG8_SA(0, 1), a2 + hstep, voffA);
            PG8_WAIT_L(8); PG8_BAR; PG8_WAIT_L(0); PG8_MMA(0, 0, At, B0); PG8_BAR; PG8_SCHED;
            PG8_LDB(B1, 1, 1); PG8_STAGE(PG8_SB(1, 0), b3, voffB);
            PG8_BAR; PG8_WAIT_L(0); PG8_MMA(0, 1, At, B1); PG8_BAR;
            PG8_LDA(At, 1, 1); PG8_STAGE(PG8_SA(1, 0), a3, voffA);
            PG8_BAR; PG8_WAIT_L(0); PG8_MMA(1, 0, At, B0); PG8_BAR; PG8_SCHED;
            PG8_STAGE(PG8_SB(1, 1), b3 + hstep, voffB);
            PG8_WAIT_V(6); PG8_BAR; PG8_MMA(1, 1, At, B1); PG8_BAR;
            }
        }
        if constexpr (ALIGN_EPI) { if (wr == 0) PG8_BAR; }
        if constexpr (!Epi::AFTER_DRAIN) { E(acc, cur, wr, wc, fr, fq, ui, lds); S.done(cur); if (has_next) E.prefetch(nxt, ui + 1, lds, wid, lane); }
        if (!has_next) break;
#pragma unroll
        for (int a = 0; a < 2; ++a)
#pragma unroll
            for (int b = 0; b < 2; ++b)
#pragma unroll
                for (int m = 0; m < 4; ++m)
#pragma unroll
                    for (int n = 0; n < 2; ++n) acc[a][b][m][n] = (f32x4){0.f, 0.f, 0.f, 0.f};
        cur = nxt; cA = nA; cB = nB; ++ui;
        if constexpr (ALIGN_EPI) { if (wr == 1) PG8_BAR; }
    }
    PG8_WAIT_V(0);
    if constexpr (!ALIGN_EPI) { if (wr == 0) PG8_BAR; }
    PG8_BAR;
    if constexpr (Epi::AFTER_DRAIN) { E.fused(acc, cur, wr, wc, fr, fq, lds, wid, lane); S.done(cur); }
#undef PG8_SA
#undef PG8_SB
#undef PG8_STAGE
#undef PG8_LDA
#undef PG8_LDB
#undef PG8_MMA
#undef PG8_WAIT_V
#undef PG8_WAIT_L
#undef PG8_BAR
#undef PG8_SCHED
}
}
constexpr int NB = 8, SEQ = 4096, DM = 1024, NTOK = NB * SEQ, INW = 3844, NPERM = 4096, NLAYER = 2;
constexpr size_t MiB = 1u << 20;
constexpr size_t WS_CTL = 0, CTL_ZERO_BYTES = 1 * MiB;
constexpr size_t WS_WIN = 2 * MiB;
constexpr size_t WS_WOUT = 18 * MiB;
constexpr size_t WS_LF = 22 * MiB;
constexpr size_t WS_RS = 26 * MiB;
constexpr size_t WS_TAB = 23 * MiB;
constexpr size_t WS_KM = 24 * MiB;
constexpr size_t WS_MF = 25 * MiB;
constexpr int CW_BAR = 4096;
constexpr int CW_RDY = 1024;
constexpr int CW_QUEUE = 64;
constexpr size_t WS_HN = 32 * MiB;
constexpr size_t WS_Q = 96 * MiB, WS_K = 160 * MiB, WS_V = 216 * MiB, WS_G = 272 * MiB, WS_X1 = 336 * MiB  , WS_X0 = 400 * MiB  , WS_END = 464 * MiB;
constexpr float LOG2E = 1.4426950408889634f;
constexpr int NWAVES = 8;
#define TIMER_SEL -1
#define TIMER_FS 100
#define TIMER_WG 37
#define TIMER_TYPE 1
#define PROBE_ATT 0
#define PROBE_REPS 2
#define PROBE_P1 0
#define PROBE_P3 0
#define PROBE_P0 0
#ifndef N_LAUNCHES
#define N_LAUNCHES 1
#endif
constexpr int RING_BYTES = 131072, LDSCTL_OFF = 139264, MISC_OFF = LDSCTL_OFF + 320, LDS_BYTES = 147456;

#define GAS __attribute__((address_space(1)))
#define LAS __attribute__((address_space(3)))
typedef unsigned short bf16;
typedef unsigned v4u __attribute__((ext_vector_type(4)));
typedef float f32x4 __attribute__((ext_vector_type(4)));
__device__ __forceinline__ unsigned f2bf(float f) { unsigned u = __builtin_bit_cast(unsigned, f); return (u + 0x7fffu + ((u >> 16) & 1u)) >> 16; }
typedef float f32x2h_t __attribute__((ext_vector_type(2))); typedef __bf16 bf16x2h_t __attribute__((ext_vector_type(2)));
__device__ __forceinline__ unsigned pk2(float lo, float hi) { f32x2h_t v = {lo, hi}; bf16x2h_t b = __builtin_convertvector(v, bf16x2h_t); return __builtin_bit_cast(unsigned, b); }
__device__ __forceinline__ float bf2f(unsigned v) { return __uint_as_float(v << 16); }
__device__ __forceinline__ float wave_sum(float v) {
#pragma unroll
    for (int o = 1; o < 64; o <<= 1) v += __shfl_xor(v, o);
    return v;
}
#define RLX_AGENT __ATOMIC_RELAXED, __HIP_MEMORY_SCOPE_AGENT
#define XB_TMO      128
#define XB_XCNT(j)  (256  + 64 * (j))
#define XB_XSUB(j)  (1280 + 64 * (j))
#define XB_XGEN(j)  (2304 + 64 * (j))
#define XB_TOP      3328
#define XB_TOPGEN   3392
#define XCD_BAR_WORDS 3456
#define XB_SPIN_CAP (1u << 18)

__device__ __forceinline__ unsigned xb_ld(unsigned* p)              { return __hip_atomic_load(p, __ATOMIC_RELAXED, __HIP_MEMORY_SCOPE_AGENT); }
__device__ __forceinline__ unsigned xb_add(unsigned* p, unsigned v) { return __hip_atomic_fetch_add(p, v, __ATOMIC_RELAXED, __HIP_MEMORY_SCOPE_AGENT); }
__device__ __forceinline__ unsigned xb_xcc_id() { return (unsigned)__builtin_amdgcn_s_getreg((3 << 11) | 20) & 0xFu; }
#define XB_SPIN(cond, bar) do { unsigned _sp = 0; while (cond) { __builtin_amdgcn_s_sleep(1); \
    if ((++_sp & 255u) == 0u) { if (xb_ld(&(bar)[XB_TMO])) break; if (_sp > XB_SPIN_CAP) { atomicAdd(&(bar)[XB_TMO], 1u); break; } } } } while (0)

struct XcdBarrier {
    unsigned* bar; unsigned x;
    volatile LAS unsigned* st;
};

__device__ __forceinline__ XcdBarrier xcd_barrier_post(unsigned* bar, volatile LAS unsigned* st) {
    XcdBarrier b; b.bar = bar; b.x = xb_xcc_id(); b.st = st;
    if (threadIdx.x == 0) (void)xb_add(&bar[XB_XCNT(b.x)], 1u);
    return b;
}
__device__ __forceinline__ void xcd_barrier_complete(unsigned* bar, unsigned x, unsigned& nloc, unsigned& nx) {
    const unsigned G = gridDim.x * gridDim.y * gridDim.z;
    unsigned sum, cnt, mine, sp = 0u;
    for (;;) {
        sum = 0u; cnt = 0u; mine = 0u;
#pragma unroll
        for (unsigned j = 0; j < 16; ++j) { const unsigned c = xb_ld(&bar[XB_XCNT(j)]); sum += c; cnt += (c > 0u) ? 1u : 0u; mine = (j == x) ? c : mine; }
        if (sum == G) break;
        __builtin_amdgcn_s_sleep(1);
        if ((++sp & 255u) == 0u) { if (xb_ld(&bar[XB_TMO])) break; if (sp > XB_SPIN_CAP) { atomicAdd(&bar[XB_TMO], 1u); break; } }
    }
    nloc = mine > 0u ? mine : 1u; nx = cnt > 0u ? cnt : 1u;
}

__device__ __forceinline__ void xcd_barrier(const XcdBarrier& b) {
    asm volatile("s_waitcnt vmcnt(0)" ::: "memory");
    __syncthreads();
    if (threadIdx.x == 0) {
        unsigned* bar = b.bar;
        __builtin_amdgcn_s_waitcnt(0);
        unsigned nloc = b.st[0], nx = b.st[1];
        if (nloc == 0u) { xcd_barrier_complete(bar, b.x, nloc, nx); b.st[0] = nloc; b.st[1] = nx; }
        const unsigned old = xb_add(&bar[XB_XSUB(b.x)], 1u);
        const unsigned gen = old / nloc;
        if (old + 1u == (gen + 1u) * nloc) {
            __builtin_amdgcn_fence(__ATOMIC_RELEASE, "agent");
            asm volatile("s_waitcnt vmcnt(0)" ::: "memory");
            const unsigned og = xb_add(&bar[XB_TOP], 1u);
            const unsigned tg = og / nx;
            if (og + 1u == (tg + 1u) * nx) xb_add(&bar[XB_TOPGEN], 1u);
            else XB_SPIN(xb_ld(&bar[XB_TOPGEN]) == tg, bar);
            __builtin_amdgcn_fence(__ATOMIC_ACQUIRE, "agent");
            xb_add(&bar[XB_XGEN(b.x)], 1u);
            asm volatile("s_waitcnt vmcnt(0)" ::: "memory");
        } else {
            XB_SPIN(xb_ld(&bar[XB_XGEN(b.x)]) == gen, bar);
            __builtin_amdgcn_fence(__ATOMIC_ACQUIRE, "agent");
            asm volatile("s_waitcnt vmcnt(0)" ::: "memory");
        }
    }
    __syncthreads();
}

__device__ __forceinline__ int rel_bucket(int d) {
    if (d < 16) return d;
    int b = 16;
    b += (d >= 21); b += (d >= 27); b += (d >= 35); b += (d >= 46); b += (d >= 59); b += (d >= 77); b += (d >= 99); b += (d >= 128);
    b += (d >= 166); b += (d >= 216); b += (d >= 280); b += (d >= 363); b += (d >= 470); b += (d >= 609); b += (d >= 790);
    return b;
}

struct Args { const float* x; const float* norm_gain; const float* w_in; const float* b_forget; const float* fox_g; const float* moba_g; const float* swa_g; const float* sinks; const float* w_out; const float* rel_bias; float* out; unsigned char* ws; int ph_lo, ph_hi, tmask, pad; };

struct Frame { LAS unsigned char* lds; int tid, lane, wave, vcu, G; };

__device__ __forceinline__ void transpose_item(const float* W, int ldw, bf16* WT, int dst_row0, int src_col0, int ncol, const float* gk, LAS float* scr, int kb, int lane) {
    const int k0 = 64 * kb;
    { float wv[32]; const int c = lane & 31;
#pragma unroll
        for (int i = 0; i < 32; ++i) { const int kk = 2 * i + (lane >> 5); wv[i] = (c < ncol) ? W[(size_t)(k0 + kk) * ldw + src_col0 + c] : 0.f; }
        if (gk) {
#pragma unroll
            for (int i = 0; i < 32; ++i) wv[i] *= gk[k0 + 2 * i + (lane >> 5)]; }
#pragma unroll
        for (int i = 0; i < 32; ++i) scr[(2 * i + (lane >> 5)) * 33 + c] = wv[i]; }
    asm volatile("s_waitcnt lgkmcnt(0)" ::: "memory");
    const int c = lane & 7;
#pragma unroll
    for (int j = 0; j < 4; ++j) { const int n = (lane >> 3) + 8 * j; const LAS float* s = scr + (8 * c) * 33 + n;
        v4u o; o.x = pk2(s[0 * 33], s[1 * 33]); o.y = pk2(s[2 * 33], s[3 * 33]); o.z = pk2(s[4 * 33], s[5 * 33]); o.w = pk2(s[6 * 33], s[7 * 33]);
        *(v4u*)(WT + (size_t)(dst_row0 + n) * 1024 + k0 + 8 * c) = o; }
    asm volatile("s_waitcnt lgkmcnt(0)" ::: "memory");
}
__device__ __forceinline__ int tile_src(int T, int wc) {
    switch (T) { case 0: return 0 + 64 * wc; case 1: return 256 + 64 * wc; case 2: return 512 + 64 * wc; case 3: return 772 + 64 * wc;
        case 4: return 1028 + 64 * wc; case 5: return 1284 + 64 * wc; case 6: return 1540 + 64 * wc; case 7: return 1796 + 64 * wc;
        case 8: return 2052 + 64 * wc; case 9: return 2308 + 64 * wc; case 10: return 2564 + 64 * wc; case 11: return 2820 + 64 * wc;
        case 12: return 3076 + 64 * wc; case 13: return wc < 2 ? 3332 + 64 * wc : 3460 + 64 * (wc - 2); default: return 3588 + 64 * wc; }
}
__device__ __forceinline__ void p_weights(Frame& F, const Args& a) {
    LAS float* scr = (LAS float*)(F.lds + F.wave * 16384);
    const int gw = F.vcu * 2 + (F.wave - 6), NGW = F.G * 2;
    bf16* win = (bf16*)(a.ws + WS_WIN); bf16* wout = (bf16*)(a.ws + WS_WOUT);
    constexpr int I_IN = 128 * 16, I_OUT = 32 * 16;
    for (int it = gw; it < 2 * (I_IN + I_OUT); it += NGW) {
        const int layer = it / (I_IN + I_OUT); int r = it % (I_IN + I_OUT);
        if (r < I_IN) { const int kb = r >> 7, g = r & 127, T = g >> 3, gg = g & 7, bj = gg >> 2, wc = gg & 3;
            const int src = (T < 15) ? tile_src(T, wc) + 32 * bj : 768, ncol = (T < 15) ? 32 : (gg == 0 ? 4 : 0);
            transpose_item(a.w_in + (size_t)layer * DM * INW, INW, win + (size_t)layer * NPERM * DM, 32 * g, src, ncol, a.norm_gain + layer * DM, scr, kb, F.lane); }
        else { r -= I_IN; const int kb = r / 32, g = r % 32;
            transpose_item(a.w_out + (size_t)layer * DM * DM, DM, wout + (size_t)layer * DM * DM, 32 * g, 32 * g, 32, nullptr, scr, kb, F.lane); }
    }
}
__device__ __forceinline__ void p_tables(Frame& F, const Args& a) {
    if (F.vcu == 0) { float* tab = (float*)(a.ws + WS_TAB);
        for (int i = F.tid; i < 8 * 1024; i += NWAVES * 64) { const int hc = i >> 10, d = i & 1023; tab[i] = a.rel_bias[rel_bucket(d) * 8 + hc] * LOG2E; } }
}
__device__ __forceinline__ void p_consts(Frame& F, const Args& a) {
    if (F.vcu == 0 && F.wave == 0) for (int layer = 0; layer < NLAYER; ++layer) {
        const int lane = F.lane; float* MF = (float*)(a.ws + WS_MF) + layer * 4;
        float bm = 0.f;
#pragma unroll
        for (int j = 0; j < 4; ++j) bm = fmaxf(bm, fabsf(a.rel_bias[64 * j + lane]));
#pragma unroll
        for (int o = 1; o < 64; o <<= 1) bm = fmaxf(bm, __shfl_xor(bm, o));
        const float* gp[3] = {a.fox_g + layer * 128, a.moba_g + layer * 128, a.swa_g + layer * 128};
#pragma unroll
        for (int k = 0; k < 3; ++k) { float mq = fabsf(gp[k][lane]), mk = fabsf(gp[k][64 + lane]);
#pragma unroll
            for (int o = 1; o < 64; o <<= 1) { mq = fmaxf(mq, __shfl_xor(mq, o)); mk = fmaxf(mk, __shfl_xor(mk, o)); }
            const float m = 8.f * LOG2E * mq * mk * 1.02f + 0.1f + (k == 0 ? 0.f : bm * LOG2E);
            if (lane == 0) MF[k == 0 ? 0 : (k == 1 ? 1 : 3)] = m; }
        if (lane == 0) MF[2] = 0.f;
    }
}
__device__ __forceinline__ void p_convert(Frame& F, const Args& a) {
    const int lane = F.lane, gt = F.vcu * 384 + F.tid, NT_ = F.G * 384;
    { float* KM = (float*)(a.ws + WS_KM); for (int i = gt; i < 2 * 32 * 16 * 64; i += NT_) KM[i] = 0.f;
      float* RS1 = (float*)(a.ws + WS_RS) + NTOK; for (int i = gt; i < NTOK; i += NT_) RS1[i] = 0.f; }
    bf16* XB = (bf16*)(a.ws + WS_X0); float* RS0 = (float*)(a.ws + WS_RS);
    const int gwv = F.vcu * 6 + F.wave, NGW = F.G * 6;
    for (int r0 = 4 * gwv; r0 < NTOK; r0 += 4 * NGW) {
        f32x4 v[4][4];
#pragma unroll
        for (int rr = 0; rr < 4; ++rr) { const f32x4* xr = (const f32x4*)(a.x + (size_t)(r0 + rr) * DM) + lane;
#pragma unroll
            for (int j = 0; j < 4; ++j) v[rr][j] = __builtin_nontemporal_load(xr + 64 * j); }
        float ss[4];
#pragma unroll
        for (int rr = 0; rr < 4; ++rr) { ss[rr] = 0.f; unsigned long long* o8 = (unsigned long long*)(XB + (size_t)(r0 + rr) * DM) + lane;
#pragma unroll
            for (int j = 0; j < 4; ++j) { const f32x4 y = v[rr][j]; ss[rr] += (y[0] * y[0] + y[1] * y[1]) + (y[2] * y[2] + y[3] * y[3]);
                __builtin_nontemporal_store((unsigned long long)pk2(y[0], y[1]) | ((unsigned long long)pk2(y[2], y[3]) << 32), o8 + 64 * j); } }
#pragma unroll
        for (int o = 1; o < 64; o <<= 1)
#pragma unroll
            for (int rr = 0; rr < 4; ++rr) ss[rr] += __shfl_xor(ss[rr], o);
        if (lane < 4) RS0[r0 + lane] = lane == 0 ? ss[0] : (lane == 1 ? ss[1] : (lane == 2 ? ss[2] : ss[3]));
    }
}
namespace att {
using bf16x8 = __attribute__((ext_vector_type(8))) short;
using s16x4 = __attribute__((ext_vector_type(4))) short;
using f32x16 = __attribute__((ext_vector_type(16))) float;
using u32x4 = __attribute__((ext_vector_type(4))) unsigned;
typedef __attribute__((address_space(3))) const char* lds_cptr;
typedef __attribute__((address_space(3))) char* lds_ptr;
typedef short v4i16_t __attribute__((ext_vector_type(4)));
typedef float f32x2_t __attribute__((ext_vector_type(2))); typedef __bf16 bf16x2_t __attribute__((ext_vector_type(2)));
constexpr int NSLOT = 5, PFD = 2, SLOTB = 8192;
constexpr int L_K = 0, L_V = NSLOT * SLOTB, L_OST = 0  , L_WS = 2 * NSLOT * SLOTB, L_CS = L_WS + 8 * 256, L_TAB = L_CS + 16384, L_G = L_TAB + 4608, L_MISC = L_G + 8 * 4096, L_END = L_MISC + 1024;
static_assert(L_END <= 139264 && 8 * 4096 <= NSLOT * SLOTB, "attention LDS map (the kernel's control words start at 136 KiB)");
constexpr float THR2 = 44.f;
#define SBAR() __builtin_amdgcn_sched_barrier(0)
__device__ __forceinline__ int crow(int r, int hi) { return (r & 3) + 8 * (r >> 2) + 4 * hi; }
__device__ __forceinline__ void glds16(const void* gsrc, unsigned lds_dst) { unsigned keep;
    asm volatile("s_mov_b32 %0, m0\n\ts_mov_b32 m0, %2\n\ts_nop 0\n\tglobal_load_lds_dwordx4 %1, off\n\ts_mov_b32 m0, %0" : "=&s"(keep) : "v"(gsrc), "s"(lds_dst) : "memory"); }
__device__ __forceinline__ unsigned cvtpk_s(float lo, float hi) { f32x2_t v = {lo, hi}; bf16x2_t b = __builtin_convertvector(v, bf16x2_t); return __builtin_bit_cast(unsigned, b); }
__device__ __forceinline__ s16x4 vtr(lds_cptr p) { return __builtin_bit_cast(s16x4, __builtin_amdgcn_ds_read_tr16_b64_v4i16((__attribute__((address_space(3))) v4i16_t*)p)); }
#define MFMA32(a, b, c) __builtin_amdgcn_mfma_f32_32x32x16_bf16(a, b, c, 0, 0, 0)
__device__ __forceinline__ void qkt(f32x16& p0, f32x16& p1, lds_cptr kp, const bf16x8* qr, float cinit) {
    f32x16 c;
#pragma unroll
    for (int r = 0; r < 16; ++r) c[r] = cinit;
    p0 = c; p1 = c;
#pragma unroll
    for (int d0 = 0; d0 < 4; ++d0) {
        const bf16x8 b0 = *(const __attribute__((address_space(3))) bf16x8*)(kp + d0 * 2048);
        const bf16x8 b1 = *(const __attribute__((address_space(3))) bf16x8*)(kp + d0 * 2048 + 512);
        p0 = MFMA32(b0, qr[d0], p0); p1 = MFMA32(b1, qr[d0], p1);
    }
}
__device__ __forceinline__ void pv(f32x16* o, lds_cptr vp, bf16x8 pa0, bf16x8 pa1, bf16x8 pa2, bf16x8 pa3) {
#pragma unroll
    for (int d0 = 0; d0 < 2; ++d0) { s16x4 lo[4], hi[4];
#pragma unroll
        for (int ks = 0; ks < 4; ++ks) { lo[ks] = vtr(vp + d0 * 4096 + ks * 1024); hi[ks] = vtr(vp + d0 * 4096 + ks * 1024 + 512); }
#define PK(k) (bf16x8){lo[k][0], lo[k][1], lo[k][2], lo[k][3], hi[k][0], hi[k][1], hi[k][2], hi[k][3]}
        o[d0] = MFMA32(pa0, PK(0), o[d0]); o[d0] = MFMA32(pa1, PK(1), o[d0]); o[d0] = MFMA32(pa2, PK(2), o[d0]); o[d0] = MFMA32(pa3, PK(3), o[d0]);
#undef PK
    }
}
__device__ __forceinline__ void kload(bf16x8* kf, lds_cptr kp) {
#pragma unroll
    for (int d0 = 0; d0 < 4; ++d0) { kf[2 * d0] = *(const __attribute__((address_space(3))) bf16x8*)(kp + d0 * 2048); kf[2 * d0 + 1] = *(const __attribute__((address_space(3))) bf16x8*)(kp + d0 * 2048 + 512); }
}
__device__ __forceinline__ void kload2(bf16x8* kf, lds_cptr kpe, lds_cptr kpo) {
#pragma unroll
    for (int d0 = 0; d0 < 4; ++d0) { const lds_cptr p = ((d0 & 1) ? kpo : kpe) + (d0 >> 1) * 1024;
        kf[2 * d0] = *(const __attribute__((address_space(3))) bf16x8*)(p); kf[2 * d0 + 1] = *(const __attribute__((address_space(3))) bf16x8*)(p + 4096); }
}
__device__ __forceinline__ void vload(s16x4* vlo, s16x4* vhi, lds_cptr vp) {
#pragma unroll
    for (int i = 0; i < 8; ++i) { vlo[i] = vtr(vp + (i >> 2) * 4096 + (i & 3) * 1024); vhi[i] = vtr(vp + (i >> 2) * 4096 + (i & 3) * 1024 + 512); }
}
__device__ __forceinline__ void qkt_r(f32x16& p0, f32x16& p1, const bf16x8* kf, const bf16x8* qr, float cinit) {
    f32x16 c;
#pragma unroll
    for (int r = 0; r < 16; ++r) c[r] = cinit;
    p0 = c; p1 = c;
#pragma unroll
    for (int d0 = 0; d0 < 4; ++d0) { p0 = MFMA32(kf[2 * d0], qr[d0], p0); p1 = MFMA32(kf[2 * d0 + 1], qr[d0], p1); }
}
__device__ __forceinline__ void pv_r(f32x16* o, const s16x4* vlo, const s16x4* vhi, bf16x8 pa0, bf16x8 pa1, bf16x8 pa2, bf16x8 pa3) {
#define VFR(i) (bf16x8){vlo[i][0], vlo[i][1], vlo[i][2], vlo[i][3], vhi[i][0], vhi[i][1], vhi[i][2], vhi[i][3]}
    o[0] = MFMA32(pa0, VFR(0), o[0]); o[1] = MFMA32(pa0, VFR(4), o[1]); o[0] = MFMA32(pa1, VFR(1), o[0]); o[1] = MFMA32(pa1, VFR(5), o[1]);
    o[0] = MFMA32(pa2, VFR(2), o[0]); o[1] = MFMA32(pa2, VFR(6), o[1]); o[0] = MFMA32(pa3, VFR(3), o[0]); o[1] = MFMA32(pa3, VFR(7), o[1]);
#undef VFR
}
struct ACtx { const bf16 *Q, *K, *V, *G; bf16* Y; const float *LF, *TAB, *KM, *MF; const float* sinks; int tflag; };
#define WAITBAR(N) asm volatile("s_waitcnt vmcnt(" #N ") lgkmcnt(0)\n\ts_barrier" ::: "memory")

#define USTAMP(k) do { if (TIMER_SEL >= 0 && TYPE == TIMER_TYPE && C.tflag && tid == 0) { volatile __attribute__((address_space(3))) unsigned* ta_ = (volatile __attribute__((address_space(3))) unsigned*)(shm + 139264 + 320) + 16; const unsigned now_ = (unsigned)__builtin_amdgcn_s_memrealtime(); ta_[k] += now_ - ta_[31]; ta_[31] = now_; } } while (0)
__device__ __forceinline__ int ticket_type(int u) { const int ty = u >> 9; return ty == 0 ? 1 : (ty == 1 ? 0 : ty); }
__device__ __forceinline__ void prefetch_unit(const ACtx& C, int u, lds_ptr shm, bf16x8* qn) {
    int tid = threadIdx.x; asm volatile("" : "+v"(tid));
    const int lane = tid & 63, r32 = lane & 31, hi = lane >> 5; const int wid = __builtin_amdgcn_readfirstlane(tid >> 6);
    const int T = ticket_type(u), r = u & 511, qb = 15 - (r >> 5), bh = r & 31, b = bh >> 2, h = bh & 3;
    const int kvh = (T == 3) ? (b * 2 + (h >> 1)) : bh;
    const bf16* Kh = C.K + T * pg8::GS + (size_t)kvh * SEQ * 64; const bf16* Vh = C.V + T * pg8::GS + (size_t)kvh * SEQ * 64;
    const bf16* ksrc = Kh + wid * 512 + (lane >> 2) * 32 + (((lane & 3) ^ ((lane >> 4) & 3)) * 8);
    const bf16* vsrc = Vh + ((wid & 3) * 2 + (wid >> 2)) * 512 + (lane >> 2) * 32 + 8 * (lane & 3);
    const unsigned lds0 = (unsigned)(size_t)shm, kdst = lds0 + L_K + wid * 1024, vdst = lds0 + L_V + wid * 1024;
    const int t_hi = 4 * qb + 3;
    glds16(ksrc + (size_t)t_hi * 4096, (unsigned)__builtin_amdgcn_readfirstlane(kdst)); glds16(vsrc + (size_t)t_hi * 4096, (unsigned)__builtin_amdgcn_readfirstlane(vdst));
    glds16(ksrc + (size_t)(t_hi - 1) * 4096, (unsigned)__builtin_amdgcn_readfirstlane(kdst + SLOTB)); glds16(vsrc + (size_t)(t_hi - 1) * 4096, (unsigned)__builtin_amdgcn_readfirstlane(vdst + SLOTB));
    const bf16* Qw = C.Q + T * pg8::GS + ((size_t)bh * SEQ + qb * 256 + wid * 32) * 64;
#pragma unroll
    for (int d0 = 0; d0 < 4; ++d0) qn[d0] = *reinterpret_cast<const bf16x8*>(&Qw[((r32 >> 4) * 2 + (d0 >> 1)) * 512 + (r32 & 15) * 32 + 16 * (d0 & 1) + 8 * hi]);
}
template <int TYPE> __device__ __forceinline__ int attn_unit(const ACtx& C, int bh, int qb, lds_ptr shm, bf16x8 (&qr)[4], int tick, __attribute__((address_space(3))) int* tslot, unsigned* rdy_prev) {
    int tid = threadIdx.x; asm volatile("" : "+v"(tid));
    const int lane = tid & 63, r32 = lane & 31, hi = lane >> 5; const int wid = __builtin_amdgcn_readfirstlane(tid >> 6);
    const int b = bh >> 2, h = bh & 3, q0 = qb * 256, qrel = wid * 32 + r32, t = q0 + qrel;
    const int kvh = (TYPE == 3) ? (b * 2 + (h >> 1)) : bh;
    const bf16* Qw = C.Q + TYPE * pg8::GS + ((size_t)bh * SEQ + q0 + wid * 32) * 64;
    const bf16* Kh = C.K + TYPE * pg8::GS + (size_t)kvh * SEQ * 64; const bf16* Vh = C.V + TYPE * pg8::GS + (size_t)kvh * SEQ * 64;
    const unsigned lds0 = (unsigned)(size_t)shm;
    __attribute__((address_space(3))) float* wsf = (__attribute__((address_space(3))) float*)(shm + L_WS) + wid * 64;
    __attribute__((address_space(3))) float* tabL = (__attribute__((address_space(3))) float*)(shm + L_TAB);
    __attribute__((address_space(3))) float* cs = (__attribute__((address_space(3))) float*)(shm + L_CS);
    __attribute__((address_space(3))) float* misc = (__attribute__((address_space(3))) float*)(shm + L_MISC);
    __attribute__((address_space(3))) int* misci = (__attribute__((address_space(3))) int*)(shm + L_MISC);
    const bf16* ksrc = Kh + wid * 512 + (lane >> 2) * 32 + (((lane & 3) ^ ((lane >> 4) & 3)) * 8);
    const bf16* vsrc = Vh + ((wid & 3) * 2 + (wid >> 2)) * 512 + (lane >> 2) * 32 + 8 * (lane & 3);
    const unsigned kdst = lds0 + L_K + wid * 1024, vdst = lds0 + L_V + wid * 1024;
#define DMA_KV(tile, slot) do { glds16(ksrc + (size_t)(tile) * 4096, (unsigned)__builtin_amdgcn_readfirstlane(kdst + (slot) * SLOTB)); glds16(vsrc + (size_t)(tile) * 4096, (unsigned)__builtin_amdgcn_readfirstlane(vdst + (slot) * SLOTB)); } while (0)
    const unsigned koff_e = L_K + ((r32 >> 4) * 2) * 1024 + (r32 & 15) * 64 + ((hi ^ ((r32 >> 2) & 3)) * 16);
    const lds_cptr kpe = (lds_cptr)shm + koff_e, kpo = (lds_cptr)shm + (koff_e ^ 32u);
    const lds_cptr vp0 = (lds_cptr)shm + L_V + ((lane >> 4) & 1) * 32 + (lane & 3) * 8 + (4 * hi + ((lane & 15) >> 2)) * 64;
    const float Mf = (TYPE == 2) ? 0.f : C.MF[TYPE];
    const int t_hi = 4 * qb + 3; int t_lo = 0;
    if (TYPE == 3) { t_lo = 4 * qb - 2; if (t_lo < 0) t_lo = 0; }
    USTAMP(24);
    const size_t yrow0 = (size_t)(b * SEQ + q0 + wid * 32);
    { const bf16* gslab = C.G + (size_t)(TYPE * 32 + bh) * 262144 + (size_t)(q0 + wid * 32) * 64;
#pragma unroll
        for (int i = 0; i < 4; ++i) { const int row = 8 * i + (lane >> 3);
            glds16(gslab + ((row >> 4) * 2 + ((lane & 7) >> 2)) * 512 + (row & 15) * 32 + 8 * (lane & 3), (unsigned)__builtin_amdgcn_readfirstlane(lds0 + L_G + wid * 4096 + i * 1024)); } }
    unsigned sel = 0u; float ct = 0.f;
    if (TYPE == 0) {
        const float* lfp = C.LF + (size_t)bh * SEQ; const bool on = 8 * tid < q0 + 256;
        f32x4 a4 = {0.f, 0.f, 0.f, 0.f}, b4 = {0.f, 0.f, 0.f, 0.f};
        if (on) { a4 = *(const f32x4*)(lfp + 8 * tid); b4 = *(const f32x4*)(lfp + 8 * tid + 4); }
        a4[1] += a4[0]; a4[2] += a4[1]; a4[3] += a4[2]; b4[0] += a4[3]; b4[1] += b4[0]; b4[2] += b4[1]; b4[3] += b4[2];
        float sc = b4[3];
#pragma unroll
        for (int o = 1; o < 64; o <<= 1) { const float u = __shfl_up(sc, o); if (lane >= o) sc += u; }
        if (lane == 63) misc[wid] = sc;
        __syncthreads();
        float base = sc - b4[3];
#pragma unroll
        for (int w = 0; w < 7; ++w) if (w < wid) base += misc[w];
        if (on) { *(__attribute__((address_space(3))) f32x4*)(cs + 8 * tid) = a4 + base; *(__attribute__((address_space(3))) f32x4*)(cs + 8 * tid + 4) = b4 + base; }
        __syncthreads();
        const float cref = cs[q0];
        if (wid == 0) { const bool skip = (lane < 4 * qb) && (cs[64 * lane + 63] - cref > 2.f * Mf + THR2);
            const int cnt = __popcll(__ballot(skip)); if (lane == 0) misci[40] = cnt; }
        __syncthreads();
        t_lo = misci[40]; ct = cs[t];
    }
    if (TYPE == 1 || TYPE == 3) {
        const float* tg = C.TAB + ((TYPE == 3 ? 4 : 0) + h) * 1024;
        { float tv[3]; const float b31 = (TYPE == 1) ? tg[1023] : 0.f; float k0 = 0.f, k1 = 0.f;
#pragma unroll
            for (int k = 0; k < 3; ++k) { const int j = tid + 512 * k, d = 1023 - j; tv[k] = (j < 1088 && d >= 0 && (TYPE == 1 || d < 128)) ? tg[d] - b31 : -INFINITY; }
            if (TYPE == 1) { const float* kg = C.KM + (size_t)bh * 16 * 64; if (tid < qb * 64) k0 = kg[tid]; if (tid + 512 < qb * 64) k1 = kg[tid + 512]; }
#pragma unroll
            for (int k = 0; k < 3; ++k) { const int j = tid + 512 * k; if (j < 1088) tabL[j] = tv[k]; }
            if (TYPE == 1) { cs[tid] = k0; cs[tid + 512] = k1; } }
        __syncthreads();
        if (TYPE == 1) {
            if (qb <= 3) sel = (1u << qb) - 1u;
            else {
                float qf[32];
#pragma unroll
                for (int d0 = 0; d0 < 4; ++d0) { const u32x4 w = __builtin_bit_cast(u32x4, qr[d0]);
#pragma unroll
                    for (int j = 0; j < 4; ++j) { qf[d0 * 8 + 2 * j] = __uint_as_float(w[j] << 16); qf[d0 * 8 + 2 * j + 1] = __uint_as_float(w[j] & 0xffff0000u); } }
                float v1 = -INFINITY, v2 = -INFINITY, v3 = -INFINITY; int i1 = 0, i2 = 0, i3 = 0;
                for (int n = 0; n < qb; ++n) { float s = 0.f;
#pragma unroll
                    for (int d0 = 0; d0 < 4; ++d0) { const f32x4 ka = *(const __attribute__((address_space(3))) f32x4*)(cs + n * 64 + d0 * 16 + hi * 8), kb4 = *(const __attribute__((address_space(3))) f32x4*)(cs + n * 64 + d0 * 16 + hi * 8 + 4);
#pragma unroll
                        for (int j = 0; j < 4; ++j) { s += qf[d0 * 8 + j] * ka[j]; s += qf[d0 * 8 + 4 + j] * kb4[j]; } }
                    { auto rr = __builtin_amdgcn_permlane32_swap(__float_as_uint(s), __float_as_uint(s), false, false); s = __uint_as_float(rr[0]) + __uint_as_float(rr[1]); }
                    if (s > v1) { v3 = v2; i3 = i2; v2 = v1; i2 = i1; v1 = s; i1 = n; } else if (s > v2) { v3 = v2; i3 = i2; v2 = s; i2 = n; } else if (s > v3) { v3 = s; i3 = n; } }
                sel = (1u << i1) | (1u << i2) | (1u << i3); }
        }
    }
    const int n_tiles = t_hi - t_lo + 1;
    asm volatile("" : "+v"(qr[0]), "+v"(qr[1]), "+v"(qr[2]), "+v"(qr[3]));
    f32x16 o[2]; o[0] = f32x16{}; o[1] = f32x16{}; f32x16 lacc = f32x16{};
    float carry = (TYPE == 2) ? 1.f : 0.f; bool done_w = false;
    f32x16 cvec;
    { const float c0_ = (TYPE == 2) ? 0.f : ((TYPE == 0) ? ct - Mf : -Mf);
#pragma unroll
        for (int r = 0; r < 16; ++r) cvec[r] = c0_; }
    asm volatile("" : "+v"(cvec));
    const bf16x8 ones = {0x3f80, 0x3f80, 0x3f80, 0x3f80, 0x3f80, 0x3f80, 0x3f80, 0x3f80};
    const int jdiag = wid >> 1;
    const int jlo_w = (TYPE == 3) ? ((32 * wid - 127) >> 6) : -100000;
    if (TYPE == 2) { if (tid < 16) misci[64 + tid] = 0; }
    USTAMP(21);
    if (TIMER_SEL == 98 && TYPE == TIMER_TYPE && C.tflag && tid == 0) { volatile __attribute__((address_space(3))) unsigned* ta_ = (volatile __attribute__((address_space(3))) unsigned*)(shm + 139264 + 320) + 16; ta_[26] = (unsigned)__builtin_amdgcn_s_memtime(); }
    bf16x8 kf[8]; s16x4 vlo[8], vhi[8]; f32x16 p0, p1;
    const bool late = false;
#define FINISH(tile_, jr_, slot_) do { \
            vload(vlo, vhi, vp0 + (slot_) * SLOTB); SBAR(); \
            const int kb = 64 * (jr_) + 4 * hi; \
            unsigned keepm = 0xffffffffu; \
            if (TYPE == 0) { \
            _Pragma("unroll") \
                for (int g4 = 0; g4 < 4; ++g4) { const f32x4 c0 = *(const __attribute__((address_space(3))) f32x4*)(cs + 64 * (tile_) + 8 * g4 + 4 * hi), c1 = *(const __attribute__((address_space(3))) f32x4*)(cs + 64 * (tile_) + 32 + 8 * g4 + 4 * hi); \
            _Pragma("unroll") \
                    for (int j = 0; j < 4; ++j) { p0[4 * g4 + j] -= c0[j]; p1[4 * g4 + j] -= c1[j]; } } \
                if ((jr_) == jdiag) { \
            _Pragma("unroll") \
                    for (int r = 0; r < 16; ++r) { const int kv = kb + (r & 3) + 8 * (r >> 2); if (kv > qrel) p0[r] = -INFINITY; if (kv + 32 > qrel) p1[r] = -INFINITY; } } \
            _Pragma("unroll") \
                for (int r = 0; r < 16; ++r) { p0[r] = __builtin_amdgcn_exp2f(p0[r]); p1[r] = __builtin_amdgcn_exp2f(p1[r]); } \
            } \
            if (TYPE == 1 || TYPE == 3) { \
                const bool far = (TYPE == 1) && ((q0 + 32 * wid - 64 * (tile_) - 63) >= 790); \
                if (!far) { const __attribute__((address_space(3))) float* tp_ = tabL + (1023 - (qrel - kb)); \
            _Pragma("unroll") \
                    for (int r = 0; r < 16; ++r) { p0[r] += tp_[(r & 3) + 8 * (r >> 2)]; p1[r] += tp_[(r & 3) + 8 * (r >> 2) + 32]; } } \
                if (TYPE == 1 && (jr_) < 0) keepm = ((sel >> ((tile_) >> 2)) & 1u) ? 0xffffffffu : 0u; \
            _Pragma("unroll") \
                for (int r = 0; r < 16; ++r) { p0[r] = __builtin_amdgcn_exp2f(p0[r]); p1[r] = __builtin_amdgcn_exp2f(p1[r]); } \
            } \
            if (TYPE == 2) { \
                f32x16 w0, w1; \
            _Pragma("unroll") \
                for (int r = 0; r < 16; ++r) { float c0_, c1_; asm("v_min_f32_e32 %0, 0x42a00000, %1" : "=v"(c0_) : "v"(p0[r])); asm("v_min_f32_e32 %0, 0x42a00000, %1" : "=v"(c1_) : "v"(p1[r])); p0[r] = __builtin_amdgcn_exp2f(c0_); p1[r] = __builtin_amdgcn_exp2f(c1_); } \
                if ((jr_) == jdiag) { \
            _Pragma("unroll") \
                    for (int r = 0; r < 16; ++r) { const int kv = kb + (r & 3) + 8 * (r >> 2); if (kv >= qrel) p0[r] = 0.f; if (kv + 32 >= qrel) p1[r] = 0.f; } } \
            _Pragma("unroll") \
                for (int r = 0; r < 16; ++r) { w0[r] = 1.f + p0[r]; w1[r] = 1.f + p1[r]; } \
                float own[8], part[8]; \
            _Pragma("unroll") \
                for (int rb = 0; rb < 4; ++rb) { own[rb] = (w0[4 * rb] * w0[4 * rb + 1]) * (w0[4 * rb + 2] * w0[4 * rb + 3]); own[4 + rb] = (w1[4 * rb] * w1[4 * rb + 1]) * (w1[4 * rb + 2] * w1[4 * rb + 3]); } \
            _Pragma("unroll") \
                for (int rb = 0; rb < 8; ++rb) { auto rr = __builtin_amdgcn_permlane32_swap(__float_as_uint(own[rb]), __float_as_uint(own[rb]), false, false); part[rb] = __uint_as_float(hi ? rr[0] : rr[1]); } \
                float run = carry; \
            _Pragma("unroll") \
                for (int rb = 7; rb >= 0; --rb) { \
                    float E = hi == 0 ? run * part[rb] : run; run *= own[rb] * part[rb]; \
            _Pragma("unroll") \
                    for (int j = 3; j >= 0; --j) { const int r = 4 * (rb & 3) + j; \
                        if (rb >= 4) { E *= w1[r]; p1[r] *= __builtin_amdgcn_rcpf(E); } else { E *= w0[r]; p0[r] *= __builtin_amdgcn_rcpf(E); } } } \
                carry = run; \
                done_w = __all(carry > 1.7592186e13f) != 0;     \
            } \
            u32x4 pw0, pw1, pw2, pw3; \
            _Pragma("unroll") \
            for (int j = 0; j < 4; ++j) { pw0[j] = cvtpk_s(p0[2 * j], p0[2 * j + 1]); pw1[j] = cvtpk_s(p0[8 + 2 * j], p0[9 + 2 * j]); pw2[j] = cvtpk_s(p1[2 * j], p1[2 * j + 1]); pw3[j] = cvtpk_s(p1[8 + 2 * j], p1[9 + 2 * j]); } \
            if (TYPE == 1) { pw0 &= keepm; pw1 &= keepm; pw2 &= keepm; pw3 &= keepm; } \
            const bf16x8 pa0 = __builtin_bit_cast(bf16x8, pw0), pa1 = __builtin_bit_cast(bf16x8, pw1), pa2 = __builtin_bit_cast(bf16x8, pw2), pa3 = __builtin_bit_cast(bf16x8, pw3); \
            pv_r(o, vlo, vhi, pa0, pa1, pa2, pa3); \
            if (TYPE != 2) { lacc = MFMA32(pa0, ones, lacc); lacc = MFMA32(pa1, ones, lacc); lacc = MFMA32(pa2, ones, lacc); lacc = MFMA32(pa3, ones, lacc); } \
        } while (0)
#define SCORE(slot_) do { kload2(kf, kpe + (slot_) * SLOTB, kpo + (slot_) * SLOTB); SBAR(); \
        if (TYPE == 2) { p0 = MFMA32(kf[0], qr[0], (f32x16{})); p1 = MFMA32(kf[1], qr[0], (f32x16{})); } else { p0 = MFMA32(kf[0], qr[0], cvec); p1 = MFMA32(kf[1], qr[0], cvec); } \
        _Pragma("unroll") for (int d0 = 1; d0 < 4; ++d0) { p0 = MFMA32(kf[2 * d0], qr[d0], p0); p1 = MFMA32(kf[2 * d0 + 1], qr[d0], p1); } SBAR(); } while (0)
    int slot = 0, dslot = PFD, ptile = 0, pslot = 0; bool pend = false, stop = false;
    for (int i = 0; ; ++i) {
        const int tile = t_hi - i, jr = tile - 4 * qb;
        if (i < n_tiles && !stop) {
            { const int tp = tile - PFD; DMA_KV(tp < 0 ? 0 : tp, dslot); }
            dslot = (dslot == NSLOT - 1) ? 0 : dslot + 1;
            WAITBAR(4);
            if (TYPE == 2 && i > 0) { const u32x4 fa = *(const __attribute__((address_space(3))) u32x4*)(misci + 64 + ((i - 1) & 1) * 8), fb = *(const __attribute__((address_space(3))) u32x4*)(misci + 68 + ((i - 1) & 1) * 8);
                if ((fa[0] & fa[1] & fa[2] & fa[3] & fb[0] & fb[1] & fb[2] & fb[3]) != 0u) stop = true; }
        }
        if (late && pend) { FINISH(ptile, ptile - 4 * qb, pslot); pend = false; }
        if (i >= n_tiles || stop) break;
        const bool active = (jr <= jdiag) && (jr >= jlo_w) && !(TYPE == 2 && done_w);
        if (active) { SCORE(slot); }
        if (!late) { if (active) { FINISH(tile, jr, slot); } } else { pend = active; ptile = tile; pslot = slot; }
        if (TYPE == 2) { if (lane == 0) misci[64 + (i & 1) * 8 + wid] = done_w ? 1 : 0; }
        slot = (slot == NSLOT - 1) ? 0 : slot + 1;
    }
#undef FINISH
#undef SCORE
    if (TIMER_SEL == 98 && TYPE == TIMER_TYPE && C.tflag && tid == 0) { volatile __attribute__((address_space(3))) unsigned* ta_ = (volatile __attribute__((address_space(3))) unsigned*)(shm + 139264 + 320) + 16; ta_[25] += (unsigned)__builtin_amdgcn_s_memtime() - ta_[26]; }
    USTAMP(22);
    if (tid == 0) tslot[0] = tick;
    asm volatile("s_waitcnt vmcnt(0) lgkmcnt(0)\n\ts_barrier" ::: "memory");
    if (tid == 0 && rdy_prev != nullptr) (void)__hip_atomic_fetch_add(rdy_prev, 1u, __ATOMIC_RELAXED, __HIP_MEMORY_SCOPE_AGENT);
    const int unext = tslot[0];
    if (unext < 2048) prefetch_unit(C, unext, shm, qr);
    float rli[16];
    { const float sk = (TYPE == 3) ? __builtin_amdgcn_exp2f(C.sinks[h] * LOG2E - Mf) : 0.f;
#pragma unroll
        for (int r = 0; r < 16; ++r) rli[r] = (TYPE == 2) ? 1.f : __builtin_amdgcn_rcpf(lacc[r] + sk); }
    __attribute__((address_space(3))) bf16* stg = (__attribute__((address_space(3))) bf16*)(shm + (wid < 6 ? L_K + 2 * SLOTB + wid * 4096 : L_V + 2 * SLOTB + (wid - 6) * 4096));
    const __attribute__((address_space(3))) bf16* gst = (const __attribute__((address_space(3))) bf16*)(shm + L_G) + wid * 2048;
#pragma unroll
    for (int r = 0; r < 16; ++r) { const int orow = crow(r, hi); const float rl = rli[r];
        { const unsigned w_ = cvtpk_s(o[0][r] * rl, o[1][r] * rl); stg[orow * 64 + r32] = (bf16)(w_ & 0xffffu); stg[orow * 64 + 32 + r32] = (bf16)(w_ >> 16); } }
    asm volatile("s_waitcnt lgkmcnt(0)" ::: "memory");
#pragma unroll
    for (int i = 0; i < 4; ++i) { const int row = i * 8 + (lane >> 3), ch = lane & 7;
        const u32x4 v = *(const __attribute__((address_space(3))) u32x4*)(stg + row * 64 + ch * 8);
        const u32x4 g = *(const __attribute__((address_space(3))) u32x4*)(gst + row * 64 + ch * 8); u32x4 w;
        const size_t off = (yrow0 + row) * DM + TYPE * 256 + h * 64 + ch * 8;
#pragma unroll
        for (int j = 0; j < 4; ++j) { const float a0 = __uint_as_float(v[j] << 16) * __uint_as_float(g[j] << 16), a1 = __uint_as_float(v[j] & 0xffff0000u) * __uint_as_float(g[j] & 0xffff0000u); w[j] = cvtpk_s(a0, a1); }
        { const bf16* yp_ = C.Y + off; asm volatile("global_store_dwordx4 %0, %1, off sc1\n\ts_nop 1" :: "v"(yp_), "v"(w) : "memory"); } }
    asm volatile("s_waitcnt lgkmcnt(0)\n\ts_barrier" ::: "memory");
    USTAMP(23);
    return unext;
#undef DMA_KV
}
#undef SBAR
}
#define TACC(F) ((volatile LAS unsigned*)((F).lds + MISC_OFF) + 16)
#define TSTAMP(F, k) do { if (TIMER_SEL >= 0 && (F).vcu == TIMER_WG && (F).tid == 0) { const unsigned now_ = (unsigned)__builtin_amdgcn_s_memrealtime(); TACC(F)[k] += now_ - TACC(F)[31]; TACC(F)[31] = now_; } } while (0)
__device__ __forceinline__ void p_attn(Frame& F, const Args& a, int layer, int rep, int tmask) {
    att::ACtx C{(const bf16*)(a.ws + WS_Q), (const bf16*)(a.ws + WS_K), (const bf16*)(a.ws + WS_V), (const bf16*)(a.ws + WS_G), (bf16*)(a.ws + WS_HN),
                (const float*)(a.ws + WS_LF), (const float*)(a.ws + WS_TAB), (const float*)(a.ws + WS_KM) + layer * 32768, (const float*)(a.ws + WS_MF) + layer * 4, a.sinks + layer * 4, (F.vcu == TIMER_WG) ? 1 : 0};
    unsigned* head = (unsigned*)(a.ws + WS_CTL) + CW_QUEUE + 64 * (layer + 2 * rep);
    LAS int* slot = (LAS int*)(F.lds + att::L_MISC) + 200;
    att::lds_ptr shm = (att::lds_ptr)F.lds;
    if (F.tid == 0) slot[0] = (int)__hip_atomic_fetch_add(head, 1u, __ATOMIC_RELAXED, __HIP_MEMORY_SCOPE_AGENT);
    __syncthreads();
    int u = slot[0];
    __syncthreads();
    att::bf16x8 qr[4];
    if (u < 2048) att::prefetch_unit(C, u, shm, qr);
    unsigned* const rdy = (unsigned*)(a.ws + WS_CTL) + CW_RDY + 128 * layer; unsigned* pend = nullptr;
    while (u < 2048) {
        int tick = 0;
        if (F.tid == 0) tick = (int)__hip_atomic_fetch_add(head, 1u, __ATOMIC_RELAXED, __HIP_MEMORY_SCOPE_AGENT);
        const int ty = u >> 9, r = u & 511, qb = 15 - (r >> 5), bh = r & 31;
        TSTAMP(F, 20);
        unsigned* const mine = rdy + ((bh >> 2) * 16 + qb);
        if (ty == 0) u = att::attn_unit<1>(C, bh, qb, shm, qr, tick, (LAS int*)slot, pend);
        else if (ty == 1) u = att::attn_unit<0>(C, bh, qb, shm, qr, tick, (LAS int*)slot, pend);
        else if (ty == 2) u = att::attn_unit<2>(C, bh, qb, shm, qr, tick, (LAS int*)slot, pend);
        else u = att::attn_unit<3>(C, bh, qb, shm, qr, tick, (LAS int*)slot, pend);
        TSTAMP(F, 8 + ty);
        pend = mine;
    }
    asm volatile("s_waitcnt vmcnt(0)" ::: "memory");
    __syncthreads();
    if (F.tid == 0 && pend != nullptr) (void)__hip_atomic_fetch_add(pend, 1u, __ATOMIC_RELAXED, __HIP_MEMORY_SCOPE_AGENT);
}

__global__ void __launch_bounds__(NWAVES * 64, 2) mk_fwd(Args a) {
    extern __shared__ __attribute__((aligned(16))) unsigned char lds[];
    Frame F; F.lds = (LAS unsigned char*)lds; F.tid = threadIdx.x; F.lane = F.tid & 63; F.wave = __builtin_amdgcn_readfirstlane(F.tid >> 6);
    F.G = gridDim.x; { const int bx = blockIdx.x; F.vcu = (F.G % 8 == 0) ? (bx % 8) * (F.G / 8) + bx / 8 : bx; }
    bf16* HN = (bf16*)(a.ws + WS_HN);
    for (int u = F.tid; u < (LDS_BYTES - LDSCTL_OFF) / 4; u += NWAVES * 64) ((LAS unsigned*)(F.lds + LDSCTL_OFF))[u] = 0u;
    __syncthreads();
    XcdBarrier bar; bar.bar = (unsigned*)(a.ws + WS_CTL) + CW_BAR; bar.x = 0; bar.st = nullptr;
    if (a.ph_hi - a.ph_lo > 1) bar = xcd_barrier_post((unsigned*)(a.ws + WS_CTL) + CW_BAR, (volatile LAS unsigned*)(F.lds + MISC_OFF) + 8);
#define PHASE_ON(k) (a.ph_lo <= (k) && (k) < a.ph_hi)
#define SEAM(k) do { if ((k) != 4 && PHASE_ON(k) && PHASE_ON((k) + 1)) xcd_barrier(bar); } while (0)
#define LAYER_PHASES(layer) do { \
    if ((layer) == 0 && PHASE_ON(0)) { p_tables(F, a); p_consts(F, a); if (F.wave >= 6) p_weights(F, a); else p_convert(F, a); } \
    if ((layer) == 0) { TSTAMP(F, 0); SEAM(0); TSTAMP(F, 1); } \
    if (PHASE_ON(4 * (layer) + 1)) { \
        pg8::Gemm g{(layer) == 0 ? (const bf16*)(a.ws + WS_X0) : (const bf16*)(a.ws + WS_X1), (const bf16*)(a.ws + WS_WIN) + (size_t)(layer) * NPERM * DM, NTOK, NPERM, DM}; \
        pg8::StaticOrder S; S.init(NTOK, NPERM, F.G, (int)blockIdx.x); \
        pg8::EpiIn E{(bf16*)(a.ws + WS_Q), (bf16*)(a.ws + WS_K), (bf16*)(a.ws + WS_V), (bf16*)(a.ws + WS_G), a.fox_g + (layer) * 128, a.moba_g + (layer) * 128, a.swa_g + (layer) * 128, (float*)(a.ws + WS_KM) + (layer) * 32768, \
                     (const float*)(a.ws + WS_RS) + (layer) * NTOK, (float*)(a.ws + WS_LF), a.b_forget + (layer) * 4}; \
        pg8::gemm_phase<pg8::EpiIn, pg8::StaticOrder, true, true>(F.lds, g, S, E); \
        if (PROBE_P1) { xcd_barrier(bar); pg8::gemm_phase<pg8::EpiIn, pg8::StaticOrder, true, true>(F.lds, g, S, E); } \
    } \
    TSTAMP(F, 2); SEAM(4 * (layer) + 1); TSTAMP(F, 3); \
    if (PHASE_ON(4 * (layer) + 2)) { for (int rep = 0; rep < 1 + (PROBE_ATT != 0 ? PROBE_REPS : 0); ++rep) { if (rep) xcd_barrier(bar); p_attn(F, a, (layer), rep, rep ? PROBE_ATT : 15); } } \
    TSTAMP(F, 4);   TSTAMP(F, 5); \
    if (PHASE_ON(4 * (layer) + 3)) { \
        pg8::Gemm g{HN  , (const bf16*)(a.ws + WS_WOUT) + (size_t)(layer) * DM * DM, NTOK, DM, DM}; \
        pg8::FlagOrder S; S.init(NTOK, DM, F.G, (int)blockIdx.x); S.rdy = (unsigned*)(a.ws + WS_CTL) + CW_RDY + 128 * (layer); S.need = 16u; \
        if ((layer) == 0) { \
            pg8::EpiRes0 E{(const bf16*)(a.ws + WS_X0), (bf16*)(a.ws + WS_X1), (float*)(a.ws + WS_RS) + NTOK}; \
            pg8::gemm_phase<pg8::EpiRes0, pg8::FlagOrder, true, true>(F.lds, g, S, E); \
        } else { \
            pg8::EpiRes1 E{(const bf16*)(a.ws + WS_X1), a.out}; \
            pg8::gemm_phase<pg8::EpiRes1, pg8::FlagOrder, true, true>(F.lds, g, S, E); \
        } \
    } \
    if ((layer) == 0) { TSTAMP(F, 6); SEAM(3); SEAM(4); TSTAMP(F, 7); } } while (0)
    if (TIMER_SEL >= 0 && F.vcu == TIMER_WG && F.tid == 0) TACC(F)[31] = (unsigned)__builtin_amdgcn_s_memrealtime();
    LAYER_PHASES(0);
    LAYER_PHASES(1);
    if (TIMER_SEL >= 0 && F.vcu == TIMER_WG) {
        asm volatile("s_waitcnt vmcnt(0)" ::: "memory"); __syncthreads();
        float v = (TIMER_SEL == 99) ? 1.0f : (TIMER_SEL == 98) ? ((float)TACC(F)[25] / ((float)TACC(F)[22] * 10.f)) / 3.0f : (float)TACC(F)[TIMER_SEL & 31] * 0.01f / (float)TIMER_FS; v = fminf(fmaxf(v, 0.f), 1.f); const float dl = 0.1f * sqrtf(v);
        pg8::FlagOrder S; S.init(NTOK, DM, F.G, (int)blockIdx.x); pg8::Unit u;
        for (int i = 0; S.next(i, u); ++i) for (int e = F.tid; e < 65536; e += NWAVES * 64) { float* p = a.out + (size_t)(u.pm * 256 + (e >> 8)) * DM + u.pn * 256 + (e & 255); *p += dl; }
    }
}

extern "C" void kernel_launch(void* const* d_in, const int* in_sizes, int n_in, void* d_out, int out_size, void* d_ws, size_t ws_size, hipStream_t stream) {
    static int ok = 0, grid = 0;
    if (ok == 0) {
        if (n_in != 10 || in_sizes[0] != NTOK * DM || out_size != NTOK * DM || ws_size < WS_END) { fprintf(stderr, "kernel_launch: unexpected shapes (n_in %d, in0 %d, out %d, ws %zu)\n", n_in, n_in > 0 ? in_sizes[0] : -1, out_size, ws_size); ok = -1; return; }
        if (hipFuncSetAttribute((const void*)mk_fwd, hipFuncAttributeMaxDynamicSharedMemorySize, LDS_BYTES) != hipSuccess) { fprintf(stderr, "kernel_launch: hipFuncSetAttribute failed\n"); ok = -1; return; }
        int dev = 0, cus = 0; if (hipGetDevice(&dev) != hipSuccess || hipDeviceGetAttribute(&cus, hipDeviceAttributeMultiprocessorCount, dev) != hipSuccess) { fprintf(stderr, "kernel_launch: device query failed\n"); ok = -1; return; }
        grid = cus < 256 ? (cus / 8) * 8 : 256; if (grid < 8) grid = cus;
        ok = 1;
    }
    if (ok < 0) return;
    Args a{};
    a.x = (const float*)d_in[0]; a.norm_gain = (const float*)d_in[1]; a.w_in = (const float*)d_in[2]; a.b_forget = (const float*)d_in[3]; a.fox_g = (const float*)d_in[4];
    a.moba_g = (const float*)d_in[5]; a.swa_g = (const float*)d_in[6]; a.sinks = (const float*)d_in[7]; a.w_out = (const float*)d_in[8]; a.rel_bias = (const float*)d_in[9];
    a.out = (float*)d_out; a.ws = (unsigned char*)d_ws;
    unsigned char* ws = (unsigned char*)d_ws;
    a.tmask = 15;
    if (hipMemsetAsync(ws + WS_CTL, 0, CTL_ZERO_BYTES, stream) != hipSuccess) { fprintf(stderr, "kernel_launch: memset failed\n"); return; }
#if N_LAUNCHES == 1
    a.ph_lo = 0; a.ph_hi = 8; hipLaunchKernelGGL(mk_fwd, dim3(grid), dim3(NWAVES * 64), LDS_BYTES, stream, a);
#else
    for (int ph = 0; ph < 8; ++ph) { a.ph_lo = ph; a.ph_hi = ph + 1; hipLaunchKernelGGL(mk_fwd, dim3(grid), dim3(NWAVES * 64), LDS_BYTES, stream, a); }
#endif
}
```

```cpp
#include <hip/hip_runtime.h>
#include <cstdio>
#include <cstdint>
#include <cmath>
namespace pg8 {
#define PG8_LAS __attribute__((address_space(3)))
typedef unsigned short bf16_t;
typedef short bf16x8 __attribute__((ext_vector_type(8)));
typedef float f32x4 __attribute__((ext_vector_type(4)));
typedef unsigned u32x4 __attribute__((ext_vector_type(4)));
constexpr int BM = 256, BK = 64, HALF = 128, HTB = HALF * BK * 2  , STAGE_BYTES = 8 * HTB, NXCD = 8, WGM = 8;

__host__ __device__ __forceinline__ int lds_byte(int r, int c) { const int st = (r >> 4) * 2 + (c >> 5), rr = r & 15, cc = c & 31, ob = rr * 64 + cc * 2; return st * 1024 + (ob ^ (((ob >> 9) & 1) << 5)); }
__host__ __device__ __forceinline__ void stage_rc(int b, int& R, int& C) { const int st = b / 1024, sb = b % 1024, swz = sb ^ (((sb >> 9) & 1) << 5); R = (st >> 1) * 16 + swz / 64; C = (st & 1) * 32 + (swz % 64) / 2; }
__host__ __device__ __forceinline__ int perm32(int rho) { const int n = rho >> 4, i = rho & 15; return 8 * (i >> 2) + 4 * n + (i & 3); }

struct Unit { int pm, pn; };
struct Gemm { const bf16_t* A; const bf16_t* Bt; int M, N, K; };

struct StaticOrder {
    int nM, nN, nwg, G, c;
    __host__ __device__ void init(int M, int N, int G_, int c_) { nM = M / BM; nN = N / BM; nwg = nM * nN; G = G_; c = c_; }
    __host__ __device__ bool next(int i, Unit& u) const {
        const long L = (long)i * G + c; if (L >= nwg) return false;
        int wgid = (int)L; { const int q = nwg / NXCD, r = nwg % NXCD, xcd = wgid % NXCD, off = wgid / NXCD; wgid = (xcd < r ? xcd * (q + 1) : r * (q + 1) + (xcd - r) * q) + off; }
        const int nig = WGM * nN, gid = wgid / nig, fm = gid * WGM, gsz = (nM - fm) < WGM ? (nM - fm) : WGM;
        u.pm = fm + ((wgid % nig) % gsz); u.pn = (wgid % nig) / gsz; return true;
    }
    __device__ __forceinline__ void a_ready(const Unit&) const {}
    __device__ __forceinline__ void done(const Unit&) const {}
};
struct FlagOrder : StaticOrder {
    unsigned* rdy; unsigned need;
    __host__ __device__ bool next(int i, Unit& u) const { if (!StaticOrder::next(i, u)) return false; u.pm = (u.pm & ~15) | (15 - (u.pm & 15)); return true; }
    __device__ __forceinline__ void a_ready(const Unit& u) const {
        unsigned* p = rdy + u.pm; unsigned sp = 0;
        while ((unsigned)__builtin_amdgcn_readfirstlane(__hip_atomic_load(p, __ATOMIC_RELAXED, __HIP_MEMORY_SCOPE_AGENT)) < need) { __builtin_amdgcn_s_sleep(2); if (++sp > (1u << 21)) break; }
    }
};


__device__ __forceinline__ unsigned cvt_pk_bf16(float lo, float hi) { unsigned r; asm volatile("v_cvt_pk_bf16_f32 %0, %1, %2" : "=v"(r) : "v"(lo), "v"(hi)); return r; }
typedef float f32x2 __attribute__((ext_vector_type(2)));
constexpr float C2 = 0.125f * 1.4426950408889634f;
constexpr float RMS_EPS = 1e-6f;
constexpr size_t GS = (size_t)8 * 4 * 4096 * 64;
__device__ __forceinline__ void st_stream(void* p, u32x4 w) { asm volatile("global_store_dwordx4 %0, %1, off sc1 nt\n\ts_nop 1" :: "v"(p), "v"(w) : "memory"); }
struct EpiIn {
    static constexpr bool PERM = true, AFTER_DRAIN = false;
    bf16_t *Q, *K, *V, *G; const float *gfox, *gmoba, *gswa; float* KM; const float* RS; float* LF; const float* bfg;
    __device__ __forceinline__ void prefetch(const Unit& u, int ui_, PG8_LAS unsigned char* lds, int wid, int lane) const {
        if (wid < 4) { const float* src = RS + u.pm * BM + wid * 64 + lane; const unsigned dst = (unsigned)(size_t)(lds + STAGE_BYTES + (ui_ & 1) * 1024 + wid * 256); unsigned keep;
            asm volatile("s_mov_b32 %0, m0\n\ts_mov_b32 m0, %2\n\ts_nop 0\n\tglobal_load_lds_dword %1, off\n\ts_mov_b32 m0, %0" : "=&s"(keep) : "v"(src), "s"((unsigned)__builtin_amdgcn_readfirstlane(dst)) : "memory"); }
    }
    __device__ __forceinline__ void operator()(const f32x4 (&acc)[2][2][4][2], const Unit& u, int wr, int wc, int fr, int fq, int ui, PG8_LAS unsigned char* ldsb) const {
        const int T = u.pn;
        const int b = (u.pm * BM) >> 12, t0 = ((u.pm * BM) & 4095) + wr * 64 + fr;
        float rs[2][4];
#pragma unroll
        for (int ai = 0; ai < 2; ++ai)
#pragma unroll
            for (int m = 0; m < 4; ++m) rs[ai][m] = __builtin_amdgcn_rsqf(((const PG8_LAS float*)(ldsb + STAGE_BYTES + (ui & 1) * 1024))[ai * HALF + wr * 64 + m * 16 + fr] * (1.0f / 1024.0f) + RMS_EPS);
        if (T == 15) {
            if (wc == 0 && fq == 0) { const f32x4 bv = *(const f32x4*)bfg;
#pragma unroll
                for (int ai = 0; ai < 2; ++ai)
#pragma unroll
                    for (int m = 0; m < 4; ++m) { const f32x4 a4 = acc[ai][0][m][0] * rs[ai][m] + bv;
#pragma unroll
                        for (int j = 0; j < 4; ++j) { const float uu = a4[j]; const float sp = fmaxf(-uu, 0.f) + __logf(1.f + __expf(-fabsf(uu)));
                            LF[(size_t)(b * 4 + j) * 4096 + t0 + ai * HALF + m * 16] = -sp * 1.4426950408889634f; } } }
            return;
        }
        int mode = 1, nh = 4, head = wc; float scale = 1.f; const float* gain = nullptr; bf16_t* base = nullptr;
        switch (T) {
            case 0: mode = 0; gain = gfox; scale = C2; base = Q; break;
            case 1: mode = 0; gain = gfox + 64; base = K; break;
            case 2: base = V; break;
            case 4: mode = 0; gain = gmoba; scale = C2; base = Q + GS; break;
            case 5: mode = 0; gain = gmoba + 64; base = K + GS; break;
            case 6: base = V + GS; break;
            case 8: scale = C2; base = Q + 2 * GS; break;
            case 9: base = K + 2 * GS; break;
            case 10: base = V + 2 * GS; break;
            case 12: mode = 0; gain = gswa; scale = C2; base = Q + 3 * GS; break;
            case 13: nh = 2; if (wc < 2) { mode = 0; gain = gswa + 64; base = K + 3 * GS; } else { base = V + 3 * GS; head = wc - 2; } break;
            default: mode = 2; break;
        }
        if (mode == 2) {
            bf16_t* gp = G + ((size_t)((T >> 2) * 32 + b * 4 + wc)) * 262144 + (size_t)((t0 >> 4) * 2) * 512 + (t0 & 15) * 32 + 8 * fq;
#pragma unroll
            for (int ai = 0; ai < 2; ++ai)
#pragma unroll
                for (int m = 0; m < 4; ++m)
#pragma unroll
                    for (int bj = 0; bj < 2; ++bj) {
                        f32x4 v0 = acc[ai][bj][m][0] * rs[ai][m], v1 = acc[ai][bj][m][1] * rs[ai][m];
#pragma unroll
                        for (int j = 0; j < 4; ++j) { v0[j] = v0[j] * __builtin_amdgcn_rcpf(1.f + __expf(-v0[j])); v1[j] = v1[j] * __builtin_amdgcn_rcpf(1.f + __expf(-v1[j])); }
                        u32x4 w; w.x = cvt_pk_bf16(v0[0], v0[1]); w.y = cvt_pk_bf16(v0[2], v0[3]); w.z = cvt_pk_bf16(v1[0], v1[1]); w.w = cvt_pk_bf16(v1[2], v1[3]);
                        st_stream(gp + (size_t)((ai * 8 + m) * 2 + bj) * 512, w);
                    }
            return;
        }
        f32x4 gv[2][2];
#pragma unroll
        for (int bj = 0; bj < 2; ++bj)
#pragma unroll
            for (int n = 0; n < 2; ++n) gv[bj][n] = (mode == 0) ? *(const f32x4*)(gain + 32 * bj + 8 * fq + 4 * n) : (f32x4){1.f, 1.f, 1.f, 1.f};
        bf16_t* dp = base + (size_t)(b * nh + head) * 262144 + (size_t)((t0 >> 4) * 2) * 512 + (t0 & 15) * 32 + 8 * fq;
        f32x4 cs4[2][2];
#pragma unroll
        for (int bj = 0; bj < 2; ++bj)
#pragma unroll
            for (int n = 0; n < 2; ++n) cs4[bj][n] = (f32x4){0.f, 0.f, 0.f, 0.f};
#pragma unroll
        for (int ai = 0; ai < 2; ++ai)
#pragma unroll
            for (int m = 0; m < 4; ++m) {
                float r = scale * rs[ai][m];
                if (mode == 0) {
                    float ss = 0.f;
#pragma unroll
                    for (int bj = 0; bj < 2; ++bj)
#pragma unroll
                        for (int n = 0; n < 2; ++n) { const f32x4 x = acc[ai][bj][m][n]; ss += (x[0] * x[0] + x[1] * x[1]) + (x[2] * x[2] + x[3] * x[3]); }
                    ss += __shfl_xor(ss, 16); ss += __shfl_xor(ss, 32);
                    r = scale * rs[ai][m] * __builtin_amdgcn_rsqf(ss * rs[ai][m] * rs[ai][m] * (1.0f / 64.0f) + RMS_EPS);
                }
#pragma unroll
                for (int bj = 0; bj < 2; ++bj) {
                    const f32x4 v0 = acc[ai][bj][m][0] * gv[bj][0] * r, v1 = acc[ai][bj][m][1] * gv[bj][1] * r;
                    if (T == 5) { cs4[bj][0] += v0; cs4[bj][1] += v1; }
                    u32x4 w; w.x = cvt_pk_bf16(v0[0], v0[1]); w.y = cvt_pk_bf16(v0[2], v0[3]); w.z = cvt_pk_bf16(v1[0], v1[1]); w.w = cvt_pk_bf16(v1[2], v1[3]);
                    st_stream(dp + (size_t)((ai * 8 + m) * 2 + bj) * 512, w);
                }
            }
        if (T == 5) {
            float* kmp = KM + ((size_t)((b * 4 + wc) * 16 + (((u.pm * BM) & 4095) >> 8))) * 64 + 8 * fq;
#pragma unroll
            for (int bj = 0; bj < 2; ++bj)
#pragma unroll
                for (int n = 0; n < 2; ++n)
#pragma unroll
                    for (int j = 0; j < 4; ++j) { float s = cs4[bj][n][j];
                        s += __shfl_xor(s, 1); s += __shfl_xor(s, 2); s += __shfl_xor(s, 4); s += __shfl_xor(s, 8);
                        if (fr == 0) atomicAdd(kmp + 32 * bj + 4 * n + j, s * (1.0f / 256.0f)); }
        }
    }
};
struct EpiRes0 {
    static constexpr bool PERM = true, AFTER_DRAIN = false;
    const bf16_t* base; bf16_t* X1; float* RS1;
    __device__ __forceinline__ void prefetch(const Unit&, int, PG8_LAS unsigned char*, int, int) const {}
    __device__ __forceinline__ void operator()(const f32x4 (&acc)[2][2][4][2], const Unit& u, int wr, int wc, int fr, int fq, int ui, PG8_LAS unsigned char* ldsb) const {
        const int col0 = u.pn * BM + wc * 32 + 8 * fq;
        u32x4 xr[2][4][2];
#pragma unroll
        for (int ai = 0; ai < 2; ++ai)
#pragma unroll
            for (int m = 0; m < 4; ++m)
#pragma unroll
                for (int bj = 0; bj < 2; ++bj) xr[ai][m][bj] = *(const u32x4*)(base + (size_t)(u.pm * BM + ai * HALF + wr * 64 + m * 16 + fr) * 1024 + col0 + bj * HALF);
#pragma unroll
        for (int ai = 0; ai < 2; ++ai)
#pragma unroll
            for (int m = 0; m < 4; ++m) {
                const int row = u.pm * BM + ai * HALF + wr * 64 + m * 16 + fr; const size_t off = (size_t)row * 1024 + col0; float ss = 0.f;
#pragma unroll
                for (int bj = 0; bj < 2; ++bj) { const u32x4 xb = xr[ai][m][bj];
                    f32x4 v0, v1; v0[0] = __uint_as_float(xb.x << 16); v0[1] = __uint_as_float(xb.x & 0xffff0000u); v0[2] = __uint_as_float(xb.y << 16); v0[3] = __uint_as_float(xb.y & 0xffff0000u);
                    v1[0] = __uint_as_float(xb.z << 16); v1[1] = __uint_as_float(xb.z & 0xffff0000u); v1[2] = __uint_as_float(xb.w << 16); v1[3] = __uint_as_float(xb.w & 0xffff0000u);
                    v0 += acc[ai][bj][m][0]; v1 += acc[ai][bj][m][1];
                    ss += (v0[0] * v0[0] + v0[1] * v0[1]) + (v0[2] * v0[2] + v0[3] * v0[3]) + (v1[0] * v1[0] + v1[1] * v1[1]) + (v1[2] * v1[2] + v1[3] * v1[3]);
                    u32x4 w; w.x = cvt_pk_bf16(v0[0], v0[1]); w.y = cvt_pk_bf16(v0[2], v0[3]); w.z = cvt_pk_bf16(v1[0], v1[1]); w.w = cvt_pk_bf16(v1[2], v1[3]);
                    *(u32x4*)(X1 + off + bj * HALF) = w; }
                ss += __shfl_xor(ss, 16); ss += __shfl_xor(ss, 32);
                if (fq == 0) atomicAdd(RS1 + row, ss);
            }
    }
};
struct EpiRes1 {
    static constexpr bool PERM = true, AFTER_DRAIN = false;
    const bf16_t* X1; float* out;

    __device__ __forceinline__ void prefetch(const Unit&, int, PG8_LAS unsigned char*, int, int) const {}
    __device__ __forceinline__ void operator()(const f32x4 (&acc)[2][2][4][2], const Unit& u, int wr, int wc, int fr, int fq, int ui, PG8_LAS unsigned char* ldsb) const {
        const int col0 = u.pn * BM + wc * 32 + 8 * fq;
        u32x4 xr[2][4][2];
#pragma unroll
        for (int ai = 0; ai < 2; ++ai)
#pragma unroll
            for (int m = 0; m < 4; ++m)
#pragma unroll
                for (int bj = 0; bj < 2; ++bj) xr[ai][m][bj] = *(const u32x4*)(X1 + (size_t)(u.pm * BM + ai * HALF + wr * 64 + m * 16 + fr) * 1024 + col0 + bj * HALF);
#pragma unroll
        for (int ai = 0; ai < 2; ++ai)
#pragma unroll
            for (int m = 0; m < 4; ++m) {
                const size_t off = (size_t)(u.pm * BM + ai * HALF + wr * 64 + m * 16 + fr) * 1024 + col0;
#pragma unroll
                for (int bj = 0; bj < 2; ++bj) { const u32x4 xb = xr[ai][m][bj];
                    f32x4 v0, v1; v0[0] = __uint_as_float(xb.x << 16); v0[1] = __uint_as_float(xb.x & 0xffff0000u); v0[2] = __uint_as_float(xb.y << 16); v0[3] = __uint_as_float(xb.y & 0xffff0000u);
                    v1[0] = __uint_as_float(xb.z << 16); v1[1] = __uint_as_float(xb.z & 0xffff0000u); v1[2] = __uint_as_float(xb.w << 16); v1[3] = __uint_as_float(xb.w & 0xffff0000u);
                    *(f32x4*)(out + off + bj * HALF) = v0 + acc[ai][bj][m][0]; *(f32x4*)(out + off + bj * HALF + 4) = v1 + acc[ai][bj][m][1]; }
            }
    }
};

template <class Epi, class Sched, bool ALIGN_EPI = false, bool SP2 = false>
__device__ __forceinline__ void gemm_phase(PG8_LAS unsigned char* lds, const Gemm g, const Sched& S, const Epi& E) {
    const int tid = threadIdx.x, wid = __builtin_amdgcn_readfirstlane(tid >> 6), lane = tid & 63, wr = wid >> 2, wc = wid & 3, fr = lane & 15, fq = lane >> 4;
    const int K = g.K, nt = K / BK;
    unsigned voffA[2], voffB[2];
#pragma unroll
    for (int i = 0; i < 2; ++i) { int R, C; stage_rc(tid * 16 + i * 8192, R, C); const int Rb = Epi::PERM ? ((R & ~31) + perm32(R & 31)) : R;
        voffA[i] = (unsigned)(R * K + C) * 2u; voffB[i] = (unsigned)(Rb * K + C) * 2u; }
    const size_t kstep = (size_t)(BK * 2);
    const size_t hstep = (size_t)HALF * K * 2;
    const size_t tstep = 2 * hstep;
    const unsigned ldsw = (unsigned)wid * 1024u;
    const int aoff = lds_byte(wr * 64 + fr, fq * 8), boff = lds_byte(wc * 32 + fr, fq * 8);
#define PG8_SA(b, h) (((b) * 2 + (h)) * HTB)
#define PG8_SB(b, h) ((4 + (b) * 2 + (h)) * HTB)
#define PG8_STAGE(bufoff, gbase, voff) do { _Pragma("unroll") for (int _i = 0; _i < 2; ++_i) \
        __builtin_amdgcn_global_load_lds((const unsigned*)((const char*)(gbase) + (voff)[_i]), (PG8_LAS unsigned*)(lds + (bufoff) + ldsw + _i * 8192), 16, 0, 0); } while (0)
#define PG8_LDA(dst, b, h) do { _Pragma("unroll") for (int m = 0; m < 4; ++m) _Pragma("unroll") for (int k = 0; k < 2; ++k) dst[m][k] = *(const PG8_LAS bf16x8*)(lds + PG8_SA(b, h) + aoff + m * 2048 + k * 1024); } while (0)
#define PG8_LDB(dst, b, h) do { _Pragma("unroll") for (int n = 0; n < 2; ++n) _Pragma("unroll") for (int k = 0; k < 2; ++k) dst[n][k] = *(const PG8_LAS bf16x8*)(lds + PG8_SB(b, h) + boff + n * 2048 + k * 1024); } while (0)
#define PG8_MMA(ai, bj, At, Bt) do { __builtin_amdgcn_s_setprio(1); _Pragma("unroll") for (int m = 0; m < 4; ++m) _Pragma("unroll") for (int n = 0; n < 2; ++n) _Pragma("unroll") for (int k = 0; k < 2; ++k) \
        acc[ai][bj][m][n] = __builtin_amdgcn_mfma_f32_16x16x32_bf16(Bt[n][k], At[m][k], acc[ai][bj][m][n], 0, 0, 0); __builtin_amdgcn_s_setprio(0); } while (0)
#define PG8_WAIT_V(n) asm volatile("s_waitcnt vmcnt(" #n ")" ::: "memory")
#define PG8_WAIT_L(n) asm volatile("s_waitcnt lgkmcnt(" #n ")" ::: "memory")
#define PG8_BAR __builtin_amdgcn_s_barrier()
#define PG8_SCHED __builtin_amdgcn_sched_barrier(0)
    Unit cur, nxt; int ui = 0;
    if (!S.next(0, cur)) return;
    f32x4 acc[2][2][4][2];
#pragma unroll
    for (int a = 0; a < 2; ++a)
#pragma unroll
        for (int b = 0; b < 2; ++b)
#pragma unroll
            for (int m = 0; m < 4; ++m)
#pragma unroll
                for (int n = 0; n < 2; ++n) acc[a][b][m][n] = (f32x4){0.f, 0.f, 0.f, 0.f};
    bf16x8 At[4][2], B0[2][2], B1[2][2];
    const char* cA = (const char*)g.A + (size_t)cur.pm * tstep; const char* cB = (const char*)g.Bt + (size_t)cur.pn * tstep;
    S.a_ready(cur); E.prefetch(cur, 0, lds, wid, lane);
    if constexpr (SP2) {
        PG8_STAGE(PG8_SB(0, 0), cB, voffB); PG8_STAGE(PG8_SB(0, 1), cB + hstep, voffB); PG8_STAGE(PG8_SA(0, 0), cA, voffA); PG8_STAGE(PG8_SA(0, 1), cA + hstep, voffA);
        if (wr == 1) PG8_BAR;
        PG8_WAIT_V(2); PG8_BAR;
        PG8_STAGE(PG8_SB(1, 0), cB + kstep, voffB); PG8_STAGE(PG8_SA(1, 0), cA + kstep, voffA); PG8_STAGE(PG8_SB(1, 1), cB + hstep + kstep, voffB);
        PG8_WAIT_V(6); PG8_BAR;
    } else {
        PG8_STAGE(PG8_SB(0, 0), cB, voffB); PG8_STAGE(PG8_SA(0, 0), cA, voffA); PG8_STAGE(PG8_SB(0, 1), cB + hstep, voffB); PG8_STAGE(PG8_SA(0, 1), cA + hstep, voffA);
        if (wr == 1) PG8_BAR;
        PG8_WAIT_V(4); PG8_BAR;
        PG8_STAGE(PG8_SB(1, 0), cB + kstep, voffB); PG8_STAGE(PG8_SA(1, 0), cA + kstep, voffA); PG8_STAGE(PG8_SB(1, 1), cB + hstep + kstep, voffB);
        PG8_WAIT_V(6); PG8_BAR;
    }
    for (;;) {
        const bool has_next = S.next(ui + 1, nxt);
        const char* nA = has_next ? (const char*)g.A + (size_t)nxt.pm * tstep : cA; const char* nB = has_next ? (const char*)g.Bt + (size_t)nxt.pn * tstep : cB;
        for (int t = 0; t < nt; t += 2) {
            const bool last = (t == nt - 2);
            const char* a1 = cA + (size_t)(t + 1) * kstep;
            const char* a2 = last ? nA : cA + (size_t)(t + 2) * kstep; const char* b2 = last ? nB : cB + (size_t)(t + 2) * kstep;
            const char* a3 = a2 + kstep; const char* b3 = b2 + kstep;
            if (last && has_next) S.a_ready(nxt);
            if constexpr (SP2) {
            PG8_LDB(B0, 0, 0); PG8_LDB(B1, 0, 1); PG8_SCHED; PG8_LDA(At, 0, 0); PG8_STAGE(PG8_SA(1, 1), a1 + hstep, voffA);
            PG8_WAIT_V(8); PG8_WAIT_L(0); PG8_BAR; PG8_MMA(0, 0, At, B0); PG8_MMA(0, 1, At, B1); PG8_BAR; PG8_SCHED;
            PG8_LDA(At, 0, 1); PG8_STAGE(PG8_SB(0, 0), b2, voffB); PG8_STAGE(PG8_SB(0, 1), b2 + hstep, voffB); PG8_STAGE(PG8_SA(0, 0), a2, voffA);
            PG8_WAIT_V(8); PG8_WAIT_L(0); PG8_BAR; PG8_MMA(1, 0, At, B0); PG8_MMA(1, 1, At, B1); PG8_BAR; PG8_SCHED;
            PG8_LDB(B0, 1, 0); PG8_LDB(B1, 1, 1); PG8_SCHED; PG8_LDA(At, 1, 0); PG8_STAGE(PG8_SA(0, 1), a2 + hstep, voffA);
            PG8_WAIT_V(8); PG8_WAIT_L(0); PG8_BAR; PG8_MMA(0, 0, At, B0); PG8_MMA(0, 1, At, B1); PG8_BAR; PG8_SCHED;
            PG8_LDA(At, 1, 1); PG8_STAGE(PG8_SB(1, 0), b3, voffB); PG8_STAGE(PG8_SB(1, 1), b3 + hstep, voffB); PG8_STAGE(PG8_SA(1, 0), a3, voffA);
            PG8_WAIT_V(8); PG8_WAIT_L(0); PG8_BAR; PG8_MMA(1, 0, At, B0); PG8_MMA(1, 1, At, B1); PG8_BAR; PG8_SCHED;
            } else {
            PG8_LDB(B0, 0, 0); PG8_SCHED; PG8_LDA(At, 0, 0); PG8_STAGE(PG8_SA(1, 1), a1 + hstep, voffA);
            PG8_WAIT_L(8); PG8_BAR; PG8_WAIT_L(0); PG8_MMA(0, 0, At, B0); PG8_BAR; PG8_SCHED;
            PG8_LDB(B1, 0, 1); PG8_STAGE(PG8_SB(0, 0), b2, voffB);
            PG8_BAR; PG8_WAIT_L(0); PG8_MMA(0, 1, At, B1); PG8_BAR;
            PG8_LDA(At, 0, 1); PG8_STAGE(PG8_SA(0, 0), a2, voffA);
            PG8_BAR; PG8_WAIT_L(0); PG8_MMA(1, 0, At, B0); PG8_BAR; PG8_SCHED;
            PG8_STAGE(PG8_SB(0, 1), b2 + hstep, voffB);
            PG8_WAIT_V(6); PG8_BAR; PG8_MMA(1, 1, At, B1); PG8_BAR;
            PG8_LDB(B0, 1, 0); PG8_SCHED; PG8_LDA(At, 1, 0); PG8_STAGE(PG8_SA(0, 1), a2 + hstep, voffA);
            PG8_WAIT_L(8); PG8_BAR; PG8_WAIT_L(0); PG8_MMA(0, 0, At, B0); PG8_BAR; PG8_SCHED;
            PG8_LDB(B1, 1, 1); PG8_STAGE(PG8_SB(1, 0), b3, voffB);
            PG8_BAR; PG8_WAIT_L(0); PG8_MMA(0, 1, At, B1); PG8_BAR;
            PG8_LDA(At, 1, 1); PG8_STAGE(PG8_SA(1, 0), a3, voffA);
            PG8_BAR; PG8_WAIT_L(0); PG8_MMA(1, 0, At, B0); PG8_BAR; PG8_SCHED;
            PG8_STAGE(PG8_SB(1, 1), b3 + hstep, voffB);
            PG8_WAIT_V(6); PG8_BAR; PG8_MMA(1, 1, At, B1); PG8_BAR;
            }
        }
        if constexpr (ALIGN_EPI) { if (wr == 0) PG8_BAR; }
        if constexpr (!Epi::AFTER_DRAIN) { E(acc, cur, wr, wc, fr, fq, ui, lds); S.done(cur); if (has_next) E.prefetch(nxt, ui + 1, lds, wid, lane); }
        if (!has_next) break;
#pragma unroll
        for (int a = 0; a < 2; ++a)
#pragma unroll
            for (int b = 0; b < 2; ++b)
#pragma unroll
                for (int m = 0; m < 4; ++m)
#pragma unroll
                    for (int n = 0; n < 2; ++n) acc[a][b][m][n] = (f32x4){0.f, 0.f, 0.f, 0.f};
        cur = nxt; cA = nA; cB = nB; ++ui;
        if constexpr (ALIGN_EPI) { if (wr == 1) PG8_BAR; }
    }
    PG8_WAIT_V(0);
    if constexpr (!ALIGN_EPI) { if (wr == 0) PG8_BAR; }
    PG8_BAR;
    if constexpr (Epi::AFTER_DRAIN) { E.fused(acc, cur, wr, wc, fr, fq, lds, wid, lane); S.done(cur); }
#undef PG8_SA
#undef PG8_SB
#undef PG8_STAGE
#undef PG8_LDA
#undef PG8_LDB
#undef PG8_MMA
#undef PG8_WAIT_V
#undef PG8_WAIT_L
#undef PG8_BAR
#undef PG8_SCHED
}
}
constexpr int NB = 8, SEQ = 4096, DM = 1024, NTOK = NB * SEQ, INW = 3844, NPERM = 4096, NLAYER = 2;
constexpr size_t MiB = 1u << 20;
constexpr size_t WS_CTL = 0, CTL_ZERO_BYTES = 1 * MiB;
constexpr size_t WS_WIN = 2 * MiB;
constexpr size_t WS_WOUT = 18 * MiB;
constexpr size_t WS_LF = 22 * MiB;
constexpr size_t WS_RS = 26 * MiB;
constexpr size_t WS_TAB = 23 * MiB;
constexpr size_t WS_KM = 24 * MiB;
constexpr size_t WS_MF = 25 * MiB;
constexpr int CW_BAR = 4096;
constexpr int CW_RDY = 1024;
constexpr int CW_QUEUE = 64;
constexpr size_t WS_HN = 32 * MiB;
constexpr size_t WS_Q = 96 * MiB, WS_K = 160 * MiB, WS_V = 216 * MiB, WS_G = 272 * MiB, WS_X1 = 336 * MiB  , WS_X0 = 400 * MiB  , WS_END = 464 * MiB;
constexpr float LOG2E = 1.4426950408889634f;
constexpr int NWAVES = 8;
constexpr int NW_X = 4;
#define TIMER_SEL -1
#define TIMER_FS 100
#define TIMER_WG 37
#define TIMER_TYPE 1
#define PROBE_ATT 0
#define PROBE_REPS 2
#define PROBE_P1 0
#define PROBE_P3 0
#define PROBE_P0 0
#ifndef N_LAUNCHES
#define N_LAUNCHES 1
#endif
constexpr int RING_BYTES = 131072, LDSCTL_OFF = 139264, MISC_OFF = LDSCTL_OFF + 320, LDS_BYTES = 147456;

#define GAS __attribute__((address_space(1)))
#define LAS __attribute__((address_space(3)))
typedef unsigned short bf16;
typedef unsigned v4u __attribute__((ext_vector_type(4)));
typedef float f32x4 __attribute__((ext_vector_type(4)));
__device__ __forceinline__ unsigned f2bf(float f) { unsigned u = __builtin_bit_cast(unsigned, f); return (u + 0x7fffu + ((u >> 16) & 1u)) >> 16; }
typedef float f32x2h_t __attribute__((ext_vector_type(2))); typedef __bf16 bf16x2h_t __attribute__((ext_vector_type(2)));
__device__ __forceinline__ unsigned pk2(float lo, float hi) { f32x2h_t v = {lo, hi}; bf16x2h_t b = __builtin_convertvector(v, bf16x2h_t); return __builtin_bit_cast(unsigned, b); }
__device__ __forceinline__ float bf2f(unsigned v) { return __uint_as_float(v << 16); }
__device__ __forceinline__ float wave_sum(float v) {
#pragma unroll
    for (int o = 1; o < 64; o <<= 1) v += __shfl_xor(v, o);
    return v;
}
#define RLX_AGENT __ATOMIC_RELAXED, __HIP_MEMORY_SCOPE_AGENT
#define XB_TMO      128
#define XB_XCNT(j)  (256  + 64 * (j))
#define XB_XSUB(j)  (1280 + 64 * (j))
#define XB_XGEN(j)  (2304 + 64 * (j))
#define XB_TOP      3328
#define XB_TOPGEN   3392
#define XCD_BAR_WORDS 3456
#define XB_SPIN_CAP (1u << 18)

__device__ __forceinline__ unsigned xb_ld(unsigned* p)              { return __hip_atomic_load(p, __ATOMIC_RELAXED, __HIP_MEMORY_SCOPE_AGENT); }
__device__ __forceinline__ unsigned xb_add(unsigned* p, unsigned v) { return __hip_atomic_fetch_add(p, v, __ATOMIC_RELAXED, __HIP_MEMORY_SCOPE_AGENT); }
__device__ __forceinline__ unsigned xb_xcc_id() { return (unsigned)__builtin_amdgcn_s_getreg((3 << 11) | 20) & 0xFu; }
#define XB_SPIN(cond, bar) do { unsigned _sp = 0; while (cond) { __builtin_amdgcn_s_sleep(1); \
    if ((++_sp & 255u) == 0u) { if (xb_ld(&(bar)[XB_TMO])) break; if (_sp > XB_SPIN_CAP) { atomicAdd(&(bar)[XB_TMO], 1u); break; } } } } while (0)

struct XcdBarrier {
    unsigned* bar; unsigned x;
    volatile LAS unsigned* st;
};

__device__ __forceinline__ XcdBarrier xcd_barrier_post(unsigned* bar, volatile LAS unsigned* st) {
    XcdBarrier b; b.bar = bar; b.x = xb_xcc_id(); b.st = st;
    if (threadIdx.x == 0) (void)xb_add(&bar[XB_XCNT(b.x)], 1u);
    return b;
}
__device__ __forceinline__ void xcd_barrier_complete(unsigned* bar, unsigned x, unsigned& nloc, unsigned& nx) {
    const unsigned G = gridDim.x * gridDim.y * gridDim.z;
    unsigned sum, cnt, mine, sp = 0u;
    for (;;) {
        sum = 0u; cnt = 0u; mine = 0u;
#pragma unroll
        for (unsigned j = 0; j < 16; ++j) { const unsigned c = xb_ld(&bar[XB_XCNT(j)]); sum += c; cnt += (c > 0u) ? 1u : 0u; mine = (j == x) ? c : mine; }
        if (sum == G) break;
        __builtin_amdgcn_s_sleep(1);
        if ((++sp & 255u) == 0u) { if (xb_ld(&bar[XB_TMO])) break; if (sp > XB_SPIN_CAP) { atomicAdd(&bar[XB_TMO], 1u); break; } }
    }
    nloc = mine > 0u ? mine : 1u; nx = cnt > 0u ? cnt : 1u;
}

__device__ __forceinline__ void xcd_barrier(const XcdBarrier& b) {
    asm volatile("s_waitcnt vmcnt(0)" ::: "memory");
    __syncthreads();
    if (threadIdx.x == 0) {
        unsigned* bar = b.bar;
        __builtin_amdgcn_s_waitcnt(0);
        unsigned nloc = b.st[0], nx = b.st[1];
        if (nloc == 0u) { xcd_barrier_complete(bar, b.x, nloc, nx); b.st[0] = nloc; b.st[1] = nx; }
        const unsigned old = xb_add(&bar[XB_XSUB(b.x)], 1u);
        const unsigned gen = old / nloc;
        if (old + 1u == (gen + 1u) * nloc) {
            __builtin_amdgcn_fence(__ATOMIC_RELEASE, "agent");
            asm volatile("s_waitcnt vmcnt(0)" ::: "memory");
            const unsigned og = xb_add(&bar[XB_TOP], 1u);
            const unsigned tg = og / nx;
            if (og + 1u == (tg + 1u) * nx) xb_add(&bar[XB_TOPGEN], 1u);
            else XB_SPIN(xb_ld(&bar[XB_TOPGEN]) == tg, bar);
            __builtin_amdgcn_fence(__ATOMIC_ACQUIRE, "agent");
            xb_add(&bar[XB_XGEN(b.x)], 1u);
            asm volatile("s_waitcnt vmcnt(0)" ::: "memory");
        } else {
            XB_SPIN(xb_ld(&bar[XB_XGEN(b.x)]) == gen, bar);
            __builtin_amdgcn_fence(__ATOMIC_ACQUIRE, "agent");
            asm volatile("s_waitcnt vmcnt(0)" ::: "memory");
        }
    }
    __syncthreads();
}

__device__ __forceinline__ int rel_bucket(int d) {
    if (d < 16) return d;
    int b = 16;
    b += (d >= 21); b += (d >= 27); b += (d >= 35); b += (d >= 46); b += (d >= 59); b += (d >= 77); b += (d >= 99); b += (d >= 128);
    b += (d >= 166); b += (d >= 216); b += (d >= 280); b += (d >= 363); b += (d >= 470); b += (d >= 609); b += (d >= 790);
    return b;
}

struct Args { const float* x; const float* norm_gain; const float* w_in; const float* b_forget; const float* fox_g; const float* moba_g; const float* swa_g; const float* sinks; const float* w_out; const float* rel_bias; float* out; unsigned char* ws; int ph_lo, ph_hi, tmask, pad; };

struct Frame { LAS unsigned char* lds; int tid, lane, wave, vcu, G; };

__device__ __forceinline__ void transpose_item(const float* W, int ldw, bf16* WT, int dst_row0, int src_col0, int ncol, const float* gk, LAS float* scr, int kb, int lane) {
    const int k0 = 64 * kb;
    { float wv[32]; const int c = lane & 31;
#pragma unroll
        for (int i = 0; i < 32; ++i) { const int kk = 2 * i + (lane >> 5); wv[i] = (c < ncol) ? W[(size_t)(k0 + kk) * ldw + src_col0 + c] : 0.f; }
        if (gk) {
#pragma unroll
            for (int i = 0; i < 32; ++i) wv[i] *= gk[k0 + 2 * i + (lane >> 5)]; }
#pragma unroll
        for (int i = 0; i < 32; ++i) scr[(2 * i + (lane >> 5)) * 33 + c] = wv[i]; }
    asm volatile("s_waitcnt lgkmcnt(0)" ::: "memory");
    const int c = lane & 7;
#pragma unroll
    for (int j = 0; j < 4; ++j) { const int n = (lane >> 3) + 8 * j; const LAS float* s = scr + (8 * c) * 33 + n;
        v4u o; o.x = pk2(s[0 * 33], s[1 * 33]); o.y = pk2(s[2 * 33], s[3 * 33]); o.z = pk2(s[4 * 33], s[5 * 33]); o.w = pk2(s[6 * 33], s[7 * 33]);
        *(v4u*)(WT + (size_t)(dst_row0 + n) * 1024 + k0 + 8 * c) = o; }
    asm volatile("s_waitcnt lgkmcnt(0)" ::: "memory");
}
__device__ __forceinline__ int tile_src(int T, int wc) {
    switch (T) { case 0: return 0 + 64 * wc; case 1: return 256 + 64 * wc; case 2: return 512 + 64 * wc; case 3: return 772 + 64 * wc;
        case 4: return 1028 + 64 * wc; case 5: return 1284 + 64 * wc; case 6: return 1540 + 64 * wc; case 7: return 1796 + 64 * wc;
        case 8: return 2052 + 64 * wc; case 9: return 2308 + 64 * wc; case 10: return 2564 + 64 * wc; case 11: return 2820 + 64 * wc;
        case 12: return 3076 + 64 * wc; case 13: return wc < 2 ? 3332 + 64 * wc : 3460 + 64 * (wc - 2); default: return 3588 + 64 * wc; }
}
__device__ __forceinline__ void p_weights(Frame& F, const Args& a) {
    LAS float* scr = (LAS float*)(F.lds + F.wave * 16384);
    const int gw = F.vcu * (NWAVES - NW_X) + (F.wave - NW_X), NGW = F.G * (NWAVES - NW_X);
    bf16* win = (bf16*)(a.ws + WS_WIN); bf16* wout = (bf16*)(a.ws + WS_WOUT);
    constexpr int I_IN = 128 * 16, I_OUT = 32 * 16;
    for (int it = gw; it < 2 * (I_IN + I_OUT); it += NGW) {
        const int layer = it / (I_IN + I_OUT); int r = it % (I_IN + I_OUT);
        if (r < I_IN) { const int kb = r >> 7, g = r & 127, T = g >> 3, gg = g & 7, bj = gg >> 2, wc = gg & 3;
            const int src = (T < 15) ? tile_src(T, wc) + 32 * bj : 768, ncol = (T < 15) ? 32 : (gg == 0 ? 4 : 0);
            transpose_item(a.w_in + (size_t)layer * DM * INW, INW, win + (size_t)layer * NPERM * DM, 32 * g, src, ncol, a.norm_gain + layer * DM, scr, kb, F.lane); }
        else { r -= I_IN; const int kb = r / 32, g = r % 32;
            transpose_item(a.w_out + (size_t)layer * DM * DM, DM, wout + (size_t)layer * DM * DM, 32 * g, 32 * g, 32, nullptr, scr, kb, F.lane); }
    }
}
__device__ __forceinline__ void p_tables(Frame& F, const Args& a) {
    { float* tab = (float*)(a.ws + WS_TAB);
        for (int i = F.vcu * (NWAVES * 64) + F.tid; i < 8 * 1024; i += F.G * NWAVES * 64) { const int hc = i >> 10, d = i & 1023; tab[i] = a.rel_bias[rel_bucket(d) * 8 + hc] * LOG2E; } }
}
__device__ __forceinline__ void p_consts(Frame& F, const Args& a) {
    if (F.wave == 0) for (int layer = 0; layer < NLAYER; ++layer) if (F.vcu == (F.G - 1 - layer)) {
        const int lane = F.lane; float* MF = (float*)(a.ws + WS_MF) + layer * 4;
        float bm = 0.f;
#pragma unroll
        for (int j = 0; j < 4; ++j) bm = fmaxf(bm, fabsf(a.rel_bias[64 * j + lane]));
#pragma unroll
        for (int o = 1; o < 64; o <<= 1) bm = fmaxf(bm, __shfl_xor(bm, o));
        const float* gp[3] = {a.fox_g + layer * 128, a.moba_g + layer * 128, a.swa_g + layer * 128};
#pragma unroll
        for (int k = 0; k < 3; ++k) { float mq = fabsf(gp[k][lane]), mk = fabsf(gp[k][64 + lane]);
#pragma unroll
            for (int o = 1; o < 64; o <<= 1) { mq = fmaxf(mq, __shfl_xor(mq, o)); mk = fmaxf(mk, __shfl_xor(mk, o)); }
            const float m = 8.f * LOG2E * mq * mk * 1.02f + 0.1f + (k == 0 ? 0.f : bm * LOG2E);
            if (lane == 0) MF[k == 0 ? 0 : (k == 1 ? 1 : 3)] = m; }
        if (lane == 0) MF[2] = 0.f;
    }
}
__device__ __forceinline__ void p_convert(Frame& F, const Args& a) {
    const int lane = F.lane, gt = F.vcu * (NW_X * 64) + F.tid, NT_ = F.G * (NW_X * 64);
    { float* KM = (float*)(a.ws + WS_KM); for (int i = gt; i < 2 * 32 * 16 * 64; i += NT_) KM[i] = 0.f;
      float* RS1 = (float*)(a.ws + WS_RS) + NTOK; for (int i = gt; i < NTOK; i += NT_) RS1[i] = 0.f; }
    bf16* XB = (bf16*)(a.ws + WS_X0); float* RS0 = (float*)(a.ws + WS_RS);
    const int gwv = F.vcu * NW_X + F.wave, NGW = F.G * NW_X;
    for (int r0 = 4 * gwv; r0 < NTOK; r0 += 4 * NGW) {
        f32x4 v[4][4];
#pragma unroll
        for (int rr = 0; rr < 4; ++rr) { const f32x4* xr = (const f32x4*)(a.x + (size_t)(r0 + rr) * DM) + lane;
#pragma unroll
            for (int j = 0; j < 4; ++j) v[rr][j] = __builtin_nontemporal_load(xr + 64 * j); }
        float ss[4];
#pragma unroll
        for (int rr = 0; rr < 4; ++rr) { ss[rr] = 0.f; unsigned long long* o8 = (unsigned long long*)(XB + (size_t)(r0 + rr) * DM) + lane;
#pragma unroll
            for (int j = 0; j < 4; ++j) { const f32x4 y = v[rr][j]; ss[rr] += (y[0] * y[0] + y[1] * y[1]) + (y[2] * y[2] + y[3] * y[3]);
                __builtin_nontemporal_store((unsigned long long)pk2(y[0], y[1]) | ((unsigned long long)pk2(y[2], y[3]) << 32), o8 + 64 * j); } }
#pragma unroll
        for (int o = 1; o < 64; o <<= 1)
#pragma unroll
            for (int rr = 0; rr < 4; ++rr) ss[rr] += __shfl_xor(ss[rr], o);
        if (lane < 4) RS0[r0 + lane] = lane == 0 ? ss[0] : (lane == 1 ? ss[1] : (lane == 2 ? ss[2] : ss[3]));
    }
}
namespace att {
using bf16x8 = __attribute__((ext_vector_type(8))) short;
using s16x4 = __attribute__((ext_vector_type(4))) short;
using f32x16 = __attribute__((ext_vector_type(16))) float;
using u32x4 = __attribute__((ext_vector_type(4))) unsigned;
typedef __attribute__((address_space(3))) const char* lds_cptr;
typedef __attribute__((address_space(3))) char* lds_ptr;
typedef short v4i16_t __attribute__((ext_vector_type(4)));
typedef float f32x2_t __attribute__((ext_vector_type(2))); typedef __bf16 bf16x2_t __attribute__((ext_vector_type(2)));
constexpr int NSLOT = 5, PFD = 2, SLOTB = 8192;
constexpr int L_K = 0, L_V = NSLOT * SLOTB, L_OST = 0  , L_WS = 2 * NSLOT * SLOTB, L_CS = L_WS + 8 * 256, L_TAB = L_CS + 16384, L_G = L_TAB + 4608, L_MISC = L_G + 8 * 4096, L_END = L_MISC + 1024;
static_assert(L_END <= 139264 && 8 * 4096 <= NSLOT * SLOTB, "attention LDS map (the kernel's control words start at 136 KiB)");
constexpr float THR2 = 44.f;
#define SBAR() __builtin_amdgcn_sched_barrier(0)
__device__ __forceinline__ int crow(int r, int hi) { return (r & 3) + 8 * (r >> 2) + 4 * hi; }
__device__ __forceinline__ void glds16(const void* gsrc, unsigned lds_dst) { unsigned keep;
    asm volatile("s_mov_b32 %0, m0\n\ts_mov_b32 m0, %2\n\ts_nop 0\n\tglobal_load_lds_dwordx4 %1, off\n\ts_mov_b32 m0, %0" : "=&s"(keep) : "v"(gsrc), "s"(lds_dst) : "memory"); }
__device__ __forceinline__ unsigned cvtpk_s(float lo, float hi) { f32x2_t v = {lo, hi}; bf16x2_t b = __builtin_convertvector(v, bf16x2_t); return __builtin_bit_cast(unsigned, b); }
__device__ __forceinline__ s16x4 vtr(lds_cptr p) { return __builtin_bit_cast(s16x4, __builtin_amdgcn_ds_read_tr16_b64_v4i16((__attribute__((address_space(3))) v4i16_t*)p)); }
#define MFMA32(a, b, c) __builtin_amdgcn_mfma_f32_32x32x16_bf16(a, b, c, 0, 0, 0)
__device__ __forceinline__ void qkt(f32x16& p0, f32x16& p1, lds_cptr kp, const bf16x8* qr, float cinit) {
    f32x16 c;
#pragma unroll
    for (int r = 0; r < 16; ++r) c[r] = cinit;
    p0 = c; p1 = c;
#pragma unroll
    for (int d0 = 0; d0 < 4; ++d0) {
        const bf16x8 b0 = *(const __attribute__((address_space(3))) bf16x8*)(kp + d0 * 2048);
        const bf16x8 b1 = *(const __attribute__((address_space(3))) bf16x8*)(kp + d0 * 2048 + 512);
        p0 = MFMA32(b0, qr[d0], p0); p1 = MFMA32(b1, qr[d0], p1);
    }
}
__device__ __forceinline__ void pv(f32x16* o, lds_cptr vp, bf16x8 pa0, bf16x8 pa1, bf16x8 pa2, bf16x8 pa3) {
#pragma unroll
    for (int d0 = 0; d0 < 2; ++d0) { s16x4 lo[4], hi[4];
#pragma unroll
        for (int ks = 0; ks < 4; ++ks) { lo[ks] = vtr(vp + d0 * 4096 + ks * 1024); hi[ks] = vtr(vp + d0 * 4096 + ks * 1024 + 512); }
#define PK(k) (bf16x8){lo[k][0], lo[k][1], lo[k][2], lo[k][3], hi[k][0], hi[k][1], hi[k][2], hi[k][3]}
        o[d0] = MFMA32(pa0, PK(0), o[d0]); o[d0] = MFMA32(pa1, PK(1), o[d0]); o[d0] = MFMA32(pa2, PK(2), o[d0]); o[d0] = MFMA32(pa3, PK(3), o[d0]);
#undef PK
    }
}
__device__ __forceinline__ void kload(bf16x8* kf, lds_cptr kp) {
#pragma unroll
    for (int d0 = 0; d0 < 4; ++d0) { kf[2 * d0] = *(const __attribute__((address_space(3))) bf16x8*)(kp + d0 * 2048); kf[2 * d0 + 1] = *(const __attribute__((address_space(3))) bf16x8*)(kp + d0 * 2048 + 512); }
}
__device__ __forceinline__ void kload2(bf16x8* kf, lds_cptr kpe, lds_cptr kpo) {
#pragma unroll
    for (int d0 = 0; d0 < 4; ++d0) { const lds_cptr p = ((d0 & 1) ? kpo : kpe) + (d0 >> 1) * 1024;
        kf[2 * d0] = *(const __attribute__((address_space(3))) bf16x8*)(p); kf[2 * d0 + 1] = *(const __attribute__((address_space(3))) bf16x8*)(p + 4096); }
}
__device__ __forceinline__ void vload(s16x4* vlo, s16x4* vhi, lds_cptr vp) {
#pragma unroll
    for (int i = 0; i < 8; ++i) { vlo[i] = vtr(vp + (i >> 2) * 4096 + (i & 3) * 1024); vhi[i] = vtr(vp + (i >> 2) * 4096 + (i & 3) * 1024 + 512); }
}
__device__ __forceinline__ void qkt_r(f32x16& p0, f32x16& p1, const bf16x8* kf, const bf16x8* qr, float cinit) {
    f32x16 c;
#pragma unroll
    for (int r = 0; r < 16; ++r) c[r] = cinit;
    p0 = c; p1 = c;
#pragma unroll
    for (int d0 = 0; d0 < 4; ++d0) { p0 = MFMA32(kf[2 * d0], qr[d0], p0); p1 = MFMA32(kf[2 * d0 + 1], qr[d0], p1); }
}
__device__ __forceinline__ void pv_r(f32x16* o, const s16x4* vlo, const s16x4* vhi, bf16x8 pa0, bf16x8 pa1, bf16x8 pa2, bf16x8 pa3) {
#define VFR(i) (bf16x8){vlo[i][0], vlo[i][1], vlo[i][2], vlo[i][3], vhi[i][0], vhi[i][1], vhi[i][2], vhi[i][3]}
    o[0] = MFMA32(pa0, VFR(0), o[0]); o[1] = MFMA32(pa0, VFR(4), o[1]); o[0] = MFMA32(pa1, VFR(1), o[0]); o[1] = MFMA32(pa1, VFR(5), o[1]);
    o[0] = MFMA32(pa2, VFR(2), o[0]); o[1] = MFMA32(pa2, VFR(6), o[1]); o[0] = MFMA32(pa3, VFR(3), o[0]); o[1] = MFMA32(pa3, VFR(7), o[1]);
#undef VFR
}
struct ACtx { const bf16 *Q, *K, *V, *G; bf16* Y; const float *LF, *TAB, *KM, *MF; const float* sinks; int tflag; };
#define WAITBAR(N) asm volatile("s_waitcnt vmcnt(" #N ") lgkmcnt(0)\n\ts_barrier" ::: "memory")

#define USTAMP(k) do { if (TIMER_SEL >= 0 && TYPE == TIMER_TYPE && C.tflag && tid == 0) { volatile __attribute__((address_space(3))) unsigned* ta_ = (volatile __attribute__((address_space(3))) unsigned*)(shm + 139264 + 320) + 16; const unsigned now_ = (unsigned)__builtin_amdgcn_s_memrealtime(); ta_[k] += now_ - ta_[31]; ta_[31] = now_; } } while (0)
__device__ __forceinline__ int ticket_type(int u) { const int ty = u >> 9; return ty == 0 ? 1 : (ty == 1 ? 0 : ty); }
__device__ __forceinline__ void prefetch_unit(const ACtx& C, int u, lds_ptr shm, bf16x8* qn) {
    int tid = threadIdx.x; asm volatile("" : "+v"(tid));
    const int lane = tid & 63, r32 = lane & 31, hi = lane >> 5; const int wid = __builtin_amdgcn_readfirstlane(tid >> 6);
    const int T = ticket_type(u), r = u & 511, qb = 15 - (r >> 5), bh = r & 31, b = bh >> 2, h = bh & 3;
    const int kvh = (T == 3) ? (b * 2 + (h >> 1)) : bh;
    const bf16* Kh = C.K + T * pg8::GS + (size_t)kvh * SEQ * 64; const bf16* Vh = C.V + T * pg8::GS + (size_t)kvh * SEQ * 64;
    const bf16* ksrc = Kh + wid * 512 + (lane >> 2) * 32 + (((lane & 3) ^ ((lane >> 4) & 3)) * 8);
    const bf16* vsrc = Vh + ((wid & 3) * 2 + (wid >> 2)) * 512 + (lane >> 2) * 32 + 8 * (lane & 3);
    const unsigned lds0 = (unsigned)(size_t)shm, kdst = lds0 + L_K + wid * 1024, vdst = lds0 + L_V + wid * 1024;
    const int t_hi = 4 * qb + 3;
    glds16(ksrc + (size_t)t_hi * 4096, (unsigned)__builtin_amdgcn_readfirstlane(kdst)); glds16(vsrc + (size_t)t_hi * 4096, (unsigned)__builtin_amdgcn_readfirstlane(vdst));
    glds16(ksrc + (size_t)(t_hi - 1) * 4096, (unsigned)__builtin_amdgcn_readfirstlane(kdst + SLOTB)); glds16(vsrc + (size_t)(t_hi - 1) * 4096, (unsigned)__builtin_amdgcn_readfirstlane(vdst + SLOTB));
    const bf16* Qw = C.Q + T * pg8::GS + ((size_t)bh * SEQ + qb * 256 + wid * 32) * 64;
#pragma unroll
    for (int d0 = 0; d0 < 4; ++d0) qn[d0] = *reinterpret_cast<const bf16x8*>(&Qw[((r32 >> 4) * 2 + (d0 >> 1)) * 512 + (r32 & 15) * 32 + 16 * (d0 & 1) + 8 * hi]);
}
template <int TYPE> __device__ __forceinline__ int attn_unit(const ACtx& C, int bh, int qb, lds_ptr shm, bf16x8 (&qr)[4], int tick, __attribute__((address_space(3))) int* tslot, unsigned* rdy_prev) {
    int tid = threadIdx.x; asm volatile("" : "+v"(tid));
    const int lane = tid & 63, r32 = lane & 31, hi = lane >> 5; const int wid = __builtin_amdgcn_readfirstlane(tid >> 6);
    const int b = bh >> 2, h = bh & 3, q0 = qb * 256, qrel = wid * 32 + r32, t = q0 + qrel;
    const int kvh = (TYPE == 3) ? (b * 2 + (h >> 1)) : bh;
    const bf16* Qw = C.Q + TYPE * pg8::GS + ((size_t)bh * SEQ + q0 + wid * 32) * 64;
    const bf16* Kh = C.K + TYPE * pg8::GS + (size_t)kvh * SEQ * 64; const bf16* Vh = C.V + TYPE * pg8::GS + (size_t)kvh * SEQ * 64;
    const unsigned lds0 = (unsigned)(size_t)shm;
    __attribute__((address_space(3))) float* wsf = (__attribute__((address_space(3))) float*)(shm + L_WS) + wid * 64;
    __attribute__((address_space(3))) float* tabL = (__attribute__((address_space(3))) float*)(shm + L_TAB);
    __attribute__((address_space(3))) float* cs = (__attribute__((address_space(3))) float*)(shm + L_CS);
    __attribute__((address_space(3))) float* misc = (__attribute__((address_space(3))) float*)(shm + L_MISC);
    __attribute__((address_space(3))) int* misci = (__attribute__((address_space(3))) int*)(shm + L_MISC);
    const bf16* ksrc = Kh + wid * 512 + (lane >> 2) * 32 + (((lane & 3) ^ ((lane >> 4) & 3)) * 8);
    const bf16* vsrc = Vh + ((wid & 3) * 2 + (wid >> 2)) * 512 + (lane >> 2) * 32 + 8 * (lane & 3);
    const unsigned kdst = lds0 + L_K + wid * 1024, vdst = lds0 + L_V + wid * 1024;
#define DMA_KV(tile, slot) do { glds16(ksrc + (size_t)(tile) * 4096, (unsigned)__builtin_amdgcn_readfirstlane(kdst + (slot) * SLOTB)); glds16(vsrc + (size_t)(tile) * 4096, (unsigned)__builtin_amdgcn_readfirstlane(vdst + (slot) * SLOTB)); } while (0)
    const unsigned koff_e = L_K + ((r32 >> 4) * 2) * 1024 + (r32 & 15) * 64 + ((hi ^ ((r32 >> 2) & 3)) * 16);
    const lds_cptr kpe = (lds_cptr)shm + koff_e, kpo = (lds_cptr)shm + (koff_e ^ 32u);
    const lds_cptr vp0 = (lds_cptr)shm + L_V + ((lane >> 4) & 1) * 32 + (lane & 3) * 8 + (4 * hi + ((lane & 15) >> 2)) * 64;
    const float Mf = (TYPE == 2) ? 0.f : C.MF[TYPE];
    const int t_hi = 4 * qb + 3; int t_lo = 0;
    if (TYPE == 3) { t_lo = 4 * qb - 2; if (t_lo < 0) t_lo = 0; }
    USTAMP(24);
    const size_t yrow0 = (size_t)(b * SEQ + q0 + wid * 32);
    { const bf16* gslab = C.G + (size_t)(TYPE * 32 + bh) * 262144 + (size_t)(q0 + wid * 32) * 64;
#pragma unroll
        for (int i = 0; i < 4; ++i) { const int row = 8 * i + (lane >> 3);
            glds16(gslab + ((row >> 4) * 2 + ((lane & 7) >> 2)) * 512 + (row & 15) * 32 + 8 * (lane & 3), (unsigned)__builtin_amdgcn_readfirstlane(lds0 + L_G + wid * 4096 + i * 1024)); } }
    unsigned sel = 0u; float ct = 0.f;
    if (TYPE == 0) {
        const float* lfp = C.LF + (size_t)bh * SEQ; const bool on = 8 * tid < q0 + 256;
        f32x4 a4 = {0.f, 0.f, 0.f, 0.f}, b4 = {0.f, 0.f, 0.f, 0.f};
        if (on) { a4 = *(const f32x4*)(lfp + 8 * tid); b4 = *(const f32x4*)(lfp + 8 * tid + 4); }
        a4[1] += a4[0]; a4[2] += a4[1]; a4[3] += a4[2]; b4[0] += a4[3]; b4[1] += b4[0]; b4[2] += b4[1]; b4[3] += b4[2];
        float sc = b4[3];
#pragma unroll
        for (int o = 1; o < 64; o <<= 1) { const float u = __shfl_up(sc, o); if (lane >= o) sc += u; }
        if (lane == 63) misc[wid] = sc;
        __syncthreads();
        float base = sc - b4[3];
#pragma unroll
        for (int w = 0; w < 7; ++w) if (w < wid) base += misc[w];
        if (on) { *(__attribute__((address_space(3))) f32x4*)(cs + 8 * tid) = a4 + base; *(__attribute__((address_space(3))) f32x4*)(cs + 8 * tid + 4) = b4 + base; }
        __syncthreads();
        const float cref = cs[q0];
        if (wid == 0) { const bool skip = (lane < 4 * qb) && (cs[64 * lane + 63] - cref > 2.f * Mf + THR2);
            const int cnt = __popcll(__ballot(skip)); if (lane == 0) misci[40] = cnt; }
        __syncthreads();
        t_lo = misci[40]; ct = cs[t];
    }
    if (TYPE == 1 || TYPE == 3) {
        const float* tg = C.TAB + ((TYPE == 3 ? 4 : 0) + h) * 1024;
        { float tv[3]; const float b31 = (TYPE == 1) ? tg[1023] : 0.f; float k0 = 0.f, k1 = 0.f;
#pragma unroll
            for (int k = 0; k < 3; ++k) { const int j = tid + 512 * k, d = 1023 - j; tv[k] = (j < 1088 && d >= 0 && (TYPE == 1 || d < 128)) ? tg[d] - b31 : -INFINITY; }
            if (TYPE == 1) { const float* kg = C.KM + (size_t)bh * 16 * 64; if (tid < qb * 64) k0 = kg[tid]; if (tid + 512 < qb * 64) k1 = kg[tid + 512]; }
#pragma unroll
            for (int k = 0; k < 3; ++k) { const int j = tid + 512 * k; if (j < 1088) tabL[j] = tv[k]; }
            if (TYPE == 1) { cs[tid] = k0; cs[tid + 512] = k1; } }
        __syncthreads();
        if (TYPE == 1) {
            if (qb <= 3) sel = (1u << qb) - 1u;
            else {
                float qf[32];
#pragma unroll
                for (int d0 = 0; d0 < 4; ++d0) { const u32x4 w = __builtin_bit_cast(u32x4, qr[d0]);
#pragma unroll
                    for (int j = 0; j < 4; ++j) { qf[d0 * 8 + 2 * j] = __uint_as_float(w[j] << 16); qf[d0 * 8 + 2 * j + 1] = __uint_as_float(w[j] & 0xffff0000u); } }
                float v1 = -INFINITY, v2 = -INFINITY, v3 = -INFINITY; int i1 = 0, i2 = 0, i3 = 0;
                for (int n = 0; n < qb; ++n) { float s = 0.f;
#pragma unroll
                    for (int d0 = 0; d0 < 4; ++d0) { const f32x4 ka = *(const __attribute__((address_space(3))) f32x4*)(cs + n * 64 + d0 * 16 + hi * 8), kb4 = *(const __attribute__((address_space(3))) f32x4*)(cs + n * 64 + d0 * 16 + hi * 8 + 4);
#pragma unroll
                        for (int j = 0; j < 4; ++j) { s += qf[d0 * 8 + j] * ka[j]; s += qf[d0 * 8 + 4 + j] * kb4[j]; } }
                    { auto rr = __builtin_amdgcn_permlane32_swap(__float_as_uint(s), __float_as_uint(s), false, false); s = __uint_as_float(rr[0]) + __uint_as_float(rr[1]); }
                    if (s > v1) { v3 = v2; i3 = i2; v2 = v1; i2 = i1; v1 = s; i1 = n; } else if (s > v2) { v3 = v2; i3 = i2; v2 = s; i2 = n; } else if (s > v3) { v3 = s; i3 = n; } }
                sel = (1u << i1) | (1u << i2) | (1u << i3); }
        }
    }
    const int n_tiles = t_hi - t_lo + 1;
    asm volatile("" : "+v"(qr[0]), "+v"(qr[1]), "+v"(qr[2]), "+v"(qr[3]));
    f32x16 o[2]; o[0] = f32x16{}; o[1] = f32x16{}; f32x16 lacc = f32x16{};
    float carry = (TYPE == 2) ? 1.f : 0.f; bool done_w = false;
    f32x16 cvec;
    { const float c0_ = (TYPE == 2) ? 0.f : ((TYPE == 0) ? ct - Mf : -Mf);
#pragma unroll
        for (int r = 0; r < 16; ++r) cvec[r] = c0_; }
    asm volatile("" : "+v"(cvec));
    const bf16x8 ones = {0x3f80, 0x3f80, 0x3f80, 0x3f80, 0x3f80, 0x3f80, 0x3f80, 0x3f80};
    const int jdiag = wid >> 1;
    const int jlo_w = (TYPE == 3) ? ((32 * wid - 127) >> 6) : -100000;
    if (TYPE == 2) { if (tid < 16) misci[64 + tid] = 0; }
    USTAMP(21);
    if (TIMER_SEL == 98 && TYPE == TIMER_TYPE && C.tflag && tid == 0) { volatile __attribute__((address_space(3))) unsigned* ta_ = (volatile __attribute__((address_space(3))) unsigned*)(shm + 139264 + 320) + 16; ta_[26] = (unsigned)__builtin_amdgcn_s_memtime(); }
    bf16x8 kf[8]; s16x4 vlo[8], vhi[8]; f32x16 p0, p1;
    const bool late = false;
#define FINISH(tile_, jr_, slot_) do { \
            vload(vlo, vhi, vp0 + (slot_) * SLOTB); SBAR(); \
            const int kb = 64 * (jr_) + 4 * hi; \
            unsigned keepm = 0xffffffffu; \
            if (TYPE == 0) { \
            _Pragma("unroll") \
                for (int g4 = 0; g4 < 4; ++g4) { const f32x4 c0 = *(const __attribute__((address_space(3))) f32x4*)(cs + 64 * (tile_) + 8 * g4 + 4 * hi), c1 = *(const __attribute__((address_space(3))) f32x4*)(cs + 64 * (tile_) + 32 + 8 * g4 + 4 * hi); \
            _Pragma("unroll") \
                    for (int j = 0; j < 4; ++j) { p0[4 * g4 + j] -= c0[j]; p1[4 * g4 + j] -= c1[j]; } } \
                if ((jr_) == jdiag) { \
            _Pragma("unroll") \
                    for (int r = 0; r < 16; ++r) { const int kv = kb + (r & 3) + 8 * (r >> 2); if (kv > qrel) p0[r] = -INFINITY; if (kv + 32 > qrel) p1[r] = -INFINITY; } } \
            _Pragma("unroll") \
                for (int r = 0; r < 16; ++r) { p0[r] = __builtin_amdgcn_exp2f(p0[r]); p1[r] = __builtin_amdgcn_exp2f(p1[r]); } \
            } \
            if (TYPE == 1 || TYPE == 3) { \
                const bool far = (TYPE == 1) && ((q0 + 32 * wid - 64 * (tile_) - 63) >= 790); \
                if (!far) { const __attribute__((address_space(3))) float* tp_ = tabL + (1023 - (qrel - kb)); \
            _Pragma("unroll") \
                    for (int r = 0; r < 16; ++r) { p0[r] += tp_[(r & 3) + 8 * (r >> 2)]; p1[r] += tp_[(r & 3) + 8 * (r >> 2) + 32]; } } \
                if (TYPE == 1 && (jr_) < 0) keepm = ((sel >> ((tile_) >> 2)) & 1u) ? 0xffffffffu : 0u; \
            _Pragma("unroll") \
                for (int r = 0; r < 16; ++r) { p0[r] = __builtin_amdgcn_exp2f(p0[r]); p1[r] = __builtin_amdgcn_exp2f(p1[r]); } \
            } \
            if (TYPE == 2) { \
                f32x16 w0, w1; \
            _Pragma("unroll") \
                for (int r = 0; r < 16; ++r) { float c0_, c1_; asm("v_min_f32_e32 %0, 0x42a00000, %1" : "=v"(c0_) : "v"(p0[r])); asm("v_min_f32_e32 %0, 0x42a00000, %1" : "=v"(c1_) : "v"(p1[r])); p0[r] = __builtin_amdgcn_exp2f(c0_); p1[r] = __builtin_amdgcn_exp2f(c1_); } \
                if ((jr_) == jdiag) { \
            _Pragma("unroll") \
                    for (int r = 0; r < 16; ++r) { const int kv = kb + (r & 3) + 8 * (r >> 2); if (kv >= qrel) p0[r] = 0.f; if (kv + 32 >= qrel) p1[r] = 0.f; } } \
            _Pragma("unroll") \
                for (int r = 0; r < 16; ++r) { w0[r] = 1.f + p0[r]; w1[r] = 1.f + p1[r]; } \
                float own[8], part[8]; \
            _Pragma("unroll") \
                for (int rb = 0; rb < 4; ++rb) { own[rb] = (w0[4 * rb] * w0[4 * rb + 1]) * (w0[4 * rb + 2] * w0[4 * rb + 3]); own[4 + rb] = (w1[4 * rb] * w1[4 * rb + 1]) * (w1[4 * rb + 2] * w1[4 * rb + 3]); } \
            _Pragma("unroll") \
                for (int rb = 0; rb < 8; ++rb) { auto rr = __builtin_amdgcn_permlane32_swap(__float_as_uint(own[rb]), __float_as_uint(own[rb]), false, false); part[rb] = __uint_as_float(hi ? rr[0] : rr[1]); } \
                float run = carry; \
            _Pragma("unroll") \
                for (int rb = 7; rb >= 0; --rb) { \
                    float E = hi == 0 ? run * part[rb] : run; run *= own[rb] * part[rb]; \
            _Pragma("unroll") \
                    for (int j = 3; j >= 0; --j) { const int r = 4 * (rb & 3) + j; \
                        if (rb >= 4) { E *= w1[r]; p1[r] *= __builtin_amdgcn_rcpf(E); } else { E *= w0[r]; p0[r] *= __builtin_amdgcn_rcpf(E); } } } \
                carry = run; \
                done_w = __all(carry > 1.7592186e13f) != 0;     \
            } \
            u32x4 pw0, pw1, pw2, pw3; \
            _Pragma("unroll") \
            for (int j = 0; j < 4; ++j) { pw0[j] = cvtpk_s(p0[2 * j], p0[2 * j + 1]); pw1[j] = cvtpk_s(p0[8 + 2 * j], p0[9 + 2 * j]); pw2[j] = cvtpk_s(p1[2 * j], p1[2 * j + 1]); pw3[j] = cvtpk_s(p1[8 + 2 * j], p1[9 + 2 * j]); } \
            if (TYPE == 1) { pw0 &= keepm; pw1 &= keepm; pw2 &= keepm; pw3 &= keepm; } \
            const bf16x8 pa0 = __builtin_bit_cast(bf16x8, pw0), pa1 = __builtin_bit_cast(bf16x8, pw1), pa2 = __builtin_bit_cast(bf16x8, pw2), pa3 = __builtin_bit_cast(bf16x8, pw3); \
            pv_r(o, vlo, vhi, pa0, pa1, pa2, pa3); \
            if (TYPE != 2) { lacc = MFMA32(pa0, ones, lacc); lacc = MFMA32(pa1, ones, lacc); lacc = MFMA32(pa2, ones, lacc); lacc = MFMA32(pa3, ones, lacc); } \
        } while (0)
#define SCORE(slot_) do { kload2(kf, kpe + (slot_) * SLOTB, kpo + (slot_) * SLOTB); SBAR(); \
        if (TYPE == 2) { p0 = MFMA32(kf[0], qr[0], (f32x16{})); p1 = MFMA32(kf[1], qr[0], (f32x16{})); } else { p0 = MFMA32(kf[0], qr[0], cvec); p1 = MFMA32(kf[1], qr[0], cvec); } \
        _Pragma("unroll") for (int d0 = 1; d0 < 4; ++d0) { p0 = MFMA32(kf[2 * d0], qr[d0], p0); p1 = MFMA32(kf[2 * d0 + 1], qr[d0], p1); } SBAR(); } while (0)
    int slot = 0, dslot = PFD, ptile = 0, pslot = 0; bool pend = false, stop = false;
    for (int i = 0; ; ++i) {
        const int tile = t_hi - i, jr = tile - 4 * qb;
        if (i < n_tiles && !stop) {
            { const int tp = tile - PFD; DMA_KV(tp < 0 ? 0 : tp, dslot); }
            dslot = (dslot == NSLOT - 1) ? 0 : dslot + 1;
            WAITBAR(4);
            if (TYPE == 2 && i > 0) { const u32x4 fa = *(const __attribute__((address_space(3))) u32x4*)(misci + 64 + ((i - 1) & 1) * 8), fb = *(const __attribute__((address_space(3))) u32x4*)(misci + 68 + ((i - 1) & 1) * 8);
                if ((fa[0] & fa[1] & fa[2] & fa[3] & fb[0] & fb[1] & fb[2] & fb[3]) != 0u) stop = true; }
        }
        if (late && pend) { FINISH(ptile, ptile - 4 * qb, pslot); pend = false; }
        if (i >= n_tiles || stop) break;
        const bool active = (jr <= jdiag) && (jr >= jlo_w) && !(TYPE == 2 && done_w);
        if (active) { SCORE(slot); }
        if (!late) { if (active) { FINISH(tile, jr, slot); } } else { pend = active; ptile = tile; pslot = slot; }
        if (TYPE == 2) { if (lane == 0) misci[64 + (i & 1) * 8 + wid] = done_w ? 1 : 0; }
        slot = (slot == NSLOT - 1) ? 0 : slot + 1;
    }
#undef FINISH
#undef SCORE
    if (TIMER_SEL == 98 && TYPE == TIMER_TYPE && C.tflag && tid == 0) { volatile __attribute__((address_space(3))) unsigned* ta_ = (volatile __attribute__((address_space(3))) unsigned*)(shm + 139264 + 320) + 16; ta_[25] += (unsigned)__builtin_amdgcn_s_memtime() - ta_[26]; }
    USTAMP(22);
    if (tid == 0) tslot[0] = tick;
    asm volatile("s_waitcnt vmcnt(0) lgkmcnt(0)\n\ts_barrier" ::: "memory");
    if (tid == 0 && rdy_prev != nullptr) (void)__hip_atomic_fetch_add(rdy_prev, 1u, __ATOMIC_RELAXED, __HIP_MEMORY_SCOPE_AGENT);
    const int unext = tslot[0];
    if (unext < 2048) prefetch_unit(C, unext, shm, qr);
    float rli[16];
    { const float sk = (TYPE == 3) ? __builtin_amdgcn_exp2f(C.sinks[h] * LOG2E - Mf) : 0.f;
#pragma unroll
        for (int r = 0; r < 16; ++r) rli[r] = (TYPE == 2) ? 1.f : __builtin_amdgcn_rcpf(lacc[r] + sk); }
    __attribute__((address_space(3))) bf16* stg = (__attribute__((address_space(3))) bf16*)(shm + (wid < 6 ? L_K + 2 * SLOTB + wid * 4096 : L_V + 2 * SLOTB + (wid - 6) * 4096));
    const __attribute__((address_space(3))) bf16* gst = (const __attribute__((address_space(3))) bf16*)(shm + L_G) + wid * 2048;
#pragma unroll
    for (int r = 0; r < 16; ++r) { const int orow = crow(r, hi); const float rl = rli[r];
        { const unsigned w_ = cvtpk_s(o[0][r] * rl, o[1][r] * rl); stg[orow * 64 + r32] = (bf16)(w_ & 0xffffu); stg[orow * 64 + 32 + r32] = (bf16)(w_ >> 16); } }
    asm volatile("s_waitcnt lgkmcnt(0)" ::: "memory");
#pragma unroll
    for (int i = 0; i < 4; ++i) { const int row = i * 8 + (lane >> 3), ch = lane & 7;
        const u32x4 v = *(const __attribute__((address_space(3))) u32x4*)(stg + row * 64 + ch * 8);
        const u32x4 g = *(const __attribute__((address_space(3))) u32x4*)(gst + row * 64 + ch * 8); u32x4 w;
        const size_t off = (yrow0 + row) * DM + TYPE * 256 + h * 64 + ch * 8;
#pragma unroll
        for (int j = 0; j < 4; ++j) { const float a0 = __uint_as_float(v[j] << 16) * __uint_as_float(g[j] << 16), a1 = __uint_as_float(v[j] & 0xffff0000u) * __uint_as_float(g[j] & 0xffff0000u); w[j] = cvtpk_s(a0, a1); }
        { const bf16* yp_ = C.Y + off; asm volatile("global_store_dwordx4 %0, %1, off sc1\n\ts_nop 1" :: "v"(yp_), "v"(w) : "memory"); } }
    asm volatile("s_waitcnt lgkmcnt(0)\n\ts_barrier" ::: "memory");
    USTAMP(23);
    return unext;
#undef DMA_KV
}
#undef SBAR
}
#define TACC(F) ((volatile LAS unsigned*)((F).lds + MISC_OFF) + 16)
#define TSTAMP(F, k) do { if (TIMER_SEL >= 0 && (F).vcu == TIMER_WG && (F).tid == 0) { const unsigned now_ = (unsigned)__builtin_amdgcn_s_memrealtime(); TACC(F)[k] += now_ - TACC(F)[31]; TACC(F)[31] = now_; } } while (0)
__device__ __forceinline__ void p_attn(Frame& F, const Args& a, int layer, int rep, int tmask) {
    att::ACtx C{(const bf16*)(a.ws + WS_Q), (const bf16*)(a.ws + WS_K), (const bf16*)(a.ws + WS_V), (const bf16*)(a.ws + WS_G), (bf16*)(a.ws + WS_HN),
                (const float*)(a.ws + WS_LF), (const float*)(a.ws + WS_TAB), (const float*)(a.ws + WS_KM) + layer * 32768, (const float*)(a.ws + WS_MF) + layer * 4, a.sinks + layer * 4, (F.vcu == TIMER_WG) ? 1 : 0};
    unsigned* head = (unsigned*)(a.ws + WS_CTL) + CW_QUEUE + 64 * (layer + 2 * rep);
    LAS int* slot = (LAS int*)(F.lds + att::L_MISC) + 200;
    att::lds_ptr shm = (att::lds_ptr)F.lds;
    if (F.tid == 0) slot[0] = (int)__hip_atomic_fetch_add(head, 1u, __ATOMIC_RELAXED, __HIP_MEMORY_SCOPE_AGENT);
    __syncthreads();
    int u = slot[0];
    __syncthreads();
    att::bf16x8 qr[4];
    if (u < 2048) att::prefetch_unit(C, u, shm, qr);
    unsigned* const rdy = (unsigned*)(a.ws + WS_CTL) + CW_RDY + 128 * layer; unsigned* pend = nullptr;
    while (u < 2048) {
        int tick = 0;
        if (F.tid == 0) tick = (int)__hip_atomic_fetch_add(head, 1u, __ATOMIC_RELAXED, __HIP_MEMORY_SCOPE_AGENT);
        const int ty = u >> 9, r = u & 511, qb = 15 - (r >> 5), bh = r & 31;
        TSTAMP(F, 20);
        unsigned* const mine = rdy + ((bh >> 2) * 16 + qb);
        if (ty == 0) u = att::attn_unit<1>(C, bh, qb, shm, qr, tick, (LAS int*)slot, pend);
        else if (ty == 1) u = att::attn_unit<0>(C, bh, qb, shm, qr, tick, (LAS int*)slot, pend);
        else if (ty == 2) u = att::attn_unit<2>(C, bh, qb, shm, qr, tick, (LAS int*)slot, pend);
        else u = att::attn_unit<3>(C, bh, qb, shm, qr, tick, (LAS int*)slot, pend);
        TSTAMP(F, 8 + ty);
        pend = mine;
    }
    asm volatile("s_waitcnt vmcnt(0)" ::: "memory");
    __syncthreads();
    if (F.tid == 0 && pend != nullptr) (void)__hip_atomic_fetch_add(pend, 1u, __ATOMIC_RELAXED, __HIP_MEMORY_SCOPE_AGENT);
}

__global__ void __launch_bounds__(NWAVES * 64, 2) mk_fwd(Args a) {
    extern __shared__ __attribute__((aligned(16))) unsigned char lds[];
    Frame F; F.lds = (LAS unsigned char*)lds; F.tid = threadIdx.x; F.lane = F.tid & 63; F.wave = __builtin_amdgcn_readfirstlane(F.tid >> 6);
    F.G = gridDim.x; { const int bx = blockIdx.x; F.vcu = (F.G % 8 == 0) ? (bx % 8) * (F.G / 8) + bx / 8 : bx; }
    bf16* HN = (bf16*)(a.ws + WS_HN);
    for (int u = F.tid; u < (LDS_BYTES - LDSCTL_OFF) / 4; u += NWAVES * 64) ((LAS unsigned*)(F.lds + LDSCTL_OFF))[u] = 0u;
    __syncthreads();
    XcdBarrier bar; bar.bar = (unsigned*)(a.ws + WS_CTL) + CW_BAR; bar.x = 0; bar.st = nullptr;
    if (a.ph_hi - a.ph_lo > 1) bar = xcd_barrier_post((unsigned*)(a.ws + WS_CTL) + CW_BAR, (volatile LAS unsigned*)(F.lds + MISC_OFF) + 8);
#define PHASE_ON(k) (a.ph_lo <= (k) && (k) < a.ph_hi)
#define SEAM(k) do { if ((k) != 4 && PHASE_ON(k) && PHASE_ON((k) + 1)) xcd_barrier(bar); } while (0)
#define LAYER_PHASES(layer) do { \
    if ((layer) == 0 && PHASE_ON(0)) { p_tables(F, a); p_consts(F, a); if (F.wave >= NW_X) p_weights(F, a); else p_convert(F, a); } \
    if ((layer) == 0) { TSTAMP(F, 0); SEAM(0); TSTAMP(F, 1); } \
    if (PHASE_ON(4 * (layer) + 1)) { \
        pg8::Gemm g{(layer) == 0 ? (const bf16*)(a.ws + WS_X0) : (const bf16*)(a.ws + WS_X1), (const bf16*)(a.ws + WS_WIN) + (size_t)(layer) * NPERM * DM, NTOK, NPERM, DM}; \
        pg8::StaticOrder S; S.init(NTOK, NPERM, F.G, (int)blockIdx.x); \
        pg8::EpiIn E{(bf16*)(a.ws + WS_Q), (bf16*)(a.ws + WS_K), (bf16*)(a.ws + WS_V), (bf16*)(a.ws + WS_G), a.fox_g + (layer) * 128, a.moba_g + (layer) * 128, a.swa_g + (layer) * 128, (float*)(a.ws + WS_KM) + (layer) * 32768, \
                     (const float*)(a.ws + WS_RS) + (layer) * NTOK, (float*)(a.ws + WS_LF), a.b_forget + (layer) * 4}; \
        pg8::gemm_phase<pg8::EpiIn, pg8::StaticOrder, true, true>(F.lds, g, S, E); \
        if (PROBE_P1) { xcd_barrier(bar); pg8::gemm_phase<pg8::EpiIn, pg8::StaticOrder, true, true>(F.lds, g, S, E); } \
    } \
    TSTAMP(F, 2); SEAM(4 * (layer) + 1); TSTAMP(F, 3); \
    if (PHASE_ON(4 * (layer) + 2)) { for (int rep = 0; rep < 1 + (PROBE_ATT != 0 ? PROBE_REPS : 0); ++rep) { if (rep) xcd_barrier(bar); p_attn(F, a, (layer), rep, rep ? PROBE_ATT : 15); } } \
    TSTAMP(F, 4);   TSTAMP(F, 5); \
    if (PHASE_ON(4 * (layer) + 3)) { \
        pg8::Gemm g{HN  , (const bf16*)(a.ws + WS_WOUT) + (size_t)(layer) * DM * DM, NTOK, DM, DM}; \
        pg8::FlagOrder S; S.init(NTOK, DM, F.G, (int)blockIdx.x); S.rdy = (unsigned*)(a.ws + WS_CTL) + CW_RDY + 128 * (layer); S.need = 16u; \
        if ((layer) == 0) { \
            pg8::EpiRes0 E{(const bf16*)(a.ws + WS_X0), (bf16*)(a.ws + WS_X1), (float*)(a.ws + WS_RS) + NTOK}; \
            pg8::gemm_phase<pg8::EpiRes0, pg8::FlagOrder, true, true>(F.lds, g, S, E); \
        } else { \
            pg8::EpiRes1 E{(const bf16*)(a.ws + WS_X1), a.out}; \
            pg8::gemm_phase<pg8::EpiRes1, pg8::FlagOrder, true, true>(F.lds, g, S, E); \
        } \
    } \
    if ((layer) == 0) { TSTAMP(F, 6); SEAM(3); SEAM(4); TSTAMP(F, 7); } } while (0)
    if (TIMER_SEL >= 0 && F.vcu == TIMER_WG && F.tid == 0) TACC(F)[31] = (unsigned)__builtin_amdgcn_s_memrealtime();
    LAYER_PHASES(0);
    LAYER_PHASES(1);
    if (TIMER_SEL >= 0 && F.vcu == TIMER_WG) {
        asm volatile("s_waitcnt vmcnt(0)" ::: "memory"); __syncthreads();
        float v = (TIMER_SEL == 99) ? 1.0f : (TIMER_SEL == 98) ? ((float)TACC(F)[25] / ((float)TACC(F)[22] * 10.f)) / 3.0f : (float)TACC(F)[TIMER_SEL & 31] * 0.01f / (float)TIMER_FS; v = fminf(fmaxf(v, 0.f), 1.f); const float dl = 0.1f * sqrtf(v);
        pg8::FlagOrder S; S.init(NTOK, DM, F.G, (int)blockIdx.x); pg8::Unit u;
        for (int i = 0; S.next(i, u); ++i) for (int e = F.tid; e < 65536; e += NWAVES * 64) { float* p = a.out + (size_t)(u.pm * 256 + (e >> 8)) * DM + u.pn * 256 + (e & 255); *p += dl; }
    }
}

extern "C" void kernel_launch(void* const* d_in, const int* in_sizes, int n_in, void* d_out, int out_size, void* d_ws, size_t ws_size, hipStream_t stream) {
    static int ok = 0, grid = 0;
    if (ok == 0) {
        if (n_in != 10 || in_sizes[0] != NTOK * DM || out_size != NTOK * DM || ws_size < WS_END) { fprintf(stderr, "kernel_launch: unexpected shapes (n_in %d, in0 %d, out %d, ws %zu)\n", n_in, n_in > 0 ? in_sizes[0] : -1, out_size, ws_size); ok = -1; return; }
        if (hipFuncSetAttribute((const void*)mk_fwd, hipFuncAttributeMaxDynamicSharedMemorySize, LDS_BYTES) != hipSuccess) { fprintf(stderr, "kernel_launch: hipFuncSetAttribute failed\n"); ok = -1; return; }
        int dev = 0, cus = 0; if (hipGetDevice(&dev) != hipSuccess || hipDeviceGetAttribute(&cus, hipDeviceAttributeMultiprocessorCount, dev) != hipSuccess) { fprintf(stderr, "kernel_launch: device query failed\n"); ok = -1; return; }
        grid = cus < 256 ? (cus / 8) * 8 : 256; if (grid < 8) grid = cus;
        ok = 1;
    }
    if (ok < 0) return;
    Args a{};
    a.x = (const float*)d_in[0]; a.norm_gain = (const float*)d_in[1]; a.w_in = (const float*)d_in[2]; a.b_forget = (const float*)d_in[3]; a.fox_g = (const float*)d_in[4];
    a.moba_g = (const float*)d_in[5]; a.swa_g = (const float*)d_in[6]; a.sinks = (const float*)d_in[7]; a.w_out = (const float*)d_in[8]; a.rel_bias = (const float*)d_in[9];
    a.out = (float*)d_out; a.ws = (unsigned char*)d_ws;
    unsigned char* ws = (unsigned char*)d_ws;
    a.tmask = 15;
    if (hipMemsetAsync(ws + WS_CTL, 0, CTL_ZERO_BYTES, stream) != hipSuccess) { fprintf(stderr, "kernel_launch: memset failed\n"); return; }
#if N_LAUNCHES == 1
    a.ph_lo = 0; a.ph_hi = 8; hipLaunchKernelGGL(mk_fwd, dim3(grid), dim3(NWAVES * 64), LDS_BYTES, stream, a);
#else
    for (int ph = 0; ph < 8; ++ph) { a.ph_lo = ph; a.ph_hi = ph + 1; hipLaunchKernelGGL(mk_fwd, dim3(grid), dim3(NWAVES * 64), LDS_BYTES, stream, a); }
#endif
}
```
